# Optimizing an MI355X kernel written in HIP

```python
import jax
import jax.numpy as jnp
from jax import lax
import numpy as np

D_MODEL = 1024
BATCH = 2
SEQ = 8192
DEPTH = 1

N_META = 16
EPS = 1e-6

ATT_HEADS = 8
ATT_HEAD_DIM = 64
ATT_WIDTH = ATT_HEADS * ATT_HEAD_DIM
Q_BLOCK = 128

HGRN_HEADS = 8
HGRN_K = 128
HGRN_V = 128
HGRN_KEY_WIDTH = HGRN_HEADS * HGRN_K
HGRN_WIDTH = HGRN_HEADS * HGRN_V
HGRN_CHUNK = 64

N_GROUPS = 4
EXPERTS_PER_GROUP = 8
N_EXPERTS = N_GROUPS * EXPERTS_PER_GROUP
TOP_K = 2
EXPERT_FF = 512
MOE_BLOCK = 128

IN_SIZES = (ATT_WIDTH, ATT_WIDTH, ATT_WIDTH, ATT_HEADS, HGRN_KEY_WIDTH, HGRN_KEY_WIDTH, HGRN_WIDTH, HGRN_WIDTH, D_MODEL, D_MODEL)
IN_WIDTH = sum(IN_SIZES)

kernel_name = 'hybrid_fox_hgrn2_hier_moe_block'


def split_points(sizes):
    pts, acc = [], 0
    for s in sizes[:-1]:
        acc += s
        pts.append(acc)
    return pts


def rms_norm(x, w):
    xf = x.astype(jnp.float32)
    y = xf * lax.rsqrt(jnp.mean(xf * xf, axis=-1, keepdims=True) + EPS)
    return (y * w.astype(jnp.float32)).astype(x.dtype)


def forgetting_attention(q, k, v, log_f):
    B, L, H, Dh = q.shape
    scale = Dh ** -0.5
    c = jnp.cumsum(log_f, axis=1)
    c_k = jnp.transpose(c, (0, 2, 1))

    def attend(q_blk, c_q, q_pos, k_blk, v_blk, c_kb, k_pos):
        s = jnp.einsum('bqhd,bkhd->bhqk', q_blk, k_blk).astype(jnp.float32) * scale
        s = s + jnp.transpose(c_q, (0, 2, 1))[..., :, None] - c_kb[:, :, None, :]
        mask = k_pos[None, :] <= q_pos[:, None]
        s = jnp.where(mask[None, None], s, -jnp.inf)
        p = jax.nn.softmax(s, axis=-1).astype(v_blk.dtype)
        return jnp.einsum('bhqk,bkhd->bqhd', p, v_blk)

    meta_pos = jnp.arange(N_META)
    o_meta = attend(q[:, :N_META], c[:, :N_META], meta_pos, k[:, :N_META], v[:, :N_META], c_k[:, :, :N_META], meta_pos)

    n_blk = (L - N_META) // Q_BLOCK
    k_pos = jnp.arange(L)

    def real_block(i):
        start = N_META + i * Q_BLOCK
        q_blk = lax.dynamic_slice_in_dim(q, start, Q_BLOCK, axis=1)
        c_q = lax.dynamic_slice_in_dim(c, start, Q_BLOCK, axis=1)
        q_pos = start + jnp.arange(Q_BLOCK)
        return attend(q_blk, c_q, q_pos, k, v, c_k, k_pos)

    o_real = lax.map(real_block, jnp.arange(n_blk))
    o_real = jnp.moveaxis(o_real, 0, 1).reshape(B, n_blk * Q_BLOCK, H, Dh)
    return jnp.concatenate([o_meta, o_real], axis=1)


def hgrn2_chunk(state, chunk):
    q, log_f, k, v = chunk
    C = q.shape[1]
    b = jnp.cumsum(log_f, axis=1)
    o_inter = jnp.einsum('bchk,bhkv->bchv', q * jnp.exp(b), state)
    causal = jnp.tril(jnp.ones((C, C), dtype=bool))
    diff = b[:, :, None] - b[:, None, :]
    decay = jnp.exp(jnp.where(causal[None, :, :, None, None], diff, -jnp.inf))
    scores = jnp.sum(q[:, :, None] * k[:, None] * decay, axis=-1)
    o_intra = jnp.einsum('btsh,bshv->bthv', scores, v)
    b_last = b[:, -1]
    k_dec = k * jnp.exp(b_last[:, None] - b)
    new_state = jnp.exp(b_last)[..., None] * state + jnp.einsum('bshk,bshv->bhkv', k_dec, v)
    return new_state, o_inter + o_intra


def hgrn2_recurrence(q, log_f, k, v):
    B, L, H, K = q.shape
    V = v.shape[-1]
    state0 = jnp.zeros((B, H, K, V), jnp.float32)
    state1, o_meta = hgrn2_chunk(state0, (q[:, :N_META], log_f[:, :N_META], k[:, :N_META], v[:, :N_META]))
    n_chunks = (L - N_META) // HGRN_CHUNK

    def to_chunks(a):
        return jnp.moveaxis(a[:, N_META:].reshape(B, n_chunks, HGRN_CHUNK, H, a.shape[-1]), 1, 0)

    _, o_real = lax.scan(hgrn2_chunk, state1, (to_chunks(q), to_chunks(log_f), to_chunks(k), to_chunks(v)))
    o_real = jnp.moveaxis(o_real, 0, 1).reshape(B, L - N_META, H, V)
    return jnp.concatenate([o_meta, o_real], axis=1)


def hierarchical_moe(v2d, w_rg, b_rg, w_re, b_re, w_e_in, w_e_out):
    T, D = v2d.shape
    dtype = v2d.dtype
    vf = v2d.astype(jnp.float32)
    g_logits = vf @ w_rg.astype(jnp.float32) + b_rg.astype(jnp.float32)
    g_prob = jax.nn.softmax(g_logits, axis=-1)
    g_idx = jnp.argmax(g_logits, axis=-1)
    p_g = jnp.take_along_axis(g_prob, g_idx[:, None], axis=1)[:, 0]
    e_logits = (vf @ w_re.astype(jnp.float32) + b_re.astype(jnp.float32)).reshape(T, N_GROUPS, EXPERTS_PER_GROUP)
    e_sel = jnp.take_along_axis(e_logits, g_idx[:, None, None], axis=1)[:, 0]
    top_v, top_i = lax.top_k(e_sel, TOP_K)
    gate = jax.nn.softmax(top_v, axis=-1) * p_g[:, None]
    expert_id = (g_idx[:, None] * EXPERTS_PER_GROUP + top_i).astype(jnp.int32)

    A = T * TOP_K
    eid = expert_id.reshape(-1)
    tok = jnp.repeat(jnp.arange(T, dtype=jnp.int32), TOP_K)
    wt = gate.reshape(-1)
    order = jnp.argsort(eid)
    se, st, sw = eid[order], tok[order], wt[order]
    counts = jnp.bincount(eid, length=N_EXPERTS).astype(jnp.int32)
    starts = jnp.cumsum(counts) - counts
    pcounts = (counts + MOE_BLOCK - 1) // MOE_BLOCK * MOE_BLOCK
    pends = jnp.cumsum(pcounts)
    pstarts = pends - pcounts
    dest = pstarts[se] + jnp.arange(A, dtype=jnp.int32) - starts[se]
    n_blocks = -(-A // MOE_BLOCK) + N_EXPERTS
    rows_tok = jnp.full((n_blocks * MOE_BLOCK,), T, jnp.int32).at[dest].set(st)
    rows_w = jnp.zeros((n_blocks * MOE_BLOCK,), jnp.float32).at[dest].set(sw)
    blk_exp = jnp.clip(jnp.searchsorted(pends, jnp.arange(n_blocks, dtype=jnp.int32) * MOE_BLOCK, side='right'), 0, N_EXPERTS - 1)
    v_pad = jnp.concatenate([v2d, jnp.zeros((1, D), dtype)], axis=0)

    def run(args):
        tok_b, e = args
        xb = v_pad[tok_b]
        hu = xb @ w_e_in[e]
        a, u = jnp.split(hu, 2, axis=-1)
        return (jax.nn.silu(a) * u) @ w_e_out[e]

    ys = lax.map(run, (rows_tok.reshape(n_blocks, MOE_BLOCK), blk_exp)).reshape(-1, D)
    ys = ys * rows_w[:, None].astype(ys.dtype)
    out = jnp.zeros((T + 1, D), ys.dtype).at[rows_tok].add(ys)
    return out[:T].astype(dtype)


def setup_inputs(seed: int = 0) -> dict:
    key = jax.random.key(seed)
    ks = jax.random.split(key, 18)
    n = jax.random.normal
    f32 = jnp.float32
    return {
        'x': n(ks[0], (BATCH, SEQ, D_MODEL), f32),
        'meta_tokens': n(ks[1], (N_META, D_MODEL), f32),
        'norm_mix_w': 1.0 + 0.02 * n(ks[2], (DEPTH, D_MODEL), f32),
        'w_in': n(ks[3], (DEPTH, D_MODEL, IN_WIDTH), f32) * D_MODEL ** -0.5,
        'attn_forget_b': 3.0 + 0.5 * n(ks[4], (DEPTH, ATT_HEADS), f32),
        'hgrn_lb_logits': 0.1 * n(ks[5], (DEPTH + 1, HGRN_KEY_WIDTH), f32),
        'hgrn_norm_w': 1.0 + 0.02 * n(ks[6], (DEPTH, HGRN_V), f32),
        'w_attn_out': n(ks[7], (DEPTH, ATT_WIDTH, D_MODEL), f32) * ATT_WIDTH ** -0.5,
        'w_hgrn_out': n(ks[8], (DEPTH, HGRN_WIDTH, D_MODEL), f32) * HGRN_WIDTH ** -0.5,
        'w_o': n(ks[9], (DEPTH, D_MODEL, D_MODEL), f32) * D_MODEL ** -0.5,
        'norm_ffn_w': 1.0 + 0.02 * n(ks[10], (DEPTH, D_MODEL), f32),
        'w_router_group': n(ks[11], (DEPTH, D_MODEL, N_GROUPS), f32) * D_MODEL ** -0.5,
        'b_router_group': 0.01 * n(ks[12], (DEPTH, N_GROUPS), f32),
        'w_router_expert': n(ks[13], (DEPTH, D_MODEL, N_EXPERTS), f32) * D_MODEL ** -0.5,
        'b_router_expert': 0.01 * n(ks[14], (DEPTH, N_EXPERTS), f32),
        'w_expert_in': n(ks[15], (DEPTH, N_EXPERTS, D_MODEL, 2 * EXPERT_FF), f32) * D_MODEL ** -0.5,
        'w_expert_out': n(ks[16], (DEPTH, N_EXPERTS, EXPERT_FF, D_MODEL), f32) * EXPERT_FF ** -0.5,
        'norm_final_w': 1.0 + 0.02 * n(ks[17], (D_MODEL,), f32),
    }


def reference(x, meta_tokens, norm_mix_w, w_in, attn_forget_b, hgrn_lb_logits, hgrn_norm_w, w_attn_out, w_hgrn_out, w_o, norm_ffn_w, w_router_group, b_router_group, w_router_expert, b_router_expert, w_expert_in, w_expert_out, norm_final_w):
    B, S, D = x.shape
    L = S + N_META
    meta = jnp.broadcast_to(meta_tokens.astype(x.dtype)[None], (B, N_META, D))
    h = jnp.concatenate([meta, x], axis=1)
    lb_all = jnp.cumsum(jax.nn.softmax(hgrn_lb_logits.astype(jnp.float32), axis=0), axis=0)
    for layer in range(DEPTH):
        u = rms_norm(h, norm_mix_w[layer])
        proj = u @ w_in[layer]
        q_a, k_a, v_a, f_a, q_h, f_h, i_h, g_h, gate_a, gate_h = jnp.split(proj, split_points(IN_SIZES), axis=-1)

        log_f_a = jax.nn.log_sigmoid(f_a.astype(jnp.float32) + attn_forget_b[layer].astype(jnp.float32))
        att_shape = (B, L, ATT_HEADS, ATT_HEAD_DIM)
        o_a = forgetting_attention(q_a.reshape(att_shape), k_a.reshape(att_shape), v_a.reshape(att_shape), log_f_a)
        y_a = o_a.reshape(B, L, ATT_WIDTH) @ w_attn_out[layer]

        lb = lb_all[layer]
        f_val = lb + (1.0 - lb) * jax.nn.sigmoid(f_h.astype(jnp.float32))
        key_shape = (B, L, HGRN_HEADS, HGRN_K)
        log_f_h = jnp.log(f_val).reshape(key_shape)
        k_h = (1.0 - f_val).reshape(key_shape)
        q_hr = q_h.astype(jnp.float32).reshape(key_shape) * HGRN_K ** -0.5
        v_h = i_h.astype(jnp.float32).reshape(B, L, HGRN_HEADS, HGRN_V)
        o_h = hgrn2_recurrence(q_hr, log_f_h, k_h, v_h)
        o_h = rms_norm(o_h, hgrn_norm_w[layer]) * jax.nn.sigmoid(g_h.astype(jnp.float32)).reshape(B, L, HGRN_HEADS, HGRN_V)
        y_h = o_h.reshape(B, L, HGRN_WIDTH).astype(x.dtype) @ w_hgrn_out[layer]

        mixed = jax.nn.sigmoid(gate_a) * y_a + jax.nn.sigmoid(gate_h) * y_h
        h = h + mixed @ w_o[layer]

        v_in = rms_norm(h, norm_ffn_w[layer]).reshape(B * L, D)
        moe_out = hierarchical_moe(v_in, w_router_group[layer], b_router_group[layer], w_router_expert[layer], b_router_expert[layer], w_expert_in[layer], w_expert_out[layer])
        h = h + moe_out.reshape(B, L, D)
    return rms_norm(h, norm_final_w)[:, N_META:]
```

```cpp
#include <hip/hip_runtime.h>
#include <cstdio>
#include <cstdint>

#ifndef MK_N_LAUNCHES
#define MK_N_LAUNCHES 12
#endif

namespace pg8 {
#define PG8_LAS __attribute__((address_space(3)))
typedef unsigned short bf16_t;
typedef short bf16x8 __attribute__((ext_vector_type(8)));
typedef float f32x4 __attribute__((ext_vector_type(4)));
typedef unsigned u32x4 __attribute__((ext_vector_type(4)));
typedef unsigned u32x2 __attribute__((ext_vector_type(2)));
constexpr int BM = 256, BK = 64, HALF = 128, HTB = HALF * BK * 2  , STAGE_BYTES = 8 * HTB, NXCD = 8, WGM = 8;

__host__ __device__ __forceinline__ int lds_byte(int r, int c) { const int st = (r >> 4) * 2 + (c >> 5), rr = r & 15, cc = c & 31, ob = rr * 64 + cc * 2; return st * 1024 + (ob ^ (((ob >> 9) & 1) << 5)); }
__host__ __device__ __forceinline__ void stage_rc(int b, int& R, int& C) { const int st = b / 1024, sb = b % 1024, swz = sb ^ (((sb >> 9) & 1) << 5); R = (st >> 1) * 16 + swz / 64; C = (st & 1) * 32 + (swz % 64) / 2; }
__host__ __device__ __forceinline__ int perm32(int rho) { const int n = rho >> 4, i = rho & 15; return 8 * (i >> 2) + 4 * n + (i & 3); }

struct Unit { int pm, pn, e; };
struct Gemm { const bf16_t* A; const bf16_t* Bt; int M, N, K; size_t bexp; };

struct StaticOrder {
    int nM, nN, nwg, G, c;
    __host__ __device__ void init(int M, int N, int G_, int c_) { nM = M / BM; nN = N / BM; nwg = nM * nN; G = G_; c = c_; }
    __host__ __device__ bool next(int i, Unit& u) const {
        const long L = (long)i * G + c; if (L >= nwg) return false;
        int wgid = (int)L; { const int q = nwg / NXCD, r = nwg % NXCD, xcd = wgid % NXCD, off = wgid / NXCD; wgid = (xcd < r ? xcd * (q + 1) : r * (q + 1) + (xcd - r) * q) + off; }
        const int nig = WGM * nN, gid = wgid / nig, fm = gid * WGM, gsz = (nM - fm) < WGM ? (nM - fm) : WGM;
        u.pm = fm + ((wgid % nig) % gsz); u.pn = (wgid % nig) / gsz; u.e = 0; return true;
    }
    __device__ __forceinline__ void a_ready(const Unit&) const {}
    __device__ __forceinline__ void done(const Unit&) const {}
};
struct MoeOrder {
    int ntu, G, c; const unsigned* tile_e;
    __device__ bool next(int i, Unit& u) const {
        const long L = (long)i * G + c; if (L >= ntu) return false;
        u.pm = (int)(L >> 2); u.pn = (int)(L & 3);
        u.e = (int)__builtin_amdgcn_readfirstlane(__hip_atomic_load(tile_e + u.pm, __ATOMIC_RELAXED, __HIP_MEMORY_SCOPE_AGENT)); return true;
    }
    __device__ __forceinline__ void a_ready(const Unit&) const {}
    __device__ __forceinline__ void done(const Unit&) const {}
};

__device__ __forceinline__ unsigned cvt_pk_bf16(float lo, float hi) { unsigned r; asm volatile("v_cvt_pk_bf16_f32 %0, %1, %2" : "=v"(r) : "v"(lo), "v"(hi)); return r; }
__device__ __forceinline__ float fsig(float x) { return __builtin_amdgcn_rcpf(1.0f + __builtin_amdgcn_exp2f(-1.4426950408889634f * x)); }
__device__ __forceinline__ float bflo(unsigned w) { return __builtin_bit_cast(float, w << 16); }
__device__ __forceinline__ float bfhi(unsigned w) { return __builtin_bit_cast(float, w & 0xffff0000u); }
__device__ __forceinline__ float dpp_shr(float v, int) { return v; }
#define PG8_SCAN16(v) do { \
    v += __builtin_bit_cast(float, __builtin_amdgcn_update_dpp(0, __builtin_bit_cast(int, v), 0x111, 0xf, 0xf, true)); \
    v += __builtin_bit_cast(float, __builtin_amdgcn_update_dpp(0, __builtin_bit_cast(int, v), 0x112, 0xf, 0xf, true)); \
    v += __builtin_bit_cast(float, __builtin_amdgcn_update_dpp(0, __builtin_bit_cast(int, v), 0x114, 0xf, 0xf, true)); \
    v += __builtin_bit_cast(float, __builtin_amdgcn_update_dpp(0, __builtin_bit_cast(int, v), 0x118, 0xf, 0xf, true)); } while (0)

constexpr float ATT_C2 = 0.125f * 1.4426950408889634f;
constexpr float HG_QS = 0.08838834764831845f;

struct EpiProj {
    static constexpr bool PERM = true, AFTER_DRAIN = false;
    bf16_t *QA, *KA, *VA, *QH, *EB, *KT, *KD, *VH, *GH, *GA, *GT; const float* lbl;
    __device__ __forceinline__ void operator()(const f32x4 (&acc)[2][2][4][2], const Unit& u, int wr, int wc, int fr, int fq) const {
        const int pn = u.pn, b = u.pm >> 5;
        const int cofs = wc * 32 + 8 * fq;
        const int row0 = u.pm * BM + wr * 64 + fr;
        if (pn >= 10 && pn < 14) {
            const int colbase = 256 * (pn - 10), lane = fq * 16 + fr, srcl = (lane & 48) | 15;
#pragma unroll
            for (int ai = 0; ai < 2; ++ai)
#pragma unroll
                for (int bj = 0; bj < 2; ++bj)
#pragma unroll
                    for (int n = 0; n < 2; ++n) {
                        const int c0 = colbase + 128 * bj + cofs + 4 * n;
                        const f32x4 l0 = *(const f32x4*)(lbl + c0), l1 = *(const f32x4*)(lbl + 1024 + c0);
                        float eb[4][4], kt[4][4], kd[4][4];
#pragma unroll
                        for (int e = 0; e < 4; ++e) {
                            const float lb = __builtin_amdgcn_rcpf(1.0f + __builtin_amdgcn_exp2f((l1[e] - l0[e]) * 1.4426950408889634f));
                            float lf[4], kk[4];
#pragma unroll
                            for (int m = 0; m < 4; ++m) { const float f = lb + (1.0f - lb) * fsig(acc[ai][bj][m][n][e]); kk[m] = 1.0f - f; lf[m] = __builtin_amdgcn_logf(f); }
#pragma unroll
                            for (int m = 0; m < 4; ++m) PG8_SCAN16(lf[m]);
                            float run = 0.f, bb[4];
#pragma unroll
                            for (int m = 0; m < 4; ++m) { const float tot = __shfl(lf[m], srcl); bb[m] = lf[m] + run; run += tot; }
#pragma unroll
                            for (int m = 0; m < 4; ++m) { eb[m][e] = __builtin_amdgcn_exp2f(bb[m]); kt[m][e] = kk[m] * __builtin_amdgcn_exp2f(-bb[m]); kd[m][e] = kk[m] * __builtin_amdgcn_exp2f(run - bb[m]); }
                        }
#pragma unroll
                        for (int m = 0; m < 4; ++m) {
                            const size_t r = (size_t)(row0 + ai * HALF + m * 16);
                            u32x2 w;
                            w.x = cvt_pk_bf16(eb[m][0], eb[m][1]); w.y = cvt_pk_bf16(eb[m][2], eb[m][3]); *(u32x2*)(EB + r * 1024 + c0) = w;
                            w.x = cvt_pk_bf16(kt[m][0], kt[m][1]); w.y = cvt_pk_bf16(kt[m][2], kt[m][3]); *(u32x2*)(KT + r * 1024 + c0) = w;
                            w.x = cvt_pk_bf16(kd[m][0], kd[m][1]); w.y = cvt_pk_bf16(kd[m][2], kd[m][3]); *(u32x2*)(KD + (r + 64 * (b + 1)) * 1024 + c0) = w;
                        }
                    }
            return;
        }
        bf16_t* base; int ld = 1024, radd = 0, cb; int mode = 0; float sc = 1.f;
        if (pn < 2) { base = QA; ld = 512; cb = 256 * pn; sc = ATT_C2; }
        else if (pn < 4) { base = KA; ld = 512; cb = 256 * (pn - 2); radd = 128 * (b + 1); }
        else if (pn < 6) { base = VA; ld = 512; cb = 256 * (pn - 4); radd = 128 * (b + 1); }
        else if (pn < 10) { base = QH; cb = 256 * (pn - 6); sc = HG_QS; }
        else if (pn < 18) { base = VH; cb = 256 * (pn - 14); radd = 64 * (b + 1); }
        else if (pn < 22) { base = GH; cb = 256 * (pn - 18); mode = 1; }
        else if (pn < 26) { base = GA; cb = 256 * (pn - 22); mode = 1; }
        else { base = GT; cb = 256 * (pn - 26); mode = 1; }
#pragma unroll
        for (int ai = 0; ai < 2; ++ai)
#pragma unroll
            for (int m = 0; m < 4; ++m) { bf16_t* rowp = base + (size_t)(row0 + ai * HALF + m * 16 + radd) * ld + cb + cofs;
#pragma unroll
                for (int bj = 0; bj < 2; ++bj) { f32x4 v0 = acc[ai][bj][m][0], v1 = acc[ai][bj][m][1];
                    if (mode) {
#pragma unroll
                        for (int e = 0; e < 4; ++e) { v0[e] = fsig(v0[e]); v1[e] = fsig(v1[e]); }
                    } else { v0 = v0 * sc; v1 = v1 * sc; }
                    u32x4 w; w.x = cvt_pk_bf16(v0[0], v0[1]); w.y = cvt_pk_bf16(v0[2], v0[3]); w.z = cvt_pk_bf16(v1[0], v1[1]); w.w = cvt_pk_bf16(v1[2], v1[3]);
                    *(u32x4*)(rowp + bj * HALF) = w; } }
    }
};
struct EpiYa {
    static constexpr bool PERM = true, AFTER_DRAIN = false;
    const bf16_t* G; float* Y;
    __device__ __forceinline__ void operator()(const f32x4 (&acc)[2][2][4][2], const Unit& u, int wr, int wc, int fr, int fq) const {
        const int row0 = u.pm * BM + wr * 64 + fr, col0 = u.pn * BM + wc * 32 + 8 * fq;
#pragma unroll
        for (int ai = 0; ai < 2; ++ai)
#pragma unroll
            for (int m = 0; m < 4; ++m) { const size_t off = (size_t)(row0 + ai * HALF + m * 16) * 1024 + col0;
#pragma unroll
                for (int bj = 0; bj < 2; ++bj) { const u32x4 g = *(const u32x4*)(G + off + bj * HALF);
                    f32x4 v0 = acc[ai][bj][m][0], v1 = acc[ai][bj][m][1];
                    v0[0] *= bflo(g.x); v0[1] *= bfhi(g.x); v0[2] *= bflo(g.y); v0[3] *= bfhi(g.y); v1[0] *= bflo(g.z); v1[1] *= bfhi(g.z); v1[2] *= bflo(g.w); v1[3] *= bfhi(g.w);
                    *(f32x4*)(Y + off + bj * HALF) = v0; *(f32x4*)(Y + off + bj * HALF + 4) = v1; } }
    }
};
struct EpiMixed {
    static constexpr bool PERM = true, AFTER_DRAIN = false;
    const bf16_t* G; const float* Y; bf16_t* O;
    __device__ __forceinline__ void operator()(const f32x4 (&acc)[2][2][4][2], const Unit& u, int wr, int wc, int fr, int fq) const {
        const int row0 = u.pm * BM + wr * 64 + fr, col0 = u.pn * BM + wc * 32 + 8 * fq;
#pragma unroll
        for (int ai = 0; ai < 2; ++ai)
#pragma unroll
            for (int m = 0; m < 4; ++m) { const size_t off = (size_t)(row0 + ai * HALF + m * 16) * 1024 + col0;
#pragma unroll
                for (int bj = 0; bj < 2; ++bj) { const u32x4 g = *(const u32x4*)(G + off + bj * HALF);
                    const f32x4 y0 = *(const f32x4*)(Y + off + bj * HALF), y1 = *(const f32x4*)(Y + off + bj * HALF + 4);
                    f32x4 v0 = acc[ai][bj][m][0], v1 = acc[ai][bj][m][1];
                    v0[0] = y0[0] + v0[0] * bflo(g.x); v0[1] = y0[1] + v0[1] * bfhi(g.x); v0[2] = y0[2] + v0[2] * bflo(g.y); v0[3] = y0[3] + v0[3] * bfhi(g.y);
                    v1[0] = y1[0] + v1[0] * bflo(g.z); v1[1] = y1[1] + v1[1] * bfhi(g.z); v1[2] = y1[2] + v1[2] * bflo(g.w); v1[3] = y1[3] + v1[3] * bfhi(g.w);
                    u32x4 w; w.x = cvt_pk_bf16(v0[0], v0[1]); w.y = cvt_pk_bf16(v0[2], v0[3]); w.z = cvt_pk_bf16(v1[0], v1[1]); w.w = cvt_pk_bf16(v1[2], v1[3]);
                    *(u32x4*)(O + off + bj * HALF) = w; } }
    }
};
struct EpiRes {
    static constexpr bool PERM = true, AFTER_DRAIN = false;
    const float* X; float* O;
    __device__ __forceinline__ void operator()(const f32x4 (&acc)[2][2][4][2], const Unit& u, int wr, int wc, int fr, int fq) const {
        const int row0 = u.pm * BM + wr * 64 + fr, col0 = u.pn * BM + wc * 32 + 8 * fq;
#pragma unroll
        for (int ai = 0; ai < 2; ++ai)
#pragma unroll
            for (int m = 0; m < 4; ++m) { const size_t off = (size_t)(row0 + ai * HALF + m * 16) * 1024 + col0;
#pragma unroll
                for (int bj = 0; bj < 2; ++bj) {
                    const f32x4 x0 = *(const f32x4*)(X + off + bj * HALF), x1 = *(const f32x4*)(X + off + bj * HALF + 4);
                    *(f32x4*)(O + off + bj * HALF) = x0 + acc[ai][bj][m][0]; *(f32x4*)(O + off + bj * HALF + 4) = x1 + acc[ai][bj][m][1]; } }
    }
};
struct EpiSwiglu {
    static constexpr bool PERM = true, AFTER_DRAIN = false;
    bf16_t* O;
    __device__ __forceinline__ void operator()(const f32x4 (&acc)[2][2][4][2], const Unit& u, int wr, int wc, int fr, int fq) const {
        const int row0 = u.pm * BM + wr * 64 + fr, col0 = u.pn * HALF + wc * 32 + 8 * fq;
#pragma unroll
        for (int ai = 0; ai < 2; ++ai)
#pragma unroll
            for (int m = 0; m < 4; ++m) { const size_t off = (size_t)(row0 + ai * HALF + m * 16) * 512 + col0;
                f32x4 v0, v1;
#pragma unroll
                for (int e = 0; e < 4; ++e) { const float a0 = acc[ai][0][m][0][e], a1 = acc[ai][0][m][1][e];
                    v0[e] = a0 * fsig(a0) * acc[ai][1][m][0][e]; v1[e] = a1 * fsig(a1) * acc[ai][1][m][1][e]; }
                u32x4 w; w.x = cvt_pk_bf16(v0[0], v0[1]); w.y = cvt_pk_bf16(v0[2], v0[3]); w.z = cvt_pk_bf16(v1[0], v1[1]); w.w = cvt_pk_bf16(v1[2], v1[3]);
                *(u32x4*)(O + off) = w; }
    }
};
struct EpiPlain {
    static constexpr bool PERM = true, AFTER_DRAIN = false;
    bf16_t* O; int ldc;
    __device__ __forceinline__ void operator()(const f32x4 (&acc)[2][2][4][2], const Unit& u, int wr, int wc, int fr, int fq) const {
        const int row0 = u.pm * BM + wr * 64 + fr, col0 = u.pn * BM + wc * 32 + 8 * fq;
#pragma unroll
        for (int ai = 0; ai < 2; ++ai)
#pragma unroll
            for (int m = 0; m < 4; ++m) { const size_t off = (size_t)(row0 + ai * HALF + m * 16) * ldc + col0;
#pragma unroll
                for (int bj = 0; bj < 2; ++bj) { const f32x4 v0 = acc[ai][bj][m][0], v1 = acc[ai][bj][m][1];
                    u32x4 w; w.x = cvt_pk_bf16(v0[0], v0[1]); w.y = cvt_pk_bf16(v0[2], v0[3]); w.z = cvt_pk_bf16(v1[0], v1[1]); w.w = cvt_pk_bf16(v1[2], v1[3]);
                    *(u32x4*)(O + off + bj * HALF) = w; } }
    }
};

template <class Epi, class Sched, bool ALIGN_EPI = false, bool SP2 = false>
__device__ __forceinline__ void gemm_phase(PG8_LAS unsigned char* lds, const Gemm g, const Sched& S, const Epi& E) {
    const int tid = threadIdx.x, wid = __builtin_amdgcn_readfirstlane(tid >> 6), lane = tid & 63, wr = wid >> 2, wc = wid & 3, fr = lane & 15, fq = lane >> 4;
    const int K = g.K, nt = K / BK;
    unsigned voffA[2], voffB[2];
#pragma unroll
    for (int i = 0; i < 2; ++i) { int R, C; stage_rc(tid * 16 + i * 8192, R, C); const int Rb = Epi::PERM ? ((R & ~31) + perm32(R & 31)) : R;
        voffA[i] = (unsigned)(R * K + C) * 2u; voffB[i] = (unsigned)(Rb * K + C) * 2u; }
    const size_t kstep = (size_t)(BK * 2);
    const size_t hstep = (size_t)HALF * K * 2;
    const size_t tstep = 2 * hstep;
    const unsigned ldsw = (unsigned)wid * 1024u;
    const int aoff = lds_byte(wr * 64 + fr, fq * 8), boff = lds_byte(wc * 32 + fr, fq * 8);
#define PG8_SA(b, h) (((b) * 2 + (h)) * HTB)
#define PG8_SB(b, h) ((4 + (b) * 2 + (h)) * HTB)
#define PG8_STAGE(bufoff, gbase, voff) do { _Pragma("unroll") for (int _i = 0; _i < 2; ++_i) \
        __builtin_amdgcn_global_load_lds((const unsigned*)((const char*)(gbase) + (voff)[_i]), (PG8_LAS unsigned*)(lds + (bufoff) + ldsw + _i * 8192), 16, 0, 0); } while (0)
#define PG8_LDA(dst, b, h) do { _Pragma("unroll") for (int m = 0; m < 4; ++m) _Pragma("unroll") for (int k = 0; k < 2; ++k) dst[m][k] = *(const PG8_LAS bf16x8*)(lds + PG8_SA(b, h) + aoff + m * 2048 + k * 1024); } while (0)
#define PG8_LDB(dst, b, h) do { _Pragma("unroll") for (int n = 0; n < 2; ++n) _Pragma("unroll") for (int k = 0; k < 2; ++k) dst[n][k] = *(const PG8_LAS bf16x8*)(lds + PG8_SB(b, h) + boff + n * 2048 + k * 1024); } while (0)
#define PG8_MMA(ai, bj, At, Bt) do { __builtin_amdgcn_s_setprio(1); _Pragma("unroll") for (int m = 0; m < 4; ++m) _Pragma("unroll") for (int n = 0; n < 2; ++n) _Pragma("unroll") for (int k = 0; k < 2; ++k) \
        acc[ai][bj][m][n] = __builtin_amdgcn_mfma_f32_16x16x32_bf16(Bt[n][k], At[m][k], acc[ai][bj][m][n], 0, 0, 0); __builtin_amdgcn_s_setprio(0); } while (0)
#define PG8_WAIT_V(n) asm volatile("s_waitcnt vmcnt(" #n ")" ::: "memory")
#define PG8_WAIT_L(n) asm volatile("s_waitcnt lgkmcnt(" #n ")" ::: "memory")
#define PG8_BAR __builtin_amdgcn_s_barrier()
#define PG8_SCHED __builtin_amdgcn_sched_barrier(0)
    Unit cur, nxt; int ui = 0;
    if (!S.next(0, cur)) return;
    f32x4 acc[2][2][4][2];
#pragma unroll
    for (int a = 0; a < 2; ++a)
#pragma unroll
        for (int b = 0; b < 2; ++b)
#pragma unroll
            for (int m = 0; m < 4; ++m)
#pragma unroll
                for (int n = 0; n < 2; ++n) acc[a][b][m][n] = (f32x4){0.f, 0.f, 0.f, 0.f};
    bf16x8 At[4][2], B0[2][2], B1[2][2];
    const char* cA = (const char*)g.A + (size_t)cur.pm * tstep; const char* cB = (const char*)g.Bt + (size_t)cur.e * g.bexp + (size_t)cur.pn * tstep;
    S.a_ready(cur);
    if constexpr (SP2) {
        PG8_STAGE(PG8_SB(0, 0), cB, voffB); PG8_STAGE(PG8_SB(0, 1), cB + hstep, voffB); PG8_STAGE(PG8_SA(0, 0), cA, voffA); PG8_STAGE(PG8_SA(0, 1), cA + hstep, voffA);
        if (wr == 1) PG8_BAR;
        PG8_WAIT_V(2); PG8_BAR;
        PG8_STAGE(PG8_SB(1, 0), cB + kstep, voffB); PG8_STAGE(PG8_SA(1, 0), cA + kstep, voffA); PG8_STAGE(PG8_SB(1, 1), cB + hstep + kstep, voffB);
        PG8_WAIT_V(6); PG8_BAR;
    } else {
        PG8_STAGE(PG8_SB(0, 0), cB, voffB); PG8_STAGE(PG8_SA(0, 0), cA, voffA); PG8_STAGE(PG8_SB(0, 1), cB + hstep, voffB); PG8_STAGE(PG8_SA(0, 1), cA + hstep, voffA);
        if (wr == 1) PG8_BAR;
        PG8_WAIT_V(4); PG8_BAR;
        PG8_STAGE(PG8_SB(1, 0), cB + kstep, voffB); PG8_STAGE(PG8_SA(1, 0), cA + kstep, voffA); PG8_STAGE(PG8_SB(1, 1), cB + hstep + kstep, voffB);
        PG8_WAIT_V(6); PG8_BAR;
    }
    for (;;) {
        const bool has_next = S.next(ui + 1, nxt);
        const char* nA = has_next ? (const char*)g.A + (size_t)nxt.pm * tstep : cA; const char* nB = has_next ? (const char*)g.Bt + (size_t)nxt.e * g.bexp + (size_t)nxt.pn * tstep : cB;
        for (int t = 0; t < nt; t += 2) {
            const bool last = (t == nt - 2);
            const char* a1 = cA + (size_t)(t + 1) * kstep;
            const char* a2 = last ? nA : cA + (size_t)(t + 2) * kstep; const char* b2 = last ? nB : cB + (size_t)(t + 2) * kstep;
            const char* a3 = a2 + kstep; const char* b3 = b2 + kstep;
            if (last && has_next) S.a_ready(nxt);
            if constexpr (SP2) {
            PG8_LDB(B0, 0, 0); PG8_LDB(B1, 0, 1); PG8_SCHED; PG8_LDA(At, 0, 0); PG8_STAGE(PG8_SA(1, 1), a1 + hstep, voffA);
            PG8_WAIT_V(8); PG8_WAIT_L(0); PG8_BAR; PG8_MMA(0, 0, At, B0); PG8_MMA(0, 1, At, B1); PG8_BAR; PG8_SCHED;
            PG8_LDA(At, 0, 1); PG8_STAGE(PG8_SB(0, 0), b2, voffB); PG8_STAGE(PG8_SB(0, 1), b2 + hstep, voffB); PG8_STAGE(PG8_SA(0, 0), a2, voffA);
            PG8_WAIT_V(8); PG8_WAIT_L(0); PG8_BAR; PG8_MMA(1, 0, At, B0); PG8_MMA(1, 1, At, B1); PG8_BAR; PG8_SCHED;
            PG8_LDB(B0, 1, 0); PG8_LDB(B1, 1, 1); PG8_SCHED; PG8_LDA(At, 1, 0); PG8_STAGE(PG8_SA(0, 1), a2 + hstep, voffA);
            PG8_WAIT_V(8); PG8_WAIT_L(0); PG8_BAR; PG8_MMA(0, 0, At, B0); PG8_MMA(0, 1, At, B1); PG8_BAR; PG8_SCHED;
            PG8_LDA(At, 1, 1); PG8_STAGE(PG8_SB(1, 0), b3, voffB); PG8_STAGE(PG8_SB(1, 1), b3 + hstep, voffB); PG8_STAGE(PG8_SA(1, 0), a3, voffA);
            PG8_WAIT_V(8); PG8_WAIT_L(0); PG8_BAR; PG8_MMA(1, 0, At, B0); PG8_MMA(1, 1, At, B1); PG8_BAR; PG8_SCHED;
            } else {
            PG8_LDB(B0, 0, 0); PG8_SCHED; PG8_LDA(At, 0, 0); PG8_STAGE(PG8_SA(1, 1), a1 + hstep, voffA);
            PG8_WAIT_L(8); PG8_BAR; PG8_WAIT_L(0); PG8_MMA(0, 0, At, B0); PG8_BAR; PG8_SCHED;
            PG8_LDB(B1, 0, 1); PG8_STAGE(PG8_SB(0, 0), b2, voffB);
            PG8_BAR; PG8_WAIT_L(0); PG8_MMA(0, 1, At, B1); PG8_BAR;
            PG8_LDA(At, 0, 1); PG8_STAGE(PG8_SA(0, 0), a2, voffA);
            PG8_BAR; PG8_WAIT_L(0); PG8_MMA(1, 0, At, B0); PG8_BAR; PG8_SCHED;
            PG8_STAGE(PG8_SB(0, 1), b2 + hstep, voffB);
            PG8_WAIT_V(6); PG8_BAR; PG8_MMA(1, 1, At, B1); PG8_BAR;
            PG8_LDB(B0, 1, 0); PG8_SCHED; PG8_LDA(At, 1, 0); PG8_STAGE(PG8_SA(0, 1), a2 + hstep, voffA);
            PG8_WAIT_L(8); PG8_BAR; PG8_WAIT_L(0); PG8_MMA(0, 0, At, B0); PG8_BAR; PG8_SCHED;
            PG8_LDB(B1, 1, 1); PG8_STAGE(PG8_SB(1, 0), b3, voffB);
            PG8_BAR; PG8_WAIT_L(0); PG8_MMA(0, 1, At, B1); PG8_BAR;
            PG8_LDA(At, 1, 1); PG8_STAGE(PG8_SA(1, 0), a3, voffA);
            PG8_BAR; PG8_WAIT_L(0); PG8_MMA(1, 0, At, B0); PG8_BAR; PG8_SCHED;
            PG8_STAGE(PG8_SB(1, 1), b3 + hstep, voffB);
            PG8_WAIT_V(6); PG8_BAR; PG8_MMA(1, 1, At, B1); PG8_BAR;
            }
        }
        if constexpr (ALIGN_EPI) { if (wr == 0) PG8_BAR; }
        if constexpr (!Epi::AFTER_DRAIN) { E(acc, cur, wr, wc, fr, fq); S.done(cur); }
        if (!has_next) break;
#pragma unroll
        for (int a = 0; a < 2; ++a)
#pragma unroll
            for (int b = 0; b < 2; ++b)
#pragma unroll
                for (int m = 0; m < 4; ++m)
#pragma unroll
                    for (int n = 0; n < 2; ++n) acc[a][b][m][n] = (f32x4){0.f, 0.f, 0.f, 0.f};
        cur = nxt; cA = nA; cB = nB; ++ui;
        if constexpr (ALIGN_EPI) { if (wr == 1) PG8_BAR; }
    }
    PG8_WAIT_V(0);
    if constexpr (!ALIGN_EPI) { if (wr == 0) PG8_BAR; }
    PG8_BAR;
    if constexpr (Epi::AFTER_DRAIN) { E.fused(acc, cur, wr, wc, fr, fq, lds, wid, lane); S.done(cur); }
#undef PG8_SA
#undef PG8_SB
#undef PG8_STAGE
#undef PG8_LDA
#undef PG8_LDB
#undef PG8_MMA
#undef PG8_WAIT_V
#undef PG8_WAIT_L
#undef PG8_BAR
#undef PG8_SCHED
}
}

constexpr int NWAVES = 8;
constexpr int NB = 2, SEQ = 8192, DM = 1024, MR = NB * SEQ;
constexpr int NMETA = 16, INW = 7688, NPROJ = 7680;
constexpr int AH = 8, ADH = 64, AWID = 512, KROWS = SEQ + 128;
constexpr int HH = 8, HK = 128, HV = 128, HROWS = SEQ + 64, NCH = 129;
constexpr int NE = 32, EFF = 512, APAD = 40960;
constexpr float EPS = 1e-6f;
constexpr int N_LAUNCHES = MK_N_LAUNCHES;
constexpr int NPHASE = 12;

constexpr size_t MiB = 1u << 20;
constexpr size_t WS_CTL = 0, CTL_ZERO_BYTES = 1 * MiB;
constexpr size_t WS_WIN = 1 * MiB, WS_WA = 16 * MiB, WS_WH = 17 * MiB, WS_WO = 19 * MiB;
constexpr size_t WS_LFA = 21 * MiB, WS_LFAM = WS_LFA + 512 * 1024, WS_CL = 22 * MiB, WS_ASG = 23 * MiB, WS_GATE = WS_ASG + 128 * 1024, WS_SLOT = WS_GATE + 128 * 1024, WS_GSORT = 24 * MiB;
constexpr size_t WS_U = 26 * MiB;
constexpr size_t WS_OA = 26 * MiB;
constexpr size_t WS_QA = 58 * MiB, WS_KA = 74 * MiB, WS_VA = 90 * MiB + 512 * 1024;
constexpr size_t WS_QH = 107 * MiB, WS_EB = 139 * MiB, WS_KT = 171 * MiB, WS_KD = 203 * MiB, WS_VH = 235 * MiB + 512 * 1024;
constexpr size_t WS_GH = 268 * MiB, WS_GA = 300 * MiB, WS_GT = 332 * MiB;
constexpr size_t WS_US = 364 * MiB;
constexpr size_t WS_OH = 429 * MiB;
constexpr size_t WS_YA = 107 * MiB;
constexpr size_t WS_MIX = 171 * MiB;
constexpr size_t WS_XN = 26 * MiB, WS_WE1 = 58 * MiB, WS_WE2 = 122 * MiB, WS_XS = 154 * MiB, WS_ACT = 234 * MiB, WS_Y = 274 * MiB;
constexpr size_t WS_END = 461 * MiB;
static_assert(WS_KA + (size_t)2 * KROWS * AWID * 2 <= WS_VA && WS_VA + (size_t)2 * KROWS * AWID * 2 <= WS_QH && WS_KD + (size_t)2 * HROWS * DM * 2 <= WS_VH && WS_VH + (size_t)2 * HROWS * DM * 2 <= WS_GH, "ws map");
static_assert(WS_US + (size_t)16 * NCH * HK * HV * 2 <= WS_OH && WS_OH + (size_t)MR * DM * 2 <= WS_END && WS_Y + (size_t)APAD * DM * 2 <= WS_END && WS_XS + (size_t)APAD * DM * 2 <= WS_ACT && WS_ACT + (size_t)APAD * EFF * 2 <= WS_Y, "ws map 2");
constexpr int CW_TMO = 0, CW_CODE = 1;
constexpr int CW_CNT = 1024;
constexpr int CW_NT = 2048;
constexpr int CW_TILEE = 2112;
constexpr int CW_BAR = 4096;

constexpr int RING_OFF = 0, RING_BYTES = 131072;
constexpr int LDSCTL_OFF = RING_BYTES, MISC_OFF = LDSCTL_OFF + 320;
constexpr int LDS_BYTES = 147456;

#define GAS __attribute__((address_space(1)))
#define LAS __attribute__((address_space(3)))
typedef unsigned short bf16;
typedef unsigned v4u __attribute__((ext_vector_type(4)));
typedef unsigned v2u __attribute__((ext_vector_type(2)));
typedef float f32x4 __attribute__((ext_vector_type(4)));
typedef short bf16x8 __attribute__((ext_vector_type(8)));
typedef GAS unsigned gu32;
typedef GAS unsigned long long gu64;
#define RLX_AGENT __ATOMIC_RELAXED, __HIP_MEMORY_SCOPE_AGENT
#define LDS_WAIT() asm volatile("s_waitcnt lgkmcnt(0)" ::: "memory")
#define VM_WAIT() asm volatile("s_waitcnt vmcnt(0)" ::: "memory")
__device__ __forceinline__ unsigned f2bf(float f) { unsigned u = __builtin_bit_cast(unsigned, f); return (u + 0x7fffu + ((u >> 16) & 1u)) >> 16; }
__device__ __forceinline__ unsigned pk2(float lo, float hi) { return f2bf(lo) | (f2bf(hi) << 16); }
__device__ __forceinline__ float bf2f(unsigned short h) { return __builtin_bit_cast(float, (unsigned)h << 16); }
__device__ __forceinline__ float blo(unsigned w) { return __builtin_bit_cast(float, w << 16); }
__device__ __forceinline__ float bhi(unsigned w) { return __builtin_bit_cast(float, w & 0xffff0000u); }
__device__ __forceinline__ float ex2(float x) { return __builtin_amdgcn_exp2f(x); }
__device__ __forceinline__ float sigm(float x) { return __builtin_amdgcn_rcpf(1.0f + ex2(-1.4426950408889634f * x)); }
__device__ __forceinline__ unsigned ald(const unsigned* p) { return __hip_atomic_load(p, __ATOMIC_RELAXED, __HIP_MEMORY_SCOPE_AGENT); }
__device__ __forceinline__ float aldf(const float* p) { return __builtin_bit_cast(float, __hip_atomic_load((const unsigned*)p, __ATOMIC_RELAXED, __HIP_MEMORY_SCOPE_AGENT)); }
__device__ __forceinline__ float log_sigmoid(float z) { const float a = fabsf(z); return fminf(z, 0.f) - __logf(1.0f + __expf(-a)); }

#define XB_TMO      128
#define XB_XCNT(j)  (256  + 64 * (j))
#define XB_XSUB(j)  (1280 + 64 * (j))
#define XB_XGEN(j)  (2304 + 64 * (j))
#define XB_TOP      3328
#define XB_TOPGEN   3392
#define XCD_BAR_WORDS 3456
#define XB_SPIN_CAP (1u << 18)

__device__ __forceinline__ unsigned xb_ld(unsigned* p)              { return __hip_atomic_load(p, __ATOMIC_RELAXED, __HIP_MEMORY_SCOPE_AGENT); }
__device__ __forceinline__ unsigned xb_add(unsigned* p, unsigned v) { return __hip_atomic_fetch_add(p, v, __ATOMIC_RELAXED, __HIP_MEMORY_SCOPE_AGENT); }
__device__ __forceinline__ unsigned xb_xcc_id() { return (unsigned)__builtin_amdgcn_s_getreg((3 << 11) | 20) & 0xFu; }
#define XB_SPIN(cond, bar) do { unsigned _sp = 0; while (cond) { __builtin_amdgcn_s_sleep(1); \
    if ((++_sp & 255u) == 0u) { if (xb_ld(&(bar)[XB_TMO])) break; if (_sp > XB_SPIN_CAP) { atomicAdd(&(bar)[XB_TMO], 1u); break; } } } } while (0)

struct XcdBarrier {
    unsigned* bar; unsigned x;
    volatile LAS unsigned* st;
};

__device__ __forceinline__ XcdBarrier xcd_barrier_post(unsigned* bar, volatile LAS unsigned* st) {
    XcdBarrier b; b.bar = bar; b.x = xb_xcc_id(); b.st = st;
    if (threadIdx.x == 0) (void)xb_add(&bar[XB_XCNT(b.x)], 1u);
    return b;
}
__device__ __forceinline__ void xcd_barrier_complete(unsigned* bar, unsigned x, unsigned& nloc, unsigned& nx) {
    const unsigned G = gridDim.x * gridDim.y * gridDim.z;
    unsigned sum, cnt, mine, sp = 0u;
    for (;;) {
        sum = 0u; cnt = 0u; mine = 0u;
#pragma unroll
        for (unsigned j = 0; j < 16; ++j) { const unsigned c = xb_ld(&bar[XB_XCNT(j)]); sum += c; cnt += (c > 0u) ? 1u : 0u; mine = (j == x) ? c : mine; }
        if (sum == G) break;
        __builtin_amdgcn_s_sleep(1);
        if ((++sp & 255u) == 0u) { if (xb_ld(&bar[XB_TMO])) break; if (sp > XB_SPIN_CAP) { atomicAdd(&bar[XB_TMO], 1u); break; } }
    }
    nloc = mine > 0u ? mine : 1u; nx = cnt > 0u ? cnt : 1u;
}

__device__ __forceinline__ void xcd_barrier(const XcdBarrier& b) {
    asm volatile("s_waitcnt vmcnt(0)" ::: "memory");
    __syncthreads();
    if (threadIdx.x == 0) {
        unsigned* bar = b.bar;
        __builtin_amdgcn_s_waitcnt(0);
        unsigned nloc = b.st[0], nx = b.st[1];
        if (nloc == 0u) { xcd_barrier_complete(bar, b.x, nloc, nx); b.st[0] = nloc; b.st[1] = nx; }
        const unsigned old = xb_add(&bar[XB_XSUB(b.x)], 1u);
        const unsigned gen = old / nloc;
        if (old + 1u == (gen + 1u) * nloc) {
            __builtin_amdgcn_fence(__ATOMIC_RELEASE, "agent");
            asm volatile("s_waitcnt vmcnt(0)" ::: "memory");
            const unsigned og = xb_add(&bar[XB_TOP], 1u);
            const unsigned tg = og / nx;
            if (og + 1u == (tg + 1u) * nx) xb_add(&bar[XB_TOPGEN], 1u);
            else XB_SPIN(xb_ld(&bar[XB_TOPGEN]) == tg, bar);
            __builtin_amdgcn_fence(__ATOMIC_ACQUIRE, "agent");
            xb_add(&bar[XB_XGEN(b.x)], 1u);
            asm volatile("s_waitcnt vmcnt(0)" ::: "memory");
        } else {
            XB_SPIN(xb_ld(&bar[XB_XGEN(b.x)]) == gen, bar);
            __builtin_amdgcn_fence(__ATOMIC_ACQUIRE, "agent");
            asm volatile("s_waitcnt vmcnt(0)" ::: "memory");
        }
    }
    __syncthreads();
}
struct Frame {
    LAS unsigned char* lds;
    volatile LAS unsigned* MISC;
    gu32* ctl;
    unsigned char* ws;
    int tid, lane, wave;
    int vcu, G;
    const float* in[18];
    float* out;
};
__device__ __forceinline__ float wave_sum(float v) {
#pragma unroll
    for (int o = 1; o < 64; o <<= 1) v += __shfl_xor(v, o);
    return v;
}

__device__ __forceinline__ void p0_transpose_item(const float* W, int ldw, int K, int ncols, bf16* WT, int mode, int row_off, LAS float* scr, int item, int lane) {
    const int nblk = ncols / 32, kb = item / nblk, nb = item % nblk, k0 = 64 * kb, n0 = 32 * nb;
    int d0 = row_off + n0;
    if (mode == 1) { d0 = (n0 < 512) ? (256 * (n0 >> 7) + (n0 & 127)) : (256 * ((n0 - 512) >> 7) + 128 + ((n0 - 512) & 127)); }
#pragma unroll 8
    for (int i = 0; i < 32; ++i) { const int kk = 2 * i + (lane >> 5); scr[kk * 33 + (lane & 31)] = W[(size_t)(k0 + kk) * ldw + n0 + (lane & 31)]; }
    LDS_WAIT(); asm volatile("" ::: "memory");
    const int c = lane & 7;
#pragma unroll
    for (int j = 0; j < 4; ++j) { const int n = (lane >> 3) + 8 * j; const LAS float* s = scr + (8 * c) * 33 + n;
        v4u o; o.x = pk2(s[0 * 33], s[1 * 33]); o.y = pk2(s[2 * 33], s[3 * 33]); o.z = pk2(s[4 * 33], s[5 * 33]); o.w = pk2(s[6 * 33], s[7 * 33]);
        *(GAS v4u*)(WT + (size_t)(d0 + n) * K + k0 + 8 * c) = o; }
    LDS_WAIT(); asm volatile("" ::: "memory");
}

__device__ __forceinline__ void p0_meta(Frame& F) {
    const float* meta = F.in[1]; const float* nw = F.in[2]; const float* Win = F.in[3];
    LAS float* um = (LAS float*)(F.lds + RING_OFF);
#pragma unroll
    for (int rr = 0; rr < 2; ++rr) {
        const int r = 2 * F.wave + rr;
        f32x4 v[4]; float ss = 0.f;
#pragma unroll
        for (int j = 0; j < 4; ++j) { v[j] = *(const f32x4*)(meta + (size_t)r * DM + 4 * F.lane + 256 * j); ss += (v[j].x * v[j].x + v[j].y * v[j].y) + (v[j].z * v[j].z + v[j].w * v[j].w); }
        const float rs = 1.0f / sqrtf(wave_sum(ss) * (1.0f / DM) + EPS);
#pragma unroll
        for (int j = 0; j < 4; ++j) { const f32x4 w = *(const f32x4*)(nw + 4 * F.lane + 256 * j); const int k = 4 * F.lane + 256 * j;
            um[(k + 0) * 16 + r] = v[j].x * rs * w.x; um[(k + 1) * 16 + r] = v[j].y * rs * w.y; um[(k + 2) * 16 + r] = v[j].z * rs * w.z; um[(k + 3) * 16 + r] = v[j].w * rs * w.w; }
    }
    __syncthreads();
    const int item = F.vcu * NWAVES + F.wave;
    if (item < 49) {
        int type, strip;
        if (item < 8) { type = 0; strip = item; } else if (item < 16) { type = 1; strip = item - 8; } else if (item < 32) { type = 2; strip = item - 16; } else if (item < 48) { type = 3; strip = item - 32; } else { type = 4; strip = 0; }
        int col;
        if (type == 0) col = 512 + 64 * strip + F.lane; else if (type == 1) col = 1024 + 64 * strip + F.lane; else if (type == 2) col = 2568 + 64 * strip + F.lane;
        else if (type == 3) col = 3592 + 64 * strip + F.lane; else col = 1536 + (F.lane & 7);
        float acc[16];
#pragma unroll
        for (int r = 0; r < 16; ++r) acc[r] = 0.f;
#pragma unroll 4
        for (int k = 0; k < DM; ++k) {
            const float w = Win[(size_t)k * INW + col];
            const LAS f32x4* up = (const LAS f32x4*)(um + k * 16);
            const f32x4 u0 = up[0], u1 = up[1], u2 = up[2], u3 = up[3];
            acc[0] += w * u0.x; acc[1] += w * u0.y; acc[2] += w * u0.z; acc[3] += w * u0.w;
            acc[4] += w * u1.x; acc[5] += w * u1.y; acc[6] += w * u1.z; acc[7] += w * u1.w;
            acc[8] += w * u2.x; acc[9] += w * u2.y; acc[10] += w * u2.z; acc[11] += w * u2.w;
            acc[12] += w * u3.x; acc[13] += w * u3.y; acc[14] += w * u3.z; acc[15] += w * u3.w;
        }
        const int c = 64 * strip + F.lane;
        if (type == 0 || type == 1) {
            bf16* dst = (bf16*)(F.ws + (type == 0 ? WS_KA : WS_VA));
#pragma unroll
            for (int b = 0; b < 2; ++b) {
#pragma unroll
                for (int r = 0; r < 16; ++r) dst[((size_t)b * KROWS + r) * AWID + c] = (bf16)f2bf(acc[r]);
                for (int r = 16; r < 128; ++r) dst[((size_t)b * KROWS + r) * AWID + c] = (bf16)0;
            }
        } else if (type == 3) {
            bf16* dst = (bf16*)(F.ws + WS_VH);
#pragma unroll
            for (int b = 0; b < 2; ++b) {
                for (int r = 0; r < 48; ++r) dst[((size_t)b * HROWS + r) * DM + c] = (bf16)0;
#pragma unroll
                for (int r = 0; r < 16; ++r) dst[((size_t)b * HROWS + 48 + r) * DM + c] = (bf16)f2bf(acc[r]);
            }
        } else if (type == 2) {
            const float* lbl = F.in[5];
            const float lb = 1.0f / (1.0f + __expf(lbl[1024 + c] - lbl[c]));
            float kk[16], bb[16]; float run = 0.f;
#pragma unroll
            for (int r = 0; r < 16; ++r) { const float f = lb + (1.0f - lb) * (1.0f / (1.0f + __expf(-acc[r]))); kk[r] = 1.0f - f; run += __logf(f); bb[r] = run; }
            bf16* dst = (bf16*)(F.ws + WS_KD);
#pragma unroll
            for (int b = 0; b < 2; ++b) {
                for (int r = 0; r < 48; ++r) dst[((size_t)b * HROWS + r) * DM + c] = (bf16)0;
#pragma unroll
                for (int r = 0; r < 16; ++r) dst[((size_t)b * HROWS + 48 + r) * DM + c] = (bf16)f2bf(kk[r] * __expf(run - bb[r]));
            }
        } else {
            if (F.lane < 8) { float* lfam = (float*)(F.ws + WS_LFAM); const float bias = F.in[4][F.lane];
#pragma unroll
                for (int r = 0; r < 16; ++r) lfam[r * 8 + F.lane] = log_sigmoid(acc[r] + bias); }
        }
    }
    __syncthreads();
}

__device__ __forceinline__ void p0_rows(Frame& F) {
    const float* x = F.in[0]; const float* nw = F.in[2]; const float* Win = F.in[3]; const float* afb = F.in[4];
    LAS float* wfa = (LAS float*)(F.lds + RING_OFF);
    for (int i = F.tid; i < 8 * DM; i += NWAVES * 64) { const int k = i >> 3, h = i & 7; wfa[h * DM + k] = nw[k] * Win[(size_t)k * INW + 1536 + h]; }
    __syncthreads();
    const int gw = F.vcu * NWAVES + F.wave, NGW = F.G * NWAVES;
    f32x4 wv[4];
#pragma unroll
    for (int j = 0; j < 4; ++j) wv[j] = *(const f32x4*)(nw + 4 * F.lane + 256 * j);
    bf16* U = (bf16*)(F.ws + WS_U); float* lfa = (float*)(F.ws + WS_LFA);
    for (int m = gw; m < MR; m += NGW) {
        f32x4 v[4]; float ss = 0.f;
#pragma unroll
        for (int j = 0; j < 4; ++j) { v[j] = *(const f32x4*)(x + (size_t)m * DM + 4 * F.lane + 256 * j); ss += (v[j].x * v[j].x + v[j].y * v[j].y) + (v[j].z * v[j].z + v[j].w * v[j].w); }
        const float rs = 1.0f / sqrtf(wave_sum(ss) * (1.0f / DM) + EPS);
        GAS unsigned long long* o8 = (GAS unsigned long long*)(U + (size_t)m * DM) + F.lane;
#pragma unroll
        for (int j = 0; j < 4; ++j) { const f32x4 u = v[j] * rs * wv[j]; o8[64 * j] = (unsigned long long)pk2(u.x, u.y) | ((unsigned long long)pk2(u.z, u.w) << 32); }
        float z[8];
#pragma unroll
        for (int h = 0; h < 8; ++h) { float s = 0.f;
#pragma unroll
            for (int j = 0; j < 4; ++j) { const f32x4 w = *(const LAS f32x4*)(wfa + h * DM + 4 * F.lane + 256 * j); s += (v[j].x * w.x + v[j].y * w.y) + (v[j].z * w.z + v[j].w * w.w); }
            z[h] = wave_sum(s); }
        float zz = z[0];
#pragma unroll
        for (int h = 1; h < 8; ++h) zz = (F.lane == h) ? z[h] : zz;
        if (F.lane < 8) lfa[(size_t)m * 8 + F.lane] = log_sigmoid(zz * rs + afb[F.lane]);
    }
    __syncthreads();
}

__device__ __forceinline__ void p0_weights(Frame& F) {
    LAS float* scr = (LAS float*)(F.lds + RING_OFF + F.wave * 16384);
    const int gw = F.vcu * NWAVES + F.wave, NGW = F.G * NWAVES;
    constexpr int I1 = 16 * 48, I2 = 16 * 192, IA = 8 * 32, IH = 16 * 32, IO = 16 * 32;
    constexpr int NIT = I1 + I2 + IA + IH + IO;
    bf16* win = (bf16*)(F.ws + WS_WIN);
    for (int it = gw; it < NIT; it += NGW) {
        int r = it;
        if (r < I1) { p0_transpose_item(F.in[3], INW, DM, 1536, win, 0, 0, scr, r, F.lane); continue; } r -= I1;
        if (r < I2) { p0_transpose_item(F.in[3] + 1544, INW, DM, 6144, win, 0, 1536, scr, r, F.lane); continue; } r -= I2;
        if (r < IA) { p0_transpose_item(F.in[7], DM, AWID, DM, (bf16*)(F.ws + WS_WA), 0, 0, scr, r, F.lane); continue; } r -= IA;
        if (r < IH) { p0_transpose_item(F.in[8], DM, DM, DM, (bf16*)(F.ws + WS_WH), 0, 0, scr, r, F.lane); continue; } r -= IH;
        p0_transpose_item(F.in[9], DM, DM, DM, (bf16*)(F.ws + WS_WO), 0, 0, scr, r, F.lane);
    }
}
__device__ __forceinline__ void p7_expert_weights(Frame& F) {
    LAS float* scr = (LAS float*)(F.lds + RING_OFF + F.wave * 16384);
    const int gw = F.vcu * NWAVES + F.wave, NGW = F.G * NWAVES;
    constexpr int I1 = 16 * 32, I2 = 8 * 32;
    for (int it = gw; it < NE * (I1 + I2); it += NGW) {
        const int e = it / (I1 + I2); int r = it % (I1 + I2);
        if (r < I1) p0_transpose_item(F.in[15] + (size_t)e * DM * DM, DM, DM, DM, (bf16*)(F.ws + WS_WE1) + (size_t)e * DM * DM, 1, 0, scr, r, F.lane);
        else p0_transpose_item(F.in[16] + (size_t)e * EFF * DM, DM, EFF, DM, (bf16*)(F.ws + WS_WE2) + (size_t)e * DM * EFF, 0, 0, scr, r - I1, F.lane);
    }
}

__device__ __forceinline__ void p1_cumsum(Frame& F, int bh) {
    const int b = bh >> 3, h = bh & 7;
    const float* lfa = (const float*)(F.ws + WS_LFA); const float* lfam = (const float*)(F.ws + WS_LFAM); float* cl = (float*)(F.ws + WS_CL) + (size_t)bh * KROWS;
    LAS float* wtot = (LAS float*)(F.lds + RING_OFF);
    float cm = 0.f;
    for (int r = 0; r < 16; ++r) { cm += lfam[r * 8 + h]; if (F.tid == r) cl[r] = cm * 1.4426950408889634f; }
    if (F.tid >= 16 && F.tid < 128) cl[F.tid] = 1e30f;
    float loc[16]; float run = 0.f;
#pragma unroll
    for (int i = 0; i < 16; ++i) { run += lfa[((size_t)b * SEQ + 16 * F.tid + i) * 8 + h]; loc[i] = run; }
    float inc = run;
#pragma unroll
    for (int o = 1; o < 64; o <<= 1) { const float t = __shfl_up(inc, o); if (F.lane >= o) inc += t; }
    if (F.lane == 63) wtot[F.wave] = inc;
    __syncthreads();
    float pre = cm + (inc - run);
    for (int w = 0; w < F.wave; ++w) pre += wtot[w];
#pragma unroll
    for (int i = 0; i < 16; ++i) cl[128 + 16 * F.tid + i] = (pre + loc[i]) * 1.4426950408889634f;
    __syncthreads();
}

__device__ __forceinline__ void attn_simple_unit(Frame& F, int bh, int qb) {
    const int tid = F.tid, row = tid & 255, p = tid >> 8, b = bh >> 3, h = bh & 7;
    const bf16* QA = (const bf16*)(F.ws + WS_QA); const bf16* KA = (const bf16*)(F.ws + WS_KA); const bf16* VA = (const bf16*)(F.ws + WS_VA);
    const float* CL = (const float*)(F.ws + WS_CL) + (size_t)bh * KROWS; bf16* OA = (bf16*)(F.ws + WS_OA);
    LAS bf16* Ks = (LAS bf16*)(F.lds + RING_OFF); LAS bf16* Vs = (LAS bf16*)(F.lds + RING_OFF + 8192);
    LAS float* cks = (LAS float*)(F.lds + RING_OFF + 16384); LAS float* cmb = (LAS float*)(F.lds + RING_OFF + 16640);
    float q[64], o[64];
    const size_t qrow = (size_t)b * SEQ + 256 * qb + row;
#pragma unroll
    for (int c = 0; c < 8; ++c) { const v4u w = *(const v4u*)(QA + qrow * AWID + h * 64 + 8 * c);
        q[8 * c + 0] = blo(w.x); q[8 * c + 1] = bhi(w.x); q[8 * c + 2] = blo(w.y); q[8 * c + 3] = bhi(w.y); q[8 * c + 4] = blo(w.z); q[8 * c + 5] = bhi(w.z); q[8 * c + 6] = blo(w.w); q[8 * c + 7] = bhi(w.w); }
#pragma unroll
    for (int d = 0; d < 64; ++d) o[d] = 0.f;
    const int qp = 128 + 256 * qb + row; const float clq = CL[qp];
    float mx = -1e30f, l = 0.f;
    const int NT = 4 * qb + 6;
    for (int t = 0; t < NT; ++t) {
        if (t == 1) continue;
        __syncthreads();
        { const int r = tid >> 3, ch = tid & 7; const size_t g = ((size_t)b * KROWS + 64 * t + r) * AWID + h * 64 + ch * 8;
          *(LAS v4u*)(Ks + r * 64 + ch * 8) = *(const v4u*)(KA + g); *(LAS v4u*)(Vs + r * 64 + ch * 8) = *(const v4u*)(VA + g);
          if (tid < 64) cks[tid] = CL[64 * t + tid]; }
        __syncthreads();
        const int smax = (t == 0) ? 16 : 64;
        for (int s = p; s < smax; s += 2) {
            const int kp = 64 * t + s;
            if (t >= 2 && kp > qp) continue;
            float dot = 0.f;
#pragma unroll
            for (int c = 0; c < 8; ++c) { const v4u w = *(const LAS v4u*)(Ks + s * 64 + 8 * c);
                dot += q[8 * c + 0] * blo(w.x) + q[8 * c + 1] * bhi(w.x) + q[8 * c + 2] * blo(w.y) + q[8 * c + 3] * bhi(w.y) + q[8 * c + 4] * blo(w.z) + q[8 * c + 5] * bhi(w.z) + q[8 * c + 6] * blo(w.w) + q[8 * c + 7] * bhi(w.w); }
            const float sc = dot + (clq - cks[s]);
            const float mn = fmaxf(mx, sc), al = ex2(mx - mn), pp = ex2(sc - mn);
            l = l * al + pp; mx = mn;
#pragma unroll
            for (int c = 0; c < 8; ++c) { const v4u w = *(const LAS v4u*)(Vs + s * 64 + 8 * c);
                o[8 * c + 0] = o[8 * c + 0] * al + pp * blo(w.x); o[8 * c + 1] = o[8 * c + 1] * al + pp * bhi(w.x); o[8 * c + 2] = o[8 * c + 2] * al + pp * blo(w.y); o[8 * c + 3] = o[8 * c + 3] * al + pp * bhi(w.y);
                o[8 * c + 4] = o[8 * c + 4] * al + pp * blo(w.z); o[8 * c + 5] = o[8 * c + 5] * al + pp * bhi(w.z); o[8 * c + 6] = o[8 * c + 6] * al + pp * blo(w.w); o[8 * c + 7] = o[8 * c + 7] * al + pp * bhi(w.w); }
        }
    }
    __syncthreads();
    if (p == 1) { cmb[row * 66 + 0] = mx; cmb[row * 66 + 1] = l;
#pragma unroll
        for (int d = 0; d < 64; ++d) cmb[row * 66 + 2 + d] = o[d]; }
    __syncthreads();
    if (p == 0) { const float m1 = cmb[row * 66 + 0], l1 = cmb[row * 66 + 1]; const float mn = fmaxf(mx, m1), a0 = ex2(mx - mn), a1 = ex2(m1 - mn); const float inv = 1.0f / (l * a0 + l1 * a1);
#pragma unroll
        for (int c = 0; c < 8; ++c) { float r8[8];
#pragma unroll
            for (int e = 0; e < 8; ++e) r8[e] = (o[8 * c + e] * a0 + cmb[row * 66 + 2 + 8 * c + e] * a1) * inv;
            v4u w; w.x = pk2(r8[0], r8[1]); w.y = pk2(r8[2], r8[3]); w.z = pk2(r8[4], r8[5]); w.w = pk2(r8[6], r8[7]);
            *(v4u*)(OA + qrow * AWID + h * 64 + 8 * c) = w; } }
    __syncthreads();
}

__device__ __forceinline__ void hgrn_a_simple(Frame& F, int item) {
    const int bh = item / NCH, c = item % NCH, b = bh >> 3, h = bh & 7, tid = F.tid;
    const bf16* KD = (const bf16*)(F.ws + WS_KD); const bf16* VH = (const bf16*)(F.ws + WS_VH); bf16* US = (bf16*)(F.ws + WS_US);
    LAS float* KDs = (LAS float*)(F.lds + RING_OFF); LAS float* Vs = KDs + 8192;
    __syncthreads();
    { const int r = tid >> 3, cc = (tid & 7) * 16; const size_t g = ((size_t)b * HROWS + 64 * c + r) * DM + h * 128 + cc;
#pragma unroll
      for (int q2 = 0; q2 < 2; ++q2) { const v4u a = *(const v4u*)(KD + g + 8 * q2), v = *(const v4u*)(VH + g + 8 * q2); LAS float* kd = KDs + r * 128 + cc + 8 * q2; LAS float* vs = Vs + r * 128 + cc + 8 * q2;
          kd[0] = blo(a.x); kd[1] = bhi(a.x); kd[2] = blo(a.y); kd[3] = bhi(a.y); kd[4] = blo(a.z); kd[5] = bhi(a.z); kd[6] = blo(a.w); kd[7] = bhi(a.w);
          vs[0] = blo(v.x); vs[1] = bhi(v.x); vs[2] = blo(v.y); vs[3] = bhi(v.y); vs[4] = blo(v.z); vs[5] = bhi(v.z); vs[6] = blo(v.w); vs[7] = bhi(v.w); } }
    __syncthreads();
    const int k = tid >> 2, vg = (tid & 3) * 32;
    float acc[32];
#pragma unroll
    for (int j = 0; j < 32; ++j) acc[j] = 0.f;
    for (int s = 0; s < 64; ++s) { const float kd = KDs[s * 128 + k];
#pragma unroll
        for (int j4 = 0; j4 < 8; ++j4) { const f32x4 v = *(const LAS f32x4*)(Vs + s * 128 + vg + 4 * j4); acc[4 * j4 + 0] += kd * v.x; acc[4 * j4 + 1] += kd * v.y; acc[4 * j4 + 2] += kd * v.z; acc[4 * j4 + 3] += kd * v.w; } }
    bf16* dst = US + (size_t)item * (HK * HV) + k * 128 + vg;
#pragma unroll
    for (int j8 = 0; j8 < 4; ++j8) { v4u w; w.x = pk2(acc[8 * j8 + 0], acc[8 * j8 + 1]); w.y = pk2(acc[8 * j8 + 2], acc[8 * j8 + 3]); w.z = pk2(acc[8 * j8 + 4], acc[8 * j8 + 5]); w.w = pk2(acc[8 * j8 + 6], acc[8 * j8 + 7]); *(v4u*)(dst + 8 * j8) = w; }
}
__device__ __forceinline__ void hgrn_scan(Frame& F) {
    const bf16* EB = (const bf16*)(F.ws + WS_EB); bf16* US = (bf16*)(F.ws + WS_US);
    for (int idx = blockIdx.x * (NWAVES * 64) + F.tid; idx < 16 * 128 * 64; idx += F.G * NWAVES * 64) {
        const int bh = idx >> 13, rem = idx & 8191, k = rem >> 6, vp = rem & 63, b = bh >> 3, h = bh & 7;
        unsigned* base = (unsigned*)(US + (size_t)bh * NCH * (HK * HV) + k * 128) + vp;
        unsigned w = base[0]; float s0 = blo(w), s1 = bhi(w);
        for (int c = 1; c < NCH - 1; ++c) {
            const float a = bf2f(EB[((size_t)b * SEQ + 64 * (c - 1) + 63) * DM + h * 128 + k]);
            const unsigned uw = base[(size_t)c * (HK * HV / 2)];
            s0 = a * s0 + blo(uw); s1 = a * s1 + bhi(uw);
            base[(size_t)c * (HK * HV / 2)] = pk2(s0, s1);
        }
    }
}
__device__ __forceinline__ void hgrn_c_simple(Frame& F, int item) {
    const int bh = item >> 7, c = (item & 127) + 1, b = bh >> 3, h = bh & 7, tid = F.tid;
    const bf16* QH = (const bf16*)(F.ws + WS_QH); const bf16* EB = (const bf16*)(F.ws + WS_EB); const bf16* KT = (const bf16*)(F.ws + WS_KT); const bf16* VH = (const bf16*)(F.ws + WS_VH);
    const bf16* GH = (const bf16*)(F.ws + WS_GH); const bf16* US = (const bf16*)(F.ws + WS_US); bf16* OH = (bf16*)(F.ws + WS_OH); const float* hnw = F.in[6];
    LAS float* QE = (LAS float*)(F.lds + RING_OFF); LAS float* KTs = QE + 8192; LAS bf16* Ss = (LAS bf16*)(F.lds + RING_OFF + 65536); LAS bf16* Vs = (LAS bf16*)(F.lds + RING_OFF + 98304); LAS float* SC = (LAS float*)(F.lds + RING_OFF + 114688);
    const size_t r0 = (size_t)b * SEQ + 64 * (c - 1);
    __syncthreads();
    { const int r = tid >> 3, cc = (tid & 7) * 16; const size_t g = (r0 + r) * DM + h * 128 + cc; const size_t gv = ((size_t)b * HROWS + 64 * c + r) * DM + h * 128 + cc;
#pragma unroll
      for (int q2 = 0; q2 < 2; ++q2) { const v4u a = *(const v4u*)(QH + g + 8 * q2), e = *(const v4u*)(EB + g + 8 * q2), kt = *(const v4u*)(KT + g + 8 * q2);
          LAS float* qe = QE + r * 128 + cc + 8 * q2; LAS float* ks = KTs + r * 128 + cc + 8 * q2;
          qe[0] = blo(a.x) * blo(e.x); qe[1] = bhi(a.x) * bhi(e.x); qe[2] = blo(a.y) * blo(e.y); qe[3] = bhi(a.y) * bhi(e.y); qe[4] = blo(a.z) * blo(e.z); qe[5] = bhi(a.z) * bhi(e.z); qe[6] = blo(a.w) * blo(e.w); qe[7] = bhi(a.w) * bhi(e.w);
          ks[0] = blo(kt.x); ks[1] = bhi(kt.x); ks[2] = blo(kt.y); ks[3] = bhi(kt.y); ks[4] = blo(kt.z); ks[5] = bhi(kt.z); ks[6] = blo(kt.w); ks[7] = bhi(kt.w);
          *(LAS v4u*)(Vs + r * 128 + cc + 8 * q2) = *(const v4u*)(VH + gv + 8 * q2); }
      const bf16* sp = US + ((size_t)bh * NCH + (c - 1)) * (HK * HV);
#pragma unroll
      for (int i = 0; i < 4; ++i) *(LAS v4u*)(Ss + (tid + 512 * i) * 8) = *(const v4u*)(sp + (tid + 512 * i) * 8); }
    __syncthreads();
    const int t = tid >> 3, g8 = tid & 7;
#pragma unroll
    for (int j = 0; j < 8; ++j) { const int s = g8 * 8 + j; float d = 0.f;
        if (s <= t) { for (int k = 0; k < 128; k += 4) { const f32x4 a = *(const LAS f32x4*)(QE + t * 128 + k), kb = *(const LAS f32x4*)(KTs + s * 128 + k); d += (a.x * kb.x + a.y * kb.y) + (a.z * kb.z + a.w * kb.w); } }
        SC[t * 64 + s] = d; }
    __syncthreads();
    const int v0 = g8 * 16;
    float o[16];
#pragma unroll
    for (int j = 0; j < 16; ++j) o[j] = 0.f;
    for (int s = 0; s <= t; ++s) { const float sc = SC[t * 64 + s]; const v4u w0 = *(const LAS v4u*)(Vs + s * 128 + v0), w1 = *(const LAS v4u*)(Vs + s * 128 + v0 + 8);
        o[0] += sc * blo(w0.x); o[1] += sc * bhi(w0.x); o[2] += sc * blo(w0.y); o[3] += sc * bhi(w0.y); o[4] += sc * blo(w0.z); o[5] += sc * bhi(w0.z); o[6] += sc * blo(w0.w); o[7] += sc * bhi(w0.w);
        o[8] += sc * blo(w1.x); o[9] += sc * bhi(w1.x); o[10] += sc * blo(w1.y); o[11] += sc * bhi(w1.y); o[12] += sc * blo(w1.z); o[13] += sc * bhi(w1.z); o[14] += sc * blo(w1.w); o[15] += sc * bhi(w1.w); }
    for (int k = 0; k < 128; ++k) { const float qe = QE[t * 128 + k]; const v4u w0 = *(const LAS v4u*)(Ss + k * 128 + v0), w1 = *(const LAS v4u*)(Ss + k * 128 + v0 + 8);
        o[0] += qe * blo(w0.x); o[1] += qe * bhi(w0.x); o[2] += qe * blo(w0.y); o[3] += qe * bhi(w0.y); o[4] += qe * blo(w0.z); o[5] += qe * bhi(w0.z); o[6] += qe * blo(w0.w); o[7] += qe * bhi(w0.w);
        o[8] += qe * blo(w1.x); o[9] += qe * bhi(w1.x); o[10] += qe * blo(w1.y); o[11] += qe * bhi(w1.y); o[12] += qe * blo(w1.z); o[13] += qe * bhi(w1.z); o[14] += qe * blo(w1.w); o[15] += qe * bhi(w1.w); }
    float ss = 0.f;
#pragma unroll
    for (int j = 0; j < 16; ++j) ss += o[j] * o[j];
    ss += __shfl_xor(ss, 1); ss += __shfl_xor(ss, 2); ss += __shfl_xor(ss, 4);
    const float rs = 1.0f / sqrtf(ss * (1.0f / HV) + EPS);
    const size_t go = (r0 + t) * DM + h * 128 + v0;
    const v4u g0 = *(const v4u*)(GH + go), g1 = *(const v4u*)(GH + go + 8);
    float gg[16] = {blo(g0.x), bhi(g0.x), blo(g0.y), bhi(g0.y), blo(g0.z), bhi(g0.z), blo(g0.w), bhi(g0.w), blo(g1.x), bhi(g1.x), blo(g1.y), bhi(g1.y), blo(g1.z), bhi(g1.z), blo(g1.w), bhi(g1.w)};
    float y[16];
#pragma unroll
    for (int j = 0; j < 16; ++j) y[j] = o[j] * rs * hnw[v0 + j] * gg[j];
    v4u w; w.x = pk2(y[0], y[1]); w.y = pk2(y[2], y[3]); w.z = pk2(y[4], y[5]); w.w = pk2(y[6], y[7]); *(v4u*)(OH + go) = w;
    w.x = pk2(y[8], y[9]); w.y = pk2(y[10], y[11]); w.z = pk2(y[12], y[13]); w.w = pk2(y[14], y[15]); *(v4u*)(OH + go + 8) = w;
}

__device__ __forceinline__ void p7_router(Frame& F) {
    const float* h1 = F.out; const float* nfw = F.in[10]; const float* wrg = F.in[11]; const float* brg = F.in[12]; const float* wre = F.in[13]; const float* bre = F.in[14];
    bf16* XN = (bf16*)(F.ws + WS_XN); unsigned* ASG = (unsigned*)(F.ws + WS_ASG); float* GATE = (float*)(F.ws + WS_GATE);
    LAS float* T = (LAS float*)(F.lds + RING_OFF);
    for (int rb = F.vcu; rb < MR / 32; rb += F.G) {
        const int rowb = rb * 32 + F.wave * 4;
        float acc[4][36]; float ss[4];
#pragma unroll
        for (int r = 0; r < 4; ++r) { ss[r] = 0.f;
#pragma unroll
            for (int j = 0; j < 36; ++j) acc[r][j] = 0.f; }
        for (int q = 0; q < 4; ++q) {
            __syncthreads();
            for (int i = F.tid; i < 36 * 256; i += NWAVES * 64) { const int kk = i / 36, j = i % 36, k = 256 * q + kk;
                T[j * 256 + kk] = nfw[k] * (j < 4 ? wrg[k * 4 + j] : wre[k * 32 + (j - 4)]); }
            __syncthreads();
            f32x4 x[4];
#pragma unroll
            for (int r = 0; r < 4; ++r) { x[r] = *(const f32x4*)(h1 + (size_t)(rowb + r) * DM + 256 * q + 4 * F.lane); ss[r] += (x[r].x * x[r].x + x[r].y * x[r].y) + (x[r].z * x[r].z + x[r].w * x[r].w); }
#pragma unroll
            for (int j = 0; j < 36; ++j) { const f32x4 w = *(const LAS f32x4*)(T + j * 256 + 4 * F.lane);
#pragma unroll
                for (int r = 0; r < 4; ++r) acc[r][j] += (x[r].x * w.x + x[r].y * w.y) + (x[r].z * w.z + x[r].w * w.w); }
        }
#pragma unroll
        for (int r = 0; r < 4; ++r) {
            const int row = rowb + r;
            const float rs = 1.0f / sqrtf(wave_sum(ss[r]) * (1.0f / DM) + EPS);
            float lg[36];
#pragma unroll
            for (int j = 0; j < 36; ++j) lg[j] = wave_sum(acc[r][j]) * rs + (j < 4 ? brg[j] : bre[j - 4]);
            { GAS unsigned long long* o8 = (GAS unsigned long long*)(XN + (size_t)row * DM) + F.lane;
#pragma unroll
              for (int j = 0; j < 4; ++j) { const f32x4 v = *(const f32x4*)(h1 + (size_t)row * DM + 4 * F.lane + 256 * j); const f32x4 w = *(const f32x4*)(nfw + 4 * F.lane + 256 * j); const f32x4 u = v * rs * w;
                  o8[64 * j] = (unsigned long long)pk2(u.x, u.y) | ((unsigned long long)pk2(u.z, u.w) << 32); } }
            int g = 0; float gm = lg[0];
#pragma unroll
            for (int j = 1; j < 4; ++j) if (lg[j] > gm) { gm = lg[j]; g = j; }
            float gs = 0.f;
#pragma unroll
            for (int j = 0; j < 4; ++j) gs += __expf(lg[j] - gm);
            const float pg = 1.0f / gs;
            float es[8];
#pragma unroll
            for (int i = 0; i < 8; ++i) es[i] = (g == 0) ? lg[4 + i] : (g == 1) ? lg[12 + i] : (g == 2) ? lg[20 + i] : lg[28 + i];
            int i1 = 0; float v1 = es[0];
#pragma unroll
            for (int i = 1; i < 8; ++i) if (es[i] > v1) { v1 = es[i]; i1 = i; }
            int i2 = -1; float v2 = -3.0e38f;
#pragma unroll
            for (int i = 0; i < 8; ++i) if (i != i1 && es[i] > v2) { v2 = es[i]; i2 = i; }
            const float s1 = 1.0f / (1.0f + __expf(v2 - v1));
            if (F.lane == 0) {
                const unsigned e1 = (unsigned)(g * 8 + i1), e2 = (unsigned)(g * 8 + i2);
                const unsigned p1 = __hip_atomic_fetch_add((unsigned*)(F.ctl + CW_CNT + e1), 1u, RLX_AGENT), p2 = __hip_atomic_fetch_add((unsigned*)(F.ctl + CW_CNT + e2), 1u, RLX_AGENT);
                ASG[2 * row] = (e1 << 16) | p1; ASG[2 * row + 1] = (e2 << 16) | p2; GATE[2 * row] = pg * s1; GATE[2 * row + 1] = pg * (1.0f - s1);
            }
        }
    }
    __syncthreads();
}
__device__ __forceinline__ void p8_permute(Frame& F) {
    LAS unsigned* pst = (LAS unsigned*)(F.lds + RING_OFF);
    if (F.wave == 0) {
        const unsigned cnt = F.lane < NE ? ald((const unsigned*)(F.ctl + CW_CNT + F.lane)) : 0u; const unsigned nt = (cnt + 255u) >> 8;
        unsigned inc = nt;
#pragma unroll
        for (int o = 1; o < 64; o <<= 1) { const unsigned t = __shfl_up(inc, o); if (F.lane >= o) inc += t; }
        const unsigned excl = inc - nt;
        if (F.lane < NE) pst[F.lane] = excl * 256u;
        if (blockIdx.x == 0) {
            if (F.lane == NE - 1) __hip_atomic_store((unsigned*)(F.ctl + CW_NT), inc, RLX_AGENT);
            if (F.lane < NE) for (unsigned t = 0; t < nt; ++t) __hip_atomic_store((unsigned*)(F.ctl + CW_TILEE + excl + t), (unsigned)F.lane, RLX_AGENT);
        }
    }
    __syncthreads();
    const unsigned* ASG = (const unsigned*)(F.ws + WS_ASG); unsigned* SLOT = (unsigned*)(F.ws + WS_SLOT); const bf16* XN = (const bf16*)(F.ws + WS_XN); bf16* XS = (bf16*)(F.ws + WS_XS);
    const int gw = F.vcu * NWAVES + F.wave, NGW = F.G * NWAVES;
    for (int a = gw; a < 2 * MR; a += NGW) {
        const unsigned w = ald(ASG + a); const unsigned e = w >> 16, pos = w & 0xffffu; const unsigned slot = pst[e] + pos;
        if (F.lane == 0) SLOT[a] = slot;
        const v4u* src = (const v4u*)(XN + (size_t)(a >> 1) * DM); v4u* dst = (v4u*)(XS + (size_t)slot * DM);
        dst[F.lane] = src[F.lane]; dst[64 + F.lane] = src[64 + F.lane];
    }
    __syncthreads();
}
__device__ __forceinline__ void p11_final(Frame& F) {
    const unsigned* SLOT = (const unsigned*)(F.ws + WS_SLOT); const float* GATE = (const float*)(F.ws + WS_GATE); const bf16* Y = (const bf16*)(F.ws + WS_Y); const float* fw = F.in[17];
    const int gw = F.vcu * NWAVES + F.wave, NGW = F.G * NWAVES;
    for (int m = gw; m < MR; m += NGW) {
        const unsigned s0 = ald(SLOT + 2 * m), s1 = ald(SLOT + 2 * m + 1); const float g0 = aldf(GATE + 2 * m), g1 = aldf(GATE + 2 * m + 1);
        f32x4 v[4]; float ss = 0.f;
#pragma unroll
        for (int j = 0; j < 4; ++j) { v[j] = *(const f32x4*)(F.out + (size_t)m * DM + 4 * F.lane + 256 * j);
            const v2u y0 = *(const v2u*)(Y + (size_t)s0 * DM + 4 * F.lane + 256 * j), y1 = *(const v2u*)(Y + (size_t)s1 * DM + 4 * F.lane + 256 * j);
            v[j].x += g0 * blo(y0.x) + g1 * blo(y1.x); v[j].y += g0 * bhi(y0.x) + g1 * bhi(y1.x); v[j].z += g0 * blo(y0.y) + g1 * blo(y1.y); v[j].w += g0 * bhi(y0.y) + g1 * bhi(y1.y);
            ss += (v[j].x * v[j].x + v[j].y * v[j].y) + (v[j].z * v[j].z + v[j].w * v[j].w); }
        const float rs = 1.0f / sqrtf(wave_sum(ss) * (1.0f / DM) + EPS);
#pragma unroll
        for (int j = 0; j < 4; ++j) { const f32x4 w = *(const f32x4*)(fw + 4 * F.lane + 256 * j); *(f32x4*)(F.out + (size_t)m * DM + 4 * F.lane + 256 * j) = v[j] * rs * w; }
    }
}

struct Args { const float* in[18]; float* out; unsigned char* ws; int ph_lo, ph_hi, li, pad; };
__global__ void __launch_bounds__(NWAVES * 64, 2) fwd(Args args) {
    extern __shared__ __attribute__((aligned(16))) unsigned char lds[];
    Frame F;
    F.lds = (LAS unsigned char*)lds;
    F.MISC = (volatile LAS unsigned*)(F.lds + MISC_OFF);
    F.tid = threadIdx.x; F.lane = F.tid & 63; F.wave = __builtin_amdgcn_readfirstlane(F.tid >> 6);
    F.G = gridDim.x; { const int bx = blockIdx.x; F.vcu = (F.G % 8 == 0) ? (bx % 8) * (F.G / 8) + bx / 8 : bx; }
    F.ws = args.ws; F.ctl = (gu32*)(args.ws + WS_CTL); F.out = args.out;
#pragma unroll
    for (int i = 0; i < 18; ++i) F.in[i] = args.in[i];
    for (int u = F.tid; u < (LDS_BYTES - LDSCTL_OFF) / 4; u += NWAVES * 64) ((LAS unsigned*)(F.lds + LDSCTL_OFF))[u] = 0u;
    __syncthreads();
    const int bli = (N_LAUNCHES == NPHASE) ? 0 : args.li;
    XcdBarrier bar; bar.bar = (unsigned*)(F.ctl + CW_BAR) + bli * XCD_BAR_WORDS; bar.x = 0; bar.st = nullptr;
    if (N_LAUNCHES != NPHASE) bar = xcd_barrier_post((unsigned*)(F.ctl + CW_BAR) + bli * XCD_BAR_WORDS, F.MISC + 8);
#define GRID_BAR(seam) do { if (N_LAUNCHES == NPHASE) { if (F.tid == 0) __hip_atomic_store(F.ctl + CW_TMO, 0xBADBA0u | (unsigned)(seam), RLX_AGENT); } else { xcd_barrier(bar); } } while (0)
    const int lo = args.ph_lo, hi = args.ph_hi;
#define IN(k) (lo <= (k) && (k) < hi)
#define BOTH(k) (IN(k) && IN((k) + 1))
    unsigned char* ws = args.ws;

    if (IN(0)) {
        if (F.vcu < 7) p0_meta(F);
        p0_rows(F);
        p0_weights(F);
        if (BOTH(0)) GRID_BAR(0);
    }
    if (IN(1)) {
        pg8::Gemm g{(const bf16*)(ws + WS_U), (const bf16*)(ws + WS_WIN), MR, NPROJ, DM, 0};
        pg8::StaticOrder S; S.init(MR, NPROJ, F.G, (int)blockIdx.x);
        pg8::EpiProj E{(bf16*)(ws + WS_QA), (bf16*)(ws + WS_KA), (bf16*)(ws + WS_VA), (bf16*)(ws + WS_QH), (bf16*)(ws + WS_EB), (bf16*)(ws + WS_KT), (bf16*)(ws + WS_KD), (bf16*)(ws + WS_VH),
                       (bf16*)(ws + WS_GH), (bf16*)(ws + WS_GA), (bf16*)(ws + WS_GT), F.in[5]};
        pg8::gemm_phase<pg8::EpiProj, pg8::StaticOrder, true, true>(F.lds + RING_OFF, g, S, E);
        __syncthreads();
        for (int bh = blockIdx.x; bh < 16; bh += F.G) p1_cumsum(F, bh);
        if (BOTH(1)) GRID_BAR(1);
    }
    if (IN(2)) {
        for (int pid = F.vcu; pid < 256; pid += F.G) { const int bh = pid >> 4, s = pid & 15; attn_simple_unit(F, bh, s); attn_simple_unit(F, bh, 31 - s); }
        for (int it = F.vcu; it < 16 * NCH; it += F.G) hgrn_a_simple(F, it);
        if (BOTH(2)) GRID_BAR(2);
    }
    if (IN(3)) { hgrn_scan(F); if (BOTH(3)) GRID_BAR(3); }
    if (IN(4)) {
        for (int it = F.vcu; it < 16 * 128; it += F.G) hgrn_c_simple(F, it);
        if (BOTH(4)) GRID_BAR(4);
    }
    if (IN(5)) {
        { pg8::Gemm g{(const bf16*)(ws + WS_OA), (const bf16*)(ws + WS_WA), MR, DM, AWID, 0}; pg8::StaticOrder S; S.init(MR, DM, F.G, (int)blockIdx.x);
          pg8::EpiYa E{(const bf16*)(ws + WS_GA), (float*)(ws + WS_YA)};
          pg8::gemm_phase<pg8::EpiYa, pg8::StaticOrder, true, true>(F.lds + RING_OFF, g, S, E); }
        __syncthreads();
        { pg8::Gemm g{(const bf16*)(ws + WS_OH), (const bf16*)(ws + WS_WH), MR, DM, DM, 0}; pg8::StaticOrder S; S.init(MR, DM, F.G, (int)blockIdx.x);
          pg8::EpiMixed E{(const bf16*)(ws + WS_GT), (const float*)(ws + WS_YA), (bf16*)(ws + WS_MIX)};
          pg8::gemm_phase<pg8::EpiMixed, pg8::StaticOrder, true, true>(F.lds + RING_OFF, g, S, E); }
        if (BOTH(5)) GRID_BAR(5);
    }
    if (IN(6)) {
        pg8::Gemm g{(const bf16*)(ws + WS_MIX), (const bf16*)(ws + WS_WO), MR, DM, DM, 0}; pg8::StaticOrder S; S.init(MR, DM, F.G, (int)blockIdx.x);
        pg8::EpiRes E{F.in[0], F.out};
        pg8::gemm_phase<pg8::EpiRes, pg8::StaticOrder, true, true>(F.lds + RING_OFF, g, S, E);
        if (BOTH(6)) GRID_BAR(6);
    }
    if (IN(7)) { p7_router(F); p7_expert_weights(F); if (BOTH(7)) GRID_BAR(7); }
    if (IN(8)) { p8_permute(F); if (BOTH(8)) GRID_BAR(8); }
    if (IN(9)) {
        const int ntile = (int)__builtin_amdgcn_readfirstlane(ald((const unsigned*)(F.ctl + CW_NT)));
        pg8::Gemm g{(const bf16*)(ws + WS_XS), (const bf16*)(ws + WS_WE1), APAD, DM, DM, (size_t)DM * DM * 2};
        pg8::MoeOrder S{ntile * 4, F.G, F.vcu, (const unsigned*)(F.ctl + CW_TILEE)};
        pg8::EpiSwiglu E{(bf16*)(ws + WS_ACT)};
        pg8::gemm_phase<pg8::EpiSwiglu, pg8::MoeOrder, true, true>(F.lds + RING_OFF, g, S, E);
        if (BOTH(9)) GRID_BAR(9);
    }
    if (IN(10)) {
        const int ntile = (int)__builtin_amdgcn_readfirstlane(ald((const unsigned*)(F.ctl + CW_NT)));
        pg8::Gemm g{(const bf16*)(ws + WS_ACT), (const bf16*)(ws + WS_WE2), APAD, DM, EFF, (size_t)DM * EFF * 2};
        pg8::MoeOrder S{ntile * 4, F.G, F.vcu, (const unsigned*)(F.ctl + CW_TILEE)};
        pg8::EpiPlain E{(bf16*)(ws + WS_Y), DM};
        pg8::gemm_phase<pg8::EpiPlain, pg8::MoeOrder, true, true>(F.lds + RING_OFF, g, S, E);
        if (BOTH(10)) GRID_BAR(10);
    }
    if (IN(11)) { p11_final(F); }
#undef IN
#undef BOTH
}

extern "C" void kernel_launch(void* const* d_in, const int* in_sizes, int n_in, void* d_out, int out_size, void* d_ws, size_t ws_size, hipStream_t stream) {
    static int grid = 0;
    if (grid == 0) {
        if (n_in != 18 || in_sizes[0] != MR * DM || out_size != MR * DM || ws_size < WS_END) {
            fprintf(stderr, "kernel_launch: unexpected problem: n_in %d in0 %d out %d ws %zu (need %zu); nothing launched\n", n_in, n_in > 0 ? in_sizes[0] : -1, out_size, ws_size, (size_t)WS_END); grid = -1; return; }
        int dev = 0, cus = 0, per_cu = 0;
        if (hipGetDevice(&dev) != hipSuccess || hipDeviceGetAttribute(&cus, hipDeviceAttributeMultiprocessorCount, dev) != hipSuccess) { grid = -1; return; }
        if (hipFuncSetAttribute((const void*)fwd, hipFuncAttributeMaxDynamicSharedMemorySize, LDS_BYTES) != hipSuccess) { fprintf(stderr, "kernel_launch: hipFuncSetAttribute failed\n"); grid = -1; return; }
        if (hipOccupancyMaxActiveBlocksPerMultiprocessor(&per_cu, (const void*)fwd, NWAVES * 64, LDS_BYTES) != hipSuccess || per_cu < 1)
            fprintf(stderr, "kernel_launch: note: occupancy query reports %d workgroups per CU\n", per_cu);
        (void)hipGetLastError();
        grid = cus;
    }
    if (grid < 0) return;
    if (hipMemsetAsync((char*)d_ws + WS_CTL, 0, CTL_ZERO_BYTES, stream) != hipSuccess) { fprintf(stderr, "kernel_launch: memset failed\n"); return; }
    Args a{};
    for (int i = 0; i < 18; ++i) a.in[i] = (const float*)d_in[i];
    a.out = (float*)d_out; a.ws = (unsigned char*)d_ws;
    for (int li = 0; li < N_LAUNCHES; ++li) {
        if (N_LAUNCHES == NPHASE) { a.ph_lo = li; a.ph_hi = li + 1; } else { a.ph_lo = 0; a.ph_hi = NPHASE; }
        a.li = li;
        hipLaunchKernelGGL(fwd, dim3(grid), dim3(NWAVES * 64), LDS_BYTES, stream, a);
        const hipError_t le = hipPeekAtLastError();
        if (le != hipSuccess) { fprintf(stderr, "kernel_launch: launch %d failed: %s\n", li, hipGetErrorName(le)); break; }
    }
}
```

```cpp
#include <hip/hip_runtime.h>
#include <cstdio>
#include <cstdint>

#ifndef MK_N_LAUNCHES
#define MK_N_LAUNCHES 1
#endif

namespace pg8 {
#define PG8_LAS __attribute__((address_space(3)))
typedef unsigned short bf16_t;
typedef short bf16x8 __attribute__((ext_vector_type(8)));
typedef float f32x4 __attribute__((ext_vector_type(4)));
typedef unsigned u32x4 __attribute__((ext_vector_type(4)));
typedef unsigned u32x2 __attribute__((ext_vector_type(2)));
constexpr int BM = 256, BK = 64, HALF = 128, HTB = HALF * BK * 2  , STAGE_BYTES = 8 * HTB, NXCD = 8, WGM = 8;

__host__ __device__ __forceinline__ int lds_byte(int r, int c) { const int st = (r >> 4) * 2 + (c >> 5), rr = r & 15, cc = c & 31, ob = rr * 64 + cc * 2; return st * 1024 + (ob ^ (((ob >> 9) & 1) << 5)); }
__host__ __device__ __forceinline__ void stage_rc(int b, int& R, int& C) { const int st = b / 1024, sb = b % 1024, swz = sb ^ (((sb >> 9) & 1) << 5); R = (st >> 1) * 16 + swz / 64; C = (st & 1) * 32 + (swz % 64) / 2; }
__host__ __device__ __forceinline__ int perm32(int rho) { const int n = rho >> 4, i = rho & 15; return 8 * (i >> 2) + 4 * n + (i & 3); }

struct Unit { int pm, pn, e; };
struct Gemm { const bf16_t* A; const bf16_t* Bt; int M, N, K; size_t bexp; };

struct StaticOrder {
    int nM, nN, nwg, G, c;
    __host__ __device__ void init(int M, int N, int G_, int c_) { nM = M / BM; nN = N / BM; nwg = nM * nN; G = G_; c = c_; }
    __host__ __device__ bool next(int i, Unit& u) const {
        const long L = (long)i * G + c; if (L >= nwg) return false;
        int wgid = (int)L; { const int q = nwg / NXCD, r = nwg % NXCD, xcd = wgid % NXCD, off = wgid / NXCD; wgid = (xcd < r ? xcd * (q + 1) : r * (q + 1) + (xcd - r) * q) + off; }
        const int nig = WGM * nN, gid = wgid / nig, fm = gid * WGM, gsz = (nM - fm) < WGM ? (nM - fm) : WGM;
        u.pm = fm + ((wgid % nig) % gsz); u.pn = (wgid % nig) / gsz; u.e = 0; return true;
    }
    __device__ __forceinline__ void a_ready(const Unit&) const {}
    __device__ __forceinline__ void done(const Unit&) const {}
};
struct MoeOrder {
    int ntu, G, c; const unsigned* tile_e;
    __device__ bool next(int i, Unit& u) const {
        const long L = (long)i * G + c; if (L >= ntu) return false;
        u.pm = (int)(L >> 2); u.pn = (int)(L & 3);
        u.e = (int)__builtin_amdgcn_readfirstlane(__hip_atomic_load(tile_e + u.pm, __ATOMIC_RELAXED, __HIP_MEMORY_SCOPE_AGENT)); return true;
    }
    __device__ __forceinline__ void a_ready(const Unit&) const {}
    __device__ __forceinline__ void done(const Unit&) const {}
};

__device__ __forceinline__ unsigned cvt_pk_bf16(float lo, float hi) { unsigned r; asm volatile("v_cvt_pk_bf16_f32 %0, %1, %2" : "=v"(r) : "v"(lo), "v"(hi)); return r; }
__device__ __forceinline__ float fsig(float x) { return __builtin_amdgcn_rcpf(1.0f + __builtin_amdgcn_exp2f(-1.4426950408889634f * x)); }
__device__ __forceinline__ float bflo(unsigned w) { return __builtin_bit_cast(float, w << 16); }
__device__ __forceinline__ float bfhi(unsigned w) { return __builtin_bit_cast(float, w & 0xffff0000u); }
__device__ __forceinline__ float dpp_shr(float v, int) { return v; }
#define PG8_SCAN16(v) do { \
    v += __builtin_bit_cast(float, __builtin_amdgcn_update_dpp(0, __builtin_bit_cast(int, v), 0x111, 0xf, 0xf, true)); \
    v += __builtin_bit_cast(float, __builtin_amdgcn_update_dpp(0, __builtin_bit_cast(int, v), 0x112, 0xf, 0xf, true)); \
    v += __builtin_bit_cast(float, __builtin_amdgcn_update_dpp(0, __builtin_bit_cast(int, v), 0x114, 0xf, 0xf, true)); \
    v += __builtin_bit_cast(float, __builtin_amdgcn_update_dpp(0, __builtin_bit_cast(int, v), 0x118, 0xf, 0xf, true)); } while (0)

constexpr float ATT_C2 = 0.125f * 1.4426950408889634f;
constexpr float HG_QS = 0.08838834764831845f;

struct EpiProj {
    static constexpr bool PERM = true, AFTER_DRAIN = false;
    bf16_t *QA, *KA, *VA, *QH, *EB, *KT, *KD, *VH, *GH, *GA, *GT; const float* lbl;
    __device__ __forceinline__ void operator()(const f32x4 (&acc)[2][2][4][2], const Unit& u, int wr, int wc, int fr, int fq) const {
        const int pn = u.pn, b = u.pm >> 5;
        const int cofs = wc * 32 + 8 * fq;
        const int row0 = u.pm * BM + wr * 64 + fr;
        if (pn >= 10 && pn < 14) {
            const int colbase = 256 * (pn - 10), lane = fq * 16 + fr, srcl = (lane & 48) | 15;
#pragma unroll
            for (int ai = 0; ai < 2; ++ai)
#pragma unroll
                for (int bj = 0; bj < 2; ++bj)
#pragma unroll
                    for (int n = 0; n < 2; ++n) {
                        const int c0 = colbase + 128 * bj + cofs + 4 * n;
                        const f32x4 l0 = *(const f32x4*)(lbl + c0), l1 = *(const f32x4*)(lbl + 1024 + c0);
                        float eb[4][4], kt[4][4], kd[4][4];
#pragma unroll
                        for (int e = 0; e < 4; ++e) {
                            const float lb = __builtin_amdgcn_rcpf(1.0f + __builtin_amdgcn_exp2f((l1[e] - l0[e]) * 1.4426950408889634f));
                            float lf[4], kk[4];
#pragma unroll
                            for (int m = 0; m < 4; ++m) { const float f = lb + (1.0f - lb) * fsig(acc[ai][bj][m][n][e]); kk[m] = 1.0f - f; lf[m] = __builtin_amdgcn_logf(f); }
#pragma unroll
                            for (int m = 0; m < 4; ++m) PG8_SCAN16(lf[m]);
                            float run = 0.f, bb[4];
#pragma unroll
                            for (int m = 0; m < 4; ++m) { const float tot = __shfl(lf[m], srcl); bb[m] = lf[m] + run; run += tot; }
#pragma unroll
                            for (int m = 0; m < 4; ++m) { eb[m][e] = __builtin_amdgcn_exp2f(bb[m]); kt[m][e] = kk[m] * __builtin_amdgcn_exp2f(-bb[m]); kd[m][e] = kk[m] * __builtin_amdgcn_exp2f(run - bb[m]); }
                        }
#pragma unroll
                        for (int m = 0; m < 4; ++m) {
                            const size_t r = (size_t)(row0 + ai * HALF + m * 16);
                            u32x2 w;
                            w.x = cvt_pk_bf16(eb[m][0], eb[m][1]); w.y = cvt_pk_bf16(eb[m][2], eb[m][3]); *(u32x2*)(EB + r * 1024 + c0) = w;
                            w.x = cvt_pk_bf16(kt[m][0], kt[m][1]); w.y = cvt_pk_bf16(kt[m][2], kt[m][3]); *(u32x2*)(KT + r * 1024 + c0) = w;
                            w.x = cvt_pk_bf16(kd[m][0], kd[m][1]); w.y = cvt_pk_bf16(kd[m][2], kd[m][3]); *(u32x2*)(KD + (r + 64 * (b + 1)) * 1024 + c0) = w;
                        }
                    }
            return;
        }
        bf16_t* base; int ld = 1024, radd = 0, cb; int mode = 0; float sc = 1.f;
        if (pn < 2) { base = QA; ld = 512; cb = 256 * pn; sc = ATT_C2; }
        else if (pn < 4) { base = KA; ld = 512; cb = 256 * (pn - 2); radd = 128 * (b + 1); }
        else if (pn < 6) { base = VA; ld = 512; cb = 256 * (pn - 4); radd = 128 * (b + 1); }
        else if (pn < 10) { base = QH; cb = 256 * (pn - 6); sc = HG_QS; }
        else if (pn < 18) { base = VH; cb = 256 * (pn - 14); radd = 64 * (b + 1); }
        else if (pn < 22) { base = GH; cb = 256 * (pn - 18); mode = 1; }
        else if (pn < 26) { base = GA; cb = 256 * (pn - 22); mode = 1; }
        else { base = GT; cb = 256 * (pn - 26); mode = 1; }
#pragma unroll
        for (int ai = 0; ai < 2; ++ai)
#pragma unroll
            for (int m = 0; m < 4; ++m) { bf16_t* rowp = base + (size_t)(row0 + ai * HALF + m * 16 + radd) * ld + cb + cofs;
#pragma unroll
                for (int bj = 0; bj < 2; ++bj) { f32x4 v0 = acc[ai][bj][m][0], v1 = acc[ai][bj][m][1];
                    if (mode) {
#pragma unroll
                        for (int e = 0; e < 4; ++e) { v0[e] = fsig(v0[e]); v1[e] = fsig(v1[e]); }
                    } else { v0 = v0 * sc; v1 = v1 * sc; }
                    u32x4 w; w.x = cvt_pk_bf16(v0[0], v0[1]); w.y = cvt_pk_bf16(v0[2], v0[3]); w.z = cvt_pk_bf16(v1[0], v1[1]); w.w = cvt_pk_bf16(v1[2], v1[3]);
                    *(u32x4*)(rowp + bj * HALF) = w; } }
    }
};
struct EpiYa {
    static constexpr bool PERM = true, AFTER_DRAIN = false;
    const bf16_t* G; float* Y;
    __device__ __forceinline__ void operator()(const f32x4 (&acc)[2][2][4][2], const Unit& u, int wr, int wc, int fr, int fq) const {
        const int row0 = u.pm * BM + wr * 64 + fr, col0 = u.pn * BM + wc * 32 + 8 * fq;
#pragma unroll
        for (int ai = 0; ai < 2; ++ai)
#pragma unroll
            for (int m = 0; m < 4; ++m) { const size_t off = (size_t)(row0 + ai * HALF + m * 16) * 1024 + col0;
#pragma unroll
                for (int bj = 0; bj < 2; ++bj) { const u32x4 g = *(const u32x4*)(G + off + bj * HALF);
                    f32x4 v0 = acc[ai][bj][m][0], v1 = acc[ai][bj][m][1];
                    v0[0] *= bflo(g.x); v0[1] *= bfhi(g.x); v0[2] *= bflo(g.y); v0[3] *= bfhi(g.y); v1[0] *= bflo(g.z); v1[1] *= bfhi(g.z); v1[2] *= bflo(g.w); v1[3] *= bfhi(g.w);
                    *(f32x4*)(Y + off + bj * HALF) = v0; *(f32x4*)(Y + off + bj * HALF + 4) = v1; } }
    }
};
struct EpiMixed {
    static constexpr bool PERM = true, AFTER_DRAIN = false;
    const bf16_t* G; const float* Y; bf16_t* O;
    __device__ __forceinline__ void operator()(const f32x4 (&acc)[2][2][4][2], const Unit& u, int wr, int wc, int fr, int fq) const {
        const int row0 = u.pm * BM + wr * 64 + fr, col0 = u.pn * BM + wc * 32 + 8 * fq;
#pragma unroll
        for (int ai = 0; ai < 2; ++ai)
#pragma unroll
            for (int m = 0; m < 4; ++m) { const size_t off = (size_t)(row0 + ai * HALF + m * 16) * 1024 + col0;
#pragma unroll
                for (int bj = 0; bj < 2; ++bj) { const u32x4 g = *(const u32x4*)(G + off + bj * HALF);
                    const f32x4 y0 = *(const f32x4*)(Y + off + bj * HALF), y1 = *(const f32x4*)(Y + off + bj * HALF + 4);
                    f32x4 v0 = acc[ai][bj][m][0], v1 = acc[ai][bj][m][1];
                    v0[0] = y0[0] + v0[0] * bflo(g.x); v0[1] = y0[1] + v0[1] * bfhi(g.x); v0[2] = y0[2] + v0[2] * bflo(g.y); v0[3] = y0[3] + v0[3] * bfhi(g.y);
                    v1[0] = y1[0] + v1[0] * bflo(g.z); v1[1] = y1[1] + v1[1] * bfhi(g.z); v1[2] = y1[2] + v1[2] * bflo(g.w); v1[3] = y1[3] + v1[3] * bfhi(g.w);
                    u32x4 w; w.x = cvt_pk_bf16(v0[0], v0[1]); w.y = cvt_pk_bf16(v0[2], v0[3]); w.z = cvt_pk_bf16(v1[0], v1[1]); w.w = cvt_pk_bf16(v1[2], v1[3]);
                    *(u32x4*)(O + off + bj * HALF) = w; } }
    }
};
struct EpiRes {
    static constexpr bool PERM = true, AFTER_DRAIN = false;
    const float* X; float* O;
    __device__ __forceinline__ void operator()(const f32x4 (&acc)[2][2][4][2], const Unit& u, int wr, int wc, int fr, int fq) const {
        const int row0 = u.pm * BM + wr * 64 + fr, col0 = u.pn * BM + wc * 32 + 8 * fq;
#pragma unroll
        for (int ai = 0; ai < 2; ++ai)
#pragma unroll
            for (int m = 0; m < 4; ++m) { const size_t off = (size_t)(row0 + ai * HALF + m * 16) * 1024 + col0;
#pragma unroll
                for (int bj = 0; bj < 2; ++bj) {
                    const f32x4 x0 = *(const f32x4*)(X + off + bj * HALF), x1 = *(const f32x4*)(X + off + bj * HALF + 4);
                    *(f32x4*)(O + off + bj * HALF) = x0 + acc[ai][bj][m][0]; *(f32x4*)(O + off + bj * HALF + 4) = x1 + acc[ai][bj][m][1]; } }
    }
};
struct EpiSwiglu {
    static constexpr bool PERM = true, AFTER_DRAIN = false;
    bf16_t* O;
    __device__ __forceinline__ void operator()(const f32x4 (&acc)[2][2][4][2], const Unit& u, int wr, int wc, int fr, int fq) const {
        const int row0 = u.pm * BM + wr * 64 + fr, col0 = u.pn * HALF + wc * 32 + 8 * fq;
#pragma unroll
        for (int ai = 0; ai < 2; ++ai)
#pragma unroll
            for (int m = 0; m < 4; ++m) { const size_t off = (size_t)(row0 + ai * HALF + m * 16) * 512 + col0;
                f32x4 v0, v1;
#pragma unroll
                for (int e = 0; e < 4; ++e) { const float a0 = acc[ai][0][m][0][e], a1 = acc[ai][0][m][1][e];
                    v0[e] = a0 * fsig(a0) * acc[ai][1][m][0][e]; v1[e] = a1 * fsig(a1) * acc[ai][1][m][1][e]; }
                u32x4 w; w.x = cvt_pk_bf16(v0[0], v0[1]); w.y = cvt_pk_bf16(v0[2], v0[3]); w.z = cvt_pk_bf16(v1[0], v1[1]); w.w = cvt_pk_bf16(v1[2], v1[3]);
                *(u32x4*)(O + off) = w; }
    }
};
struct EpiPlain {
    static constexpr bool PERM = true, AFTER_DRAIN = false;
    bf16_t* O; int ldc;
    __device__ __forceinline__ void operator()(const f32x4 (&acc)[2][2][4][2], const Unit& u, int wr, int wc, int fr, int fq) const {
        const int row0 = u.pm * BM + wr * 64 + fr, col0 = u.pn * BM + wc * 32 + 8 * fq;
#pragma unroll
        for (int ai = 0; ai < 2; ++ai)
#pragma unroll
            for (int m = 0; m < 4; ++m) { const size_t off = (size_t)(row0 + ai * HALF + m * 16) * ldc + col0;
#pragma unroll
                for (int bj = 0; bj < 2; ++bj) { const f32x4 v0 = acc[ai][bj][m][0], v1 = acc[ai][bj][m][1];
                    u32x4 w; w.x = cvt_pk_bf16(v0[0], v0[1]); w.y = cvt_pk_bf16(v0[2], v0[3]); w.z = cvt_pk_bf16(v1[0], v1[1]); w.w = cvt_pk_bf16(v1[2], v1[3]);
                    *(u32x4*)(O + off + bj * HALF) = w; } }
    }
};

template <class Epi, class Sched, bool ALIGN_EPI = false, bool SP2 = false>
__device__ __forceinline__ void gemm_phase(PG8_LAS unsigned char* lds, const Gemm g, const Sched& S, const Epi& E) {
    const int tid = threadIdx.x, wid = __builtin_amdgcn_readfirstlane(tid >> 6), lane = tid & 63, wr = wid >> 2, wc = wid & 3, fr = lane & 15, fq = lane >> 4;
    const int K = g.K, nt = K / BK;
    unsigned voffA[2], voffB[2];
#pragma unroll
    for (int i = 0; i < 2; ++i) { int R, C; stage_rc(tid * 16 + i * 8192, R, C); const int Rb = Epi::PERM ? ((R & ~31) + perm32(R & 31)) : R;
        voffA[i] = (unsigned)(R * K + C) * 2u; voffB[i] = (unsigned)(Rb * K + C) * 2u; }
    const size_t kstep = (size_t)(BK * 2);
    const size_t hstep = (size_t)HALF * K * 2;
    const size_t tstep = 2 * hstep;
    const unsigned ldsw = (unsigned)wid * 1024u;
    const int aoff = lds_byte(wr * 64 + fr, fq * 8), boff = lds_byte(wc * 32 + fr, fq * 8);
#define PG8_SA(b, h) (((b) * 2 + (h)) * HTB)
#define PG8_SB(b, h) ((4 + (b) * 2 + (h)) * HTB)
#define PG8_STAGE(bufoff, gbase, voff) do { _Pragma("unroll") for (int _i = 0; _i < 2; ++_i) \
        __builtin_amdgcn_global_load_lds((const unsigned*)((const char*)(gbase) + (voff)[_i]), (PG8_LAS unsigned*)(lds + (bufoff) + ldsw + _i * 8192), 16, 0, 0); } while (0)
#define PG8_LDA(dst, b, h) do { _Pragma("unroll") for (int m = 0; m < 4; ++m) _Pragma("unroll") for (int k = 0; k < 2; ++k) dst[m][k] = *(const PG8_LAS bf16x8*)(lds + PG8_SA(b, h) + aoff + m * 2048 + k * 1024); } while (0)
#define PG8_LDB(dst, b, h) do { _Pragma("unroll") for (int n = 0; n < 2; ++n) _Pragma("unroll") for (int k = 0; k < 2; ++k) dst[n][k] = *(const PG8_LAS bf16x8*)(lds + PG8_SB(b, h) + boff + n * 2048 + k * 1024); } while (0)
#define PG8_MMA(ai, bj, At, Bt) do { __builtin_amdgcn_s_setprio(1); _Pragma("unroll") for (int m = 0; m < 4; ++m) _Pragma("unroll") for (int n = 0; n < 2; ++n) _Pragma("unroll") for (int k = 0; k < 2; ++k) \
        acc[ai][bj][m][n] = __builtin_amdgcn_mfma_f32_16x16x32_bf16(Bt[n][k], At[m][k], acc[ai][bj][m][n], 0, 0, 0); __builtin_amdgcn_s_setprio(0); } while (0)
#define PG8_WAIT_V(n) asm volatile("s_waitcnt vmcnt(" #n ")" ::: "memory")
#define PG8_WAIT_L(n) asm volatile("s_waitcnt lgkmcnt(" #n ")" ::: "memory")
#define PG8_BAR __builtin_amdgcn_s_barrier()
#define PG8_SCHED __builtin_amdgcn_sched_barrier(0)
    Unit cur, nxt; int ui = 0;
    if (!S.next(0, cur)) return;
    f32x4 acc[2][2][4][2];
#pragma unroll
    for (int a = 0; a < 2; ++a)
#pragma unroll
        for (int b = 0; b < 2; ++b)
#pragma unroll
            for (int m = 0; m < 4; ++m)
#pragma unroll
                for (int n = 0; n < 2; ++n) acc[a][b][m][n] = (f32x4){0.f, 0.f, 0.f, 0.f};
    bf16x8 At[4][2], B0[2][2], B1[2][2];
    const char* cA = (const char*)g.A + (size_t)cur.pm * tstep; const char* cB = (const char*)g.Bt + (size_t)cur.e * g.bexp + (size_t)cur.pn * tstep;
    S.a_ready(cur);
    if constexpr (SP2) {
        PG8_STAGE(PG8_SB(0, 0), cB, voffB); PG8_STAGE(PG8_SB(0, 1), cB + hstep, voffB); PG8_STAGE(PG8_SA(0, 0), cA, voffA); PG8_STAGE(PG8_SA(0, 1), cA + hstep, voffA);
        if (wr == 1) PG8_BAR;
        PG8_WAIT_V(2); PG8_BAR;
        PG8_STAGE(PG8_SB(1, 0), cB + kstep, voffB); PG8_STAGE(PG8_SA(1, 0), cA + kstep, voffA); PG8_STAGE(PG8_SB(1, 1), cB + hstep + kstep, voffB);
        PG8_WAIT_V(6); PG8_BAR;
    } else {
        PG8_STAGE(PG8_SB(0, 0), cB, voffB); PG8_STAGE(PG8_SA(0, 0), cA, voffA); PG8_STAGE(PG8_SB(0, 1), cB + hstep, voffB); PG8_STAGE(PG8_SA(0, 1), cA + hstep, voffA);
        if (wr == 1) PG8_BAR;
        PG8_WAIT_V(4); PG8_BAR;
        PG8_STAGE(PG8_SB(1, 0), cB + kstep, voffB); PG8_STAGE(PG8_SA(1, 0), cA + kstep, voffA); PG8_STAGE(PG8_SB(1, 1), cB + hstep + kstep, voffB);
        PG8_WAIT_V(6); PG8_BAR;
    }
    for (;;) {
        const bool has_next = S.next(ui + 1, nxt);
        const char* nA = has_next ? (const char*)g.A + (size_t)nxt.pm * tstep : cA; const char* nB = has_next ? (const char*)g.Bt + (size_t)nxt.e * g.bexp + (size_t)nxt.pn * tstep : cB;
        for (int t = 0; t < nt; t += 2) {
            const bool last = (t == nt - 2);
            const char* a1 = cA + (size_t)(t + 1) * kstep;
            const char* a2 = last ? nA : cA + (size_t)(t + 2) * kstep; const char* b2 = last ? nB : cB + (size_t)(t + 2) * kstep;
            const char* a3 = a2 + kstep; const char* b3 = b2 + kstep;
            if (last && has_next) S.a_ready(nxt);
            if constexpr (SP2) {
            PG8_LDB(B0, 0, 0); PG8_LDB(B1, 0, 1); PG8_SCHED; PG8_LDA(At, 0, 0); PG8_STAGE(PG8_SA(1, 1), a1 + hstep, voffA);
            PG8_WAIT_V(8); PG8_WAIT_L(0); PG8_BAR; PG8_MMA(0, 0, At, B0); PG8_MMA(0, 1, At, B1); PG8_BAR; PG8_SCHED;
            PG8_LDA(At, 0, 1); PG8_STAGE(PG8_SB(0, 0), b2, voffB); PG8_STAGE(PG8_SB(0, 1), b2 + hstep, voffB); PG8_STAGE(PG8_SA(0, 0), a2, voffA);
            PG8_WAIT_V(8); PG8_WAIT_L(0); PG8_BAR; PG8_MMA(1, 0, At, B0); PG8_MMA(1, 1, At, B1); PG8_BAR; PG8_SCHED;
            PG8_LDB(B0, 1, 0); PG8_LDB(B1, 1, 1); PG8_SCHED; PG8_LDA(At, 1, 0); PG8_STAGE(PG8_SA(0, 1), a2 + hstep, voffA);
            PG8_WAIT_V(8); PG8_WAIT_L(0); PG8_BAR; PG8_MMA(0, 0, At, B0); PG8_MMA(0, 1, At, B1); PG8_BAR; PG8_SCHED;
            PG8_LDA(At, 1, 1); PG8_STAGE(PG8_SB(1, 0), b3, voffB); PG8_STAGE(PG8_SB(1, 1), b3 + hstep, voffB); PG8_STAGE(PG8_SA(1, 0), a3, voffA);
            PG8_WAIT_V(8); PG8_WAIT_L(0); PG8_BAR; PG8_MMA(1, 0, At, B0); PG8_MMA(1, 1, At, B1); PG8_BAR; PG8_SCHED;
            } else {
            PG8_LDB(B0, 0, 0); PG8_SCHED; PG8_LDA(At, 0, 0); PG8_STAGE(PG8_SA(1, 1), a1 + hstep, voffA);
            PG8_WAIT_L(8); PG8_BAR; PG8_WAIT_L(0); PG8_MMA(0, 0, At, B0); PG8_BAR; PG8_SCHED;
            PG8_LDB(B1, 0, 1); PG8_STAGE(PG8_SB(0, 0), b2, voffB);
            PG8_BAR; PG8_WAIT_L(0); PG8_MMA(0, 1, At, B1); PG8_BAR;
            PG8_LDA(At, 0, 1); PG8_STAGE(PG8_SA(0, 0), a2, voffA);
            PG8_BAR; PG8_WAIT_L(0); PG8_MMA(1, 0, At, B0); PG8_BAR; PG8_SCHED;
            PG8_STAGE(PG8_SB(0, 1), b2 + hstep, voffB);
            PG8_WAIT_V(6); PG8_BAR; PG8_MMA(1, 1, At, B1); PG8_BAR;
            PG8_LDB(B0, 1, 0); PG8_SCHED; PG8_LDA(At, 1, 0); PG8_STAGE(PG8_SA(0, 1), a2 + hstep, voffA);
            PG8_WAIT_L(8); PG8_BAR; PG8_WAIT_L(0); PG8_MMA(0, 0, At, B0); PG8_BAR; PG8_SCHED;
            PG8_LDB(B1, 1, 1); PG8_STAGE(PG8_SB(1, 0), b3, voffB);
            PG8_BAR; PG8_WAIT_L(0); PG8_MMA(0, 1, At, B1); PG8_BAR;
            PG8_LDA(At, 1, 1); PG8_STAGE(PG8_SA(1, 0), a3, voffA);
            PG8_BAR; PG8_WAIT_L(0); PG8_MMA(1, 0, At, B0); PG8_BAR; PG8_SCHED;
            PG8_STAGE(PG8_SB(1, 1), b3 + hstep, voffB);
            PG8_WAIT_V(6); PG8_BAR; PG8_MMA(1, 1, At, B1); PG8_BAR;
            }
        }
        if constexpr (ALIGN_EPI) { if (wr == 0) PG8_BAR; }
        if constexpr (!Epi::AFTER_DRAIN) { E(acc, cur, wr, wc, fr, fq); S.done(cur); }
        if (!has_next) break;
#pragma unroll
        for (int a = 0; a < 2; ++a)
#pragma unroll
            for (int b = 0; b < 2; ++b)
#pragma unroll
                for (int m = 0; m < 4; ++m)
#pragma unroll
                    for (int n = 0; n < 2; ++n) acc[a][b][m][n] = (f32x4){0.f, 0.f, 0.f, 0.f};
        cur = nxt; cA = nA; cB = nB; ++ui;
        if constexpr (ALIGN_EPI) { if (wr == 1) PG8_BAR; }
    }
    PG8_WAIT_V(0);
    if constexpr (!ALIGN_EPI) { if (wr == 0) PG8_BAR; }
    PG8_BAR;
    if constexpr (Epi::AFTER_DRAIN) { E.fused(acc, cur, wr, wc, fr, fq, lds, wid, lane); S.done(cur); }
#undef PG8_SA
#undef PG8_SB
#undef PG8_STAGE
#undef PG8_LDA
#undef PG8_LDB
#undef PG8_MMA
#undef PG8_WAIT_V
#undef PG8_WAIT_L
#undef PG8_BAR
#undef PG8_SCHED
}
}

constexpr int NWAVES = 8;
constexpr int NB = 2, SEQ = 8192, DM = 1024, MR = NB * SEQ;
constexpr int NMETA = 16, INW = 7688, NPROJ = 7680;
constexpr int AH = 8, ADH = 64, AWID = 512, KROWS = SEQ + 128;
constexpr int HH = 8, HK = 128, HV = 128, HROWS = SEQ + 64, NCH = 129;
constexpr int NE = 32, EFF = 512, APAD = 40960;
constexpr float EPS = 1e-6f;
constexpr int N_LAUNCHES = MK_N_LAUNCHES;
constexpr int NPHASE = 12;

constexpr size_t MiB = 1u << 20;
constexpr size_t WS_CTL = 0, CTL_ZERO_BYTES = 1 * MiB;
constexpr size_t WS_WIN = 1 * MiB, WS_WA = 16 * MiB, WS_WH = 17 * MiB, WS_WO = 19 * MiB;
constexpr size_t WS_LFA = 21 * MiB, WS_LFAM = WS_LFA + 512 * 1024, WS_CL = 22 * MiB, WS_ASG = 23 * MiB, WS_GATE = WS_ASG + 128 * 1024, WS_SLOT = WS_GATE + 128 * 1024, WS_GSORT = 24 * MiB;
constexpr size_t WS_U = 26 * MiB;
constexpr size_t WS_OA = 26 * MiB;
constexpr size_t WS_QA = 58 * MiB, WS_KA = 74 * MiB, WS_VA = 90 * MiB + 512 * 1024;
constexpr size_t WS_QH = 107 * MiB, WS_EB = 139 * MiB, WS_KT = 171 * MiB, WS_KD = 203 * MiB, WS_VH = 235 * MiB + 512 * 1024;
constexpr size_t WS_GH = 268 * MiB, WS_GA = 300 * MiB, WS_GT = 332 * MiB;
constexpr size_t WS_US = 364 * MiB;
constexpr size_t WS_OH = 429 * MiB;
constexpr size_t WS_YA = 107 * MiB;
constexpr size_t WS_MIX = 171 * MiB;
constexpr size_t WS_XN = 26 * MiB, WS_WE1 = 58 * MiB, WS_WE2 = 122 * MiB, WS_XS = 154 * MiB, WS_ACT = 234 * MiB, WS_Y = 274 * MiB;
constexpr size_t WS_END = 461 * MiB;
static_assert(WS_KA + (size_t)2 * KROWS * AWID * 2 <= WS_VA && WS_VA + (size_t)2 * KROWS * AWID * 2 <= WS_QH && WS_KD + (size_t)2 * HROWS * DM * 2 <= WS_VH && WS_VH + (size_t)2 * HROWS * DM * 2 <= WS_GH, "ws map");
static_assert(WS_US + (size_t)16 * NCH * HK * HV * 2 <= WS_OH && WS_OH + (size_t)MR * DM * 2 <= WS_END && WS_Y + (size_t)APAD * DM * 2 <= WS_END && WS_XS + (size_t)APAD * DM * 2 <= WS_ACT && WS_ACT + (size_t)APAD * EFF * 2 <= WS_Y, "ws map 2");
constexpr int CW_TMO = 0, CW_CODE = 1;
constexpr int CW_CNT = 1024;
constexpr int CW_NT = 2048;
constexpr int CW_TILEE = 2112;
constexpr int CW_BAR = 4096;

constexpr int RING_OFF = 0, RING_BYTES = 131072;
constexpr int LDSCTL_OFF = RING_BYTES, MISC_OFF = LDSCTL_OFF + 320;
constexpr int LDS_BYTES = 147456;

#define GAS __attribute__((address_space(1)))
#define LAS __attribute__((address_space(3)))
typedef unsigned short bf16;
typedef unsigned v4u __attribute__((ext_vector_type(4)));
typedef unsigned v2u __attribute__((ext_vector_type(2)));
typedef float f32x4 __attribute__((ext_vector_type(4)));
typedef short bf16x8 __attribute__((ext_vector_type(8)));
typedef GAS unsigned gu32;
typedef GAS unsigned long long gu64;
#define RLX_AGENT __ATOMIC_RELAXED, __HIP_MEMORY_SCOPE_AGENT
#define LDS_WAIT() asm volatile("s_waitcnt lgkmcnt(0)" ::: "memory")
#define VM_WAIT() asm volatile("s_waitcnt vmcnt(0)" ::: "memory")
__device__ __forceinline__ unsigned f2bf(float f) { unsigned u = __builtin_bit_cast(unsigned, f); return (u + 0x7fffu + ((u >> 16) & 1u)) >> 16; }
__device__ __forceinline__ unsigned pk2(float lo, float hi) { return f2bf(lo) | (f2bf(hi) << 16); }
__device__ __forceinline__ float bf2f(unsigned short h) { return __builtin_bit_cast(float, (unsigned)h << 16); }
__device__ __forceinline__ float blo(unsigned w) { return __builtin_bit_cast(float, w << 16); }
__device__ __forceinline__ float bhi(unsigned w) { return __builtin_bit_cast(float, w & 0xffff0000u); }
__device__ __forceinline__ float ex2(float x) { return __builtin_amdgcn_exp2f(x); }
__device__ __forceinline__ float sigm(float x) { return __builtin_amdgcn_rcpf(1.0f + ex2(-1.4426950408889634f * x)); }
__device__ __forceinline__ unsigned ald(const unsigned* p) { return __hip_atomic_load(p, __ATOMIC_RELAXED, __HIP_MEMORY_SCOPE_AGENT); }
__device__ __forceinline__ float aldf(const float* p) { return __builtin_bit_cast(float, __hip_atomic_load((const unsigned*)p, __ATOMIC_RELAXED, __HIP_MEMORY_SCOPE_AGENT)); }
__device__ __forceinline__ float log_sigmoid(float z) { const float a = fabsf(z); return fminf(z, 0.f) - __logf(1.0f + __expf(-a)); }

#define XB_TMO      128
#define XB_XCNT(j)  (256  + 64 * (j))
#define XB_XSUB(j)  (1280 + 64 * (j))
#define XB_XGEN(j)  (2304 + 64 * (j))
#define XB_TOP      3328
#define XB_TOPGEN   3392
#define XCD_BAR_WORDS 3456
#define XB_SPIN_CAP (1u << 18)

__device__ __forceinline__ unsigned xb_ld(unsigned* p)              { return __hip_atomic_load(p, __ATOMIC_RELAXED, __HIP_MEMORY_SCOPE_AGENT); }
__device__ __forceinline__ unsigned xb_add(unsigned* p, unsigned v) { return __hip_atomic_fetch_add(p, v, __ATOMIC_RELAXED, __HIP_MEMORY_SCOPE_AGENT); }
__device__ __forceinline__ unsigned xb_xcc_id() { return (unsigned)__builtin_amdgcn_s_getreg((3 << 11) | 20) & 0xFu; }
#define XB_SPIN(cond, bar) do { unsigned _sp = 0; while (cond) { __builtin_amdgcn_s_sleep(1); \
    if ((++_sp & 255u) == 0u) { if (xb_ld(&(bar)[XB_TMO])) break; if (_sp > XB_SPIN_CAP) { atomicAdd(&(bar)[XB_TMO], 1u); break; } } } } while (0)

struct XcdBarrier {
    unsigned* bar; unsigned x;
    volatile LAS unsigned* st;
};

__device__ __forceinline__ XcdBarrier xcd_barrier_post(unsigned* bar, volatile LAS unsigned* st) {
    XcdBarrier b; b.bar = bar; b.x = xb_xcc_id(); b.st = st;
    if (threadIdx.x == 0) (void)xb_add(&bar[XB_XCNT(b.x)], 1u);
    return b;
}
__device__ __forceinline__ void xcd_barrier_complete(unsigned* bar, unsigned x, unsigned& nloc, unsigned& nx) {
    const unsigned G = gridDim.x * gridDim.y * gridDim.z;
    unsigned sum, cnt, mine, sp = 0u;
    for (;;) {
        sum = 0u; cnt = 0u; mine = 0u;
#pragma unroll
        for (unsigned j = 0; j < 16; ++j) { const unsigned c = xb_ld(&bar[XB_XCNT(j)]); sum += c; cnt += (c > 0u) ? 1u : 0u; mine = (j == x) ? c : mine; }
        if (sum == G) break;
        __builtin_amdgcn_s_sleep(1);
        if ((++sp & 255u) == 0u) { if (xb_ld(&bar[XB_TMO])) break; if (sp > XB_SPIN_CAP) { atomicAdd(&bar[XB_TMO], 1u); break; } }
    }
    nloc = mine > 0u ? mine : 1u; nx = cnt > 0u ? cnt : 1u;
}

__device__ __forceinline__ void xcd_barrier(const XcdBarrier& b) {
    asm volatile("s_waitcnt vmcnt(0)" ::: "memory");
    __syncthreads();
    if (threadIdx.x == 0) {
        unsigned* bar = b.bar;
        __builtin_amdgcn_s_waitcnt(0);
        unsigned nloc = b.st[0], nx = b.st[1];
        if (nloc == 0u) { xcd_barrier_complete(bar, b.x, nloc, nx); b.st[0] = nloc; b.st[1] = nx; }
        const unsigned old = xb_add(&bar[XB_XSUB(b.x)], 1u);
        const unsigned gen = old / nloc;
        if (old + 1u == (gen + 1u) * nloc) {
            __builtin_amdgcn_fence(__ATOMIC_RELEASE, "agent");
            asm volatile("s_waitcnt vmcnt(0)" ::: "memory");
            const unsigned og = xb_add(&bar[XB_TOP], 1u);
            const unsigned tg = og / nx;
            if (og + 1u == (tg + 1u) * nx) xb_add(&bar[XB_TOPGEN], 1u);
            else XB_SPIN(xb_ld(&bar[XB_TOPGEN]) == tg, bar);
            __builtin_amdgcn_fence(__ATOMIC_ACQUIRE, "agent");
            xb_add(&bar[XB_XGEN(b.x)], 1u);
            asm volatile("s_waitcnt vmcnt(0)" ::: "memory");
        } else {
            XB_SPIN(xb_ld(&bar[XB_XGEN(b.x)]) == gen, bar);
            __builtin_amdgcn_fence(__ATOMIC_ACQUIRE, "agent");
            asm volatile("s_waitcnt vmcnt(0)" ::: "memory");
        }
    }
    __syncthreads();
}
struct Frame {
    LAS unsigned char* lds;
    volatile LAS unsigned* MISC;
    gu32* ctl;
    unsigned char* ws;
    int tid, lane, wave;
    int vcu, G;
    const float* in[18];
    float* out;
};
__device__ __forceinline__ float wave_sum(float v) {
#pragma unroll
    for (int o = 1; o < 64; o <<= 1) v += __shfl_xor(v, o);
    return v;
}

__device__ __forceinline__ void p0_transpose_item(const float* W, int ldw, int K, int ncols, bf16* WT, int mode, int row_off, LAS float* scr, int item, int lane) {
    const int nblk = ncols / 32, kb = item / nblk, nb = item % nblk, k0 = 64 * kb, n0 = 32 * nb;
    int d0 = row_off + n0;
    if (mode == 1) { d0 = (n0 < 512) ? (256 * (n0 >> 7) + (n0 & 127)) : (256 * ((n0 - 512) >> 7) + 128 + ((n0 - 512) & 127)); }
#pragma unroll 8
    for (int i = 0; i < 32; ++i) { const int kk = 2 * i + (lane >> 5); scr[kk * 33 + (lane & 31)] = W[(size_t)(k0 + kk) * ldw + n0 + (lane & 31)]; }
    LDS_WAIT(); asm volatile("" ::: "memory");
    const int c = lane & 7;
#pragma unroll
    for (int j = 0; j < 4; ++j) { const int n = (lane >> 3) + 8 * j; const LAS float* s = scr + (8 * c) * 33 + n;
        v4u o; o.x = pk2(s[0 * 33], s[1 * 33]); o.y = pk2(s[2 * 33], s[3 * 33]); o.z = pk2(s[4 * 33], s[5 * 33]); o.w = pk2(s[6 * 33], s[7 * 33]);
        *(GAS v4u*)(WT + (size_t)(d0 + n) * K + k0 + 8 * c) = o; }
    LDS_WAIT(); asm volatile("" ::: "memory");
}

__device__ __forceinline__ void p0_meta(Frame& F) {
    const float* meta = F.in[1]; const float* nw = F.in[2]; const float* Win = F.in[3];
    LAS float* um = (LAS float*)(F.lds + RING_OFF);
#pragma unroll
    for (int rr = 0; rr < 2; ++rr) {
        const int r = 2 * F.wave + rr;
        f32x4 v[4]; float ss = 0.f;
#pragma unroll
        for (int j = 0; j < 4; ++j) { v[j] = *(const f32x4*)(meta + (size_t)r * DM + 4 * F.lane + 256 * j); ss += (v[j].x * v[j].x + v[j].y * v[j].y) + (v[j].z * v[j].z + v[j].w * v[j].w); }
        const float rs = 1.0f / sqrtf(wave_sum(ss) * (1.0f / DM) + EPS);
#pragma unroll
        for (int j = 0; j < 4; ++j) { const f32x4 w = *(const f32x4*)(nw + 4 * F.lane + 256 * j); const int k = 4 * F.lane + 256 * j;
            um[(k + 0) * 16 + r] = v[j].x * rs * w.x; um[(k + 1) * 16 + r] = v[j].y * rs * w.y; um[(k + 2) * 16 + r] = v[j].z * rs * w.z; um[(k + 3) * 16 + r] = v[j].w * rs * w.w; }
    }
    __syncthreads();
    const int item = F.vcu * NWAVES + F.wave;
    if (item < 49) {
        int type, strip;
        if (item < 8) { type = 0; strip = item; } else if (item < 16) { type = 1; strip = item - 8; } else if (item < 32) { type = 2; strip = item - 16; } else if (item < 48) { type = 3; strip = item - 32; } else { type = 4; strip = 0; }
        int col;
        if (type == 0) col = 512 + 64 * strip + F.lane; else if (type == 1) col = 1024 + 64 * strip + F.lane; else if (type == 2) col = 2568 + 64 * strip + F.lane;
        else if (type == 3) col = 3592 + 64 * strip + F.lane; else col = 1536 + (F.lane & 7);
        float acc[16];
#pragma unroll
        for (int r = 0; r < 16; ++r) acc[r] = 0.f;
#pragma unroll 4
        for (int k = 0; k < DM; ++k) {
            const float w = Win[(size_t)k * INW + col];
            const LAS f32x4* up = (const LAS f32x4*)(um + k * 16);
            const f32x4 u0 = up[0], u1 = up[1], u2 = up[2], u3 = up[3];
            acc[0] += w * u0.x; acc[1] += w * u0.y; acc[2] += w * u0.z; acc[3] += w * u0.w;
            acc[4] += w * u1.x; acc[5] += w * u1.y; acc[6] += w * u1.z; acc[7] += w * u1.w;
            acc[8] += w * u2.x; acc[9] += w * u2.y; acc[10] += w * u2.z; acc[11] += w * u2.w;
            acc[12] += w * u3.x; acc[13] += w * u3.y; acc[14] += w * u3.z; acc[15] += w * u3.w;
        }
        const int c = 64 * strip + F.lane;
        if (type == 0 || type == 1) {
            bf16* dst = (bf16*)(F.ws + (type == 0 ? WS_KA : WS_VA));
#pragma unroll
            for (int b = 0; b < 2; ++b) {
#pragma unroll
                for (int r = 0; r < 16; ++r) dst[((size_t)b * KROWS + r) * AWID + c] = (bf16)f2bf(acc[r]);
                for (int r = 16; r < 128; ++r) dst[((size_t)b * KROWS + r) * AWID + c] = (bf16)0;
            }
        } else if (type == 3) {
            bf16* dst = (bf16*)(F.ws + WS_VH);
#pragma unroll
            for (int b = 0; b < 2; ++b) {
                for (int r = 0; r < 48; ++r) dst[((size_t)b * HROWS + r) * DM + c] = (bf16)0;
#pragma unroll
                for (int r = 0; r < 16; ++r) dst[((size_t)b * HROWS + 48 + r) * DM + c] = (bf16)f2bf(acc[r]);
            }
        } else if (type == 2) {
            const float* lbl = F.in[5];
            const float lb = 1.0f / (1.0f + __expf(lbl[1024 + c] - lbl[c]));
            float kk[16], bb[16]; float run = 0.f;
#pragma unroll
            for (int r = 0; r < 16; ++r) { const float f = lb + (1.0f - lb) * (1.0f / (1.0f + __expf(-acc[r]))); kk[r] = 1.0f - f; run += __logf(f); bb[r] = run; }
            bf16* dst = (bf16*)(F.ws + WS_KD);
#pragma unroll
            for (int b = 0; b < 2; ++b) {
                for (int r = 0; r < 48; ++r) dst[((size_t)b * HROWS + r) * DM + c] = (bf16)0;
#pragma unroll
                for (int r = 0; r < 16; ++r) dst[((size_t)b * HROWS + 48 + r) * DM + c] = (bf16)f2bf(kk[r] * __expf(run - bb[r]));
            }
        } else {
            if (F.lane < 8) { float* lfam = (float*)(F.ws + WS_LFAM); const float bias = F.in[4][F.lane];
#pragma unroll
                for (int r = 0; r < 16; ++r) lfam[r * 8 + F.lane] = log_sigmoid(acc[r] + bias); }
        }
    }
    __syncthreads();
}

__device__ __forceinline__ void p0_rows(Frame& F) {
    const float* x = F.in[0]; const float* nw = F.in[2]; const float* Win = F.in[3]; const float* afb = F.in[4];
    LAS float* wfa = (LAS float*)(F.lds + RING_OFF);
    for (int i = F.tid; i < 8 * DM; i += NWAVES * 64) { const int k = i >> 3, h = i & 7; wfa[h * DM + k] = nw[k] * Win[(size_t)k * INW + 1536 + h]; }
    __syncthreads();
    const int gw = F.vcu * NWAVES + F.wave, NGW = F.G * NWAVES;
    f32x4 wv[4];
#pragma unroll
    for (int j = 0; j < 4; ++j) wv[j] = *(const f32x4*)(nw + 4 * F.lane + 256 * j);
    bf16* U = (bf16*)(F.ws + WS_U); float* lfa = (float*)(F.ws + WS_LFA);
    for (int m = gw; m < MR; m += NGW) {
        f32x4 v[4]; float ss = 0.f;
#pragma unroll
        for (int j = 0; j < 4; ++j) { v[j] = *(const f32x4*)(x + (size_t)m * DM + 4 * F.lane + 256 * j); ss += (v[j].x * v[j].x + v[j].y * v[j].y) + (v[j].z * v[j].z + v[j].w * v[j].w); }
        const float rs = 1.0f / sqrtf(wave_sum(ss) * (1.0f / DM) + EPS);
        GAS unsigned long long* o8 = (GAS unsigned long long*)(U + (size_t)m * DM) + F.lane;
#pragma unroll
        for (int j = 0; j < 4; ++j) { const f32x4 u = v[j] * rs * wv[j]; o8[64 * j] = (unsigned long long)pk2(u.x, u.y) | ((unsigned long long)pk2(u.z, u.w) << 32); }
        float z[8];
#pragma unroll
        for (int h = 0; h < 8; ++h) { float s = 0.f;
#pragma unroll
            for (int j = 0; j < 4; ++j) { const f32x4 w = *(const LAS f32x4*)(wfa + h * DM + 4 * F.lane + 256 * j); s += (v[j].x * w.x + v[j].y * w.y) + (v[j].z * w.z + v[j].w * w.w); }
            z[h] = wave_sum(s); }
        float zz = z[0];
#pragma unroll
        for (int h = 1; h < 8; ++h) zz = (F.lane == h) ? z[h] : zz;
        if (F.lane < 8) lfa[(size_t)m * 8 + F.lane] = log_sigmoid(zz * rs + afb[F.lane]);
    }
    __syncthreads();
}

__device__ __forceinline__ void p0_weights(Frame& F) {
    LAS float* scr = (LAS float*)(F.lds + RING_OFF + F.wave * 16384);
    const int gw = F.vcu * NWAVES + F.wave, NGW = F.G * NWAVES;
    constexpr int I1 = 16 * 48, I2 = 16 * 192, IA = 8 * 32, IH = 16 * 32, IO = 16 * 32;
    constexpr int NIT = I1 + I2 + IA + IH + IO;
    bf16* win = (bf16*)(F.ws + WS_WIN);
    for (int it = gw; it < NIT; it += NGW) {
        int r = it;
        if (r < I1) { p0_transpose_item(F.in[3], INW, DM, 1536, win, 0, 0, scr, r, F.lane); continue; } r -= I1;
        if (r < I2) { p0_transpose_item(F.in[3] + 1544, INW, DM, 6144, win, 0, 1536, scr, r, F.lane); continue; } r -= I2;
        if (r < IA) { p0_transpose_item(F.in[7], DM, AWID, DM, (bf16*)(F.ws + WS_WA), 0, 0, scr, r, F.lane); continue; } r -= IA;
        if (r < IH) { p0_transpose_item(F.in[8], DM, DM, DM, (bf16*)(F.ws + WS_WH), 0, 0, scr, r, F.lane); continue; } r -= IH;
        p0_transpose_item(F.in[9], DM, DM, DM, (bf16*)(F.ws + WS_WO), 0, 0, scr, r, F.lane);
    }
}
__device__ __forceinline__ void p7_expert_weights(Frame& F) {
    LAS float* scr = (LAS float*)(F.lds + RING_OFF + F.wave * 16384);
    const int gw = F.vcu * NWAVES + F.wave, NGW = F.G * NWAVES;
    constexpr int I1 = 16 * 32, I2 = 8 * 32;
    for (int it = gw; it < NE * (I1 + I2); it += NGW) {
        const int e = it / (I1 + I2); int r = it % (I1 + I2);
        if (r < I1) p0_transpose_item(F.in[15] + (size_t)e * DM * DM, DM, DM, DM, (bf16*)(F.ws + WS_WE1) + (size_t)e * DM * DM, 1, 0, scr, r, F.lane);
        else p0_transpose_item(F.in[16] + (size_t)e * EFF * DM, DM, EFF, DM, (bf16*)(F.ws + WS_WE2) + (size_t)e * DM * EFF, 0, 0, scr, r - I1, F.lane);
    }
}

__device__ __forceinline__ void p1_cumsum(Frame& F, int bh) {
    const int b = bh >> 3, h = bh & 7;
    const float* lfa = (const float*)(F.ws + WS_LFA); const float* lfam = (const float*)(F.ws + WS_LFAM); float* cl = (float*)(F.ws + WS_CL) + (size_t)bh * KROWS;
    LAS float* wtot = (LAS float*)(F.lds + RING_OFF);
    float cm = 0.f;
    for (int r = 0; r < 16; ++r) { cm += lfam[r * 8 + h]; if (F.tid == r) cl[r] = cm * 1.4426950408889634f; }
    if (F.tid >= 16 && F.tid < 128) cl[F.tid] = 1e30f;
    float loc[16]; float run = 0.f;
#pragma unroll
    for (int i = 0; i < 16; ++i) { run += lfa[((size_t)b * SEQ + 16 * F.tid + i) * 8 + h]; loc[i] = run; }
    float inc = run;
#pragma unroll
    for (int o = 1; o < 64; o <<= 1) { const float t = __shfl_up(inc, o); if (F.lane >= o) inc += t; }
    if (F.lane == 63) wtot[F.wave] = inc;
    __syncthreads();
    float pre = cm + (inc - run);
    for (int w = 0; w < F.wave; ++w) pre += wtot[w];
#pragma unroll
    for (int i = 0; i < 16; ++i) cl[128 + 16 * F.tid + i] = (pre + loc[i]) * 1.4426950408889634f;
    __syncthreads();
}

__device__ __forceinline__ void attn_simple_unit(Frame& F, int bh, int qb) {
    const int tid = F.tid, row = tid & 255, p = tid >> 8, b = bh >> 3, h = bh & 7;
    const bf16* QA = (const bf16*)(F.ws + WS_QA); const bf16* KA = (const bf16*)(F.ws + WS_KA); const bf16* VA = (const bf16*)(F.ws + WS_VA);
    const float* CL = (const float*)(F.ws + WS_CL) + (size_t)bh * KROWS; bf16* OA = (bf16*)(F.ws + WS_OA);
    LAS bf16* Ks = (LAS bf16*)(F.lds + RING_OFF); LAS bf16* Vs = (LAS bf16*)(F.lds + RING_OFF + 8192);
    LAS float* cks = (LAS float*)(F.lds + RING_OFF + 16384); LAS float* cmb = (LAS float*)(F.lds + RING_OFF + 16640);
    float q[64], o[64];
    const size_t qrow = (size_t)b * SEQ + 256 * qb + row;
#pragma unroll
    for (int c = 0; c < 8; ++c) { const v4u w = *(const v4u*)(QA + qrow * AWID + h * 64 + 8 * c);
        q[8 * c + 0] = blo(w.x); q[8 * c + 1] = bhi(w.x); q[8 * c + 2] = blo(w.y); q[8 * c + 3] = bhi(w.y); q[8 * c + 4] = blo(w.z); q[8 * c + 5] = bhi(w.z); q[8 * c + 6] = blo(w.w); q[8 * c + 7] = bhi(w.w); }
#pragma unroll
    for (int d = 0; d < 64; ++d) o[d] = 0.f;
    const int qp = 128 + 256 * qb + row; const float clq = CL[qp];
    float mx = -1e30f, l = 0.f;
    const int NT = 4 * qb + 6;
    for (int t = 0; t < NT; ++t) {
        if (t == 1) continue;
        __syncthreads();
        { const int r = tid >> 3, ch = tid & 7; const size_t g = ((size_t)b * KROWS + 64 * t + r) * AWID + h * 64 + ch * 8;
          *(LAS v4u*)(Ks + r * 64 + ch * 8) = *(const v4u*)(KA + g); *(LAS v4u*)(Vs + r * 64 + ch * 8) = *(const v4u*)(VA + g);
          if (tid < 64) cks[tid] = CL[64 * t + tid]; }
        __syncthreads();
        const int smax = (t == 0) ? 16 : 64;
        for (int s = p; s < smax; s += 2) {
            const int kp = 64 * t + s;
            if (t >= 2 && kp > qp) continue;
            float dot = 0.f;
#pragma unroll
            for (int c = 0; c < 8; ++c) { const v4u w = *(const LAS v4u*)(Ks + s * 64 + 8 * c);
                dot += q[8 * c + 0] * blo(w.x) + q[8 * c + 1] * bhi(w.x) + q[8 * c + 2] * blo(w.y) + q[8 * c + 3] * bhi(w.y) + q[8 * c + 4] * blo(w.z) + q[8 * c + 5] * bhi(w.z) + q[8 * c + 6] * blo(w.w) + q[8 * c + 7] * bhi(w.w); }
            const float sc = dot + (clq - cks[s]);
            const float mn = fmaxf(mx, sc), al = ex2(mx - mn), pp = ex2(sc - mn);
            l = l * al + pp; mx = mn;
#pragma unroll
            for (int c = 0; c < 8; ++c) { const v4u w = *(const LAS v4u*)(Vs + s * 64 + 8 * c);
                o[8 * c + 0] = o[8 * c + 0] * al + pp * blo(w.x); o[8 * c + 1] = o[8 * c + 1] * al + pp * bhi(w.x); o[8 * c + 2] = o[8 * c + 2] * al + pp * blo(w.y); o[8 * c + 3] = o[8 * c + 3] * al + pp * bhi(w.y);
                o[8 * c + 4] = o[8 * c + 4] * al + pp * blo(w.z); o[8 * c + 5] = o[8 * c + 5] * al + pp * bhi(w.z); o[8 * c + 6] = o[8 * c + 6] * al + pp * blo(w.w); o[8 * c + 7] = o[8 * c + 7] * al + pp * bhi(w.w); }
        }
    }
    __syncthreads();
    if (p == 1) { cmb[row * 66 + 0] = mx; cmb[row * 66 + 1] = l;
#pragma unroll
        for (int d = 0; d < 64; ++d) cmb[row * 66 + 2 + d] = o[d]; }
    __syncthreads();
    if (p == 0) { const float m1 = cmb[row * 66 + 0], l1 = cmb[row * 66 + 1]; const float mn = fmaxf(mx, m1), a0 = ex2(mx - mn), a1 = ex2(m1 - mn); const float inv = 1.0f / (l * a0 + l1 * a1);
#pragma unroll
        for (int c = 0; c < 8; ++c) { float r8[8];
#pragma unroll
            for (int e = 0; e < 8; ++e) r8[e] = (o[8 * c + e] * a0 + cmb[row * 66 + 2 + 8 * c + e] * a1) * inv;
            v4u w; w.x = pk2(r8[0], r8[1]); w.y = pk2(r8[2], r8[3]); w.z = pk2(r8[4], r8[5]); w.w = pk2(r8[6], r8[7]);
            *(v4u*)(OA + qrow * AWID + h * 64 + 8 * c) = w; } }
    __syncthreads();
}

__device__ __forceinline__ void hgrn_a_simple(Frame& F, int item) {
    const int bh = item / NCH, c = item % NCH, b = bh >> 3, h = bh & 7, tid = F.tid;
    const bf16* KD = (const bf16*)(F.ws + WS_KD); const bf16* VH = (const bf16*)(F.ws + WS_VH); bf16* US = (bf16*)(F.ws + WS_US);
    LAS float* KDs = (LAS float*)(F.lds + RING_OFF); LAS float* Vs = KDs + 8192;
    __syncthreads();
    { const int r = tid >> 3, cc = (tid & 7) * 16; const size_t g = ((size_t)b * HROWS + 64 * c + r) * DM + h * 128 + cc;
#pragma unroll
      for (int q2 = 0; q2 < 2; ++q2) { const v4u a = *(const v4u*)(KD + g + 8 * q2), v = *(const v4u*)(VH + g + 8 * q2); LAS float* kd = KDs + r * 128 + cc + 8 * q2; LAS float* vs = Vs + r * 128 + cc + 8 * q2;
          kd[0] = blo(a.x); kd[1] = bhi(a.x); kd[2] = blo(a.y); kd[3] = bhi(a.y); kd[4] = blo(a.z); kd[5] = bhi(a.z); kd[6] = blo(a.w); kd[7] = bhi(a.w);
          vs[0] = blo(v.x); vs[1] = bhi(v.x); vs[2] = blo(v.y); vs[3] = bhi(v.y); vs[4] = blo(v.z); vs[5] = bhi(v.z); vs[6] = blo(v.w); vs[7] = bhi(v.w); } }
    __syncthreads();
    const int k = tid >> 2, vg = (tid & 3) * 32;
    float acc[32];
#pragma unroll
    for (int j = 0; j < 32; ++j) acc[j] = 0.f;
    for (int s = 0; s < 64; ++s) { const float kd = KDs[s * 128 + k];
#pragma unroll
        for (int j4 = 0; j4 < 8; ++j4) { const f32x4 v = *(const LAS f32x4*)(Vs + s * 128 + vg + 4 * j4); acc[4 * j4 + 0] += kd * v.x; acc[4 * j4 + 1] += kd * v.y; acc[4 * j4 + 2] += kd * v.z; acc[4 * j4 + 3] += kd * v.w; } }
    bf16* dst = US + (size_t)item * (HK * HV) + k * 128 + vg;
#pragma unroll
    for (int j8 = 0; j8 < 4; ++j8) { v4u w; w.x = pk2(acc[8 * j8 + 0], acc[8 * j8 + 1]); w.y = pk2(acc[8 * j8 + 2], acc[8 * j8 + 3]); w.z = pk2(acc[8 * j8 + 4], acc[8 * j8 + 5]); w.w = pk2(acc[8 * j8 + 6], acc[8 * j8 + 7]); *(v4u*)(dst + 8 * j8) = w; }
}
__device__ __forceinline__ void hgrn_scan(Frame& F) {
    const bf16* EB = (const bf16*)(F.ws + WS_EB); bf16* US = (bf16*)(F.ws + WS_US);
    for (int idx = blockIdx.x * (NWAVES * 64) + F.tid; idx < 16 * 128 * 64; idx += F.G * NWAVES * 64) {
        const int bh = idx >> 13, rem = idx & 8191, k = rem >> 6, vp = rem & 63, b = bh >> 3, h = bh & 7;
        unsigned* base = (unsigned*)(US + (size_t)bh * NCH * (HK * HV) + k * 128) + vp;
        unsigned w = base[0]; float s0 = blo(w), s1 = bhi(w);
        for (int c = 1; c < NCH - 1; ++c) {
            const float a = bf2f(EB[((size_t)b * SEQ + 64 * (c - 1) + 63) * DM + h * 128 + k]);
            const unsigned uw = base[(size_t)c * (HK * HV / 2)];
            s0 = a * s0 + blo(uw); s1 = a * s1 + bhi(uw);
            base[(size_t)c * (HK * HV / 2)] = pk2(s0, s1);
        }
    }
}
__device__ __forceinline__ void hgrn_c_simple(Frame& F, int item) {
    const int bh = item >> 7, c = (item & 127) + 1, b = bh >> 3, h = bh & 7, tid = F.tid;
    const bf16* QH = (const bf16*)(F.ws + WS_QH); const bf16* EB = (const bf16*)(F.ws + WS_EB); const bf16* KT = (const bf16*)(F.ws + WS_KT); const bf16* VH = (const bf16*)(F.ws + WS_VH);
    const bf16* GH = (const bf16*)(F.ws + WS_GH); const bf16* US = (const bf16*)(F.ws + WS_US); bf16* OH = (bf16*)(F.ws + WS_OH); const float* hnw = F.in[6];
    LAS float* QE = (LAS float*)(F.lds + RING_OFF); LAS float* KTs = QE + 8192; LAS bf16* Ss = (LAS bf16*)(F.lds + RING_OFF + 65536); LAS bf16* Vs = (LAS bf16*)(F.lds + RING_OFF + 98304); LAS float* SC = (LAS float*)(F.lds + RING_OFF + 114688);
    const size_t r0 = (size_t)b * SEQ + 64 * (c - 1);
    __syncthreads();
    { const int r = tid >> 3, cc = (tid & 7) * 16; const size_t g = (r0 + r) * DM + h * 128 + cc; const size_t gv = ((size_t)b * HROWS + 64 * c + r) * DM + h * 128 + cc;
#pragma unroll
      for (int q2 = 0; q2 < 2; ++q2) { const v4u a = *(const v4u*)(QH + g + 8 * q2), e = *(const v4u*)(EB + g + 8 * q2), kt = *(const v4u*)(KT + g + 8 * q2);
          LAS float* qe = QE + r * 128 + cc + 8 * q2; LAS float* ks = KTs + r * 128 + cc + 8 * q2;
          qe[0] = blo(a.x) * blo(e.x); qe[1] = bhi(a.x) * bhi(e.x); qe[2] = blo(a.y) * blo(e.y); qe[3] = bhi(a.y) * bhi(e.y); qe[4] = blo(a.z) * blo(e.z); qe[5] = bhi(a.z) * bhi(e.z); qe[6] = blo(a.w) * blo(e.w); qe[7] = bhi(a.w) * bhi(e.w);
          ks[0] = blo(kt.x); ks[1] = bhi(kt.x); ks[2] = blo(kt.y); ks[3] = bhi(kt.y); ks[4] = blo(kt.z); ks[5] = bhi(kt.z); ks[6] = blo(kt.w); ks[7] = bhi(kt.w);
          *(LAS v4u*)(Vs + r * 128 + cc + 8 * q2) = *(const v4u*)(VH + gv + 8 * q2); }
      const bf16* sp = US + ((size_t)bh * NCH + (c - 1)) * (HK * HV);
#pragma unroll
      for (int i = 0; i < 4; ++i) *(LAS v4u*)(Ss + (tid + 512 * i) * 8) = *(const v4u*)(sp + (tid + 512 * i) * 8); }
    __syncthreads();
    const int t = tid >> 3, g8 = tid & 7;
#pragma unroll
    for (int j = 0; j < 8; ++j) { const int s = g8 * 8 + j; float d = 0.f;
        if (s <= t) { for (int k = 0; k < 128; k += 4) { const f32x4 a = *(const LAS f32x4*)(QE + t * 128 + k), kb = *(const LAS f32x4*)(KTs + s * 128 + k); d += (a.x * kb.x + a.y * kb.y) + (a.z * kb.z + a.w * kb.w); } }
        SC[t * 64 + s] = d; }
    __syncthreads();
    const int v0 = g8 * 16;
    float o[16];
#pragma unroll
    for (int j = 0; j < 16; ++j) o[j] = 0.f;
    for (int s = 0; s <= t; ++s) { const float sc = SC[t * 64 + s]; const v4u w0 = *(const LAS v4u*)(Vs + s * 128 + v0), w1 = *(const LAS v4u*)(Vs + s * 128 + v0 + 8);
        o[0] += sc * blo(w0.x); o[1] += sc * bhi(w0.x); o[2] += sc * blo(w0.y); o[3] += sc * bhi(w0.y); o[4] += sc * blo(w0.z); o[5] += sc * bhi(w0.z); o[6] += sc * blo(w0.w); o[7] += sc * bhi(w0.w);
        o[8] += sc * blo(w1.x); o[9] += sc * bhi(w1.x); o[10] += sc * blo(w1.y); o[11] += sc * bhi(w1.y); o[12] += sc * blo(w1.z); o[13] += sc * bhi(w1.z); o[14] += sc * blo(w1.w); o[15] += sc * bhi(w1.w); }
    for (int k = 0; k < 128; ++k) { const float qe = QE[t * 128 + k]; const v4u w0 = *(const LAS v4u*)(Ss + k * 128 + v0), w1 = *(const LAS v4u*)(Ss + k * 128 + v0 + 8);
        o[0] += qe * blo(w0.x); o[1] += qe * bhi(w0.x); o[2] += qe * blo(w0.y); o[3] += qe * bhi(w0.y); o[4] += qe * blo(w0.z); o[5] += qe * bhi(w0.z); o[6] += qe * blo(w0.w); o[7] += qe * bhi(w0.w);
        o[8] += qe * blo(w1.x); o[9] += qe * bhi(w1.x); o[10] += qe * blo(w1.y); o[11] += qe * bhi(w1.y); o[12] += qe * blo(w1.z); o[13] += qe * bhi(w1.z); o[14] += qe * blo(w1.w); o[15] += qe * bhi(w1.w); }
    float ss = 0.f;
#pragma unroll
    for (int j = 0; j < 16; ++j) ss += o[j] * o[j];
    ss += __shfl_xor(ss, 1); ss += __shfl_xor(ss, 2); ss += __shfl_xor(ss, 4);
    const float rs = 1.0f / sqrtf(ss * (1.0f / HV) + EPS);
    const size_t go = (r0 + t) * DM + h * 128 + v0;
    const v4u g0 = *(const v4u*)(GH + go), g1 = *(const v4u*)(GH + go + 8);
    float gg[16] = {blo(g0.x), bhi(g0.x), blo(g0.y), bhi(g0.y), blo(g0.z), bhi(g0.z), blo(g0.w), bhi(g0.w), blo(g1.x), bhi(g1.x), blo(g1.y), bhi(g1.y), blo(g1.z), bhi(g1.z), blo(g1.w), bhi(g1.w)};
    float y[16];
#pragma unroll
    for (int j = 0; j < 16; ++j) y[j] = o[j] * rs * hnw[v0 + j] * gg[j];
    v4u w; w.x = pk2(y[0], y[1]); w.y = pk2(y[2], y[3]); w.z = pk2(y[4], y[5]); w.w = pk2(y[6], y[7]); *(v4u*)(OH + go) = w;
    w.x = pk2(y[8], y[9]); w.y = pk2(y[10], y[11]); w.z = pk2(y[12], y[13]); w.w = pk2(y[14], y[15]); *(v4u*)(OH + go + 8) = w;
}

__device__ __forceinline__ void p7_router(Frame& F) {
    const float* h1 = F.out; const float* nfw = F.in[10]; const float* wrg = F.in[11]; const float* brg = F.in[12]; const float* wre = F.in[13]; const float* bre = F.in[14];
    bf16* XN = (bf16*)(F.ws + WS_XN); unsigned* ASG = (unsigned*)(F.ws + WS_ASG); float* GATE = (float*)(F.ws + WS_GATE);
    LAS float* T = (LAS float*)(F.lds + RING_OFF);
    for (int rb = F.vcu; rb < MR / 32; rb += F.G) {
        const int rowb = rb * 32 + F.wave * 4;
        float acc[4][36]; float ss[4];
#pragma unroll
        for (int r = 0; r < 4; ++r) { ss[r] = 0.f;
#pragma unroll
            for (int j = 0; j < 36; ++j) acc[r][j] = 0.f; }
        for (int q = 0; q < 4; ++q) {
            __syncthreads();
            for (int i = F.tid; i < 36 * 256; i += NWAVES * 64) { const int kk = i / 36, j = i % 36, k = 256 * q + kk;
                T[j * 256 + kk] = nfw[k] * (j < 4 ? wrg[k * 4 + j] : wre[k * 32 + (j - 4)]); }
            __syncthreads();
            f32x4 x[4];
#pragma unroll
            for (int r = 0; r < 4; ++r) { x[r] = *(const f32x4*)(h1 + (size_t)(rowb + r) * DM + 256 * q + 4 * F.lane); ss[r] += (x[r].x * x[r].x + x[r].y * x[r].y) + (x[r].z * x[r].z + x[r].w * x[r].w); }
#pragma unroll
            for (int j = 0; j < 36; ++j) { const f32x4 w = *(const LAS f32x4*)(T + j * 256 + 4 * F.lane);
#pragma unroll
                for (int r = 0; r < 4; ++r) acc[r][j] += (x[r].x * w.x + x[r].y * w.y) + (x[r].z * w.z + x[r].w * w.w); }
        }
#pragma unroll
        for (int r = 0; r < 4; ++r) {
            const int row = rowb + r;
            const float rs = 1.0f / sqrtf(wave_sum(ss[r]) * (1.0f / DM) + EPS);
            float lg[36];
#pragma unroll
            for (int j = 0; j < 36; ++j) lg[j] = wave_sum(acc[r][j]) * rs + (j < 4 ? brg[j] : bre[j - 4]);
            { GAS unsigned long long* o8 = (GAS unsigned long long*)(XN + (size_t)row * DM) + F.lane;
#pragma unroll
              for (int j = 0; j < 4; ++j) { const f32x4 v = *(const f32x4*)(h1 + (size_t)row * DM + 4 * F.lane + 256 * j); const f32x4 w = *(const f32x4*)(nfw + 4 * F.lane + 256 * j); const f32x4 u = v * rs * w;
                  o8[64 * j] = (unsigned long long)pk2(u.x, u.y) | ((unsigned long long)pk2(u.z, u.w) << 32); } }
            int g = 0; float gm = lg[0];
#pragma unroll
            for (int j = 1; j < 4; ++j) if (lg[j] > gm) { gm = lg[j]; g = j; }
            float gs = 0.f;
#pragma unroll
            for (int j = 0; j < 4; ++j) gs += __expf(lg[j] - gm);
            const float pg = 1.0f / gs;
            float es[8];
#pragma unroll
            for (int i = 0; i < 8; ++i) es[i] = (g == 0) ? lg[4 + i] : (g == 1) ? lg[12 + i] : (g == 2) ? lg[20 + i] : lg[28 + i];
            int i1 = 0; float v1 = es[0];
#pragma unroll
            for (int i = 1; i < 8; ++i) if (es[i] > v1) { v1 = es[i]; i1 = i; }
            int i2 = -1; float v2 = -3.0e38f;
#pragma unroll
            for (int i = 0; i < 8; ++i) if (i != i1 && es[i] > v2) { v2 = es[i]; i2 = i; }
            const float s1 = 1.0f / (1.0f + __expf(v2 - v1));
            if (F.lane == 0) {
                const unsigned e1 = (unsigned)(g * 8 + i1), e2 = (unsigned)(g * 8 + i2);
                const unsigned p1 = __hip_atomic_fetch_add((unsigned*)(F.ctl + CW_CNT + e1), 1u, RLX_AGENT), p2 = __hip_atomic_fetch_add((unsigned*)(F.ctl + CW_CNT + e2), 1u, RLX_AGENT);
                ASG[2 * row] = (e1 << 16) | p1; ASG[2 * row + 1] = (e2 << 16) | p2; GATE[2 * row] = pg * s1; GATE[2 * row + 1] = pg * (1.0f - s1);
            }
        }
    }
    __syncthreads();
}
__device__ __forceinline__ void p8_permute(Frame& F) {
    LAS unsigned* pst = (LAS unsigned*)(F.lds + RING_OFF);
    if (F.wave == 0) {
        const unsigned cnt = F.lane < NE ? ald((const unsigned*)(F.ctl + CW_CNT + F.lane)) : 0u; const unsigned nt = (cnt + 255u) >> 8;
        unsigned inc = nt;
#pragma unroll
        for (int o = 1; o < 64; o <<= 1) { const unsigned t = __shfl_up(inc, o); if (F.lane >= o) inc += t; }
        const unsigned excl = inc - nt;
        if (F.lane < NE) pst[F.lane] = excl * 256u;
        if (blockIdx.x == 0) {
            if (F.lane == NE - 1) __hip_atomic_store((unsigned*)(F.ctl + CW_NT), inc, RLX_AGENT);
            if (F.lane < NE) for (unsigned t = 0; t < nt; ++t) __hip_atomic_store((unsigned*)(F.ctl + CW_TILEE + excl + t), (unsigned)F.lane, RLX_AGENT);
        }
    }
    __syncthreads();
    const unsigned* ASG = (const unsigned*)(F.ws + WS_ASG); unsigned* SLOT = (unsigned*)(F.ws + WS_SLOT); const bf16* XN = (const bf16*)(F.ws + WS_XN); bf16* XS = (bf16*)(F.ws + WS_XS);
    const int gw = F.vcu * NWAVES + F.wave, NGW = F.G * NWAVES;
    for (int a = gw; a < 2 * MR; a += NGW) {
        const unsigned w = ald(ASG + a); const unsigned e = w >> 16, pos = w & 0xffffu; const unsigned slot = pst[e] + pos;
        if (F.lane == 0) SLOT[a] = slot;
        const v4u* src = (const v4u*)(XN + (size_t)(a >> 1) * DM); v4u* dst = (v4u*)(XS + (size_t)slot * DM);
        dst[F.lane] = src[F.lane]; dst[64 + F.lane] = src[64 + F.lane];
    }
    __syncthreads();
}
__device__ __forceinline__ void p11_final(Frame& F) {
    const unsigned* SLOT = (const unsigned*)(F.ws + WS_SLOT); const float* GATE = (const float*)(F.ws + WS_GATE); const bf16* Y = (const bf16*)(F.ws + WS_Y); const float* fw = F.in[17];
    const int gw = F.vcu * NWAVES + F.wave, NGW = F.G * NWAVES;
    for (int m = gw; m < MR; m += NGW) {
        const unsigned s0 = ald(SLOT + 2 * m), s1 = ald(SLOT + 2 * m + 1); const float g0 = aldf(GATE + 2 * m), g1 = aldf(GATE + 2 * m + 1);
        f32x4 v[4]; float ss = 0.f;
#pragma unroll
        for (int j = 0; j < 4; ++j) { v[j] = *(const f32x4*)(F.out + (size_t)m * DM + 4 * F.lane + 256 * j);
            const v2u y0 = *(const v2u*)(Y + (size_t)s0 * DM + 4 * F.lane + 256 * j), y1 = *(const v2u*)(Y + (size_t)s1 * DM + 4 * F.lane + 256 * j);
            v[j].x += g0 * blo(y0.x) + g1 * blo(y1.x); v[j].y += g0 * bhi(y0.x) + g1 * bhi(y1.x); v[j].z += g0 * blo(y0.y) + g1 * blo(y1.y); v[j].w += g0 * bhi(y0.y) + g1 * bhi(y1.y);
            ss += (v[j].x * v[j].x + v[j].y * v[j].y) + (v[j].z * v[j].z + v[j].w * v[j].w); }
        const float rs = 1.0f / sqrtf(wave_sum(ss) * (1.0f / DM) + EPS);
#pragma unroll
        for (int j = 0; j < 4; ++j) { const f32x4 w = *(const f32x4*)(fw + 4 * F.lane + 256 * j); *(f32x4*)(F.out + (size_t)m * DM + 4 * F.lane + 256 * j) = v[j] * rs * w; }
    }
}

struct Args { const float* in[18]; float* out; unsigned char* ws; int ph_lo, ph_hi, li, pad; };
__global__ void __launch_bounds__(NWAVES * 64, 2) fwd(Args args) {
    extern __shared__ __attribute__((aligned(16))) unsigned char lds[];
    Frame F;
    F.lds = (LAS unsigned char*)lds;
    F.MISC = (volatile LAS unsigned*)(F.lds + MISC_OFF);
    F.tid = threadIdx.x; F.lane = F.tid & 63; F.wave = __builtin_amdgcn_readfirstlane(F.tid >> 6);
    F.G = gridDim.x; { const int bx = blockIdx.x; F.vcu = (F.G % 8 == 0) ? (bx % 8) * (F.G / 8) + bx / 8 : bx; }
    F.ws = args.ws; F.ctl = (gu32*)(args.ws + WS_CTL); F.out = args.out;
#pragma unroll
    for (int i = 0; i < 18; ++i) F.in[i] = args.in[i];
    for (int u = F.tid; u < (LDS_BYTES - LDSCTL_OFF) / 4; u += NWAVES * 64) ((LAS unsigned*)(F.lds + LDSCTL_OFF))[u] = 0u;
    __syncthreads();
    const int bli = (N_LAUNCHES == NPHASE) ? 0 : args.li;
    XcdBarrier bar; bar.bar = (unsigned*)(F.ctl + CW_BAR) + bli * XCD_BAR_WORDS; bar.x = 0; bar.st = nullptr;
    if (N_LAUNCHES != NPHASE) bar = xcd_barrier_post((unsigned*)(F.ctl + CW_BAR) + bli * XCD_BAR_WORDS, F.MISC + 8);
#define GRID_BAR(seam) do { if (N_LAUNCHES == NPHASE) { if (F.tid == 0) __hip_atomic_store(F.ctl + CW_TMO, 0xBADBA0u | (unsigned)(seam), RLX_AGENT); } else { xcd_barrier(bar); } } while (0)
    const int lo = args.ph_lo, hi = args.ph_hi;
#define IN(k) (lo <= (k) && (k) < hi)
#define BOTH(k) (IN(k) && IN((k) + 1))
    unsigned char* ws = args.ws;

    if (IN(0)) {
        if (F.vcu < 7) p0_meta(F);
        p0_rows(F);
        p0_weights(F);
        if (BOTH(0)) GRID_BAR(0);
    }
    if (IN(1)) {
        pg8::Gemm g{(const bf16*)(ws + WS_U), (const bf16*)(ws + WS_WIN), MR, NPROJ, DM, 0};
        pg8::StaticOrder S; S.init(MR, NPROJ, F.G, (int)blockIdx.x);
        pg8::EpiProj E{(bf16*)(ws + WS_QA), (bf16*)(ws + WS_KA), (bf16*)(ws + WS_VA), (bf16*)(ws + WS_QH), (bf16*)(ws + WS_EB), (bf16*)(ws + WS_KT), (bf16*)(ws + WS_KD), (bf16*)(ws + WS_VH),
                       (bf16*)(ws + WS_GH), (bf16*)(ws + WS_GA), (bf16*)(ws + WS_GT), F.in[5]};
        pg8::gemm_phase<pg8::EpiProj, pg8::StaticOrder, true, true>(F.lds + RING_OFF, g, S, E);
        __syncthreads();
        for (int bh = blockIdx.x; bh < 16; bh += F.G) p1_cumsum(F, bh);
        if (BOTH(1)) GRID_BAR(1);
    }
    if (IN(2)) {
        for (int pid = F.vcu; pid < 256; pid += F.G) { const int bh = pid >> 4, s = pid & 15; attn_simple_unit(F, bh, s); attn_simple_unit(F, bh, 31 - s); }
        for (int it = F.vcu; it < 16 * NCH; it += F.G) hgrn_a_simple(F, it);
        if (BOTH(2)) GRID_BAR(2);
    }
    if (IN(3)) { hgrn_scan(F); if (BOTH(3)) GRID_BAR(3); }
    if (IN(4)) {
        for (int it = F.vcu; it < 16 * 128; it += F.G) hgrn_c_simple(F, it);
        if (BOTH(4)) GRID_BAR(4);
    }
    if (IN(5)) {
        { pg8::Gemm g{(const bf16*)(ws + WS_OA), (const bf16*)(ws + WS_WA), MR, DM, AWID, 0}; pg8::StaticOrder S; S.init(MR, DM, F.G, (int)blockIdx.x);
          pg8::EpiYa E{(const bf16*)(ws + WS_GA), (float*)(ws + WS_YA)};
          pg8::gemm_phase<pg8::EpiYa, pg8::StaticOrder, true, true>(F.lds + RING_OFF, g, S, E); }
        __syncthreads();
        { pg8::Gemm g{(const bf16*)(ws + WS_OH), (const bf16*)(ws + WS_WH), MR, DM, DM, 0}; pg8::StaticOrder S; S.init(MR, DM, F.G, (int)blockIdx.x);
          pg8::EpiMixed E{(const bf16*)(ws + WS_GT), (const float*)(ws + WS_YA), (bf16*)(ws + WS_MIX)};
          pg8::gemm_phase<pg8::EpiMixed, pg8::StaticOrder, true, true>(F.lds + RING_OFF, g, S, E); }
        if (BOTH(5)) GRID_BAR(5);
    }
    if (IN(6)) {
        pg8::Gemm g{(const bf16*)(ws + WS_MIX), (const bf16*)(ws + WS_WO), MR, DM, DM, 0}; pg8::StaticOrder S; S.init(MR, DM, F.G, (int)blockIdx.x);
        pg8::EpiRes E{F.in[0], F.out};
        pg8::gemm_phase<pg8::EpiRes, pg8::StaticOrder, true, true>(F.lds + RING_OFF, g, S, E);
        if (BOTH(6)) GRID_BAR(6);
    }
    if (IN(7)) { p7_router(F); p7_expert_weights(F); if (BOTH(7)) GRID_BAR(7); }
    if (IN(8)) { p8_permute(F); if (BOTH(8)) GRID_BAR(8); }
    if (IN(9)) {
        const int ntile = (int)__builtin_amdgcn_readfirstlane(ald((const unsigned*)(F.ctl + CW_NT)));
        pg8::Gemm g{(const bf16*)(ws + WS_XS), (const bf16*)(ws + WS_WE1), APAD, DM, DM, (size_t)DM * DM * 2};
        pg8::MoeOrder S{ntile * 4, F.G, F.vcu, (const unsigned*)(F.ctl + CW_TILEE)};
        pg8::EpiSwiglu E{(bf16*)(ws + WS_ACT)};
        pg8::gemm_phase<pg8::EpiSwiglu, pg8::MoeOrder, true, true>(F.lds + RING_OFF, g, S, E);
        if (BOTH(9)) GRID_BAR(9);
    }
    if (IN(10)) {
        const int ntile = (int)__builtin_amdgcn_readfirstlane(ald((const unsigned*)(F.ctl + CW_NT)));
        pg8::Gemm g{(const bf16*)(ws + WS_ACT), (const bf16*)(ws + WS_WE2), APAD, DM, EFF, (size_t)DM * EFF * 2};
        pg8::MoeOrder S{ntile * 4, F.G, F.vcu, (const unsigned*)(F.ctl + CW_TILEE)};
        pg8::EpiPlain E{(bf16*)(ws + WS_Y), DM};
        pg8::gemm_phase<pg8::EpiPlain, pg8::MoeOrder, true, true>(F.lds + RING_OFF, g, S, E);
        if (BOTH(10)) GRID_BAR(10);
    }
    if (IN(11)) { p11_final(F); }
#undef IN
#undef BOTH
}

extern "C" void kernel_launch(void* const* d_in, const int* in_sizes, int n_in, void* d_out, int out_size, void* d_ws, size_t ws_size, hipStream_t stream) {
    static int grid = 0;
    if (grid == 0) {
        if (n_in != 18 || in_sizes[0] != MR * DM || out_size != MR * DM || ws_size < WS_END) {
            fprintf(stderr, "kernel_launch: unexpected problem: n_in %d in0 %d out %d ws %zu (need %zu); nothing launched\n", n_in, n_in > 0 ? in_sizes[0] : -1, out_size, ws_size, (size_t)WS_END); grid = -1; return; }
        int dev = 0, cus = 0, per_cu = 0;
        if (hipGetDevice(&dev) != hipSuccess || hipDeviceGetAttribute(&cus, hipDeviceAttributeMultiprocessorCount, dev) != hipSuccess) { grid = -1; return; }
        if (hipFuncSetAttribute((const void*)fwd, hipFuncAttributeMaxDynamicSharedMemorySize, LDS_BYTES) != hipSuccess) { fprintf(stderr, "kernel_launch: hipFuncSetAttribute failed\n"); grid = -1; return; }
        if (hipOccupancyMaxActiveBlocksPerMultiprocessor(&per_cu, (const void*)fwd, NWAVES * 64, LDS_BYTES) != hipSuccess || per_cu < 1)
            fprintf(stderr, "kernel_launch: note: occupancy query reports %d workgroups per CU\n", per_cu);
        (void)hipGetLastError();
        grid = cus;
    }
    if (grid < 0) return;
    if (hipMemsetAsync((char*)d_ws + WS_CTL, 0, CTL_ZERO_BYTES, stream) != hipSuccess) { fprintf(stderr, "kernel_launch: memset failed\n"); return; }
    Args a{};
    for (int i = 0; i < 18; ++i) a.in[i] = (const float*)d_in[i];
    a.out = (float*)d_out; a.ws = (unsigned char*)d_ws;
    for (int li = 0; li < N_LAUNCHES; ++li) {
        if (N_LAUNCHES == NPHASE) { a.ph_lo = li; a.ph_hi = li + 1; } else { a.ph_lo = 0; a.ph_hi = NPHASE; }
        a.li = li;
        hipLaunchKernelGGL(fwd, dim3(grid), dim3(NWAVES * 64), LDS_BYTES, stream, a);
        const hipError_t le = hipPeekAtLastError();
        if (le != hipSuccess) { fprintf(stderr, "kernel_launch: launch %d failed: %s\n", li, hipGetErrorName(le)); break; }
    }
}
```

```cpp
#include <hip/hip_runtime.h>
#include <hip/hip_bf16.h>
#include <cmath>
#include <cstdio>
#include <cstdint>

#ifndef MK_N_LAUNCHES
#define MK_N_LAUNCHES 1
#endif

namespace pg8 {
#define PG8_LAS __attribute__((address_space(3)))
typedef unsigned short bf16_t;
typedef short bf16x8 __attribute__((ext_vector_type(8)));
typedef float f32x4 __attribute__((ext_vector_type(4)));
typedef unsigned u32x4 __attribute__((ext_vector_type(4)));
typedef unsigned u32x2 __attribute__((ext_vector_type(2)));
constexpr int BM = 256, BK = 64, HALF = 128, HTB = HALF * BK * 2  , STAGE_BYTES = 8 * HTB, NXCD = 8, WGM = 8;

__host__ __device__ __forceinline__ int lds_byte(int r, int c) { const int st = (r >> 4) * 2 + (c >> 5), rr = r & 15, cc = c & 31, ob = rr * 64 + cc * 2; return st * 1024 + (ob ^ (((ob >> 9) & 1) << 5)); }
__host__ __device__ __forceinline__ void stage_rc(int b, int& R, int& C) { const int st = b / 1024, sb = b % 1024, swz = sb ^ (((sb >> 9) & 1) << 5); R = (st >> 1) * 16 + swz / 64; C = (st & 1) * 32 + (swz % 64) / 2; }
__host__ __device__ __forceinline__ int perm32(int rho) { const int n = rho >> 4, i = rho & 15; return 8 * (i >> 2) + 4 * n + (i & 3); }

struct Unit { int pm, pn, e; };
struct Gemm { const bf16_t* A; const bf16_t* Bt; int M, N, K; size_t bexp; };

struct StaticOrder {
    int nM, nN, nwg, G, c;
    __host__ __device__ void init(int M, int N, int G_, int c_) { nM = M / BM; nN = N / BM; nwg = nM * nN; G = G_; c = c_; }
    __host__ __device__ bool next(int i, Unit& u) const {
        const long L = (long)i * G + c; if (L >= nwg) return false;
        int wgid = (int)L; { const int q = nwg / NXCD, r = nwg % NXCD, xcd = wgid % NXCD, off = wgid / NXCD; wgid = (xcd < r ? xcd * (q + 1) : r * (q + 1) + (xcd - r) * q) + off; }
        const int nig = WGM * nN, gid = wgid / nig, fm = gid * WGM, gsz = (nM - fm) < WGM ? (nM - fm) : WGM;
        u.pm = fm + ((wgid % nig) % gsz); u.pn = (wgid % nig) / gsz; u.e = 0; return true;
    }
    __device__ __forceinline__ void a_ready(const Unit&) const {}
    __device__ __forceinline__ void done(const Unit&) const {}
};
struct MoeOrder {
    int ntu, G, c; const unsigned* tile_e;
    __device__ bool next(int i, Unit& u) const {
        const long L = (long)i * G + c; if (L >= ntu) return false;
        u.pm = (int)(L >> 2); u.pn = (int)(L & 3);
        u.e = (int)__builtin_amdgcn_readfirstlane(__hip_atomic_load(tile_e + u.pm, __ATOMIC_RELAXED, __HIP_MEMORY_SCOPE_AGENT)); return true;
    }
    __device__ __forceinline__ void a_ready(const Unit&) const {}
    __device__ __forceinline__ void done(const Unit&) const {}
};

__device__ __forceinline__ unsigned cvt_pk_bf16(float lo, float hi) { unsigned r; asm volatile("v_cvt_pk_bf16_f32 %0, %1, %2" : "=v"(r) : "v"(lo), "v"(hi)); return r; }
__device__ __forceinline__ float fsig(float x) { return __builtin_amdgcn_rcpf(1.0f + __builtin_amdgcn_exp2f(-1.4426950408889634f * x)); }
__device__ __forceinline__ float bflo(unsigned w) { return __builtin_bit_cast(float, w << 16); }
__device__ __forceinline__ float bfhi(unsigned w) { return __builtin_bit_cast(float, w & 0xffff0000u); }
__device__ __forceinline__ float dpp_shr(float v, int) { return v; }
#define PG8_SCAN16(v) do { \
    v += __builtin_bit_cast(float, __builtin_amdgcn_update_dpp(0, __builtin_bit_cast(int, v), 0x111, 0xf, 0xf, true)); \
    v += __builtin_bit_cast(float, __builtin_amdgcn_update_dpp(0, __builtin_bit_cast(int, v), 0x112, 0xf, 0xf, true)); \
    v += __builtin_bit_cast(float, __builtin_amdgcn_update_dpp(0, __builtin_bit_cast(int, v), 0x114, 0xf, 0xf, true)); \
    v += __builtin_bit_cast(float, __builtin_amdgcn_update_dpp(0, __builtin_bit_cast(int, v), 0x118, 0xf, 0xf, true)); } while (0)

constexpr float ATT_C2 = 0.125f * 1.4426950408889634f;
constexpr float HG_QS = 0.08838834764831845f;

struct EpiProj {
    static constexpr bool PERM = true, AFTER_DRAIN = false;
    bf16_t *QA, *KA, *VA, *QH, *EB, *KT, *KD, *VH, *GH, *GA, *GT; const float* lbl;
    __device__ __forceinline__ void operator()(const f32x4 (&acc)[2][2][4][2], const Unit& u, int wr, int wc, int fr, int fq) const {
        const int pn = u.pn, b = u.pm >> 5;
        const int cofs = wc * 32 + 8 * fq;
        const int row0 = u.pm * BM + wr * 64 + fr;
        if (pn >= 10 && pn < 14) {
            const int colbase = 256 * (pn - 10), lane = fq * 16 + fr, srcl = (lane & 48) | 15;
#pragma unroll
            for (int ai = 0; ai < 2; ++ai)
#pragma unroll
                for (int bj = 0; bj < 2; ++bj)
#pragma unroll
                    for (int n = 0; n < 2; ++n) {
                        const int c0 = colbase + 128 * bj + cofs + 4 * n;
                        const f32x4 l0 = *(const f32x4*)(lbl + c0), l1 = *(const f32x4*)(lbl + 1024 + c0);
                        float eb[4][4], kt[4][4], kd[4][4];
#pragma unroll
                        for (int e = 0; e < 4; ++e) {
                            const float lb = __builtin_amdgcn_rcpf(1.0f + __builtin_amdgcn_exp2f((l1[e] - l0[e]) * 1.4426950408889634f));
                            float lf[4], kk[4];
#pragma unroll
                            for (int m = 0; m < 4; ++m) { const float f = lb + (1.0f - lb) * fsig(acc[ai][bj][m][n][e]); kk[m] = 1.0f - f; lf[m] = __builtin_amdgcn_logf(f); }
#pragma unroll
                            for (int m = 0; m < 4; ++m) PG8_SCAN16(lf[m]);
                            float run = 0.f, bb[4];
#pragma unroll
                            for (int m = 0; m < 4; ++m) { const float tot = __shfl(lf[m], srcl); bb[m] = lf[m] + run; run += tot; }
#pragma unroll
                            for (int m = 0; m < 4; ++m) { eb[m][e] = __builtin_amdgcn_exp2f(bb[m]); kt[m][e] = kk[m] * __builtin_amdgcn_exp2f(-bb[m]); kd[m][e] = kk[m] * __builtin_amdgcn_exp2f(run - bb[m]); }
                        }
#pragma unroll
                        for (int m = 0; m < 4; ++m) {
                            const size_t r = (size_t)(row0 + ai * HALF + m * 16);
                            u32x2 w;
                            w.x = cvt_pk_bf16(eb[m][0], eb[m][1]); w.y = cvt_pk_bf16(eb[m][2], eb[m][3]); *(u32x2*)(EB + r * 1024 + c0) = w;
                            w.x = cvt_pk_bf16(kt[m][0], kt[m][1]); w.y = cvt_pk_bf16(kt[m][2], kt[m][3]); *(u32x2*)(KT + r * 1024 + c0) = w;
                            w.x = cvt_pk_bf16(kd[m][0], kd[m][1]); w.y = cvt_pk_bf16(kd[m][2], kd[m][3]); *(u32x2*)(KD + (r + 64 * (b + 1)) * 1024 + c0) = w;
                        }
                    }
            return;
        }
        bf16_t* base; int ld = 1024, radd = 0, cb; int mode = 0; float sc = 1.f;
        if (pn < 2) { base = QA; ld = 512; cb = 256 * pn; sc = ATT_C2; }
        else if (pn < 4) { base = KA; ld = 512; cb = 256 * (pn - 2); radd = 128 * (b + 1); }
        else if (pn < 6) { base = VA; ld = 512; cb = 256 * (pn - 4); radd = 128 * (b + 1); }
        else if (pn < 10) { base = QH; cb = 256 * (pn - 6); sc = HG_QS; }
        else if (pn < 18) { base = VH; cb = 256 * (pn - 14); radd = 64 * (b + 1); }
        else if (pn < 22) { base = GH; cb = 256 * (pn - 18); mode = 1; }
        else if (pn < 26) { base = GA; cb = 256 * (pn - 22); mode = 1; }
        else { base = GT; cb = 256 * (pn - 26); mode = 1; }
#pragma unroll
        for (int ai = 0; ai < 2; ++ai)
#pragma unroll
            for (int m = 0; m < 4; ++m) { bf16_t* rowp = base + (size_t)(row0 + ai * HALF + m * 16 + radd) * ld + cb + cofs;
#pragma unroll
                for (int bj = 0; bj < 2; ++bj) { f32x4 v0 = acc[ai][bj][m][0], v1 = acc[ai][bj][m][1];
                    if (mode) {
#pragma unroll
                        for (int e = 0; e < 4; ++e) { v0[e] = fsig(v0[e]); v1[e] = fsig(v1[e]); }
                    } else { v0 = v0 * sc; v1 = v1 * sc; }
                    u32x4 w; w.x = cvt_pk_bf16(v0[0], v0[1]); w.y = cvt_pk_bf16(v0[2], v0[3]); w.z = cvt_pk_bf16(v1[0], v1[1]); w.w = cvt_pk_bf16(v1[2], v1[3]);
                    *(u32x4*)(rowp + bj * HALF) = w; } }
    }
};
struct EpiYa {
    static constexpr bool PERM = true, AFTER_DRAIN = false;
    const bf16_t* G; float* Y;
    __device__ __forceinline__ void operator()(const f32x4 (&acc)[2][2][4][2], const Unit& u, int wr, int wc, int fr, int fq) const {
        const int row0 = u.pm * BM + wr * 64 + fr, col0 = u.pn * BM + wc * 32 + 8 * fq;
#pragma unroll
        for (int ai = 0; ai < 2; ++ai)
#pragma unroll
            for (int m = 0; m < 4; ++m) { const size_t off = (size_t)(row0 + ai * HALF + m * 16) * 1024 + col0;
#pragma unroll
                for (int bj = 0; bj < 2; ++bj) { const u32x4 g = *(const u32x4*)(G + off + bj * HALF);
                    f32x4 v0 = acc[ai][bj][m][0], v1 = acc[ai][bj][m][1];
                    v0[0] *= bflo(g.x); v0[1] *= bfhi(g.x); v0[2] *= bflo(g.y); v0[3] *= bfhi(g.y); v1[0] *= bflo(g.z); v1[1] *= bfhi(g.z); v1[2] *= bflo(g.w); v1[3] *= bfhi(g.w);
                    *(f32x4*)(Y + off + bj * HALF) = v0; *(f32x4*)(Y + off + bj * HALF + 4) = v1; } }
    }
};
struct EpiMixed {
    static constexpr bool PERM = true, AFTER_DRAIN = false;
    const bf16_t* G; const float* Y; bf16_t* O;
    __device__ __forceinline__ void operator()(const f32x4 (&acc)[2][2][4][2], const Unit& u, int wr, int wc, int fr, int fq) const {
        const int row0 = u.pm * BM + wr * 64 + fr, col0 = u.pn * BM + wc * 32 + 8 * fq;
#pragma unroll
        for (int ai = 0; ai < 2; ++ai)
#pragma unroll
            for (int m = 0; m < 4; ++m) { const size_t off = (size_t)(row0 + ai * HALF + m * 16) * 1024 + col0;
#pragma unroll
                for (int bj = 0; bj < 2; ++bj) { const u32x4 g = *(const u32x4*)(G + off + bj * HALF);
                    const f32x4 y0 = *(const f32x4*)(Y + off + bj * HALF), y1 = *(const f32x4*)(Y + off + bj * HALF + 4);
                    f32x4 v0 = acc[ai][bj][m][0], v1 = acc[ai][bj][m][1];
                    v0[0] = y0[0] + v0[0] * bflo(g.x); v0[1] = y0[1] + v0[1] * bfhi(g.x); v0[2] = y0[2] + v0[2] * bflo(g.y); v0[3] = y0[3] + v0[3] * bfhi(g.y);
                    v1[0] = y1[0] + v1[0] * bflo(g.z); v1[1] = y1[1] + v1[1] * bfhi(g.z); v1[2] = y1[2] + v1[2] * bflo(g.w); v1[3] = y1[3] + v1[3] * bfhi(g.w);
                    u32x4 w; w.x = cvt_pk_bf16(v0[0], v0[1]); w.y = cvt_pk_bf16(v0[2], v0[3]); w.z = cvt_pk_bf16(v1[0], v1[1]); w.w = cvt_pk_bf16(v1[2], v1[3]);
                    *(u32x4*)(O + off + bj * HALF) = w; } }
    }
};
struct EpiRes {
    static constexpr bool PERM = true, AFTER_DRAIN = false;
    const float* X; float* O;
    __device__ __forceinline__ void operator()(const f32x4 (&acc)[2][2][4][2], const Unit& u, int wr, int wc, int fr, int fq) const {
        const int row0 = u.pm * BM + wr * 64 + fr, col0 = u.pn * BM + wc * 32 + 8 * fq;
#pragma unroll
        for (int ai = 0; ai < 2; ++ai)
#pragma unroll
            for (int m = 0; m < 4; ++m) { const size_t off = (size_t)(row0 + ai * HALF + m * 16) * 1024 + col0;
#pragma unroll
                for (int bj = 0; bj < 2; ++bj) {
                    const f32x4 x0 = *(const f32x4*)(X + off + bj * HALF), x1 = *(const f32x4*)(X + off + bj * HALF + 4);
                    *(f32x4*)(O + off + bj * HALF) = x0 + acc[ai][bj][m][0]; *(f32x4*)(O + off + bj * HALF + 4) = x1 + acc[ai][bj][m][1]; } }
    }
};
struct EpiSwiglu {
    static constexpr bool PERM = true, AFTER_DRAIN = false;
    bf16_t* O;
    __device__ __forceinline__ void operator()(const f32x4 (&acc)[2][2][4][2], const Unit& u, int wr, int wc, int fr, int fq) const {
        const int row0 = u.pm * BM + wr * 64 + fr, col0 = u.pn * HALF + wc * 32 + 8 * fq;
#pragma unroll
        for (int ai = 0; ai < 2; ++ai)
#pragma unroll
            for (int m = 0; m < 4; ++m) { const size_t off = (size_t)(row0 + ai * HALF + m * 16) * 512 + col0;
                f32x4 v0, v1;
#pragma unroll
                for (int e = 0; e < 4; ++e) { const float a0 = acc[ai][0][m][0][e], a1 = acc[ai][0][m][1][e];
                    v0[e] = a0 * fsig(a0) * acc[ai][1][m][0][e]; v1[e] = a1 * fsig(a1) * acc[ai][1][m][1][e]; }
                u32x4 w; w.x = cvt_pk_bf16(v0[0], v0[1]); w.y = cvt_pk_bf16(v0[2], v0[3]); w.z = cvt_pk_bf16(v1[0], v1[1]); w.w = cvt_pk_bf16(v1[2], v1[3]);
                *(u32x4*)(O + off) = w; }
    }
};
struct EpiPlain {
    static constexpr bool PERM = true, AFTER_DRAIN = false;
    bf16_t* O; int ldc;
    __device__ __forceinline__ void operator()(const f32x4 (&acc)[2][2][4][2], const Unit& u, int wr, int wc, int fr, int fq) const {
        const int row0 = u.pm * BM + wr * 64 + fr, col0 = u.pn * BM + wc * 32 + 8 * fq;
#pragma unroll
        for (int ai = 0; ai < 2; ++ai)
#pragma unroll
            for (int m = 0; m < 4; ++m) { const size_t off = (size_t)(row0 + ai * HALF + m * 16) * ldc + col0;
#pragma unroll
                for (int bj = 0; bj < 2; ++bj) { const f32x4 v0 = acc[ai][bj][m][0], v1 = acc[ai][bj][m][1];
                    u32x4 w; w.x = cvt_pk_bf16(v0[0], v0[1]); w.y = cvt_pk_bf16(v0[2], v0[3]); w.z = cvt_pk_bf16(v1[0], v1[1]); w.w = cvt_pk_bf16(v1[2], v1[3]);
                    *(u32x4*)(O + off + bj * HALF) = w; } }
    }
};

template <class Epi, class Sched, bool ALIGN_EPI = false, bool SP2 = false>
__device__ __forceinline__ void gemm_phase(PG8_LAS unsigned char* lds, const Gemm g, const Sched& S, const Epi& E) {
    int tid_l = threadIdx.x; asm volatile("" : "+v"(tid_l));
    const int tid = tid_l, wid = __builtin_amdgcn_readfirstlane(tid >> 6), lane = tid & 63, wr = wid >> 2, wc = wid & 3, fr = lane & 15, fq = lane >> 4;
    const int K = g.K, nt = K / BK;
    unsigned voffA[2], voffB[2];
#pragma unroll
    for (int i = 0; i < 2; ++i) { int R, C; stage_rc(tid * 16 + i * 8192, R, C); const int Rb = Epi::PERM ? ((R & ~31) + perm32(R & 31)) : R;
        voffA[i] = (unsigned)(R * K + C) * 2u; voffB[i] = (unsigned)(Rb * K + C) * 2u; }
    const size_t kstep = (size_t)(BK * 2);
    const size_t hstep = (size_t)HALF * K * 2;
    const size_t tstep = 2 * hstep;
    const unsigned ldsw = (unsigned)wid * 1024u;
    const int aoff = lds_byte(wr * 64 + fr, fq * 8), boff = lds_byte(wc * 32 + fr, fq * 8);
#define PG8_SA(b, h) (((b) * 2 + (h)) * HTB)
#define PG8_SB(b, h) ((4 + (b) * 2 + (h)) * HTB)
#define PG8_STAGE(bufoff, gbase, voff) do { _Pragma("unroll") for (int _i = 0; _i < 2; ++_i) \
        __builtin_amdgcn_global_load_lds((const unsigned*)((const char*)(gbase) + (voff)[_i]), (PG8_LAS unsigned*)(lds + (bufoff) + ldsw + _i * 8192), 16, 0, 0); } while (0)
#define PG8_LDA(dst, b, h) do { _Pragma("unroll") for (int m = 0; m < 4; ++m) _Pragma("unroll") for (int k = 0; k < 2; ++k) dst[m][k] = *(const PG8_LAS bf16x8*)(lds + PG8_SA(b, h) + aoff + m * 2048 + k * 1024); } while (0)
#define PG8_LDB(dst, b, h) do { _Pragma("unroll") for (int n = 0; n < 2; ++n) _Pragma("unroll") for (int k = 0; k < 2; ++k) dst[n][k] = *(const PG8_LAS bf16x8*)(lds + PG8_SB(b, h) + boff + n * 2048 + k * 1024); } while (0)
#define PG8_MMA(ai, bj, At, Bt) do { __builtin_amdgcn_s_setprio(1); _Pragma("unroll") for (int m = 0; m < 4; ++m) _Pragma("unroll") for (int n = 0; n < 2; ++n) _Pragma("unroll") for (int k = 0; k < 2; ++k) \
        acc[ai][bj][m][n] = __builtin_amdgcn_mfma_f32_16x16x32_bf16(Bt[n][k], At[m][k], acc[ai][bj][m][n], 0, 0, 0); __builtin_amdgcn_s_setprio(0); } while (0)
#define PG8_WAIT_V(n) asm volatile("s_waitcnt vmcnt(" #n ")" ::: "memory")
#define PG8_WAIT_L(n) asm volatile("s_waitcnt lgkmcnt(" #n ")" ::: "memory")
#define PG8_BAR __builtin_amdgcn_s_barrier()
#define PG8_SCHED __builtin_amdgcn_sched_barrier(0)
    Unit cur, nxt; int ui = 0;
    if (!S.next(0, cur)) return;
    f32x4 acc[2][2][4][2];
#pragma unroll
    for (int a = 0; a < 2; ++a)
#pragma unroll
        for (int b = 0; b < 2; ++b)
#pragma unroll
            for (int m = 0; m < 4; ++m)
#pragma unroll
                for (int n = 0; n < 2; ++n) acc[a][b][m][n] = (f32x4){0.f, 0.f, 0.f, 0.f};
    bf16x8 At[4][2], B0[2][2], B1[2][2];
    const char* cA = (const char*)g.A + (size_t)cur.pm * tstep; const char* cB = (const char*)g.Bt + (size_t)cur.e * g.bexp + (size_t)cur.pn * tstep;
    S.a_ready(cur);
    if constexpr (SP2) {
        PG8_STAGE(PG8_SB(0, 0), cB, voffB); PG8_STAGE(PG8_SB(0, 1), cB + hstep, voffB); PG8_STAGE(PG8_SA(0, 0), cA, voffA); PG8_STAGE(PG8_SA(0, 1), cA + hstep, voffA);
        if (wr == 1) PG8_BAR;
        PG8_WAIT_V(2); PG8_BAR;
        PG8_STAGE(PG8_SB(1, 0), cB + kstep, voffB); PG8_STAGE(PG8_SA(1, 0), cA + kstep, voffA); PG8_STAGE(PG8_SB(1, 1), cB + hstep + kstep, voffB);
        PG8_WAIT_V(6); PG8_BAR;
    } else {
        PG8_STAGE(PG8_SB(0, 0), cB, voffB); PG8_STAGE(PG8_SA(0, 0), cA, voffA); PG8_STAGE(PG8_SB(0, 1), cB + hstep, voffB); PG8_STAGE(PG8_SA(0, 1), cA + hstep, voffA);
        if (wr == 1) PG8_BAR;
        PG8_WAIT_V(4); PG8_BAR;
        PG8_STAGE(PG8_SB(1, 0), cB + kstep, voffB); PG8_STAGE(PG8_SA(1, 0), cA + kstep, voffA); PG8_STAGE(PG8_SB(1, 1), cB + hstep + kstep, voffB);
        PG8_WAIT_V(6); PG8_BAR;
    }
    for (;;) {
        const bool has_next = S.next(ui + 1, nxt);
        const char* nA = has_next ? (const char*)g.A + (size_t)nxt.pm * tstep : cA; const char* nB = has_next ? (const char*)g.Bt + (size_t)nxt.e * g.bexp + (size_t)nxt.pn * tstep : cB;
        for (int t = 0; t < nt; t += 2) {
            const bool last = (t == nt - 2);
            const char* a1 = cA + (size_t)(t + 1) * kstep;
            const char* a2 = last ? nA : cA + (size_t)(t + 2) * kstep; const char* b2 = last ? nB : cB + (size_t)(t + 2) * kstep;
            const char* a3 = a2 + kstep; const char* b3 = b2 + kstep;
            if (last && has_next) S.a_ready(nxt);
            if constexpr (SP2) {
            PG8_LDB(B0, 0, 0); PG8_LDB(B1, 0, 1); PG8_SCHED; PG8_LDA(At, 0, 0); PG8_STAGE(PG8_SA(1, 1), a1 + hstep, voffA);
            PG8_WAIT_V(8); PG8_WAIT_L(0); PG8_BAR; PG8_MMA(0, 0, At, B0); PG8_MMA(0, 1, At, B1); PG8_BAR; PG8_SCHED;
            PG8_LDA(At, 0, 1); PG8_STAGE(PG8_SB(0, 0), b2, voffB); PG8_STAGE(PG8_SB(0, 1), b2 + hstep, voffB); PG8_STAGE(PG8_SA(0, 0), a2, voffA);
            PG8_WAIT_V(8); PG8_WAIT_L(0); PG8_BAR; PG8_MMA(1, 0, At, B0); PG8_MMA(1, 1, At, B1); PG8_BAR; PG8_SCHED;
            PG8_LDB(B0, 1, 0); PG8_LDB(B1, 1, 1); PG8_SCHED; PG8_LDA(At, 1, 0); PG8_STAGE(PG8_SA(0, 1), a2 + hstep, voffA);
            PG8_WAIT_V(8); PG8_WAIT_L(0); PG8_BAR; PG8_MMA(0, 0, At, B0); PG8_MMA(0, 1, At, B1); PG8_BAR; PG8_SCHED;
            PG8_LDA(At, 1, 1); PG8_STAGE(PG8_SB(1, 0), b3, voffB); PG8_STAGE(PG8_SB(1, 1), b3 + hstep, voffB); PG8_STAGE(PG8_SA(1, 0), a3, voffA);
            PG8_WAIT_V(8); PG8_WAIT_L(0); PG8_BAR; PG8_MMA(1, 0, At, B0); PG8_MMA(1, 1, At, B1); PG8_BAR; PG8_SCHED;
            } else {
            PG8_LDB(B0, 0, 0); PG8_SCHED; PG8_LDA(At, 0, 0); PG8_STAGE(PG8_SA(1, 1), a1 + hstep, voffA);
            PG8_WAIT_L(8); PG8_BAR; PG8_WAIT_L(0); PG8_MMA(0, 0, At, B0); PG8_BAR; PG8_SCHED;
            PG8_LDB(B1, 0, 1); PG8_STAGE(PG8_SB(0, 0), b2, voffB);
            PG8_BAR; PG8_WAIT_L(0); PG8_MMA(0, 1, At, B1); PG8_BAR;
            PG8_LDA(At, 0, 1); PG8_STAGE(PG8_SA(0, 0), a2, voffA);
            PG8_BAR; PG8_WAIT_L(0); PG8_MMA(1, 0, At, B0); PG8_BAR; PG8_SCHED;
            PG8_STAGE(PG8_SB(0, 1), b2 + hstep, voffB);
            PG8_WAIT_V(6); PG8_BAR; PG8_MMA(1, 1, At, B1); PG8_BAR;
            PG8_LDB(B0, 1, 0); PG8_SCHED; PG8_LDA(At, 1, 0); PG8_STAGE(PG8_SA(0, 1), a2 + hstep, voffA);
            PG8_WAIT_L(8); PG8_BAR; PG8_WAIT_L(0); PG8_MMA(0, 0, At, B0); PG8_BAR; PG8_SCHED;
            PG8_LDB(B1, 1, 1); PG8_STAGE(PG8_SB(1, 0), b3, voffB);
            PG8_BAR; PG8_WAIT_L(0); PG8_MMA(0, 1, At, B1); PG8_BAR;
            PG8_LDA(At, 1, 1); PG8_STAGE(PG8_SA(1, 0), a3, voffA);
            PG8_BAR; PG8_WAIT_L(0); PG8_MMA(1, 0, At, B0); PG8_BAR; PG8_SCHED;
            PG8_STAGE(PG8_SB(1, 1), b3 + hstep, voffB);
            PG8_WAIT_V(6); PG8_BAR; PG8_MMA(1, 1, At, B1); PG8_BAR;
            }
        }
        if constexpr (ALIGN_EPI) { if (wr == 0) PG8_BAR; }
        if constexpr (!Epi::AFTER_DRAIN) { E(acc, cur, wr, wc, fr, fq); S.done(cur); }
        if (!has_next) break;
#pragma unroll
        for (int a = 0; a < 2; ++a)
#pragma unroll
            for (int b = 0; b < 2; ++b)
#pragma unroll
                for (int m = 0; m < 4; ++m)
#pragma unroll
                    for (int n = 0; n < 2; ++n) acc[a][b][m][n] = (f32x4){0.f, 0.f, 0.f, 0.f};
        cur = nxt; cA = nA; cB = nB; ++ui;
        if constexpr (ALIGN_EPI) { if (wr == 1) PG8_BAR; }
    }
    PG8_WAIT_V(0);
    if constexpr (!ALIGN_EPI) { if (wr == 0) PG8_BAR; }
    PG8_BAR;
    if constexpr (Epi::AFTER_DRAIN) { E.fused(acc, cur, wr, wc, fr, fq, lds, wid, lane); S.done(cur); }
#undef PG8_SA
#undef PG8_SB
#undef PG8_STAGE
#undef PG8_LDA
#undef PG8_LDB
#undef PG8_MMA
#undef PG8_WAIT_V
#undef PG8_WAIT_L
#undef PG8_BAR
#undef PG8_SCHED
}
}

constexpr int NWAVES = 8;
constexpr int NB = 2, SEQ = 8192, DM = 1024, MR = NB * SEQ;
constexpr int NMETA = 16, INW = 7688, NPROJ = 7680;
constexpr int AH = 8, ADH = 64, AWID = 512, KROWS = SEQ + 128;
constexpr int HH = 8, HK = 128, HV = 128, HROWS = SEQ + 64, NCH = 129;
constexpr int NE = 32, EFF = 512, APAD = 40960;
constexpr float EPS = 1e-6f;
constexpr int N_LAUNCHES = MK_N_LAUNCHES;
constexpr int NPHASE = 12;

constexpr size_t MiB = 1u << 20;
constexpr size_t WS_CTL = 0, CTL_ZERO_BYTES = 1 * MiB;
constexpr size_t WS_WIN = 1 * MiB, WS_WA = 16 * MiB, WS_WH = 17 * MiB, WS_WO = 19 * MiB;
constexpr size_t WS_LFA = 21 * MiB, WS_LFAM = WS_LFA + 512 * 1024, WS_CL = 22 * MiB, WS_ASG = 23 * MiB, WS_GATE = WS_ASG + 128 * 1024, WS_SLOT = WS_GATE + 128 * 1024, WS_GSORT = 24 * MiB;
constexpr size_t WS_U = 26 * MiB;
constexpr size_t WS_OA = 26 * MiB;
constexpr size_t WS_QA = 58 * MiB, WS_KA = 74 * MiB, WS_VA = 90 * MiB + 512 * 1024;
constexpr size_t WS_QH = 107 * MiB, WS_EB = 139 * MiB, WS_KT = 171 * MiB, WS_KD = 203 * MiB, WS_VH = 235 * MiB + 512 * 1024;
constexpr size_t WS_GH = 268 * MiB, WS_GA = 300 * MiB, WS_GT = 332 * MiB;
constexpr size_t WS_US = 364 * MiB;
constexpr size_t WS_OH = 429 * MiB;
constexpr size_t WS_YA = 107 * MiB;
constexpr size_t WS_MIX = 171 * MiB;
constexpr size_t WS_XN = 26 * MiB, WS_WE1 = 58 * MiB, WS_WE2 = 122 * MiB, WS_XS = 154 * MiB, WS_ACT = 234 * MiB, WS_Y = 274 * MiB;
constexpr size_t WS_END = 461 * MiB;
static_assert(WS_KA + (size_t)2 * KROWS * AWID * 2 <= WS_VA && WS_VA + (size_t)2 * KROWS * AWID * 2 <= WS_QH && WS_KD + (size_t)2 * HROWS * DM * 2 <= WS_VH && WS_VH + (size_t)2 * HROWS * DM * 2 <= WS_GH, "ws map");
static_assert(WS_US + (size_t)16 * NCH * HK * HV * 2 <= WS_OH && WS_OH + (size_t)MR * DM * 2 <= WS_END && WS_Y + (size_t)APAD * DM * 2 <= WS_END && WS_XS + (size_t)APAD * DM * 2 <= WS_ACT && WS_ACT + (size_t)APAD * EFF * 2 <= WS_Y, "ws map 2");
constexpr int CW_TMO = 0, CW_CODE = 1;
constexpr int CW_CNT = 1024;
constexpr int CW_NT = 2048;
constexpr int CW_TILEE = 2112;
constexpr int CW_BAR = 4096;

constexpr int RING_OFF = 0, RING_BYTES = 131072;
constexpr int LDSCTL_OFF = RING_BYTES, MISC_OFF = LDSCTL_OFF + 320;
constexpr int LDS_BYTES = 147456;

#define GAS __attribute__((address_space(1)))
#define LAS __attribute__((address_space(3)))
typedef unsigned short bf16;
typedef unsigned v4u __attribute__((ext_vector_type(4)));
typedef unsigned v2u __attribute__((ext_vector_type(2)));
typedef float f32x4 __attribute__((ext_vector_type(4)));
typedef short bf16x8 __attribute__((ext_vector_type(8)));
typedef GAS unsigned gu32;
typedef GAS unsigned long long gu64;
#define RLX_AGENT __ATOMIC_RELAXED, __HIP_MEMORY_SCOPE_AGENT
#define LDS_WAIT() asm volatile("s_waitcnt lgkmcnt(0)" ::: "memory")
#define VM_WAIT() asm volatile("s_waitcnt vmcnt(0)" ::: "memory")
__device__ __forceinline__ unsigned f2bf(float f) { unsigned u = __builtin_bit_cast(unsigned, f); return (u + 0x7fffu + ((u >> 16) & 1u)) >> 16; }
__device__ __forceinline__ unsigned pk2(float lo, float hi) { return f2bf(lo) | (f2bf(hi) << 16); }
__device__ __forceinline__ float bf2f(unsigned short h) { return __builtin_bit_cast(float, (unsigned)h << 16); }
__device__ __forceinline__ float blo(unsigned w) { return __builtin_bit_cast(float, w << 16); }
__device__ __forceinline__ float bhi(unsigned w) { return __builtin_bit_cast(float, w & 0xffff0000u); }
__device__ __forceinline__ float ex2(float x) { return __builtin_amdgcn_exp2f(x); }
__device__ __forceinline__ float sigm(float x) { return __builtin_amdgcn_rcpf(1.0f + ex2(-1.4426950408889634f * x)); }
__device__ __forceinline__ unsigned ald(const unsigned* p) { return __hip_atomic_load(p, __ATOMIC_RELAXED, __HIP_MEMORY_SCOPE_AGENT); }
__device__ __forceinline__ float aldf(const float* p) { return __builtin_bit_cast(float, __hip_atomic_load((const unsigned*)p, __ATOMIC_RELAXED, __HIP_MEMORY_SCOPE_AGENT)); }
__device__ __forceinline__ float log_sigmoid(float z) { const float a = fabsf(z); return fminf(z, 0.f) - __logf(1.0f + __expf(-a)); }

namespace attn_body {
using bf16=__hip_bfloat16;
using bf16x8=__attribute__((ext_vector_type(8)))short;
using s16x4=__attribute__((ext_vector_type(4)))short;
using f32x16=__attribute__((ext_vector_type(16)))float;
using u32x4=__attribute__((ext_vector_type(4)))unsigned;
using f32x4g=__attribute__((ext_vector_type(4)))float;
constexpr int BATCH=2,NHEAD=8,SEQ=8192,D=64,DM=NHEAD*D;
constexpr int KFRONT=128,KSEQ=SEQ+KFRONT;
constexpr int NW=8,QBLK=32,QB=QBLK*NW,KVBLK=64,NQB=SEQ/QB;
constexpr int ATTN_PITCH=DM, ATTN_UNIT_ROWS=QB;
__device__ __forceinline__ int crow(int r,int hi){return (r&3)+8*(r>>2)+4*hi;}
#define SBAR() __builtin_amdgcn_sched_barrier(0)
__device__ __forceinline__ void cmask(f32x16&p0,f32x16&p1,int jb,int qrel,int hi){
  const float NEG=-INFINITY; int kb=64*jb+4*hi;
  #pragma unroll
  for(int r=0;r<16;++r){int kv=kb+(r&3)+8*(r>>2); if(kv>qrel)p0[r]=NEG; if(kv+32>qrel)p1[r]=NEG;}
}

constexpr int NSLOT=3, SLOTB=8192;
constexpr int LDS_K=0, LDS_V=NSLOT*SLOTB, LDS_WS=2*NSLOT*SLOTB, LDS_OST=LDS_WS+NW*64*4, LDS_CLK=LDS_OST+NW*4096, LDS_BYTES=LDS_CLK+KSEQ*4;
constexpr float C2=0.125f*1.4426950408889634f;
__device__ __forceinline__ void glds16(const void*gsrc,unsigned lds_dst){unsigned keep;
  asm volatile("s_mov_b32 %0, m0\n\ts_mov_b32 m0, %2\n\ts_nop 0\n\tglobal_load_lds_dwordx4 %1, off\n\ts_mov_b32 m0, %0":"=&s"(keep):"v"(gsrc),"s"(lds_dst):"memory");}
__device__ __forceinline__ float max3f(float a,float b,float c){float r;asm("v_max3_f32 %0, %1, %2, %3":"=v"(r):"v"(a),"v"(b),"v"(c));return r;}
__device__ __forceinline__ float max2f(float a,float b){float r;asm("v_max_f32_e32 %0, %1, %2":"=v"(r):"v"(a),"v"(b));return r;}
__device__ __forceinline__ float fadd_s(float a,float b){float r;asm("v_add_f32_e32 %0, %1, %2":"=v"(r):"v"(a),"v"(b));return r;}
__device__ __forceinline__ float fsub_s(float a,float b){float r;asm("v_sub_f32_e32 %0, %1, %2":"=v"(r):"v"(a),"v"(b));return r;}
typedef float f32x2_t __attribute__((ext_vector_type(2))); typedef __bf16 bf16x2_t __attribute__((ext_vector_type(2)));
__device__ __forceinline__ unsigned cvtpk_s(float lo,float hi){f32x2_t v={lo,hi};bf16x2_t b=__builtin_convertvector(v,bf16x2_t);return __builtin_bit_cast(unsigned,b);}
#define WAIT_BAR(N) asm volatile("s_waitcnt vmcnt(" #N ") lgkmcnt(0)\n\ts_barrier":::"memory")

__device__ __forceinline__ void qkt(f32x16&p0,f32x16&p1,const char*Kslot,const bf16x8*qr,int r32,int hi){
  const char*kb=Kslot+hi*1024+r32*16;
  #pragma unroll
  for(int d0=0;d0<4;++d0){
    const bf16x8 b0=*reinterpret_cast<const bf16x8*>(kb+d0*2048);
    const bf16x8 b1=*reinterpret_cast<const bf16x8*>(kb+d0*2048+512);
    p0=__builtin_amdgcn_mfma_f32_32x32x16_bf16(b0,qr[d0],p0,0,0,0);p1=__builtin_amdgcn_mfma_f32_32x32x16_bf16(b1,qr[d0],p1,0,0,0);}
}
typedef __attribute__((address_space(3))) const char* lds_cptr;
typedef short v4i16_t __attribute__((ext_vector_type(4)));
__device__ __forceinline__ void kload8(bf16x8*kf,lds_cptr kp){
  kf[0]=*(const __attribute__((address_space(3))) bf16x8*)(kp);      kf[1]=*(const __attribute__((address_space(3))) bf16x8*)(kp+512);
  kf[2]=*(const __attribute__((address_space(3))) bf16x8*)(kp+2048); kf[3]=*(const __attribute__((address_space(3))) bf16x8*)(kp+2560);
  kf[4]=*(const __attribute__((address_space(3))) bf16x8*)(kp+4096); kf[5]=*(const __attribute__((address_space(3))) bf16x8*)(kp+4608);
  kf[6]=*(const __attribute__((address_space(3))) bf16x8*)(kp+6144); kf[7]=*(const __attribute__((address_space(3))) bf16x8*)(kp+6656);
}
__device__ __forceinline__ void kload2(bf16x8*kf,lds_cptr kp,int j){ kf[2*j]=*(const __attribute__((address_space(3))) bf16x8*)(kp+j*2048); kf[2*j+1]=*(const __attribute__((address_space(3))) bf16x8*)(kp+j*2048+512); }
__device__ __forceinline__ s16x4 vtr(lds_cptr p){ return __builtin_bit_cast(s16x4,__builtin_amdgcn_ds_read_tr16_b64_v4i16((__attribute__((address_space(3))) v4i16_t*)p)); }
__device__ __forceinline__ float rowmax(const f32x16&p0,const f32x16&p1){
  float a=max3f(p0[0],p0[1],p1[0]),b=max3f(p0[2],p0[3],p1[1]);a=max3f(a,p1[2],p1[3]);
  #pragma unroll
  for(int r=4;r<16;r+=4){a=max3f(a,p0[r],p0[r+1]);b=max3f(b,p0[r+2],p0[r+3]);a=max3f(a,p1[r],p1[r+1]);b=max3f(b,p1[r+2],p1[r+3]);}
  const float m=max2f(a,b);
  auto rr=__builtin_amdgcn_permlane32_swap(__float_as_uint(m),__float_as_uint(m),false,false);
  return max2f(__uint_as_float(rr[0]),__uint_as_float(rr[1]));
}
__device__ __forceinline__ void pv(f32x16*o,int vb,bf16x8 pa0,bf16x8 pa1,bf16x8 pa2,bf16x8 pa3){
  #pragma unroll
  for(int d0=0;d0<2;++d0){s16x4 lo[4],hi[4];
    #pragma unroll
    for(int ks=0;ks<4;++ks){
      asm volatile("ds_read_b64_tr_b16 %0,%1 offset:%c2":"=&v"(lo[ks]):"v"(vb),"i"(d0*4096+ks*1024):"memory");
      asm volatile("ds_read_b64_tr_b16 %0,%1 offset:%c2":"=&v"(hi[ks]):"v"(vb),"i"(d0*4096+ks*1024+512):"memory");}
    asm volatile("s_waitcnt lgkmcnt(0)":::"memory");SBAR();
    #define PK(k) (bf16x8){lo[k][0],lo[k][1],lo[k][2],lo[k][3],hi[k][0],hi[k][1],hi[k][2],hi[k][3]}
    o[d0]=__builtin_amdgcn_mfma_f32_32x32x16_bf16(pa0,PK(0),o[d0],0,0,0);
    o[d0]=__builtin_amdgcn_mfma_f32_32x32x16_bf16(pa1,PK(1),o[d0],0,0,0);
    o[d0]=__builtin_amdgcn_mfma_f32_32x32x16_bf16(pa2,PK(2),o[d0],0,0,0);
    o[d0]=__builtin_amdgcn_mfma_f32_32x32x16_bf16(pa3,PK(3),o[d0],0,0,0);
    #undef PK
  }
}

#ifndef ATTN_STORE16
#define ATTN_STORE16(p,v) (*(u32x4*)(p)=(v))
#endif
template<int THRL> __device__ __forceinline__ void attn_unit(int b,int h,int qb,const bf16*Q,const bf16*__restrict__ K,const bf16*__restrict__ V,bf16*O,const float*CLg,char*shm){
  int tid_l=threadIdx.x; asm volatile("":"+v"(tid_l)); const int tid=tid_l,lane=tid&63,r32=lane&31,hi=lane>>5; const int wid=__builtin_amdgcn_readfirstlane(tid>>6);
  const long rowbase=(long)b*SEQ; const int q0=qb*QB;
  const bf16*Qw=Q+(rowbase+q0+wid*QBLK)*DM+h*D;
  const bf16*Kh=K+(long)b*KSEQ*DM+h*D,*Vh=V+(long)b*KSEQ*DM+h*D;
  const unsigned lds0=(unsigned)(uintptr_t)shm;
  float*wsf=(float*)(shm+LDS_WS)+wid*64;
  const bf16*ksrc=Kh+(long)lane*DM+wid*8;
  const bf16*vsrc=Vh+(long)(16*(wid&3)+(lane>>2))*DM+(wid>>2)*32+(lane&3)*8;
  const unsigned kdst=lds0+LDS_K+wid*1024, vdst=lds0+LDS_V+wid*1024;
  #define DMA_K(t,slot) glds16(ksrc+(long)(t)*KVBLK*DM,(unsigned)__builtin_amdgcn_readfirstlane(kdst+(slot)))
  #define DMA_V(t,slot) glds16(vsrc+(long)(t)*KVBLK*DM,(unsigned)__builtin_amdgcn_readfirstlane(vdst+(slot)))
  const int vb0=(int)(lds0+LDS_V)+((lane>>4)&1)*32+(lane&3)*8+(4*hi+((lane&15)>>2))*64;
  const char*Kbase=shm+LDS_K; bf16x8 kf[8];
  const lds_cptr shm3=(lds_cptr)shm; const lds_cptr kp0=shm3+LDS_K+hi*1024+r32*16; const lds_cptr vp0=shm3+LDS_V+((lane>>4)&1)*32+(lane&3)*8+(4*hi+((lane&15)>>2))*64;
  const int NT=(KFRONT+q0+QB)/KVBLK;
  DMA_K(0,0);DMA_V(0,0);DMA_K(1,SLOTB);
  bf16x8 qr[4];
  #pragma unroll
  for(int d0=0;d0<4;++d0)qr[d0]=*reinterpret_cast<const bf16x8*>(&Qw[(long)r32*DM+d0*16+hi*8]);
  { const f32x4g*src=(const f32x4g*)CLg; __attribute__((address_space(3))) f32x4g*dst=(__attribute__((address_space(3))) f32x4g*)(shm3+LDS_CLK);
    for(int i=tid;i<NT*16;i+=NW*64)dst[i]=src[i]; }
  const float clq=CLg[KFRONT+q0+wid*QBLK+r32];
  const __attribute__((address_space(3))) float*clkp=(const __attribute__((address_space(3))) float*)(shm3+LDS_CLK)+4*hi;
  float mhat=0.f,l_reg=0.f;f32x16 o[2];o[0]=f32x16{};o[1]=f32x16{};
  const int qrel=wid*QBLK+r32;
  #define CMASK(P0,P1,t) do{int jb_=(t)-(NT-4); if(jb_>=0)cmask(P0,P1,jb_,qrel,hi);}while(0)
  #define BRD(X0,X1,tt) do{ const __attribute__((address_space(3))) float*c_=clkp+(tt)*KVBLK; \
    _Pragma("unroll") for(int g_=0;g_<4;++g_){ const f32x4g a_=*(const __attribute__((address_space(3))) f32x4g*)(c_+8*g_), b_=*(const __attribute__((address_space(3))) f32x4g*)(c_+32+8*g_); \
      X0[4*g_]=a_.x;X0[4*g_+1]=a_.y;X0[4*g_+2]=a_.z;X0[4*g_+3]=a_.w; X1[4*g_]=b_.x;X1[4*g_+1]=b_.y;X1[4*g_+2]=b_.z;X1[4*g_+3]=b_.w; } }while(0)
  #define BSUB(X,g,nb) do{ X[4*(g)]=(nb)-X[4*(g)]; X[4*(g)+1]=(nb)-X[4*(g)+1]; X[4*(g)+2]=(nb)-X[4*(g)+2]; X[4*(g)+3]=(nb)-X[4*(g)+3]; }while(0)
  #define BFULL(X0,X1,tt,nb) do{ BRD(X0,X1,tt); _Pragma("unroll") for(int g_=0;g_<4;++g_){ BSUB(X0,g_,nb); BSUB(X1,g_,nb); } }while(0)
  bool resc=false;
  #define START(P0,P1) do{ const float rm=rowmax(P0,P1); resc=false; \
    { const float dl=rm; mhat=fadd_s(mhat,dl); \
      _Pragma("unroll") for(int r=0;r<16;++r){P0[r]=fsub_s(P0[r],dl);P1[r]=fsub_s(P1[r],dl);} } \
    _Pragma("unroll") for(int r=0;r<16;++r)P0[r]=__builtin_amdgcn_exp2f(P0[r]); }while(0)
  #define RESC() do{ if(resc){ asm volatile("s_waitcnt lgkmcnt(0)":::"memory"); \
      _Pragma("unroll") for(int d_=0;d_<2;++d_) _Pragma("unroll") for(int r=0;r<16;++r)o[d_][r]*=wsf[crow(r,hi)]; } }while(0)
  f32x16 pA0,pA1,pB0,pB1;
  int sl_prev=0,sl_cur=0,sl_next=SLOTB;
  #define ROT() do{sl_prev=sl_cur;sl_cur=sl_next;sl_next=(sl_next==(NSLOT-1)*SLOTB)?0:sl_next+SLOTB;}while(0)
  DMA_K(2,2*SLOTB);
  WAIT_BAR(3);
  BFULL(pA0,pA1,0,clq);
  qkt(pA0,pA1,Kbase,qr,r32,hi);asm volatile("s_nop 15\n\ts_nop 7":"+v"(pA0),"+v"(pA1));CMASK(pA0,pA1,0);
  START(pA0,pA1);
  { const float nb0_=clq-mhat; BFULL(pB0,pB1,1,nb0_); }
  _Pragma("unroll") for(int r=0;r<16;++r)pA1[r]=__builtin_amdgcn_exp2f(pA1[r]);
  WAIT_BAR(0);
  DMA_K(3,0);DMA_V(1,SLOTB);
  ROT();
  kload8(kf,kp0+sl_cur);
  WAIT_BAR(2);
  s16x4 vlo[8],vhi[8]; u32x4 pw0,pw1,pw2,pw3;
  #define PKW(P,B) cvtpk_s(P[B],P[B+1])
  #define PAF(k) __builtin_bit_cast(bf16x8,pw##k)
  #define VFR(i) (bf16x8){vlo[i][0],vlo[i][1],vlo[i][2],vlo[i][3],vhi[i][0],vhi[i][1],vhi[i][2],vhi[i][3]}
  #define PIN(x) asm volatile("":"+v"(x))
  #define MX3(a,b,c) __builtin_fmaxf(__builtin_fmaxf((a),(b)),(c))
  #define GAPA(MF,A0,A1,A2,A3,W0,W1,PW) do{ MF; sacc+=A0; sacc+=A1; sacc+=A2; sacc+=A3; PIN(sacc); W0; W1; PIN(PW); SBAR(); }while(0)
  #define EX(v) __builtin_amdgcn_exp2f(v)
  #define GAPB(MF,X,B,G,PX,g,OFS) do{ f32x4g c4_; if(G){ c4_=*(const __attribute__((address_space(3))) f32x4g*)(cn_+(OFS)+8*(g)); } MF; X[B]=EX(X[B]); X[B+1]=EX(X[B+1]); X[B+2]=EX(X[B+2]); X[B+3]=EX(X[B+3]); PIN(X); \
    if(G){ PX[4*(g)]=nb_-c4_.x; PX[4*(g)+1]=nb_-c4_.y; PX[4*(g)+2]=nb_-c4_.z; PX[4*(g)+3]=nb_-c4_.w; PIN(PX); } SBAR(); }while(0)
  #define VRD(i) do{ vlo[i]=vtr(vp_+(((i)>>2)*4096+((i)&3)*1024)); vhi[i]=vtr(vp_+(((i)>>2)*4096+((i)&3)*1024+512)); }while(0)
  #define KRD(G,j) do{ if(G){ kload2(kf,kp0+sl_next,j); SBAR(); } }while(0)
  #define STEP(C0,C1,P0,P1,t,GK,GV,GL) do{ SBAR(); \
    const lds_cptr vp_=vp0+sl_prev; \
    VRD(0); SBAR(); float sacc=(P0[0]+P0[1]); \
    GAPA(C0=__builtin_amdgcn_mfma_f32_32x32x16_bf16(kf[0],qr[0],C0,0,0,0), P0[2],P0[3],P0[4],P0[5],     pw0[0]=PKW(P0,0), pw0[1]=PKW(P0,2), pw0); \
    VRD(4); SBAR(); GAPA(C1=__builtin_amdgcn_mfma_f32_32x32x16_bf16(kf[1],qr[0],C1,0,0,0), P0[6],P0[7],P0[8],P0[9],     pw0[2]=PKW(P0,4), pw0[3]=PKW(P0,6), pw0); \
    VRD(1); SBAR(); GAPA(C0=__builtin_amdgcn_mfma_f32_32x32x16_bf16(kf[2],qr[1],C0,0,0,0),   P0[10],P0[11],P0[12],P0[13], pw1[0]=PKW(P0,8), pw1[1]=PKW(P0,10), pw1); \
    VRD(5); SBAR(); GAPA(C1=__builtin_amdgcn_mfma_f32_32x32x16_bf16(kf[3],qr[1],C1,0,0,0),   P0[14],P0[15],P1[0],P1[1],   pw1[2]=PKW(P0,12),pw1[3]=PKW(P0,14), pw1); \
    VRD(2); SBAR(); GAPA(C0=__builtin_amdgcn_mfma_f32_32x32x16_bf16(kf[4],qr[2],C0,0,0,0),   P1[2],P1[3],P1[4],P1[5],     pw2[0]=PKW(P1,0), pw2[1]=PKW(P1,2), pw2); \
    VRD(6); SBAR(); GAPA(C1=__builtin_amdgcn_mfma_f32_32x32x16_bf16(kf[5],qr[2],C1,0,0,0),   P1[6],P1[7],P1[8],P1[9],     pw2[2]=PKW(P1,4), pw2[3]=PKW(P1,6), pw2); \
    VRD(3); SBAR(); GAPA(C0=__builtin_amdgcn_mfma_f32_32x32x16_bf16(kf[6],qr[3],C0,0,0,0),   P1[10],P1[11],P1[12],P1[13], pw3[0]=PKW(P1,8), pw3[1]=PKW(P1,10), pw3); \
    VRD(7); SBAR(); GAPA(C1=__builtin_amdgcn_mfma_f32_32x32x16_bf16(kf[7],qr[3],C1,0,0,0),   P1[14],P1[15],0.f,0.f,       pw3[2]=PKW(P1,12),pw3[3]=PKW(P1,14), pw3); \
    l_reg+=sacc; \
    if(GK){DMA_K((t)+3,sl_cur);} if(GV){DMA_V((t)+1,sl_next);} \
    CMASK(C0,C1,t); \
    { float a=MX3(C0[0],C0[1],C1[0]),b=MX3(C0[2],C0[3],C1[1]); a=MX3(a,C1[2],C1[3]); \
      _Pragma("unroll") for(int r=4;r<16;r+=4){a=MX3(a,C0[r],C0[r+1]);b=MX3(b,C0[r+2],C0[r+3]);a=MX3(a,C1[r],C1[r+1]);b=MX3(b,C1[r+2],C1[r+3]);} \
      float rm=__builtin_fmaxf(a,b); { auto rr=__builtin_amdgcn_permlane32_swap(__float_as_uint(rm),__float_as_uint(rm),false,false); rm=__builtin_fmaxf(__uint_as_float(rr[0]),__uint_as_float(rr[1])); } \
      resc=false; \
      if(__builtin_expect(__any(rm>(float)THRL),0)){ const float dl=__builtin_fmaxf(rm,0.f); mhat+=dl; \
        _Pragma("unroll") for(int r=0;r<16;++r){C0[r]-=dl;C1[r]-=dl;} \
        const float f=__builtin_amdgcn_exp2f(-dl); l_reg*=f; if(hi==0)wsf[r32]=f; resc=true; } } \
    const float nb_=clq-mhat; const __attribute__((address_space(3))) float*cn_=clkp+((t)+1)*KVBLK; \
    SBAR(); \
    GAPB(o[0]=__builtin_amdgcn_mfma_f32_32x32x16_bf16(PAF(0),VFR(0),o[0],0,0,0), C0,0,GL,P0,0,0); \
    GAPB(o[1]=__builtin_amdgcn_mfma_f32_32x32x16_bf16(PAF(0),VFR(4),o[1],0,0,0), C0,4,GL,P0,1,0); \
    KRD(GL,0); GAPB(o[0]=__builtin_amdgcn_mfma_f32_32x32x16_bf16(PAF(1),VFR(1),o[0],0,0,0), C0,8,GL,P0,2,0); \
    KRD(GL,1); GAPB(o[1]=__builtin_amdgcn_mfma_f32_32x32x16_bf16(PAF(1),VFR(5),o[1],0,0,0), C0,12,GL,P0,3,0); \
    KRD(GL,2); GAPB(o[0]=__builtin_amdgcn_mfma_f32_32x32x16_bf16(PAF(2),VFR(2),o[0],0,0,0), C1,0,GL,P1,0,32); \
    KRD(GL,3); GAPB(o[1]=__builtin_amdgcn_mfma_f32_32x32x16_bf16(PAF(2),VFR(6),o[1],0,0,0), C1,4,GL,P1,1,32); \
    GAPB(o[0]=__builtin_amdgcn_mfma_f32_32x32x16_bf16(PAF(3),VFR(3),o[0],0,0,0), C1,8,GL,P1,2,32); \
    GAPB(o[1]=__builtin_amdgcn_mfma_f32_32x32x16_bf16(PAF(3),VFR(7),o[1],0,0,0), C1,12,GL,P1,3,32); \
    }while(0)
  int t=1;
  #undef CMASK
  #define CMASK(P0,P1,t) do{}while(0)
  for(;t+5<NT;t+=2){
    STEP(pB0,pB1,pA0,pA1,t,true,true,true);     WAIT_BAR(2); RESC(); ROT();
    STEP(pA0,pA1,pB0,pB1,t+1,true,true,true);   WAIT_BAR(2); RESC(); ROT();
  }
  #undef CMASK
  #define CMASK(P0,P1,t) do{int jb_=(t)-(NT-4); if(jb_>=0)cmask(P0,P1,jb_,qrel,hi);}while(0)
  #define ENDW(tt) do{ if((tt)+3<NT){WAIT_BAR(2);} else if((tt)+2<NT){WAIT_BAR(1);} else {WAIT_BAR(0);} }while(0)
  for(;t+1<NT;t+=2){
    STEP(pB0,pB1,pA0,pA1,t,(t+3<NT),(t+1<NT),(t+1<NT));       ENDW(t);   RESC(); ROT();
    STEP(pA0,pA1,pB0,pB1,t+1,(t+4<NT),(t+2<NT),(t+2<NT));     ENDW(t+1); RESC(); ROT();
  }
  STEP(pB0,pB1,pA0,pA1,NT-1,false,false,false); RESC();
  { float sacc=pB0[0]+pB0[1]; _Pragma("unroll") for(int r=2;r<16;++r)sacc+=pB0[r]; _Pragma("unroll") for(int r=0;r<16;++r)sacc+=pB1[r]; l_reg+=sacc;
    pw0=(u32x4){PKW(pB0,0),PKW(pB0,2),PKW(pB0,4),PKW(pB0,6)};pw1=(u32x4){PKW(pB0,8),PKW(pB0,10),PKW(pB0,12),PKW(pB0,14)};pw2=(u32x4){PKW(pB1,0),PKW(pB1,2),PKW(pB1,4),PKW(pB1,6)};pw3=(u32x4){PKW(pB1,8),PKW(pB1,10),PKW(pB1,12),PKW(pB1,14)};
    SBAR(); pv(o,vb0+sl_cur,PAF(0),PAF(1),PAF(2),PAF(3)); }
  #undef PKW
  #undef PAF
  #undef VFR
  #undef PIN
  #undef MX3
  #undef GAPA
  #undef GAPB
  #undef EX
  #undef VRD
  #undef KRD
  #undef STEP
  #undef ENDW
  {auto rr=__builtin_amdgcn_permlane32_swap(__float_as_uint(l_reg),__float_as_uint(l_reg),false,false);l_reg=__uint_as_float(rr[0])+__uint_as_float(rr[1]);}
  if(hi==0)wsf[32+r32]=l_reg;asm volatile("s_waitcnt lgkmcnt(0)":::"memory");
  float rli[16];
  #pragma unroll
  for(int r=0;r<16;++r)rli[r]=__builtin_amdgcn_rcpf(wsf[32+crow(r,hi)]);
  bf16*Ow=O+(rowbase+q0+wid*QBLK)*DM+h*D;
  { bf16*stg=(bf16*)(shm+LDS_OST)+wid*2048;
    #pragma unroll
    for(int r=0;r<16;++r){const int orow=crow(r,hi);
      #pragma unroll
      for(int d0=0;d0<2;++d0)stg[orow*64+d0*32+r32]=__float2bfloat16(o[d0][r]*rli[r]);}
    asm volatile("s_waitcnt lgkmcnt(0)":::"memory");
    #pragma unroll
    for(int i=0;i<4;++i){const int row=i*8+(lane>>3),ch=lane&7; const u32x4 v=*(const u32x4*)(stg+row*64+ch*8); ATTN_STORE16(Ow+(long)row*DM+ch*8,v);} }
  asm volatile("s_waitcnt lgkmcnt(0)\n\ts_barrier":::"memory");
  #undef BRD
  #undef BSUB
  #undef BFULL
  #undef DMA_K
  #undef DMA_V
  #undef CMASK
  #undef START
  #undef RESC
  #undef ROT
}
constexpr int ATTN_LDS_BYTES=LDS_BYTES;
#undef SBAR
#undef WAIT_BAR
}
#define XB_TMO      128
#define XB_XCNT(j)  (256  + 64 * (j))
#define XB_XSUB(j)  (1280 + 64 * (j))
#define XB_XGEN(j)  (2304 + 64 * (j))
#define XB_TOP      3328
#define XB_TOPGEN   3392
#define XCD_BAR_WORDS 3456
#define XB_SPIN_CAP (1u << 18)

__device__ __forceinline__ unsigned xb_ld(unsigned* p)              { return __hip_atomic_load(p, __ATOMIC_RELAXED, __HIP_MEMORY_SCOPE_AGENT); }
__device__ __forceinline__ unsigned xb_add(unsigned* p, unsigned v) { return __hip_atomic_fetch_add(p, v, __ATOMIC_RELAXED, __HIP_MEMORY_SCOPE_AGENT); }
__device__ __forceinline__ unsigned xb_xcc_id() { return (unsigned)__builtin_amdgcn_s_getreg((3 << 11) | 20) & 0xFu; }
#define XB_SPIN(cond, bar) do { unsigned _sp = 0; while (cond) { __builtin_amdgcn_s_sleep(1); \
    if ((++_sp & 255u) == 0u) { if (xb_ld(&(bar)[XB_TMO])) break; if (_sp > XB_SPIN_CAP) { atomicAdd(&(bar)[XB_TMO], 1u); break; } } } } while (0)

struct XcdBarrier {
    unsigned* bar; unsigned x;
    volatile LAS unsigned* st;
};

__device__ __forceinline__ XcdBarrier xcd_barrier_post(unsigned* bar, volatile LAS unsigned* st) {
    XcdBarrier b; b.bar = bar; b.x = xb_xcc_id(); b.st = st;
    if (threadIdx.x == 0) (void)xb_add(&bar[XB_XCNT(b.x)], 1u);
    return b;
}
__device__ __forceinline__ void xcd_barrier_complete(unsigned* bar, unsigned x, unsigned& nloc, unsigned& nx) {
    const unsigned G = gridDim.x * gridDim.y * gridDim.z;
    unsigned sum, cnt, mine, sp = 0u;
    for (;;) {
        sum = 0u; cnt = 0u; mine = 0u;
#pragma unroll
        for (unsigned j = 0; j < 16; ++j) { const unsigned c = xb_ld(&bar[XB_XCNT(j)]); sum += c; cnt += (c > 0u) ? 1u : 0u; mine = (j == x) ? c : mine; }
        if (sum == G) break;
        __builtin_amdgcn_s_sleep(1);
        if ((++sp & 255u) == 0u) { if (xb_ld(&bar[XB_TMO])) break; if (sp > XB_SPIN_CAP) { atomicAdd(&bar[XB_TMO], 1u); break; } }
    }
    nloc = mine > 0u ? mine : 1u; nx = cnt > 0u ? cnt : 1u;
}

__device__ __forceinline__ void xcd_barrier(const XcdBarrier& b) {
    asm volatile("s_waitcnt vmcnt(0)" ::: "memory");
    __syncthreads();
    if (threadIdx.x == 0) {
        unsigned* bar = b.bar;
        __builtin_amdgcn_s_waitcnt(0);
        unsigned nloc = b.st[0], nx = b.st[1];
        if (nloc == 0u) { xcd_barrier_complete(bar, b.x, nloc, nx); b.st[0] = nloc; b.st[1] = nx; }
        const unsigned old = xb_add(&bar[XB_XSUB(b.x)], 1u);
        const unsigned gen = old / nloc;
        if (old + 1u == (gen + 1u) * nloc) {
            __builtin_amdgcn_fence(__ATOMIC_RELEASE, "agent");
            asm volatile("s_waitcnt vmcnt(0)" ::: "memory");
            const unsigned og = xb_add(&bar[XB_TOP], 1u);
            const unsigned tg = og / nx;
            if (og + 1u == (tg + 1u) * nx) xb_add(&bar[XB_TOPGEN], 1u);
            else XB_SPIN(xb_ld(&bar[XB_TOPGEN]) == tg, bar);
            __builtin_amdgcn_fence(__ATOMIC_ACQUIRE, "agent");
            xb_add(&bar[XB_XGEN(b.x)], 1u);
            asm volatile("s_waitcnt vmcnt(0)" ::: "memory");
        } else {
            XB_SPIN(xb_ld(&bar[XB_XGEN(b.x)]) == gen, bar);
            __builtin_amdgcn_fence(__ATOMIC_ACQUIRE, "agent");
            asm volatile("s_waitcnt vmcnt(0)" ::: "memory");
        }
    }
    __syncthreads();
}
struct Frame {
    LAS unsigned char* lds;
    volatile LAS unsigned* MISC;
    gu32* ctl;
    unsigned char* ws;
    int tid, lane, wave;
    int vcu, G;
    const float* in[18];
    float* out;
};
__device__ __forceinline__ float wave_sum(float v) {
#pragma unroll
    for (int o = 1; o < 64; o <<= 1) v += __shfl_xor(v, o);
    return v;
}

__device__ __forceinline__ void p0_transpose_item(const float* W, int ldw, int K, int ncols, bf16* WT, int mode, int row_off, LAS float* scr, int item, int lane) {
    const int nblk = ncols / 32, kb = item / nblk, nb = item % nblk, k0 = 64 * kb, n0 = 32 * nb;
    int d0 = row_off + n0;
    if (mode == 1) { d0 = (n0 < 512) ? (256 * (n0 >> 7) + (n0 & 127)) : (256 * ((n0 - 512) >> 7) + 128 + ((n0 - 512) & 127)); }
#pragma unroll 8
    for (int i = 0; i < 32; ++i) { const int kk = 2 * i + (lane >> 5); scr[kk * 33 + (lane & 31)] = W[(size_t)(k0 + kk) * ldw + n0 + (lane & 31)]; }
    LDS_WAIT(); asm volatile("" ::: "memory");
    const int c = lane & 7;
#pragma unroll
    for (int j = 0; j < 4; ++j) { const int n = (lane >> 3) + 8 * j; const LAS float* s = scr + (8 * c) * 33 + n;
        v4u o; o.x = pk2(s[0 * 33], s[1 * 33]); o.y = pk2(s[2 * 33], s[3 * 33]); o.z = pk2(s[4 * 33], s[5 * 33]); o.w = pk2(s[6 * 33], s[7 * 33]);
        *(GAS v4u*)(WT + (size_t)(d0 + n) * K + k0 + 8 * c) = o; }
    LDS_WAIT(); asm volatile("" ::: "memory");
}

__device__ __forceinline__ void p0_meta(Frame& F) {
    const float* meta = F.in[1]; const float* nw = F.in[2]; const float* Win = F.in[3];
    LAS float* um = (LAS float*)(F.lds + RING_OFF);
#pragma unroll
    for (int rr = 0; rr < 2; ++rr) {
        const int r = 2 * F.wave + rr;
        f32x4 v[4]; float ss = 0.f;
#pragma unroll
        for (int j = 0; j < 4; ++j) { v[j] = *(const f32x4*)(meta + (size_t)r * DM + 4 * F.lane + 256 * j); ss += (v[j].x * v[j].x + v[j].y * v[j].y) + (v[j].z * v[j].z + v[j].w * v[j].w); }
        const float rs = 1.0f / sqrtf(wave_sum(ss) * (1.0f / DM) + EPS);
#pragma unroll
        for (int j = 0; j < 4; ++j) { const f32x4 w = *(const f32x4*)(nw + 4 * F.lane + 256 * j); const int k = 4 * F.lane + 256 * j;
            um[(k + 0) * 16 + r] = v[j].x * rs * w.x; um[(k + 1) * 16 + r] = v[j].y * rs * w.y; um[(k + 2) * 16 + r] = v[j].z * rs * w.z; um[(k + 3) * 16 + r] = v[j].w * rs * w.w; }
    }
    __syncthreads();
    const int item = F.vcu * NWAVES + F.wave;
    if (item < 49) {
        int type, strip;
        if (item < 8) { type = 0; strip = item; } else if (item < 16) { type = 1; strip = item - 8; } else if (item < 32) { type = 2; strip = item - 16; } else if (item < 48) { type = 3; strip = item - 32; } else { type = 4; strip = 0; }
        int col;
        if (type == 0) col = 512 + 64 * strip + F.lane; else if (type == 1) col = 1024 + 64 * strip + F.lane; else if (type == 2) col = 2568 + 64 * strip + F.lane;
        else if (type == 3) col = 3592 + 64 * strip + F.lane; else col = 1536 + (F.lane & 7);
        float acc[16];
#pragma unroll
        for (int r = 0; r < 16; ++r) acc[r] = 0.f;
#pragma unroll 4
        for (int k = 0; k < DM; ++k) {
            const float w = Win[(size_t)k * INW + col];
            const LAS f32x4* up = (const LAS f32x4*)(um + k * 16);
            const f32x4 u0 = up[0], u1 = up[1], u2 = up[2], u3 = up[3];
            acc[0] += w * u0.x; acc[1] += w * u0.y; acc[2] += w * u0.z; acc[3] += w * u0.w;
            acc[4] += w * u1.x; acc[5] += w * u1.y; acc[6] += w * u1.z; acc[7] += w * u1.w;
            acc[8] += w * u2.x; acc[9] += w * u2.y; acc[10] += w * u2.z; acc[11] += w * u2.w;
            acc[12] += w * u3.x; acc[13] += w * u3.y; acc[14] += w * u3.z; acc[15] += w * u3.w;
        }
        const int c = 64 * strip + F.lane;
        if (type == 0 || type == 1) {
            bf16* dst = (bf16*)(F.ws + (type == 0 ? WS_KA : WS_VA));
#pragma unroll
            for (int b = 0; b < 2; ++b) {
#pragma unroll
                for (int r = 0; r < 16; ++r) dst[((size_t)b * KROWS + r) * AWID + c] = (bf16)f2bf(acc[r]);
                for (int r = 16; r < 128; ++r) dst[((size_t)b * KROWS + r) * AWID + c] = (bf16)0;
            }
        } else if (type == 3) {
            bf16* dst = (bf16*)(F.ws + WS_VH);
#pragma unroll
            for (int b = 0; b < 2; ++b) {
                for (int r = 0; r < 48; ++r) dst[((size_t)b * HROWS + r) * DM + c] = (bf16)0;
#pragma unroll
                for (int r = 0; r < 16; ++r) dst[((size_t)b * HROWS + 48 + r) * DM + c] = (bf16)f2bf(acc[r]);
            }
        } else if (type == 2) {
            const float* lbl = F.in[5];
            const float lb = 1.0f / (1.0f + __expf(lbl[1024 + c] - lbl[c]));
            float kk[16], bb[16]; float run = 0.f;
#pragma unroll
            for (int r = 0; r < 16; ++r) { const float f = lb + (1.0f - lb) * (1.0f / (1.0f + __expf(-acc[r]))); kk[r] = 1.0f - f; run += __logf(f); bb[r] = run; }
            bf16* dst = (bf16*)(F.ws + WS_KD);
#pragma unroll
            for (int b = 0; b < 2; ++b) {
                for (int r = 0; r < 48; ++r) dst[((size_t)b * HROWS + r) * DM + c] = (bf16)0;
#pragma unroll
                for (int r = 0; r < 16; ++r) dst[((size_t)b * HROWS + 48 + r) * DM + c] = (bf16)f2bf(kk[r] * __expf(run - bb[r]));
            }
        } else {
            if (F.lane < 8) { float* lfam = (float*)(F.ws + WS_LFAM); const float bias = F.in[4][F.lane];
#pragma unroll
                for (int r = 0; r < 16; ++r) lfam[r * 8 + F.lane] = log_sigmoid(acc[r] + bias); }
        }
    }
    __syncthreads();
}

__device__ __forceinline__ void p0_rows(Frame& F) {
    const float* x = F.in[0]; const float* nw = F.in[2]; const float* Win = F.in[3]; const float* afb = F.in[4];
    LAS float* wfa = (LAS float*)(F.lds + RING_OFF);
    for (int i = F.tid; i < 8 * DM; i += NWAVES * 64) { const int k = i >> 3, h = i & 7; wfa[h * DM + k] = nw[k] * Win[(size_t)k * INW + 1536 + h]; }
    __syncthreads();
    const int gw = F.vcu * NWAVES + F.wave, NGW = F.G * NWAVES;
    f32x4 wv[4];
#pragma unroll
    for (int j = 0; j < 4; ++j) wv[j] = *(const f32x4*)(nw + 4 * F.lane + 256 * j);
    bf16* U = (bf16*)(F.ws + WS_U); float* lfa = (float*)(F.ws + WS_LFA);
    for (int m = gw; m < MR; m += NGW) {
        f32x4 v[4]; float ss = 0.f;
#pragma unroll
        for (int j = 0; j < 4; ++j) { v[j] = *(const f32x4*)(x + (size_t)m * DM + 4 * F.lane + 256 * j); ss += (v[j].x * v[j].x + v[j].y * v[j].y) + (v[j].z * v[j].z + v[j].w * v[j].w); }
        const float rs = 1.0f / sqrtf(wave_sum(ss) * (1.0f / DM) + EPS);
        GAS unsigned long long* o8 = (GAS unsigned long long*)(U + (size_t)m * DM) + F.lane;
#pragma unroll
        for (int j = 0; j < 4; ++j) { const f32x4 u = v[j] * rs * wv[j]; o8[64 * j] = (unsigned long long)pk2(u.x, u.y) | ((unsigned long long)pk2(u.z, u.w) << 32); }
        float z[8];
#pragma unroll
        for (int h = 0; h < 8; ++h) { float s = 0.f;
#pragma unroll
            for (int j = 0; j < 4; ++j) { const f32x4 w = *(const LAS f32x4*)(wfa + h * DM + 4 * F.lane + 256 * j); s += (v[j].x * w.x + v[j].y * w.y) + (v[j].z * w.z + v[j].w * w.w); }
            z[h] = wave_sum(s); }
        float zz = z[0];
#pragma unroll
        for (int h = 1; h < 8; ++h) zz = (F.lane == h) ? z[h] : zz;
        if (F.lane < 8) lfa[(size_t)m * 8 + F.lane] = log_sigmoid(zz * rs + afb[F.lane]);
    }
    __syncthreads();
}

__device__ __forceinline__ void p0_weights(Frame& F) {
    LAS float* scr = (LAS float*)(F.lds + RING_OFF + F.wave * 16384);
    const int gw = F.vcu * NWAVES + F.wave, NGW = F.G * NWAVES;
    constexpr int I1 = 16 * 48, I2 = 16 * 192, IA = 8 * 32, IH = 16 * 32, IO = 16 * 32;
    constexpr int NIT = I1 + I2 + IA + IH + IO;
    bf16* win = (bf16*)(F.ws + WS_WIN);
    for (int it = gw; it < NIT; it += NGW) {
        int r = it;
        if (r < I1) { p0_transpose_item(F.in[3], INW, DM, 1536, win, 0, 0, scr, r, F.lane); continue; } r -= I1;
        if (r < I2) { p0_transpose_item(F.in[3] + 1544, INW, DM, 6144, win, 0, 1536, scr, r, F.lane); continue; } r -= I2;
        if (r < IA) { p0_transpose_item(F.in[7], DM, AWID, DM, (bf16*)(F.ws + WS_WA), 0, 0, scr, r, F.lane); continue; } r -= IA;
        if (r < IH) { p0_transpose_item(F.in[8], DM, DM, DM, (bf16*)(F.ws + WS_WH), 0, 0, scr, r, F.lane); continue; } r -= IH;
        p0_transpose_item(F.in[9], DM, DM, DM, (bf16*)(F.ws + WS_WO), 0, 0, scr, r, F.lane);
    }
}
__device__ __forceinline__ void p7_expert_weights(Frame& F) {
    LAS float* scr = (LAS float*)(F.lds + RING_OFF + F.wave * 16384);
    const int gw = F.vcu * NWAVES + F.wave, NGW = F.G * NWAVES;
    constexpr int I1 = 16 * 32, I2 = 8 * 32;
    for (int it = gw; it < NE * (I1 + I2); it += NGW) {
        const int e = it / (I1 + I2); int r = it % (I1 + I2);
        if (r < I1) p0_transpose_item(F.in[15] + (size_t)e * DM * DM, DM, DM, DM, (bf16*)(F.ws + WS_WE1) + (size_t)e * DM * DM, 1, 0, scr, r, F.lane);
        else p0_transpose_item(F.in[16] + (size_t)e * EFF * DM, DM, EFF, DM, (bf16*)(F.ws + WS_WE2) + (size_t)e * DM * EFF, 0, 0, scr, r - I1, F.lane);
    }
}

__device__ __forceinline__ void p1_cumsum(Frame& F, int bh) {
    const int b = bh >> 3, h = bh & 7;
    const float* lfa = (const float*)(F.ws + WS_LFA); const float* lfam = (const float*)(F.ws + WS_LFAM); float* cl = (float*)(F.ws + WS_CL) + (size_t)bh * KROWS;
    LAS float* wtot = (LAS float*)(F.lds + RING_OFF);
    float cm = 0.f;
    for (int r = 0; r < 16; ++r) { cm += lfam[r * 8 + h]; if (F.tid == r) cl[r] = cm * 1.4426950408889634f; }
    if (F.tid >= 16 && F.tid < 128) cl[F.tid] = 1e30f;
    float loc[16]; float run = 0.f;
#pragma unroll
    for (int i = 0; i < 16; ++i) { run += lfa[((size_t)b * SEQ + 16 * F.tid + i) * 8 + h]; loc[i] = run; }
    float inc = run;
#pragma unroll
    for (int o = 1; o < 64; o <<= 1) { const float t = __shfl_up(inc, o); if (F.lane >= o) inc += t; }
    if (F.lane == 63) wtot[F.wave] = inc;
    __syncthreads();
    float pre = cm + (inc - run);
    for (int w = 0; w < F.wave; ++w) pre += wtot[w];
#pragma unroll
    for (int i = 0; i < 16; ++i) cl[128 + 16 * F.tid + i] = (pre + loc[i]) * 1.4426950408889634f;
    __syncthreads();
}

__device__ __forceinline__ void attn_simple_unit(Frame& F, int bh, int qb) {
    const int tid = F.tid, row = tid & 255, p = tid >> 8, b = bh >> 3, h = bh & 7;
    const bf16* QA = (const bf16*)(F.ws + WS_QA); const bf16* KA = (const bf16*)(F.ws + WS_KA); const bf16* VA = (const bf16*)(F.ws + WS_VA);
    const float* CL = (const float*)(F.ws + WS_CL) + (size_t)bh * KROWS; bf16* OA = (bf16*)(F.ws + WS_OA);
    LAS bf16* Ks = (LAS bf16*)(F.lds + RING_OFF); LAS bf16* Vs = (LAS bf16*)(F.lds + RING_OFF + 8192);
    LAS float* cks = (LAS float*)(F.lds + RING_OFF + 16384); LAS float* cmb = (LAS float*)(F.lds + RING_OFF + 16640);
    float q[64], o[64];
    const size_t qrow = (size_t)b * SEQ + 256 * qb + row;
#pragma unroll
    for (int c = 0; c < 8; ++c) { const v4u w = *(const v4u*)(QA + qrow * AWID + h * 64 + 8 * c);
        q[8 * c + 0] = blo(w.x); q[8 * c + 1] = bhi(w.x); q[8 * c + 2] = blo(w.y); q[8 * c + 3] = bhi(w.y); q[8 * c + 4] = blo(w.z); q[8 * c + 5] = bhi(w.z); q[8 * c + 6] = blo(w.w); q[8 * c + 7] = bhi(w.w); }
#pragma unroll
    for (int d = 0; d < 64; ++d) o[d] = 0.f;
    const int qp = 128 + 256 * qb + row; const float clq = CL[qp];
    float mx = -1e30f, l = 0.f;
    const int NT = 4 * qb + 6;
    for (int t = 0; t < NT; ++t) {
        if (t == 1) continue;
        __syncthreads();
        { const int r = tid >> 3, ch = tid & 7; const size_t g = ((size_t)b * KROWS + 64 * t + r) * AWID + h * 64 + ch * 8;
          *(LAS v4u*)(Ks + r * 64 + ch * 8) = *(const v4u*)(KA + g); *(LAS v4u*)(Vs + r * 64 + ch * 8) = *(const v4u*)(VA + g);
          if (tid < 64) cks[tid] = CL[64 * t + tid]; }
        __syncthreads();
        const int smax = (t == 0) ? 16 : 64;
        for (int s = p; s < smax; s += 2) {
            const int kp = 64 * t + s;
            if (t >= 2 && kp > qp) continue;
            float dot = 0.f;
#pragma unroll
            for (int c = 0; c < 8; ++c) { const v4u w = *(const LAS v4u*)(Ks + s * 64 + 8 * c);
                dot += q[8 * c + 0] * blo(w.x) + q[8 * c + 1] * bhi(w.x) + q[8 * c + 2] * blo(w.y) + q[8 * c + 3] * bhi(w.y) + q[8 * c + 4] * blo(w.z) + q[8 * c + 5] * bhi(w.z) + q[8 * c + 6] * blo(w.w) + q[8 * c + 7] * bhi(w.w); }
            const float sc = dot + (clq - cks[s]);
            const float mn = fmaxf(mx, sc), al = ex2(mx - mn), pp = ex2(sc - mn);
            l = l * al + pp; mx = mn;
#pragma unroll
            for (int c = 0; c < 8; ++c) { const v4u w = *(const LAS v4u*)(Vs + s * 64 + 8 * c);
                o[8 * c + 0] = o[8 * c + 0] * al + pp * blo(w.x); o[8 * c + 1] = o[8 * c + 1] * al + pp * bhi(w.x); o[8 * c + 2] = o[8 * c + 2] * al + pp * blo(w.y); o[8 * c + 3] = o[8 * c + 3] * al + pp * bhi(w.y);
                o[8 * c + 4] = o[8 * c + 4] * al + pp * blo(w.z); o[8 * c + 5] = o[8 * c + 5] * al + pp * bhi(w.z); o[8 * c + 6] = o[8 * c + 6] * al + pp * blo(w.w); o[8 * c + 7] = o[8 * c + 7] * al + pp * bhi(w.w); }
        }
    }
    __syncthreads();
    if (p == 1) { cmb[row * 66 + 0] = mx; cmb[row * 66 + 1] = l;
#pragma unroll
        for (int d = 0; d < 64; ++d) cmb[row * 66 + 2 + d] = o[d]; }
    __syncthreads();
    if (p == 0) { const float m1 = cmb[row * 66 + 0], l1 = cmb[row * 66 + 1]; const float mn = fmaxf(mx, m1), a0 = ex2(mx - mn), a1 = ex2(m1 - mn); const float inv = 1.0f / (l * a0 + l1 * a1);
#pragma unroll
        for (int c = 0; c < 8; ++c) { float r8[8];
#pragma unroll
            for (int e = 0; e < 8; ++e) r8[e] = (o[8 * c + e] * a0 + cmb[row * 66 + 2 + 8 * c + e] * a1) * inv;
            v4u w; w.x = pk2(r8[0], r8[1]); w.y = pk2(r8[2], r8[3]); w.z = pk2(r8[4], r8[5]); w.w = pk2(r8[6], r8[7]);
            *(v4u*)(OA + qrow * AWID + h * 64 + 8 * c) = w; } }
    __syncthreads();
}

__device__ __forceinline__ void hgrn_a_simple(Frame& F, int item) {
    const int bh = item / NCH, c = item % NCH, b = bh >> 3, h = bh & 7, tid = F.tid;
    const bf16* KD = (const bf16*)(F.ws + WS_KD); const bf16* VH = (const bf16*)(F.ws + WS_VH); bf16* US = (bf16*)(F.ws + WS_US);
    LAS float* KDs = (LAS float*)(F.lds + RING_OFF); LAS float* Vs = KDs + 8192;
    __syncthreads();
    { const int r = tid >> 3, cc = (tid & 7) * 16; const size_t g = ((size_t)b * HROWS + 64 * c + r) * DM + h * 128 + cc;
#pragma unroll
      for (int q2 = 0; q2 < 2; ++q2) { const v4u a = *(const v4u*)(KD + g + 8 * q2), v = *(const v4u*)(VH + g + 8 * q2); LAS float* kd = KDs + r * 128 + cc + 8 * q2; LAS float* vs = Vs + r * 128 + cc + 8 * q2;
          kd[0] = blo(a.x); kd[1] = bhi(a.x); kd[2] = blo(a.y); kd[3] = bhi(a.y); kd[4] = blo(a.z); kd[5] = bhi(a.z); kd[6] = blo(a.w); kd[7] = bhi(a.w);
          vs[0] = blo(v.x); vs[1] = bhi(v.x); vs[2] = blo(v.y); vs[3] = bhi(v.y); vs[4] = blo(v.z); vs[5] = bhi(v.z); vs[6] = blo(v.w); vs[7] = bhi(v.w); } }
    __syncthreads();
    const int k = tid >> 2, vg = (tid & 3) * 32;
    float acc[32];
#pragma unroll
    for (int j = 0; j < 32; ++j) acc[j] = 0.f;
    for (int s = 0; s < 64; ++s) { const float kd = KDs[s * 128 + k];
#pragma unroll
        for (int j4 = 0; j4 < 8; ++j4) { const f32x4 v = *(const LAS f32x4*)(Vs + s * 128 + vg + 4 * j4); acc[4 * j4 + 0] += kd * v.x; acc[4 * j4 + 1] += kd * v.y; acc[4 * j4 + 2] += kd * v.z; acc[4 * j4 + 3] += kd * v.w; } }
    bf16* dst = US + (size_t)item * (HK * HV) + k * 128 + vg;
#pragma unroll
    for (int j8 = 0; j8 < 4; ++j8) { v4u w; w.x = pk2(acc[8 * j8 + 0], acc[8 * j8 + 1]); w.y = pk2(acc[8 * j8 + 2], acc[8 * j8 + 3]); w.z = pk2(acc[8 * j8 + 4], acc[8 * j8 + 5]); w.w = pk2(acc[8 * j8 + 6], acc[8 * j8 + 7]); *(v4u*)(dst + 8 * j8) = w; }
}
__device__ __forceinline__ void hgrn_scan(Frame& F) {
    const bf16* EB = (const bf16*)(F.ws + WS_EB); bf16* US = (bf16*)(F.ws + WS_US);
    for (int idx = blockIdx.x * (NWAVES * 64) + F.tid; idx < 16 * 128 * 64; idx += F.G * NWAVES * 64) {
        const int bh = idx >> 13, rem = idx & 8191, k = rem >> 6, vp = rem & 63, b = bh >> 3, h = bh & 7;
        unsigned* base = (unsigned*)(US + (size_t)bh * NCH * (HK * HV) + k * 128) + vp;
        unsigned w = base[0]; float s0 = blo(w), s1 = bhi(w);
        for (int c = 1; c < NCH - 1; ++c) {
            const float a = bf2f(EB[((size_t)b * SEQ + 64 * (c - 1) + 63) * DM + h * 128 + k]);
            const unsigned uw = base[(size_t)c * (HK * HV / 2)];
            s0 = a * s0 + blo(uw); s1 = a * s1 + bhi(uw);
            base[(size_t)c * (HK * HV / 2)] = pk2(s0, s1);
        }
    }
}
__device__ __forceinline__ void hgrn_c_simple(Frame& F, int item) {
    const int bh = item >> 7, c = (item & 127) + 1, b = bh >> 3, h = bh & 7, tid = F.tid;
    const bf16* QH = (const bf16*)(F.ws + WS_QH); const bf16* EB = (const bf16*)(F.ws + WS_EB); const bf16* KT = (const bf16*)(F.ws + WS_KT); const bf16* VH = (const bf16*)(F.ws + WS_VH);
    const bf16* GH = (const bf16*)(F.ws + WS_GH); const bf16* US = (const bf16*)(F.ws + WS_US); bf16* OH = (bf16*)(F.ws + WS_OH); const float* hnw = F.in[6];
    LAS float* QE = (LAS float*)(F.lds + RING_OFF); LAS float* KTs = QE + 8192; LAS bf16* Ss = (LAS bf16*)(F.lds + RING_OFF + 65536); LAS bf16* Vs = (LAS bf16*)(F.lds + RING_OFF + 98304); LAS float* SC = (LAS float*)(F.lds + RING_OFF + 114688);
    const size_t r0 = (size_t)b * SEQ + 64 * (c - 1);
    __syncthreads();
    { const int r = tid >> 3, cc = (tid & 7) * 16; const size_t g = (r0 + r) * DM + h * 128 + cc; const size_t gv = ((size_t)b * HROWS + 64 * c + r) * DM + h * 128 + cc;
#pragma unroll
      for (int q2 = 0; q2 < 2; ++q2) { const v4u a = *(const v4u*)(QH + g + 8 * q2), e = *(const v4u*)(EB + g + 8 * q2), kt = *(const v4u*)(KT + g + 8 * q2);
          LAS float* qe = QE + r * 128 + cc + 8 * q2; LAS float* ks = KTs + r * 128 + cc + 8 * q2;
          qe[0] = blo(a.x) * blo(e.x); qe[1] = bhi(a.x) * bhi(e.x); qe[2] = blo(a.y) * blo(e.y); qe[3] = bhi(a.y) * bhi(e.y); qe[4] = blo(a.z) * blo(e.z); qe[5] = bhi(a.z) * bhi(e.z); qe[6] = blo(a.w) * blo(e.w); qe[7] = bhi(a.w) * bhi(e.w);
          ks[0] = blo(kt.x); ks[1] = bhi(kt.x); ks[2] = blo(kt.y); ks[3] = bhi(kt.y); ks[4] = blo(kt.z); ks[5] = bhi(kt.z); ks[6] = blo(kt.w); ks[7] = bhi(kt.w);
          *(LAS v4u*)(Vs + r * 128 + cc + 8 * q2) = *(const v4u*)(VH + gv + 8 * q2); }
      const bf16* sp = US + ((size_t)bh * NCH + (c - 1)) * (HK * HV);
#pragma unroll
      for (int i = 0; i < 4; ++i) *(LAS v4u*)(Ss + (tid + 512 * i) * 8) = *(const v4u*)(sp + (tid + 512 * i) * 8); }
    __syncthreads();
    const int t = tid >> 3, g8 = tid & 7;
#pragma unroll
    for (int j = 0; j < 8; ++j) { const int s = g8 * 8 + j; float d = 0.f;
        if (s <= t) { for (int k = 0; k < 128; k += 4) { const f32x4 a = *(const LAS f32x4*)(QE + t * 128 + k), kb = *(const LAS f32x4*)(KTs + s * 128 + k); d += (a.x * kb.x + a.y * kb.y) + (a.z * kb.z + a.w * kb.w); } }
        SC[t * 64 + s] = d; }
    __syncthreads();
    const int v0 = g8 * 16;
    float o[16];
#pragma unroll
    for (int j = 0; j < 16; ++j) o[j] = 0.f;
    for (int s = 0; s <= t; ++s) { const float sc = SC[t * 64 + s]; const v4u w0 = *(const LAS v4u*)(Vs + s * 128 + v0), w1 = *(const LAS v4u*)(Vs + s * 128 + v0 + 8);
        o[0] += sc * blo(w0.x); o[1] += sc * bhi(w0.x); o[2] += sc * blo(w0.y); o[3] += sc * bhi(w0.y); o[4] += sc * blo(w0.z); o[5] += sc * bhi(w0.z); o[6] += sc * blo(w0.w); o[7] += sc * bhi(w0.w);
        o[8] += sc * blo(w1.x); o[9] += sc * bhi(w1.x); o[10] += sc * blo(w1.y); o[11] += sc * bhi(w1.y); o[12] += sc * blo(w1.z); o[13] += sc * bhi(w1.z); o[14] += sc * blo(w1.w); o[15] += sc * bhi(w1.w); }
    for (int k = 0; k < 128; ++k) { const float qe = QE[t * 128 + k]; const v4u w0 = *(const LAS v4u*)(Ss + k * 128 + v0), w1 = *(const LAS v4u*)(Ss + k * 128 + v0 + 8);
        o[0] += qe * blo(w0.x); o[1] += qe * bhi(w0.x); o[2] += qe * blo(w0.y); o[3] += qe * bhi(w0.y); o[4] += qe * blo(w0.z); o[5] += qe * bhi(w0.z); o[6] += qe * blo(w0.w); o[7] += qe * bhi(w0.w);
        o[8] += qe * blo(w1.x); o[9] += qe * bhi(w1.x); o[10] += qe * blo(w1.y); o[11] += qe * bhi(w1.y); o[12] += qe * blo(w1.z); o[13] += qe * bhi(w1.z); o[14] += qe * blo(w1.w); o[15] += qe * bhi(w1.w); }
    float ss = 0.f;
#pragma unroll
    for (int j = 0; j < 16; ++j) ss += o[j] * o[j];
    ss += __shfl_xor(ss, 1); ss += __shfl_xor(ss, 2); ss += __shfl_xor(ss, 4);
    const float rs = 1.0f / sqrtf(ss * (1.0f / HV) + EPS);
    const size_t go = (r0 + t) * DM + h * 128 + v0;
    const v4u g0 = *(const v4u*)(GH + go), g1 = *(const v4u*)(GH + go + 8);
    float gg[16] = {blo(g0.x), bhi(g0.x), blo(g0.y), bhi(g0.y), blo(g0.z), bhi(g0.z), blo(g0.w), bhi(g0.w), blo(g1.x), bhi(g1.x), blo(g1.y), bhi(g1.y), blo(g1.z), bhi(g1.z), blo(g1.w), bhi(g1.w)};
    float y[16];
#pragma unroll
    for (int j = 0; j < 16; ++j) y[j] = o[j] * rs * hnw[v0 + j] * gg[j];
    v4u w; w.x = pk2(y[0], y[1]); w.y = pk2(y[2], y[3]); w.z = pk2(y[4], y[5]); w.w = pk2(y[6], y[7]); *(v4u*)(OH + go) = w;
    w.x = pk2(y[8], y[9]); w.y = pk2(y[10], y[11]); w.z = pk2(y[12], y[13]); w.w = pk2(y[14], y[15]); *(v4u*)(OH + go + 8) = w;
}

__device__ __forceinline__ void p7_router(Frame& F) {
    const float* h1 = F.out; const float* nfw = F.in[10]; const float* wrg = F.in[11]; const float* brg = F.in[12]; const float* wre = F.in[13]; const float* bre = F.in[14];
    bf16* XN = (bf16*)(F.ws + WS_XN); unsigned* ASG = (unsigned*)(F.ws + WS_ASG); float* GATE = (float*)(F.ws + WS_GATE);
    LAS float* T = (LAS float*)(F.lds + RING_OFF);
    for (int rb = F.vcu; rb < MR / 32; rb += F.G) {
        const int rowb = rb * 32 + F.wave * 4;
        float acc[4][36]; float ss[4];
#pragma unroll
        for (int r = 0; r < 4; ++r) { ss[r] = 0.f;
#pragma unroll
            for (int j = 0; j < 36; ++j) acc[r][j] = 0.f; }
        for (int q = 0; q < 4; ++q) {
            __syncthreads();
            for (int i = F.tid; i < 36 * 256; i += NWAVES * 64) { const int kk = i / 36, j = i % 36, k = 256 * q + kk;
                T[j * 256 + kk] = nfw[k] * (j < 4 ? wrg[k * 4 + j] : wre[k * 32 + (j - 4)]); }
            __syncthreads();
            f32x4 x[4];
#pragma unroll
            for (int r = 0; r < 4; ++r) { x[r] = *(const f32x4*)(h1 + (size_t)(rowb + r) * DM + 256 * q + 4 * F.lane); ss[r] += (x[r].x * x[r].x + x[r].y * x[r].y) + (x[r].z * x[r].z + x[r].w * x[r].w); }
#pragma unroll
            for (int j = 0; j < 36; ++j) { const f32x4 w = *(const LAS f32x4*)(T + j * 256 + 4 * F.lane);
#pragma unroll
                for (int r = 0; r < 4; ++r) acc[r][j] += (x[r].x * w.x + x[r].y * w.y) + (x[r].z * w.z + x[r].w * w.w); }
        }
#pragma unroll
        for (int r = 0; r < 4; ++r) {
            const int row = rowb + r;
            const float rs = 1.0f / sqrtf(wave_sum(ss[r]) * (1.0f / DM) + EPS);
            float lg[36];
#pragma unroll
            for (int j = 0; j < 36; ++j) lg[j] = wave_sum(acc[r][j]) * rs + (j < 4 ? brg[j] : bre[j - 4]);
            { GAS unsigned long long* o8 = (GAS unsigned long long*)(XN + (size_t)row * DM) + F.lane;
#pragma unroll
              for (int j = 0; j < 4; ++j) { const f32x4 v = *(const f32x4*)(h1 + (size_t)row * DM + 4 * F.lane + 256 * j); const f32x4 w = *(const f32x4*)(nfw + 4 * F.lane + 256 * j); const f32x4 u = v * rs * w;
                  o8[64 * j] = (unsigned long long)pk2(u.x, u.y) | ((unsigned long long)pk2(u.z, u.w) << 32); } }
            int g = 0; float gm = lg[0];
#pragma unroll
            for (int j = 1; j < 4; ++j) if (lg[j] > gm) { gm = lg[j]; g = j; }
            float gs = 0.f;
#pragma unroll
            for (int j = 0; j < 4; ++j) gs += __expf(lg[j] - gm);
            const float pg = 1.0f / gs;
            float es[8];
#pragma unroll
            for (int i = 0; i < 8; ++i) es[i] = (g == 0) ? lg[4 + i] : (g == 1) ? lg[12 + i] : (g == 2) ? lg[20 + i] : lg[28 + i];
            int i1 = 0; float v1 = es[0];
#pragma unroll
            for (int i = 1; i < 8; ++i) if (es[i] > v1) { v1 = es[i]; i1 = i; }
            int i2 = -1; float v2 = -3.0e38f;
#pragma unroll
            for (int i = 0; i < 8; ++i) if (i != i1 && es[i] > v2) { v2 = es[i]; i2 = i; }
            const float s1 = 1.0f / (1.0f + __expf(v2 - v1));
            if (F.lane == 0) {
                const unsigned e1 = (unsigned)(g * 8 + i1), e2 = (unsigned)(g * 8 + i2);
                const unsigned p1 = __hip_atomic_fetch_add((unsigned*)(F.ctl + CW_CNT + e1), 1u, RLX_AGENT), p2 = __hip_atomic_fetch_add((unsigned*)(F.ctl + CW_CNT + e2), 1u, RLX_AGENT);
                ASG[2 * row] = (e1 << 16) | p1; ASG[2 * row + 1] = (e2 << 16) | p2; GATE[2 * row] = pg * s1; GATE[2 * row + 1] = pg * (1.0f - s1);
            }
        }
    }
    __syncthreads();
}
__device__ __forceinline__ void p8_permute(Frame& F) {
    LAS unsigned* pst = (LAS unsigned*)(F.lds + RING_OFF);
    if (F.wave == 0) {
        const unsigned cnt = F.lane < NE ? ald((const unsigned*)(F.ctl + CW_CNT + F.lane)) : 0u; const unsigned nt = (cnt + 255u) >> 8;
        unsigned inc = nt;
#pragma unroll
        for (int o = 1; o < 64; o <<= 1) { const unsigned t = __shfl_up(inc, o); if (F.lane >= o) inc += t; }
        const unsigned excl = inc - nt;
        if (F.lane < NE) pst[F.lane] = excl * 256u;
        if (blockIdx.x == 0) {
            if (F.lane == NE - 1) __hip_atomic_store((unsigned*)(F.ctl + CW_NT), inc, RLX_AGENT);
            if (F.lane < NE) for (unsigned t = 0; t < nt; ++t) __hip_atomic_store((unsigned*)(F.ctl + CW_TILEE + excl + t), (unsigned)F.lane, RLX_AGENT);
        }
    }
    __syncthreads();
    const unsigned* ASG = (const unsigned*)(F.ws + WS_ASG); unsigned* SLOT = (unsigned*)(F.ws + WS_SLOT); const bf16* XN = (const bf16*)(F.ws + WS_XN); bf16* XS = (bf16*)(F.ws + WS_XS);
    const int gw = F.vcu * NWAVES + F.wave, NGW = F.G * NWAVES;
    for (int a = gw; a < 2 * MR; a += NGW) {
        const unsigned w = ald(ASG + a); const unsigned e = w >> 16, pos = w & 0xffffu; const unsigned slot = pst[e] + pos;
        if (F.lane == 0) SLOT[a] = slot;
        const v4u* src = (const v4u*)(XN + (size_t)(a >> 1) * DM); v4u* dst = (v4u*)(XS + (size_t)slot * DM);
        dst[F.lane] = src[F.lane]; dst[64 + F.lane] = src[64 + F.lane];
    }
    __syncthreads();
}
__device__ __forceinline__ void p11_final(Frame& F) {
    const unsigned* SLOT = (const unsigned*)(F.ws + WS_SLOT); const float* GATE = (const float*)(F.ws + WS_GATE); const bf16* Y = (const bf16*)(F.ws + WS_Y); const float* fw = F.in[17];
    const int gw = F.vcu * NWAVES + F.wave, NGW = F.G * NWAVES;
    for (int m = gw; m < MR; m += NGW) {
        const unsigned s0 = ald(SLOT + 2 * m), s1 = ald(SLOT + 2 * m + 1); const float g0 = aldf(GATE + 2 * m), g1 = aldf(GATE + 2 * m + 1);
        f32x4 v[4]; float ss = 0.f;
#pragma unroll
        for (int j = 0; j < 4; ++j) { v[j] = *(const f32x4*)(F.out + (size_t)m * DM + 4 * F.lane + 256 * j);
            const v2u y0 = *(const v2u*)(Y + (size_t)s0 * DM + 4 * F.lane + 256 * j), y1 = *(const v2u*)(Y + (size_t)s1 * DM + 4 * F.lane + 256 * j);
            v[j].x += g0 * blo(y0.x) + g1 * blo(y1.x); v[j].y += g0 * bhi(y0.x) + g1 * bhi(y1.x); v[j].z += g0 * blo(y0.y) + g1 * blo(y1.y); v[j].w += g0 * bhi(y0.y) + g1 * bhi(y1.y);
            ss += (v[j].x * v[j].x + v[j].y * v[j].y) + (v[j].z * v[j].z + v[j].w * v[j].w); }
        const float rs = 1.0f / sqrtf(wave_sum(ss) * (1.0f / DM) + EPS);
#pragma unroll
        for (int j = 0; j < 4; ++j) { const f32x4 w = *(const f32x4*)(fw + 4 * F.lane + 256 * j); *(f32x4*)(F.out + (size_t)m * DM + 4 * F.lane + 256 * j) = v[j] * rs * w; }
    }
}

struct Args { const float* in[18]; float* out; unsigned char* ws; int ph_lo, ph_hi, li, pad; };
__global__ void __launch_bounds__(NWAVES * 64, 2) fwd(Args args) {
    extern __shared__ __attribute__((aligned(16))) unsigned char lds[];
    Frame F;
    F.lds = (LAS unsigned char*)lds;
    F.MISC = (volatile LAS unsigned*)(F.lds + MISC_OFF);
    F.tid = threadIdx.x; F.lane = F.tid & 63; F.wave = __builtin_amdgcn_readfirstlane(F.tid >> 6);
    F.G = gridDim.x; { const int bx = blockIdx.x; F.vcu = (F.G % 8 == 0) ? (bx % 8) * (F.G / 8) + bx / 8 : bx; }
    F.ws = args.ws; F.ctl = (gu32*)(args.ws + WS_CTL); F.out = args.out;
#pragma unroll
    for (int i = 0; i < 18; ++i) F.in[i] = args.in[i];
    for (int u = F.tid; u < (LDS_BYTES - LDSCTL_OFF) / 4; u += NWAVES * 64) ((LAS unsigned*)(F.lds + LDSCTL_OFF))[u] = 0u;
    __syncthreads();
    const int bli = (N_LAUNCHES == NPHASE) ? 0 : args.li;
    XcdBarrier bar; bar.bar = (unsigned*)(F.ctl + CW_BAR) + bli * XCD_BAR_WORDS; bar.x = 0; bar.st = nullptr;
    if (N_LAUNCHES != NPHASE) bar = xcd_barrier_post((unsigned*)(F.ctl + CW_BAR) + bli * XCD_BAR_WORDS, F.MISC + 8);
#define GRID_BAR(seam) do { if (N_LAUNCHES == NPHASE) { if (F.tid == 0) __hip_atomic_store(F.ctl + CW_TMO, 0xBADBA0u | (unsigned)(seam), RLX_AGENT); } else { xcd_barrier(bar); } } while (0)
    const int lo = args.ph_lo, hi = args.ph_hi;
#define IN(k) (lo <= (k) && (k) < hi)
#define PHASE_BEGIN() do { int t_ = threadIdx.x; asm volatile("" : "+v"(t_)); F.tid = t_; F.lane = t_ & 63; } while (0)
#define BOTH(k) (IN(k) && IN((k) + 1))
    unsigned char* ws = args.ws;

    if (IN(0)) { PHASE_BEGIN();
        if (F.vcu < 7) p0_meta(F);
        p0_rows(F);
        p0_weights(F);
        if (BOTH(0)) GRID_BAR(0);
    }
    if (IN(1)) { PHASE_BEGIN();
        pg8::Gemm g{(const bf16*)(ws + WS_U), (const bf16*)(ws + WS_WIN), MR, NPROJ, DM, 0};
        pg8::StaticOrder S; S.init(MR, NPROJ, F.G, (int)blockIdx.x);
        pg8::EpiProj E{(bf16*)(ws + WS_QA), (bf16*)(ws + WS_KA), (bf16*)(ws + WS_VA), (bf16*)(ws + WS_QH), (bf16*)(ws + WS_EB), (bf16*)(ws + WS_KT), (bf16*)(ws + WS_KD), (bf16*)(ws + WS_VH),
                       (bf16*)(ws + WS_GH), (bf16*)(ws + WS_GA), (bf16*)(ws + WS_GT), F.in[5]};
        pg8::gemm_phase<pg8::EpiProj, pg8::StaticOrder, true, true>(F.lds + RING_OFF, g, S, E);
        __syncthreads();
        for (int bh = blockIdx.x; bh < 16; bh += F.G) p1_cumsum(F, bh);
        if (BOTH(1)) GRID_BAR(1);
    }
    if (IN(2)) { PHASE_BEGIN();
#if defined(ATTN_SIMPLE)
        for (int pid = F.vcu; pid < 256; pid += F.G) { const int bh = pid >> 4, s = pid & 15; attn_simple_unit(F, bh, s); attn_simple_unit(F, bh, 31 - s); }
#else
        static_assert(attn_body::ATTN_LDS_BYTES <= RING_BYTES, "attention LDS");
        for (int pid = F.vcu; pid < 256; pid += F.G) { const int bh = pid >> 4, s = pid & 15;
            for (int i = 0; i < 2; ++i)
                attn_body::attn_unit<8>(bh >> 3, bh & 7, i ? 31 - s : s, (const attn_body::bf16*)(ws + WS_QA), (const attn_body::bf16*)(ws + WS_KA), (const attn_body::bf16*)(ws + WS_VA), (attn_body::bf16*)(ws + WS_OA),
                                        (const float*)(ws + WS_CL) + (size_t)bh * KROWS, (char*)lds + RING_OFF); }
        __syncthreads();
#endif
        for (int it = F.vcu; it < 16 * NCH; it += F.G) hgrn_a_simple(F, it);
        if (BOTH(2)) GRID_BAR(2);
    }
    if (IN(3)) { PHASE_BEGIN(); hgrn_scan(F); if (BOTH(3)) GRID_BAR(3); }
    if (IN(4)) { PHASE_BEGIN();
        for (int it = F.vcu; it < 16 * 128; it += F.G) hgrn_c_simple(F, it);
        if (BOTH(4)) GRID_BAR(4);
    }
    if (IN(5)) { PHASE_BEGIN();
        { pg8::Gemm g{(const bf16*)(ws + WS_OA), (const bf16*)(ws + WS_WA), MR, DM, AWID, 0}; pg8::StaticOrder S; S.init(MR, DM, F.G, (int)blockIdx.x);
          pg8::EpiYa E{(const bf16*)(ws + WS_GA), (float*)(ws + WS_YA)};
          pg8::gemm_phase<pg8::EpiYa, pg8::StaticOrder, true, true>(F.lds + RING_OFF, g, S, E); }
        __syncthreads();
        { pg8::Gemm g{(const bf16*)(ws + WS_OH), (const bf16*)(ws + WS_WH), MR, DM, DM, 0}; pg8::StaticOrder S; S.init(MR, DM, F.G, (int)blockIdx.x);
          pg8::EpiMixed E{(const bf16*)(ws + WS_GT), (const float*)(ws + WS_YA), (bf16*)(ws + WS_MIX)};
          pg8::gemm_phase<pg8::EpiMixed, pg8::StaticOrder, true, true>(F.lds + RING_OFF, g, S, E); }
        if (BOTH(5)) GRID_BAR(5);
    }
    if (IN(6)) { PHASE_BEGIN();
        pg8::Gemm g{(const bf16*)(ws + WS_MIX), (const bf16*)(ws + WS_WO), MR, DM, DM, 0}; pg8::StaticOrder S; S.init(MR, DM, F.G, (int)blockIdx.x);
        pg8::EpiRes E{F.in[0], F.out};
        pg8::gemm_phase<pg8::EpiRes, pg8::StaticOrder, true, true>(F.lds + RING_OFF, g, S, E);
        if (BOTH(6)) GRID_BAR(6);
    }
    if (IN(7)) { PHASE_BEGIN(); p7_router(F); p7_expert_weights(F); if (BOTH(7)) GRID_BAR(7); }
    if (IN(8)) { PHASE_BEGIN(); p8_permute(F); if (BOTH(8)) GRID_BAR(8); }
    if (IN(9)) { PHASE_BEGIN();
        const int ntile = (int)__builtin_amdgcn_readfirstlane(ald((const unsigned*)(F.ctl + CW_NT)));
        pg8::Gemm g{(const bf16*)(ws + WS_XS), (const bf16*)(ws + WS_WE1), APAD, DM, DM, (size_t)DM * DM * 2};
        pg8::MoeOrder S{ntile * 4, F.G, F.vcu, (const unsigned*)(F.ctl + CW_TILEE)};
        pg8::EpiSwiglu E{(bf16*)(ws + WS_ACT)};
        pg8::gemm_phase<pg8::EpiSwiglu, pg8::MoeOrder, true, true>(F.lds + RING_OFF, g, S, E);
        if (BOTH(9)) GRID_BAR(9);
    }
    if (IN(10)) { PHASE_BEGIN();
        const int ntile = (int)__builtin_amdgcn_readfirstlane(ald((const unsigned*)(F.ctl + CW_NT)));
        pg8::Gemm g{(const bf16*)(ws + WS_ACT), (const bf16*)(ws + WS_WE2), APAD, DM, EFF, (size_t)DM * EFF * 2};
        pg8::MoeOrder S{ntile * 4, F.G, F.vcu, (const unsigned*)(F.ctl + CW_TILEE)};
        pg8::EpiPlain E{(bf16*)(ws + WS_Y), DM};
        pg8::gemm_phase<pg8::EpiPlain, pg8::MoeOrder, true, true>(F.lds + RING_OFF, g, S, E);
        if (BOTH(10)) GRID_BAR(10);
    }
    if (IN(11)) { PHASE_BEGIN(); p11_final(F); }
#undef IN
#undef BOTH
}

extern "C" void kernel_launch(void* const* d_in, const int* in_sizes, int n_in, void* d_out, int out_size, void* d_ws, size_t ws_size, hipStream_t stream) {
    static int grid = 0;
    if (grid == 0) {
        if (n_in != 18 || in_sizes[0] != MR * DM || out_size != MR * DM || ws_size < WS_END) {
            fprintf(stderr, "kernel_launch: unexpected problem: n_in %d in0 %d out %d ws %zu (need %zu); nothing launched\n", n_in, n_in > 0 ? in_sizes[0] : -1, out_size, ws_size, (size_t)WS_END); grid = -1; return; }
        int dev = 0, cus = 0, per_cu = 0;
        if (hipGetDevice(&dev) != hipSuccess || hipDeviceGetAttribute(&cus, hipDeviceAttributeMultiprocessorCount, dev) != hipSuccess) { grid = -1; return; }
        if (hipFuncSetAttribute((const void*)fwd, hipFuncAttributeMaxDynamicSharedMemorySize, LDS_BYTES) != hipSuccess) { fprintf(stderr, "kernel_launch: hipFuncSetAttribute failed\n"); grid = -1; return; }
        if (hipOccupancyMaxActiveBlocksPerMultiprocessor(&per_cu, (const void*)fwd, NWAVES * 64, LDS_BYTES) != hipSuccess || per_cu < 1)
            fprintf(stderr, "kernel_launch: note: occupancy query reports %d workgroups per CU\n", per_cu);
        (void)hipGetLastError();
        grid = cus;
    }
    if (grid < 0) return;
    if (hipMemsetAsync((char*)d_ws + WS_CTL, 0, CTL_ZERO_BYTES, stream) != hipSuccess) { fprintf(stderr, "kernel_launch: memset failed\n"); return; }
    Args a{};
    for (int i = 0; i < 18; ++i) a.in[i] = (const float*)d_in[i];
    a.out = (float*)d_out; a.ws = (unsigned char*)d_ws;
    for (int li = 0; li < N_LAUNCHES; ++li) {
        if (N_LAUNCHES == NPHASE) { a.ph_lo = li; a.ph_hi = li + 1; } else { a.ph_lo = 0; a.ph_hi = NPHASE; }
        a.li = li;
        hipLaunchKernelGGL(fwd, dim3(grid), dim3(NWAVES * 64), LDS_BYTES, stream, a);
        const hipError_t le = hipPeekAtLastError();
        if (le != hipSuccess) { fprintf(stderr, "kernel_launch: launch %d failed: %s\n", li, hipGetErrorName(le)); break; }
    }
}
```

```cpp
#include <hip/hip_runtime.h>
#include <hip/hip_bf16.h>
#include <cmath>
#include <cstdio>
#include <cstdint>

#ifndef MK_N_LAUNCHES
#define MK_N_LAUNCHES 1
#endif

namespace pg8 {
#define PG8_LAS __attribute__((address_space(3)))
typedef unsigned short bf16_t;
typedef short bf16x8 __attribute__((ext_vector_type(8)));
typedef float f32x4 __attribute__((ext_vector_type(4)));
typedef unsigned u32x4 __attribute__((ext_vector_type(4)));
typedef unsigned u32x2 __attribute__((ext_vector_type(2)));
constexpr int BM = 256, BK = 64, HALF = 128, HTB = HALF * BK * 2  , STAGE_BYTES = 8 * HTB, NXCD = 8, WGM = 8;

__host__ __device__ __forceinline__ int lds_byte(int r, int c) { const int st = (r >> 4) * 2 + (c >> 5), rr = r & 15, cc = c & 31, ob = rr * 64 + cc * 2; return st * 1024 + (ob ^ (((ob >> 9) & 1) << 5)); }
__host__ __device__ __forceinline__ void stage_rc(int b, int& R, int& C) { const int st = b / 1024, sb = b % 1024, swz = sb ^ (((sb >> 9) & 1) << 5); R = (st >> 1) * 16 + swz / 64; C = (st & 1) * 32 + (swz % 64) / 2; }
__host__ __device__ __forceinline__ int perm32(int rho) { const int n = rho >> 4, i = rho & 15; return 8 * (i >> 2) + 4 * n + (i & 3); }

struct Unit { int pm, pn, e; };
struct Gemm { const bf16_t* A; const bf16_t* Bt; int M, N, K; size_t bexp; };

struct StaticOrder {
    int nM, nN, nwg, G, c;
    __host__ __device__ void init(int M, int N, int G_, int c_) { nM = M / BM; nN = N / BM; nwg = nM * nN; G = G_; c = c_; }
    __host__ __device__ bool next(int i, Unit& u) const {
        const long L = (long)i * G + c; if (L >= nwg) return false;
        int wgid = (int)L; { const int q = nwg / NXCD, r = nwg % NXCD, xcd = wgid % NXCD, off = wgid / NXCD; wgid = (xcd < r ? xcd * (q + 1) : r * (q + 1) + (xcd - r) * q) + off; }
        const int nig = WGM * nN, gid = wgid / nig, fm = gid * WGM, gsz = (nM - fm) < WGM ? (nM - fm) : WGM;
        u.pm = fm + ((wgid % nig) % gsz); u.pn = (wgid % nig) / gsz; u.e = 0; return true;
    }
    __device__ __forceinline__ void a_ready(const Unit&) const {}
    __device__ __forceinline__ void done(const Unit&) const {}
};
struct MoeOrder {
    int ntu, G, c; const unsigned* tile_e;
    __device__ bool next(int i, Unit& u) const {
        const long L = (long)i * G + c; if (L >= ntu) return false;
        u.pm = (int)(L >> 2); u.pn = (int)(L & 3);
        u.e = (int)__builtin_amdgcn_readfirstlane(__hip_atomic_load(tile_e + u.pm, __ATOMIC_RELAXED, __HIP_MEMORY_SCOPE_AGENT)); return true;
    }
    __device__ __forceinline__ void a_ready(const Unit&) const {}
    __device__ __forceinline__ void done(const Unit&) const {}
};

__device__ __forceinline__ unsigned cvt_pk_bf16(float lo, float hi) { unsigned r; asm volatile("v_cvt_pk_bf16_f32 %0, %1, %2" : "=v"(r) : "v"(lo), "v"(hi)); return r; }
__device__ __forceinline__ float fsig(float x) { return __builtin_amdgcn_rcpf(1.0f + __builtin_amdgcn_exp2f(-1.4426950408889634f * x)); }
__device__ __forceinline__ float bflo(unsigned w) { return __builtin_bit_cast(float, w << 16); }
__device__ __forceinline__ float bfhi(unsigned w) { return __builtin_bit_cast(float, w & 0xffff0000u); }
__device__ __forceinline__ float dpp_shr(float v, int) { return v; }
#define PG8_SCAN16(v) do { \
    v += __builtin_bit_cast(float, __builtin_amdgcn_update_dpp(0, __builtin_bit_cast(int, v), 0x111, 0xf, 0xf, true)); \
    v += __builtin_bit_cast(float, __builtin_amdgcn_update_dpp(0, __builtin_bit_cast(int, v), 0x112, 0xf, 0xf, true)); \
    v += __builtin_bit_cast(float, __builtin_amdgcn_update_dpp(0, __builtin_bit_cast(int, v), 0x114, 0xf, 0xf, true)); \
    v += __builtin_bit_cast(float, __builtin_amdgcn_update_dpp(0, __builtin_bit_cast(int, v), 0x118, 0xf, 0xf, true)); } while (0)

constexpr float ATT_C2 = 0.125f * 1.4426950408889634f;
constexpr float HG_QS = 0.08838834764831845f;

struct EpiProj {
    static constexpr bool PERM = true, AFTER_DRAIN = false;
    bf16_t *QA, *KA, *VA, *QH, *EB, *KT, *KD, *VH, *GH, *GA, *GT; const float* lbl;
    __device__ __forceinline__ void operator()(const f32x4 (&acc)[2][2][4][2], const Unit& u, int wr, int wc, int fr, int fq) const {
        const int pn = u.pn, b = u.pm >> 5;
        const int cofs = wc * 32 + 8 * fq;
        const int row0 = u.pm * BM + wr * 64 + fr;
        if (pn >= 10 && pn < 14) {
            const int colbase = 256 * (pn - 10), lane = fq * 16 + fr, srcl = (lane & 48) | 15;
#pragma unroll
            for (int ai = 0; ai < 2; ++ai)
#pragma unroll
                for (int bj = 0; bj < 2; ++bj)
#pragma unroll
                    for (int n = 0; n < 2; ++n) {
                        const int c0 = colbase + 128 * bj + cofs + 4 * n;
                        const f32x4 l0 = *(const f32x4*)(lbl + c0), l1 = *(const f32x4*)(lbl + 1024 + c0);
                        float eb[4][4], kt[4][4], kd[4][4];
#pragma unroll
                        for (int e = 0; e < 4; ++e) {
                            const float lb = __builtin_amdgcn_rcpf(1.0f + __builtin_amdgcn_exp2f((l1[e] - l0[e]) * 1.4426950408889634f));
                            float lf[4], kk[4];
#pragma unroll
                            for (int m = 0; m < 4; ++m) { const float f = lb + (1.0f - lb) * fsig(acc[ai][bj][m][n][e]); kk[m] = 1.0f - f; lf[m] = __builtin_amdgcn_logf(f); }
#pragma unroll
                            for (int m = 0; m < 4; ++m) PG8_SCAN16(lf[m]);
                            float run = 0.f, bb[4];
#pragma unroll
                            for (int m = 0; m < 4; ++m) { const float tot = __shfl(lf[m], srcl); bb[m] = lf[m] + run; run += tot; }
#pragma unroll
                            for (int m = 0; m < 4; ++m) { eb[m][e] = __builtin_amdgcn_exp2f(bb[m]); kt[m][e] = kk[m] * __builtin_amdgcn_exp2f(-bb[m]); kd[m][e] = kk[m] * __builtin_amdgcn_exp2f(run - bb[m]); }
                        }
#pragma unroll
                        for (int m = 0; m < 4; ++m) {
                            const size_t r = (size_t)(row0 + ai * HALF + m * 16);
                            u32x2 w;
                            w.x = cvt_pk_bf16(eb[m][0], eb[m][1]); w.y = cvt_pk_bf16(eb[m][2], eb[m][3]); *(u32x2*)(EB + r * 1024 + c0) = w;
                            w.x = cvt_pk_bf16(kt[m][0], kt[m][1]); w.y = cvt_pk_bf16(kt[m][2], kt[m][3]); *(u32x2*)(KT + r * 1024 + c0) = w;
                            w.x = cvt_pk_bf16(kd[m][0], kd[m][1]); w.y = cvt_pk_bf16(kd[m][2], kd[m][3]); *(u32x2*)(KD + (r + 64 * (b + 1)) * 1024 + c0) = w;
                        }
                    }
            return;
        }
        bf16_t* base; int ld = 1024, radd = 0, cb; int mode = 0; float sc = 1.f;
        if (pn < 2) { base = QA; ld = 512; cb = 256 * pn; sc = ATT_C2; }
        else if (pn < 4) { base = KA; ld = 512; cb = 256 * (pn - 2); radd = 128 * (b + 1); }
        else if (pn < 6) { base = VA; ld = 512; cb = 256 * (pn - 4); radd = 128 * (b + 1); }
        else if (pn < 10) { base = QH; cb = 256 * (pn - 6); sc = HG_QS; }
        else if (pn < 18) { base = VH; cb = 256 * (pn - 14); radd = 64 * (b + 1); }
        else if (pn < 22) { base = GH; cb = 256 * (pn - 18); mode = 1; }
        else if (pn < 26) { base = GA; cb = 256 * (pn - 22); mode = 1; }
        else { base = GT; cb = 256 * (pn - 26); mode = 1; }
#pragma unroll
        for (int ai = 0; ai < 2; ++ai)
#pragma unroll
            for (int m = 0; m < 4; ++m) { bf16_t* rowp = base + (size_t)(row0 + ai * HALF + m * 16 + radd) * ld + cb + cofs;
#pragma unroll
                for (int bj = 0; bj < 2; ++bj) { f32x4 v0 = acc[ai][bj][m][0], v1 = acc[ai][bj][m][1];
                    if (mode) {
#pragma unroll
                        for (int e = 0; e < 4; ++e) { v0[e] = fsig(v0[e]); v1[e] = fsig(v1[e]); }
                    } else { v0 = v0 * sc; v1 = v1 * sc; }
                    u32x4 w; w.x = cvt_pk_bf16(v0[0], v0[1]); w.y = cvt_pk_bf16(v0[2], v0[3]); w.z = cvt_pk_bf16(v1[0], v1[1]); w.w = cvt_pk_bf16(v1[2], v1[3]);
                    *(u32x4*)(rowp + bj * HALF) = w; } }
    }
};
struct EpiYa {
    static constexpr bool PERM = true, AFTER_DRAIN = false;
    const bf16_t* G; float* Y;
    __device__ __forceinline__ void operator()(const f32x4 (&acc)[2][2][4][2], const Unit& u, int wr, int wc, int fr, int fq) const {
        const int row0 = u.pm * BM + wr * 64 + fr, col0 = u.pn * BM + wc * 32 + 8 * fq;
#pragma unroll
        for (int ai = 0; ai < 2; ++ai)
#pragma unroll
            for (int m = 0; m < 4; ++m) { const size_t off = (size_t)(row0 + ai * HALF + m * 16) * 1024 + col0;
#pragma unroll
                for (int bj = 0; bj < 2; ++bj) { const u32x4 g = *(const u32x4*)(G + off + bj * HALF);
                    f32x4 v0 = acc[ai][bj][m][0], v1 = acc[ai][bj][m][1];
                    v0[0] *= bflo(g.x); v0[1] *= bfhi(g.x); v0[2] *= bflo(g.y); v0[3] *= bfhi(g.y); v1[0] *= bflo(g.z); v1[1] *= bfhi(g.z); v1[2] *= bflo(g.w); v1[3] *= bfhi(g.w);
                    *(f32x4*)(Y + off + bj * HALF) = v0; *(f32x4*)(Y + off + bj * HALF + 4) = v1; } }
    }
};
struct EpiMixed {
    static constexpr bool PERM = true, AFTER_DRAIN = false;
    const bf16_t* G; const float* Y; bf16_t* O;
    __device__ __forceinline__ void operator()(const f32x4 (&acc)[2][2][4][2], const Unit& u, int wr, int wc, int fr, int fq) const {
        const int row0 = u.pm * BM + wr * 64 + fr, col0 = u.pn * BM + wc * 32 + 8 * fq;
#pragma unroll
        for (int ai = 0; ai < 2; ++ai)
#pragma unroll
            for (int m = 0; m < 4; ++m) { const size_t off = (size_t)(row0 + ai * HALF + m * 16) * 1024 + col0;
#pragma unroll
                for (int bj = 0; bj < 2; ++bj) { const u32x4 g = *(const u32x4*)(G + off + bj * HALF);
                    const f32x4 y0 = *(const f32x4*)(Y + off + bj * HALF), y1 = *(const f32x4*)(Y + off + bj * HALF + 4);
                    f32x4 v0 = acc[ai][bj][m][0], v1 = acc[ai][bj][m][1];
                    v0[0] = y0[0] + v0[0] * bflo(g.x); v0[1] = y0[1] + v0[1] * bfhi(g.x); v0[2] = y0[2] + v0[2] * bflo(g.y); v0[3] = y0[3] + v0[3] * bfhi(g.y);
                    v1[0] = y1[0] + v1[0] * bflo(g.z); v1[1] = y1[1] + v1[1] * bfhi(g.z); v1[2] = y1[2] + v1[2] * bflo(g.w); v1[3] = y1[3] + v1[3] * bfhi(g.w);
                    u32x4 w; w.x = cvt_pk_bf16(v0[0], v0[1]); w.y = cvt_pk_bf16(v0[2], v0[3]); w.z = cvt_pk_bf16(v1[0], v1[1]); w.w = cvt_pk_bf16(v1[2], v1[3]);
                    *(u32x4*)(O + off + bj * HALF) = w; } }
    }
};
struct EpiRes {
    static constexpr bool PERM = true, AFTER_DRAIN = false;
    const float* X; float* O;
    __device__ __forceinline__ void operator()(const f32x4 (&acc)[2][2][4][2], const Unit& u, int wr, int wc, int fr, int fq) const {
        const int row0 = u.pm * BM + wr * 64 + fr, col0 = u.pn * BM + wc * 32 + 8 * fq;
#pragma unroll
        for (int ai = 0; ai < 2; ++ai)
#pragma unroll
            for (int m = 0; m < 4; ++m) { const size_t off = (size_t)(row0 + ai * HALF + m * 16) * 1024 + col0;
#pragma unroll
                for (int bj = 0; bj < 2; ++bj) {
                    const f32x4 x0 = *(const f32x4*)(X + off + bj * HALF), x1 = *(const f32x4*)(X + off + bj * HALF + 4);
                    *(f32x4*)(O + off + bj * HALF) = x0 + acc[ai][bj][m][0]; *(f32x4*)(O + off + bj * HALF + 4) = x1 + acc[ai][bj][m][1]; } }
    }
};
struct EpiSwiglu {
    static constexpr bool PERM = true, AFTER_DRAIN = false;
    bf16_t* O;
    __device__ __forceinline__ void operator()(const f32x4 (&acc)[2][2][4][2], const Unit& u, int wr, int wc, int fr, int fq) const {
        const int row0 = u.pm * BM + wr * 64 + fr, col0 = u.pn * HALF + wc * 32 + 8 * fq;
#pragma unroll
        for (int ai = 0; ai < 2; ++ai)
#pragma unroll
            for (int m = 0; m < 4; ++m) { const size_t off = (size_t)(row0 + ai * HALF + m * 16) * 512 + col0;
                f32x4 v0, v1;
#pragma unroll
                for (int e = 0; e < 4; ++e) { const float a0 = acc[ai][0][m][0][e], a1 = acc[ai][0][m][1][e];
                    v0[e] = a0 * fsig(a0) * acc[ai][1][m][0][e]; v1[e] = a1 * fsig(a1) * acc[ai][1][m][1][e]; }
                u32x4 w; w.x = cvt_pk_bf16(v0[0], v0[1]); w.y = cvt_pk_bf16(v0[2], v0[3]); w.z = cvt_pk_bf16(v1[0], v1[1]); w.w = cvt_pk_bf16(v1[2], v1[3]);
                *(u32x4*)(O + off) = w; }
    }
};
struct EpiPlain {
    static constexpr bool PERM = true, AFTER_DRAIN = false;
    bf16_t* O; int ldc;
    __device__ __forceinline__ void operator()(const f32x4 (&acc)[2][2][4][2], const Unit& u, int wr, int wc, int fr, int fq) const {
        const int row0 = u.pm * BM + wr * 64 + fr, col0 = u.pn * BM + wc * 32 + 8 * fq;
#pragma unroll
        for (int ai = 0; ai < 2; ++ai)
#pragma unroll
            for (int m = 0; m < 4; ++m) { const size_t off = (size_t)(row0 + ai * HALF + m * 16) * ldc + col0;
#pragma unroll
                for (int bj = 0; bj < 2; ++bj) { const f32x4 v0 = acc[ai][bj][m][0], v1 = acc[ai][bj][m][1];
                    u32x4 w; w.x = cvt_pk_bf16(v0[0], v0[1]); w.y = cvt_pk_bf16(v0[2], v0[3]); w.z = cvt_pk_bf16(v1[0], v1[1]); w.w = cvt_pk_bf16(v1[2], v1[3]);
                    *(u32x4*)(O + off + bj * HALF) = w; } }
    }
};

template <class Epi, class Sched, bool ALIGN_EPI = false, bool SP2 = false>
__device__ __forceinline__ void gemm_phase(PG8_LAS unsigned char* lds, const Gemm g, const Sched& S, const Epi& E) {
    int tid_l = threadIdx.x; asm volatile("" : "+v"(tid_l));
    const int tid = tid_l, wid = __builtin_amdgcn_readfirstlane(tid >> 6), lane = tid & 63, wr = wid >> 2, wc = wid & 3, fr = lane & 15, fq = lane >> 4;
    const int K = g.K, nt = K / BK;
    unsigned voffA[2], voffB[2];
#pragma unroll
    for (int i = 0; i < 2; ++i) { int R, C; stage_rc(tid * 16 + i * 8192, R, C); const int Rb = Epi::PERM ? ((R & ~31) + perm32(R & 31)) : R;
        voffA[i] = (unsigned)(R * K + C) * 2u; voffB[i] = (unsigned)(Rb * K + C) * 2u; }
    const size_t kstep = (size_t)(BK * 2);
    const size_t hstep = (size_t)HALF * K * 2;
    const size_t tstep = 2 * hstep;
    const unsigned ldsw = (unsigned)wid * 1024u;
    const int aoff = lds_byte(wr * 64 + fr, fq * 8), boff = lds_byte(wc * 32 + fr, fq * 8);
#define PG8_SA(b, h) (((b) * 2 + (h)) * HTB)
#define PG8_SB(b, h) ((4 + (b) * 2 + (h)) * HTB)
#define PG8_STAGE(bufoff, gbase, voff) do { _Pragma("unroll") for (int _i = 0; _i < 2; ++_i) \
        __builtin_amdgcn_global_load_lds((const unsigned*)((const char*)(gbase) + (voff)[_i]), (PG8_LAS unsigned*)(lds + (bufoff) + ldsw + _i * 8192), 16, 0, 0); } while (0)
#define PG8_LDA(dst, b, h) do { _Pragma("unroll") for (int m = 0; m < 4; ++m) _Pragma("unroll") for (int k = 0; k < 2; ++k) dst[m][k] = *(const PG8_LAS bf16x8*)(lds + PG8_SA(b, h) + aoff + m * 2048 + k * 1024); } while (0)
#define PG8_LDB(dst, b, h) do { _Pragma("unroll") for (int n = 0; n < 2; ++n) _Pragma("unroll") for (int k = 0; k < 2; ++k) dst[n][k] = *(const PG8_LAS bf16x8*)(lds + PG8_SB(b, h) + boff + n * 2048 + k * 1024); } while (0)
#define PG8_MMA(ai, bj, At, Bt) do { __builtin_amdgcn_s_setprio(1); _Pragma("unroll") for (int m = 0; m < 4; ++m) _Pragma("unroll") for (int n = 0; n < 2; ++n) _Pragma("unroll") for (int k = 0; k < 2; ++k) \
        acc[ai][bj][m][n] = __builtin_amdgcn_mfma_f32_16x16x32_bf16(Bt[n][k], At[m][k], acc[ai][bj][m][n], 0, 0, 0); __builtin_amdgcn_s_setprio(0); } while (0)
#define PG8_WAIT_V(n) asm volatile("s_waitcnt vmcnt(" #n ")" ::: "memory")
#define PG8_WAIT_L(n) asm volatile("s_waitcnt lgkmcnt(" #n ")" ::: "memory")
#define PG8_BAR __builtin_amdgcn_s_barrier()
#define PG8_SCHED __builtin_amdgcn_sched_barrier(0)
    Unit cur, nxt; int ui = 0;
    if (!S.next(0, cur)) return;
    f32x4 acc[2][2][4][2];
#pragma unroll
    for (int a = 0; a < 2; ++a)
#pragma unroll
        for (int b = 0; b < 2; ++b)
#pragma unroll
            for (int m = 0; m < 4; ++m)
#pragma unroll
                for (int n = 0; n < 2; ++n) acc[a][b][m][n] = (f32x4){0.f, 0.f, 0.f, 0.f};
    bf16x8 At[4][2], B0[2][2], B1[2][2];
    const char* cA = (const char*)g.A + (size_t)cur.pm * tstep; const char* cB = (const char*)g.Bt + (size_t)cur.e * g.bexp + (size_t)cur.pn * tstep;
    S.a_ready(cur);
    if constexpr (SP2) {
        PG8_STAGE(PG8_SB(0, 0), cB, voffB); PG8_STAGE(PG8_SB(0, 1), cB + hstep, voffB); PG8_STAGE(PG8_SA(0, 0), cA, voffA); PG8_STAGE(PG8_SA(0, 1), cA + hstep, voffA);
        if (wr == 1) PG8_BAR;
        PG8_WAIT_V(2); PG8_BAR;
        PG8_STAGE(PG8_SB(1, 0), cB + kstep, voffB); PG8_STAGE(PG8_SA(1, 0), cA + kstep, voffA); PG8_STAGE(PG8_SB(1, 1), cB + hstep + kstep, voffB);
        PG8_WAIT_V(6); PG8_BAR;
    } else {
        PG8_STAGE(PG8_SB(0, 0), cB, voffB); PG8_STAGE(PG8_SA(0, 0), cA, voffA); PG8_STAGE(PG8_SB(0, 1), cB + hstep, voffB); PG8_STAGE(PG8_SA(0, 1), cA + hstep, voffA);
        if (wr == 1) PG8_BAR;
        PG8_WAIT_V(4); PG8_BAR;
        PG8_STAGE(PG8_SB(1, 0), cB + kstep, voffB); PG8_STAGE(PG8_SA(1, 0), cA + kstep, voffA); PG8_STAGE(PG8_SB(1, 1), cB + hstep + kstep, voffB);
        PG8_WAIT_V(6); PG8_BAR;
    }
    for (;;) {
        const bool has_next = S.next(ui + 1, nxt);
        const char* nA = has_next ? (const char*)g.A + (size_t)nxt.pm * tstep : cA; const char* nB = has_next ? (const char*)g.Bt + (size_t)nxt.e * g.bexp + (size_t)nxt.pn * tstep : cB;
        for (int t = 0; t < nt; t += 2) {
            const bool last = (t == nt - 2);
            const char* a1 = cA + (size_t)(t + 1) * kstep;
            const char* a2 = last ? nA : cA + (size_t)(t + 2) * kstep; const char* b2 = last ? nB : cB + (size_t)(t + 2) * kstep;
            const char* a3 = a2 + kstep; const char* b3 = b2 + kstep;
            if (last && has_next) S.a_ready(nxt);
            if constexpr (SP2) {
            PG8_LDB(B0, 0, 0); PG8_LDB(B1, 0, 1); PG8_SCHED; PG8_LDA(At, 0, 0); PG8_STAGE(PG8_SA(1, 1), a1 + hstep, voffA);
            PG8_WAIT_V(8); PG8_WAIT_L(0); PG8_BAR; PG8_MMA(0, 0, At, B0); PG8_MMA(0, 1, At, B1); PG8_BAR; PG8_SCHED;
            PG8_LDA(At, 0, 1); PG8_STAGE(PG8_SB(0, 0), b2, voffB); PG8_STAGE(PG8_SB(0, 1), b2 + hstep, voffB); PG8_STAGE(PG8_SA(0, 0), a2, voffA);
            PG8_WAIT_V(8); PG8_WAIT_L(0); PG8_BAR; PG8_MMA(1, 0, At, B0); PG8_MMA(1, 1, At, B1); PG8_BAR; PG8_SCHED;
            PG8_LDB(B0, 1, 0); PG8_LDB(B1, 1, 1); PG8_SCHED; PG8_LDA(At, 1, 0); PG8_STAGE(PG8_SA(0, 1), a2 + hstep, voffA);
            PG8_WAIT_V(8); PG8_WAIT_L(0); PG8_BAR; PG8_MMA(0, 0, At, B0); PG8_MMA(0, 1, At, B1); PG8_BAR; PG8_SCHED;
            PG8_LDA(At, 1, 1); PG8_STAGE(PG8_SB(1, 0), b3, voffB); PG8_STAGE(PG8_SB(1, 1), b3 + hstep, voffB); PG8_STAGE(PG8_SA(1, 0), a3, voffA);
            PG8_WAIT_V(8); PG8_WAIT_L(0); PG8_BAR; PG8_MMA(1, 0, At, B0); PG8_MMA(1, 1, At, B1); PG8_BAR; PG8_SCHED;
            } else {
            PG8_LDB(B0, 0, 0); PG8_SCHED; PG8_LDA(At, 0, 0); PG8_STAGE(PG8_SA(1, 1), a1 + hstep, voffA);
            PG8_WAIT_L(8); PG8_BAR; PG8_WAIT_L(0); PG8_MMA(0, 0, At, B0); PG8_BAR; PG8_SCHED;
            PG8_LDB(B1, 0, 1); PG8_STAGE(PG8_SB(0, 0), b2, voffB);
            PG8_BAR; PG8_WAIT_L(0); PG8_MMA(0, 1, At, B1); PG8_BAR;
            PG8_LDA(At, 0, 1); PG8_STAGE(PG8_SA(0, 0), a2, voffA);
            PG8_BAR; PG8_WAIT_L(0); PG8_MMA(1, 0, At, B0); PG8_BAR; PG8_SCHED;
            PG8_STAGE(PG8_SB(0, 1), b2 + hstep, voffB);
            PG8_WAIT_V(6); PG8_BAR; PG8_MMA(1, 1, At, B1); PG8_BAR;
            PG8_LDB(B0, 1, 0); PG8_SCHED; PG8_LDA(At, 1, 0); PG8_STAGE(PG8_SA(0, 1), a2 + hstep, voffA);
            PG8_WAIT_L(8); PG8_BAR; PG8_WAIT_L(0); PG8_MMA(0, 0, At, B0); PG8_BAR; PG8_SCHED;
            PG8_LDB(B1, 1, 1); PG8_STAGE(PG8_SB(1, 0), b3, voffB);
            PG8_BAR; PG8_WAIT_L(0); PG8_MMA(0, 1, At, B1); PG8_BAR;
            PG8_LDA(At, 1, 1); PG8_STAGE(PG8_SA(1, 0), a3, voffA);
            PG8_BAR; PG8_WAIT_L(0); PG8_MMA(1, 0, At, B0); PG8_BAR; PG8_SCHED;
            PG8_STAGE(PG8_SB(1, 1), b3 + hstep, voffB);
            PG8_WAIT_V(6); PG8_BAR; PG8_MMA(1, 1, At, B1); PG8_BAR;
            }
        }
        if constexpr (ALIGN_EPI) { if (wr == 0) PG8_BAR; }
        if constexpr (!Epi::AFTER_DRAIN) { E(acc, cur, wr, wc, fr, fq); S.done(cur); }
        if (!has_next) break;
#pragma unroll
        for (int a = 0; a < 2; ++a)
#pragma unroll
            for (int b = 0; b < 2; ++b)
#pragma unroll
                for (int m = 0; m < 4; ++m)
#pragma unroll
                    for (int n = 0; n < 2; ++n) acc[a][b][m][n] = (f32x4){0.f, 0.f, 0.f, 0.f};
        cur = nxt; cA = nA; cB = nB; ++ui;
        if constexpr (ALIGN_EPI) { if (wr == 1) PG8_BAR; }
    }
    PG8_WAIT_V(0);
    if constexpr (!ALIGN_EPI) { if (wr == 0) PG8_BAR; }
    PG8_BAR;
    if constexpr (Epi::AFTER_DRAIN) { E.fused(acc, cur, wr, wc, fr, fq, lds, wid, lane); S.done(cur); }
#undef PG8_SA
#undef PG8_SB
#undef PG8_STAGE
#undef PG8_LDA
#undef PG8_LDB
#undef PG8_MMA
#undef PG8_WAIT_V
#undef PG8_WAIT_L
#undef PG8_BAR
#undef PG8_SCHED
}
}

constexpr int NWAVES = 8;
constexpr int NB = 2, SEQ = 8192, DM = 1024, MR = NB * SEQ;
constexpr int NMETA = 16, INW = 7688, NPROJ = 7680;
constexpr int AH = 8, ADH = 64, AWID = 512, KROWS = SEQ + 128;
constexpr int HH = 8, HK = 128, HV = 128, HROWS = SEQ + 64, NCH = 129;
constexpr int NE = 32, EFF = 512, APAD = 40960;
constexpr float EPS = 1e-6f;
constexpr int N_LAUNCHES = MK_N_LAUNCHES;
constexpr int NPHASE = 12;

constexpr size_t MiB = 1u << 20;
constexpr size_t WS_CTL = 0, CTL_ZERO_BYTES = 1 * MiB;
constexpr size_t WS_WIN = 1 * MiB, WS_WA = 16 * MiB, WS_WH = 17 * MiB, WS_WO = 19 * MiB;
constexpr size_t WS_LFA = 21 * MiB, WS_LFAM = WS_LFA + 512 * 1024, WS_CL = 22 * MiB, WS_ASG = 23 * MiB, WS_GATE = WS_ASG + 128 * 1024, WS_SLOT = WS_GATE + 128 * 1024, WS_GSORT = 24 * MiB;
constexpr size_t WS_U = 26 * MiB;
constexpr size_t WS_OA = 26 * MiB;
constexpr size_t WS_QA = 58 * MiB, WS_KA = 74 * MiB, WS_VA = 90 * MiB + 512 * 1024;
constexpr size_t WS_QH = 107 * MiB, WS_EB = 139 * MiB, WS_KT = 171 * MiB, WS_KD = 203 * MiB, WS_VH = 235 * MiB + 512 * 1024;
constexpr size_t WS_GH = 268 * MiB, WS_GA = 300 * MiB, WS_GT = 332 * MiB;
constexpr size_t WS_US = 364 * MiB;
constexpr size_t WS_OH = 429 * MiB;
constexpr size_t WS_YA = 107 * MiB;
constexpr size_t WS_MIX = 171 * MiB;
constexpr size_t WS_XN = 26 * MiB, WS_WE1 = 58 * MiB, WS_WE2 = 122 * MiB, WS_XS = 154 * MiB, WS_ACT = 234 * MiB, WS_Y = 274 * MiB;
constexpr size_t WS_END = 461 * MiB;
static_assert(WS_KA + (size_t)2 * KROWS * AWID * 2 <= WS_VA && WS_VA + (size_t)2 * KROWS * AWID * 2 <= WS_QH && WS_KD + (size_t)2 * HROWS * DM * 2 <= WS_VH && WS_VH + (size_t)2 * HROWS * DM * 2 <= WS_GH, "ws map");
static_assert(WS_US + (size_t)16 * NCH * HK * HV * 2 <= WS_OH && WS_OH + (size_t)MR * DM * 2 <= WS_END && WS_Y + (size_t)APAD * DM * 2 <= WS_END && WS_XS + (size_t)APAD * DM * 2 <= WS_ACT && WS_ACT + (size_t)APAD * EFF * 2 <= WS_Y, "ws map 2");
constexpr int CW_TMO = 0, CW_CODE = 1;
constexpr int CW_CNT = 1024;
constexpr int CW_NT = 2048;
constexpr int CW_TILEE = 2112;
constexpr int CW_BAR = 4096;

constexpr int RING_OFF = 0, RING_BYTES = 131072;
constexpr int LDSCTL_OFF = RING_BYTES, MISC_OFF = LDSCTL_OFF + 320;
constexpr int LDS_BYTES = 147456;

#define GAS __attribute__((address_space(1)))
#define LAS __attribute__((address_space(3)))
typedef unsigned short bf16;
typedef unsigned v4u __attribute__((ext_vector_type(4)));
typedef unsigned v2u __attribute__((ext_vector_type(2)));
typedef float f32x4 __attribute__((ext_vector_type(4)));
typedef short bf16x8 __attribute__((ext_vector_type(8)));
typedef GAS unsigned gu32;
typedef GAS unsigned long long gu64;
#define RLX_AGENT __ATOMIC_RELAXED, __HIP_MEMORY_SCOPE_AGENT
#define LDS_WAIT() asm volatile("s_waitcnt lgkmcnt(0)" ::: "memory")
#define VM_WAIT() asm volatile("s_waitcnt vmcnt(0)" ::: "memory")
__device__ __forceinline__ unsigned f2bf(float f) { unsigned u = __builtin_bit_cast(unsigned, f); return (u + 0x7fffu + ((u >> 16) & 1u)) >> 16; }
__device__ __forceinline__ unsigned pk2(float lo, float hi) { return f2bf(lo) | (f2bf(hi) << 16); }
__device__ __forceinline__ float bf2f(unsigned short h) { return __builtin_bit_cast(float, (unsigned)h << 16); }
__device__ __forceinline__ float blo(unsigned w) { return __builtin_bit_cast(float, w << 16); }
__device__ __forceinline__ float bhi(unsigned w) { return __builtin_bit_cast(float, w & 0xffff0000u); }
__device__ __forceinline__ float ex2(float x) { return __builtin_amdgcn_exp2f(x); }
__device__ __forceinline__ float sigm(float x) { return __builtin_amdgcn_rcpf(1.0f + ex2(-1.4426950408889634f * x)); }
__device__ __forceinline__ unsigned ald(const unsigned* p) { return __hip_atomic_load(p, __ATOMIC_RELAXED, __HIP_MEMORY_SCOPE_AGENT); }
__device__ __forceinline__ float aldf(const float* p) { return __builtin_bit_cast(float, __hip_atomic_load((const unsigned*)p, __ATOMIC_RELAXED, __HIP_MEMORY_SCOPE_AGENT)); }
__device__ __forceinline__ float log_sigmoid(float z) { const float a = fabsf(z); return fminf(z, 0.f) - __logf(1.0f + __expf(-a)); }

namespace attn_body {
using bf16=__hip_bfloat16;
using bf16x8=__attribute__((ext_vector_type(8)))short;
using s16x4=__attribute__((ext_vector_type(4)))short;
using f32x16=__attribute__((ext_vector_type(16)))float;
using u32x4=__attribute__((ext_vector_type(4)))unsigned;
using f32x4g=__attribute__((ext_vector_type(4)))float;
constexpr int BATCH=2,NHEAD=8,SEQ=8192,D=64,DM=NHEAD*D;
constexpr int KFRONT=128,KSEQ=SEQ+KFRONT;
constexpr int NW=8,QBLK=32,QB=QBLK*NW,KVBLK=64,NQB=SEQ/QB;
constexpr int ATTN_PITCH=DM, ATTN_UNIT_ROWS=QB;
__device__ __forceinline__ int crow(int r,int hi){return (r&3)+8*(r>>2)+4*hi;}
#define SBAR() __builtin_amdgcn_sched_barrier(0)
__device__ __forceinline__ void cmask(f32x16&p0,f32x16&p1,int jb,int qrel,int hi){
  const float NEG=-INFINITY; int kb=64*jb+4*hi;
  #pragma unroll
  for(int r=0;r<16;++r){int kv=kb+(r&3)+8*(r>>2); if(kv>qrel)p0[r]=NEG; if(kv+32>qrel)p1[r]=NEG;}
}

constexpr int NSLOT=3, SLOTB=8192;
constexpr int LDS_K=0, LDS_V=NSLOT*SLOTB, LDS_WS=2*NSLOT*SLOTB, LDS_OST=LDS_WS+NW*64*4, LDS_CLK=LDS_OST+NW*4096, LDS_BYTES=LDS_CLK+KSEQ*4;
constexpr float C2=0.125f*1.4426950408889634f;
__device__ __forceinline__ void glds16(const void*gsrc,unsigned lds_dst){unsigned keep;
  asm volatile("s_mov_b32 %0, m0\n\ts_mov_b32 m0, %2\n\ts_nop 0\n\tglobal_load_lds_dwordx4 %1, off\n\ts_mov_b32 m0, %0":"=&s"(keep):"v"(gsrc),"s"(lds_dst):"memory");}
__device__ __forceinline__ float max3f(float a,float b,float c){float r;asm("v_max3_f32 %0, %1, %2, %3":"=v"(r):"v"(a),"v"(b),"v"(c));return r;}
__device__ __forceinline__ float max2f(float a,float b){float r;asm("v_max_f32_e32 %0, %1, %2":"=v"(r):"v"(a),"v"(b));return r;}
__device__ __forceinline__ float fadd_s(float a,float b){float r;asm("v_add_f32_e32 %0, %1, %2":"=v"(r):"v"(a),"v"(b));return r;}
__device__ __forceinline__ float fsub_s(float a,float b){float r;asm("v_sub_f32_e32 %0, %1, %2":"=v"(r):"v"(a),"v"(b));return r;}
typedef float f32x2_t __attribute__((ext_vector_type(2))); typedef __bf16 bf16x2_t __attribute__((ext_vector_type(2)));
__device__ __forceinline__ unsigned cvtpk_s(float lo,float hi){f32x2_t v={lo,hi};bf16x2_t b=__builtin_convertvector(v,bf16x2_t);return __builtin_bit_cast(unsigned,b);}
#define WAIT_BAR(N) asm volatile("s_waitcnt vmcnt(" #N ") lgkmcnt(0)\n\ts_barrier":::"memory")

__device__ __forceinline__ void qkt(f32x16&p0,f32x16&p1,const char*Kslot,const bf16x8*qr,int r32,int hi){
  const char*kb=Kslot+hi*1024+r32*16;
  #pragma unroll
  for(int d0=0;d0<4;++d0){
    const bf16x8 b0=*reinterpret_cast<const bf16x8*>(kb+d0*2048);
    const bf16x8 b1=*reinterpret_cast<const bf16x8*>(kb+d0*2048+512);
    p0=__builtin_amdgcn_mfma_f32_32x32x16_bf16(b0,qr[d0],p0,0,0,0);p1=__builtin_amdgcn_mfma_f32_32x32x16_bf16(b1,qr[d0],p1,0,0,0);}
}
typedef __attribute__((address_space(3))) const char* lds_cptr;
typedef short v4i16_t __attribute__((ext_vector_type(4)));
__device__ __forceinline__ void kload8(bf16x8*kf,lds_cptr kp){
  kf[0]=*(const __attribute__((address_space(3))) bf16x8*)(kp);      kf[1]=*(const __attribute__((address_space(3))) bf16x8*)(kp+512);
  kf[2]=*(const __attribute__((address_space(3))) bf16x8*)(kp+2048); kf[3]=*(const __attribute__((address_space(3))) bf16x8*)(kp+2560);
  kf[4]=*(const __attribute__((address_space(3))) bf16x8*)(kp+4096); kf[5]=*(const __attribute__((address_space(3))) bf16x8*)(kp+4608);
  kf[6]=*(const __attribute__((address_space(3))) bf16x8*)(kp+6144); kf[7]=*(const __attribute__((address_space(3))) bf16x8*)(kp+6656);
}
__device__ __forceinline__ void kload2(bf16x8*kf,lds_cptr kp,int j){ kf[2*j]=*(const __attribute__((address_space(3))) bf16x8*)(kp+j*2048); kf[2*j+1]=*(const __attribute__((address_space(3))) bf16x8*)(kp+j*2048+512); }
__device__ __forceinline__ s16x4 vtr(lds_cptr p){ return __builtin_bit_cast(s16x4,__builtin_amdgcn_ds_read_tr16_b64_v4i16((__attribute__((address_space(3))) v4i16_t*)p)); }
__device__ __forceinline__ float rowmax(const f32x16&p0,const f32x16&p1){
  float a=max3f(p0[0],p0[1],p1[0]),b=max3f(p0[2],p0[3],p1[1]);a=max3f(a,p1[2],p1[3]);
  #pragma unroll
  for(int r=4;r<16;r+=4){a=max3f(a,p0[r],p0[r+1]);b=max3f(b,p0[r+2],p0[r+3]);a=max3f(a,p1[r],p1[r+1]);b=max3f(b,p1[r+2],p1[r+3]);}
  const float m=max2f(a,b);
  auto rr=__builtin_amdgcn_permlane32_swap(__float_as_uint(m),__float_as_uint(m),false,false);
  return max2f(__uint_as_float(rr[0]),__uint_as_float(rr[1]));
}
__device__ __forceinline__ void pv(f32x16*o,int vb,bf16x8 pa0,bf16x8 pa1,bf16x8 pa2,bf16x8 pa3){
  #pragma unroll
  for(int d0=0;d0<2;++d0){s16x4 lo[4],hi[4];
    #pragma unroll
    for(int ks=0;ks<4;++ks){
      asm volatile("ds_read_b64_tr_b16 %0,%1 offset:%c2":"=&v"(lo[ks]):"v"(vb),"i"(d0*4096+ks*1024):"memory");
      asm volatile("ds_read_b64_tr_b16 %0,%1 offset:%c2":"=&v"(hi[ks]):"v"(vb),"i"(d0*4096+ks*1024+512):"memory");}
    asm volatile("s_waitcnt lgkmcnt(0)":::"memory");SBAR();
    #define PK(k) (bf16x8){lo[k][0],lo[k][1],lo[k][2],lo[k][3],hi[k][0],hi[k][1],hi[k][2],hi[k][3]}
    o[d0]=__builtin_amdgcn_mfma_f32_32x32x16_bf16(pa0,PK(0),o[d0],0,0,0);
    o[d0]=__builtin_amdgcn_mfma_f32_32x32x16_bf16(pa1,PK(1),o[d0],0,0,0);
    o[d0]=__builtin_amdgcn_mfma_f32_32x32x16_bf16(pa2,PK(2),o[d0],0,0,0);
    o[d0]=__builtin_amdgcn_mfma_f32_32x32x16_bf16(pa3,PK(3),o[d0],0,0,0);
    #undef PK
  }
}

#ifndef ATTN_STORE16
#define ATTN_STORE16(p,v) (*(u32x4*)(p)=(v))
#endif
template<int THRL> __device__ __forceinline__ void attn_unit(int b,int h,int qb,const bf16*Q,const bf16*__restrict__ K,const bf16*__restrict__ V,bf16*O,const float*CLg,char*shm){
  int tid_l=threadIdx.x; asm volatile("":"+v"(tid_l)); const int tid=tid_l,lane=tid&63,r32=lane&31,hi=lane>>5; const int wid=__builtin_amdgcn_readfirstlane(tid>>6);
  const long rowbase=(long)b*SEQ; const int q0=qb*QB;
  const bf16*Qw=Q+(rowbase+q0+wid*QBLK)*DM+h*D;
  const bf16*Kh=K+(long)b*KSEQ*DM+h*D,*Vh=V+(long)b*KSEQ*DM+h*D;
  const unsigned lds0=(unsigned)(uintptr_t)shm;
  float*wsf=(float*)(shm+LDS_WS)+wid*64;
  const bf16*ksrc=Kh+(long)lane*DM+wid*8;
  const bf16*vsrc=Vh+(long)(16*(wid&3)+(lane>>2))*DM+(wid>>2)*32+(lane&3)*8;
  const unsigned kdst=lds0+LDS_K+wid*1024, vdst=lds0+LDS_V+wid*1024;
  #define DMA_K(t,slot) glds16(ksrc+(long)(t)*KVBLK*DM,(unsigned)__builtin_amdgcn_readfirstlane(kdst+(slot)))
  #define DMA_V(t,slot) glds16(vsrc+(long)(t)*KVBLK*DM,(unsigned)__builtin_amdgcn_readfirstlane(vdst+(slot)))
  const int vb0=(int)(lds0+LDS_V)+((lane>>4)&1)*32+(lane&3)*8+(4*hi+((lane&15)>>2))*64;
  const char*Kbase=shm+LDS_K; bf16x8 kf[8];
  const lds_cptr shm3=(lds_cptr)shm; const lds_cptr kp0=shm3+LDS_K+hi*1024+r32*16; const lds_cptr vp0=shm3+LDS_V+((lane>>4)&1)*32+(lane&3)*8+(4*hi+((lane&15)>>2))*64;
  const int NT=(KFRONT+q0+QB)/KVBLK;
  DMA_K(0,0);DMA_V(0,0);DMA_K(1,SLOTB);
  bf16x8 qr[4];
  #pragma unroll
  for(int d0=0;d0<4;++d0)qr[d0]=*reinterpret_cast<const bf16x8*>(&Qw[(long)r32*DM+d0*16+hi*8]);
  { const f32x4g*src=(const f32x4g*)CLg; __attribute__((address_space(3))) f32x4g*dst=(__attribute__((address_space(3))) f32x4g*)(shm3+LDS_CLK);
    for(int i=tid;i<NT*16;i+=NW*64)dst[i]=src[i]; }
  const float clq=CLg[KFRONT+q0+wid*QBLK+r32];
  const __attribute__((address_space(3))) float*clkp=(const __attribute__((address_space(3))) float*)(shm3+LDS_CLK)+4*hi;
  float mhat=0.f,l_reg=0.f;f32x16 o[2];o[0]=f32x16{};o[1]=f32x16{};
  const int qrel=wid*QBLK+r32;
  #define CMASK(P0,P1,t) do{int jb_=(t)-(NT-4); if(jb_>=0)cmask(P0,P1,jb_,qrel,hi);}while(0)
  #define BRD(X0,X1,tt) do{ const __attribute__((address_space(3))) float*c_=clkp+(tt)*KVBLK; \
    _Pragma("unroll") for(int g_=0;g_<4;++g_){ const f32x4g a_=*(const __attribute__((address_space(3))) f32x4g*)(c_+8*g_), b_=*(const __attribute__((address_space(3))) f32x4g*)(c_+32+8*g_); \
      X0[4*g_]=a_.x;X0[4*g_+1]=a_.y;X0[4*g_+2]=a_.z;X0[4*g_+3]=a_.w; X1[4*g_]=b_.x;X1[4*g_+1]=b_.y;X1[4*g_+2]=b_.z;X1[4*g_+3]=b_.w; } }while(0)
  #define BSUB(X,g,nb) do{ X[4*(g)]=(nb)-X[4*(g)]; X[4*(g)+1]=(nb)-X[4*(g)+1]; X[4*(g)+2]=(nb)-X[4*(g)+2]; X[4*(g)+3]=(nb)-X[4*(g)+3]; }while(0)
  #define BFULL(X0,X1,tt,nb) do{ BRD(X0,X1,tt); _Pragma("unroll") for(int g_=0;g_<4;++g_){ BSUB(X0,g_,nb); BSUB(X1,g_,nb); } }while(0)
  bool resc=false;
  #define START(P0,P1) do{ const float rm=rowmax(P0,P1); resc=false; \
    { const float dl=rm; mhat=fadd_s(mhat,dl); \
      _Pragma("unroll") for(int r=0;r<16;++r){P0[r]=fsub_s(P0[r],dl);P1[r]=fsub_s(P1[r],dl);} } \
    _Pragma("unroll") for(int r=0;r<16;++r)P0[r]=__builtin_amdgcn_exp2f(P0[r]); }while(0)
  #define RESC() do{ if(resc){ asm volatile("s_waitcnt lgkmcnt(0)":::"memory"); \
      _Pragma("unroll") for(int d_=0;d_<2;++d_) _Pragma("unroll") for(int r=0;r<16;++r)o[d_][r]*=wsf[crow(r,hi)]; } }while(0)
  f32x16 pA0,pA1,pB0,pB1;
  int sl_prev=0,sl_cur=0,sl_next=SLOTB;
  #define ROT() do{sl_prev=sl_cur;sl_cur=sl_next;sl_next=(sl_next==(NSLOT-1)*SLOTB)?0:sl_next+SLOTB;}while(0)
  DMA_K(2,2*SLOTB);
  WAIT_BAR(3);
  BFULL(pA0,pA1,0,clq);
  qkt(pA0,pA1,Kbase,qr,r32,hi);asm volatile("s_nop 15\n\ts_nop 7":"+v"(pA0),"+v"(pA1));CMASK(pA0,pA1,0);
  START(pA0,pA1);
  { const float nb0_=clq-mhat; BFULL(pB0,pB1,1,nb0_); }
  _Pragma("unroll") for(int r=0;r<16;++r)pA1[r]=__builtin_amdgcn_exp2f(pA1[r]);
  WAIT_BAR(0);
  DMA_K(3,0);DMA_V(1,SLOTB);
  ROT();
  kload8(kf,kp0+sl_cur);
  WAIT_BAR(2);
  s16x4 vlo[8],vhi[8]; u32x4 pw0,pw1,pw2,pw3;
  #define PKW(P,B) cvtpk_s(P[B],P[B+1])
  #define PAF(k) __builtin_bit_cast(bf16x8,pw##k)
  #define VFR(i) (bf16x8){vlo[i][0],vlo[i][1],vlo[i][2],vlo[i][3],vhi[i][0],vhi[i][1],vhi[i][2],vhi[i][3]}
  #define PIN(x) asm volatile("":"+v"(x))
  #define MX3(a,b,c) __builtin_fmaxf(__builtin_fmaxf((a),(b)),(c))
  #define GAPA(MF,A0,A1,A2,A3,W0,W1,PW) do{ MF; sacc+=A0; sacc+=A1; sacc+=A2; sacc+=A3; PIN(sacc); W0; W1; PIN(PW); SBAR(); }while(0)
  #define EX(v) __builtin_amdgcn_exp2f(v)
  #define GAPB(MF,X,B,G,PX,g,OFS) do{ f32x4g c4_; if(G){ c4_=*(const __attribute__((address_space(3))) f32x4g*)(cn_+(OFS)+8*(g)); } MF; X[B]=EX(X[B]); X[B+1]=EX(X[B+1]); X[B+2]=EX(X[B+2]); X[B+3]=EX(X[B+3]); PIN(X); \
    if(G){ PX[4*(g)]=nb_-c4_.x; PX[4*(g)+1]=nb_-c4_.y; PX[4*(g)+2]=nb_-c4_.z; PX[4*(g)+3]=nb_-c4_.w; PIN(PX); } SBAR(); }while(0)
  #define VRD(i) do{ vlo[i]=vtr(vp_+(((i)>>2)*4096+((i)&3)*1024)); vhi[i]=vtr(vp_+(((i)>>2)*4096+((i)&3)*1024+512)); }while(0)
  #define KRD(G,j) do{ if(G){ kload2(kf,kp0+sl_next,j); SBAR(); } }while(0)
  #define STEP(C0,C1,P0,P1,t,GK,GV,GL) do{ SBAR(); \
    const lds_cptr vp_=vp0+sl_prev; \
    VRD(0); SBAR(); float sacc=(P0[0]+P0[1]); \
    GAPA(C0=__builtin_amdgcn_mfma_f32_32x32x16_bf16(kf[0],qr[0],C0,0,0,0), P0[2],P0[3],P0[4],P0[5],     pw0[0]=PKW(P0,0), pw0[1]=PKW(P0,2), pw0); \
    VRD(4); SBAR(); GAPA(C1=__builtin_amdgcn_mfma_f32_32x32x16_bf16(kf[1],qr[0],C1,0,0,0), P0[6],P0[7],P0[8],P0[9],     pw0[2]=PKW(P0,4), pw0[3]=PKW(P0,6), pw0); \
    VRD(1); SBAR(); GAPA(C0=__builtin_amdgcn_mfma_f32_32x32x16_bf16(kf[2],qr[1],C0,0,0,0),   P0[10],P0[11],P0[12],P0[13], pw1[0]=PKW(P0,8), pw1[1]=PKW(P0,10), pw1); \
    VRD(5); SBAR(); GAPA(C1=__builtin_amdgcn_mfma_f32_32x32x16_bf16(kf[3],qr[1],C1,0,0,0),   P0[14],P0[15],P1[0],P1[1],   pw1[2]=PKW(P0,12),pw1[3]=PKW(P0,14), pw1); \
    VRD(2); SBAR(); GAPA(C0=__builtin_amdgcn_mfma_f32_32x32x16_bf16(kf[4],qr[2],C0,0,0,0),   P1[2],P1[3],P1[4],P1[5],     pw2[0]=PKW(P1,0), pw2[1]=PKW(P1,2), pw2); \
    VRD(6); SBAR(); GAPA(C1=__builtin_amdgcn_mfma_f32_32x32x16_bf16(kf[5],qr[2],C1,0,0,0),   P1[6],P1[7],P1[8],P1[9],     pw2[2]=PKW(P1,4), pw2[3]=PKW(P1,6), pw2); \
    VRD(3); SBAR(); GAPA(C0=__builtin_amdgcn_mfma_f32_32x32x16_bf16(kf[6],qr[3],C0,0,0,0),   P1[10],P1[11],P1[12],P1[13], pw3[0]=PKW(P1,8), pw3[1]=PKW(P1,10), pw3); \
    VRD(7); SBAR(); GAPA(C1=__builtin_amdgcn_mfma_f32_32x32x16_bf16(kf[7],qr[3],C1,0,0,0),   P1[14],P1[15],0.f,0.f,       pw3[2]=PKW(P1,12),pw3[3]=PKW(P1,14), pw3); \
    l_reg+=sacc; \
    if(GK){DMA_K((t)+3,sl_cur);} if(GV){DMA_V((t)+1,sl_next);} \
    CMASK(C0,C1,t); \
    { float a=MX3(C0[0],C0[1],C1[0]),b=MX3(C0[2],C0[3],C1[1]); a=MX3(a,C1[2],C1[3]); \
      _Pragma("unroll") for(int r=4;r<16;r+=4){a=MX3(a,C0[r],C0[r+1]);b=MX3(b,C0[r+2],C0[r+3]);a=MX3(a,C1[r],C1[r+1]);b=MX3(b,C1[r+2],C1[r+3]);} \
      float rm=__builtin_fmaxf(a,b); { auto rr=__builtin_amdgcn_permlane32_swap(__float_as_uint(rm),__float_as_uint(rm),false,false); rm=__builtin_fmaxf(__uint_as_float(rr[0]),__uint_as_float(rr[1])); } \
      resc=false; \
      if(__builtin_expect(__any(rm>(float)THRL),0)){ const float dl=__builtin_fmaxf(rm,0.f); mhat+=dl; \
        _Pragma("unroll") for(int r=0;r<16;++r){C0[r]-=dl;C1[r]-=dl;} \
        const float f=__builtin_amdgcn_exp2f(-dl); l_reg*=f; if(hi==0)wsf[r32]=f; resc=true; } } \
    const float nb_=clq-mhat; const __attribute__((address_space(3))) float*cn_=clkp+((t)+1)*KVBLK; \
    SBAR(); \
    GAPB(o[0]=__builtin_amdgcn_mfma_f32_32x32x16_bf16(PAF(0),VFR(0),o[0],0,0,0), C0,0,GL,P0,0,0); \
    GAPB(o[1]=__builtin_amdgcn_mfma_f32_32x32x16_bf16(PAF(0),VFR(4),o[1],0,0,0), C0,4,GL,P0,1,0); \
    KRD(GL,0); GAPB(o[0]=__builtin_amdgcn_mfma_f32_32x32x16_bf16(PAF(1),VFR(1),o[0],0,0,0), C0,8,GL,P0,2,0); \
    KRD(GL,1); GAPB(o[1]=__builtin_amdgcn_mfma_f32_32x32x16_bf16(PAF(1),VFR(5),o[1],0,0,0), C0,12,GL,P0,3,0); \
    KRD(GL,2); GAPB(o[0]=__builtin_amdgcn_mfma_f32_32x32x16_bf16(PAF(2),VFR(2),o[0],0,0,0), C1,0,GL,P1,0,32); \
    KRD(GL,3); GAPB(o[1]=__builtin_amdgcn_mfma_f32_32x32x16_bf16(PAF(2),VFR(6),o[1],0,0,0), C1,4,GL,P1,1,32); \
    GAPB(o[0]=__builtin_amdgcn_mfma_f32_32x32x16_bf16(PAF(3),VFR(3),o[0],0,0,0), C1,8,GL,P1,2,32); \
    GAPB(o[1]=__builtin_amdgcn_mfma_f32_32x32x16_bf16(PAF(3),VFR(7),o[1],0,0,0), C1,12,GL,P1,3,32); \
    }while(0)
  int t=1;
  #undef CMASK
  #define CMASK(P0,P1,t) do{}while(0)
  for(;t+5<NT;t+=2){
    STEP(pB0,pB1,pA0,pA1,t,true,true,true);     WAIT_BAR(2); RESC(); ROT();
    STEP(pA0,pA1,pB0,pB1,t+1,true,true,true);   WAIT_BAR(2); RESC(); ROT();
  }
  #undef CMASK
  #define CMASK(P0,P1,t) do{int jb_=(t)-(NT-4); if(jb_>=0)cmask(P0,P1,jb_,qrel,hi);}while(0)
  #define ENDW(tt) do{ if((tt)+3<NT){WAIT_BAR(2);} else if((tt)+2<NT){WAIT_BAR(1);} else {WAIT_BAR(0);} }while(0)
  for(;t+1<NT;t+=2){
    STEP(pB0,pB1,pA0,pA1,t,(t+3<NT),(t+1<NT),(t+1<NT));       ENDW(t);   RESC(); ROT();
    STEP(pA0,pA1,pB0,pB1,t+1,(t+4<NT),(t+2<NT),(t+2<NT));     ENDW(t+1); RESC(); ROT();
  }
  STEP(pB0,pB1,pA0,pA1,NT-1,false,false,false); RESC();
  { float sacc=pB0[0]+pB0[1]; _Pragma("unroll") for(int r=2;r<16;++r)sacc+=pB0[r]; _Pragma("unroll") for(int r=0;r<16;++r)sacc+=pB1[r]; l_reg+=sacc;
    pw0=(u32x4){PKW(pB0,0),PKW(pB0,2),PKW(pB0,4),PKW(pB0,6)};pw1=(u32x4){PKW(pB0,8),PKW(pB0,10),PKW(pB0,12),PKW(pB0,14)};pw2=(u32x4){PKW(pB1,0),PKW(pB1,2),PKW(pB1,4),PKW(pB1,6)};pw3=(u32x4){PKW(pB1,8),PKW(pB1,10),PKW(pB1,12),PKW(pB1,14)};
    SBAR(); pv(o,vb0+sl_cur,PAF(0),PAF(1),PAF(2),PAF(3)); }
  #undef PKW
  #undef PAF
  #undef VFR
  #undef PIN
  #undef MX3
  #undef GAPA
  #undef GAPB
  #undef EX
  #undef VRD
  #undef KRD
  #undef STEP
  #undef ENDW
  {auto rr=__builtin_amdgcn_permlane32_swap(__float_as_uint(l_reg),__float_as_uint(l_reg),false,false);l_reg=__uint_as_float(rr[0])+__uint_as_float(rr[1]);}
  if(hi==0)wsf[32+r32]=l_reg;asm volatile("s_waitcnt lgkmcnt(0)":::"memory");
  float rli[16];
  #pragma unroll
  for(int r=0;r<16;++r)rli[r]=__builtin_amdgcn_rcpf(wsf[32+crow(r,hi)]);
  bf16*Ow=O+(rowbase+q0+wid*QBLK)*DM+h*D;
  { bf16*stg=(bf16*)(shm+LDS_OST)+wid*2048;
    #pragma unroll
    for(int r=0;r<16;++r){const int orow=crow(r,hi);
      #pragma unroll
      for(int d0=0;d0<2;++d0)stg[orow*64+d0*32+r32]=__float2bfloat16(o[d0][r]*rli[r]);}
    asm volatile("s_waitcnt lgkmcnt(0)":::"memory");
    #pragma unroll
    for(int i=0;i<4;++i){const int row=i*8+(lane>>3),ch=lane&7; const u32x4 v=*(const u32x4*)(stg+row*64+ch*8); ATTN_STORE16(Ow+(long)row*DM+ch*8,v);} }
  asm volatile("s_waitcnt lgkmcnt(0)\n\ts_barrier":::"memory");
  #undef BRD
  #undef BSUB
  #undef BFULL
  #undef DMA_K
  #undef DMA_V
  #undef CMASK
  #undef START
  #undef RESC
  #undef ROT
}
constexpr int ATTN_LDS_BYTES=LDS_BYTES;
#undef SBAR
#undef WAIT_BAR
}
namespace hg {
using attn_body::bf16x8; using attn_body::s16x4; using attn_body::f32x16; using attn_body::u32x4; using attn_body::lds_cptr; using attn_body::vtr; using attn_body::cvtpk_s;
typedef unsigned short us16;
typedef unsigned u32x2h __attribute__((ext_vector_type(2)));
#define HLAS __attribute__((address_space(3)))
constexpr int RS = 272;
constexpr int HC_QE = 0, HC_KT = 64 * RS, HC_V = 2 * 64 * RS, HC_ST = HC_V + 16384, HC_PS = HC_ST + 128 * RS, HC_END = HC_PS + 1024;
__device__ __forceinline__ float blo_(unsigned w) { return __builtin_bit_cast(float, w << 16); }
__device__ __forceinline__ float bhi_(unsigned w) { return __builtin_bit_cast(float, w & 0xffff0000u); }
__device__ __forceinline__ bf16x8 trfrag(lds_cptr blk, int s0, int lane) {
    const int hh = lane >> 5; const lds_cptr p = blk + ((lane >> 4) & 1) * 32 + (lane & 3) * 8 + (s0 + 4 * hh + ((lane & 15) >> 2)) * 64;
    const s16x4 lo = vtr(p), hi = vtr(p + 512);
    return (bf16x8){lo[0], lo[1], lo[2], lo[3], hi[0], hi[1], hi[2], hi[3]};
}
__device__ __forceinline__ void hgrn_a(int item, const us16* KD, const us16* VH, us16* UST, HLAS unsigned char* lds) {
    int tid_l = threadIdx.x; asm volatile("" : "+v"(tid_l)); const int tid = tid_l, lane = tid & 63, wid = __builtin_amdgcn_readfirstlane(tid >> 6), hh = lane >> 5;
    const int bh = item / 129, c = item % 129, b = bh >> 3, h = bh & 7;
    const lds_cptr KDi = (lds_cptr)lds, Vi = (lds_cptr)lds + 16384;
    __syncthreads();
    { const int r = tid >> 3, cc = (tid & 7) * 16; const size_t g = ((size_t)b * 8256 + 64 * c + r) * 1024 + h * 128 + cc;
#pragma unroll
      for (int q2 = 0; q2 < 2; ++q2) { const int off = (cc >> 5) * 4096 + r * 64 + ((cc & 31) + 8 * q2) * 2;
          *(HLAS u32x4*)(lds + off) = *(const u32x4*)(KD + g + 8 * q2); *(HLAS u32x4*)(lds + 16384 + off) = *(const u32x4*)(VH + g + 8 * q2); } }
    __syncthreads();
    const int kt = wid >> 1, vt0 = (wid & 1) * 2;
    f32x16 acc0 = {}, acc1 = {};
#pragma unroll
    for (int ks = 0; ks < 4; ++ks) {
        const bf16x8 a = trfrag(KDi + kt * 4096, 16 * ks, lane), b0 = trfrag(Vi + vt0 * 4096, 16 * ks, lane), b1 = trfrag(Vi + (vt0 + 1) * 4096, 16 * ks, lane);
        acc0 = __builtin_amdgcn_mfma_f32_32x32x16_bf16(a, b0, acc0, 0, 0, 0); acc1 = __builtin_amdgcn_mfma_f32_32x32x16_bf16(a, b1, acc1, 0, 0, 0);
    }
    us16* dst = UST + (size_t)item * 16384 + (size_t)(32 * vt0 + (lane & 31)) * 128 + 32 * kt + 4 * hh;
#pragma unroll
    for (int g = 0; g < 4; ++g) {
        u32x2h w; w.x = cvtpk_s(acc0[4 * g], acc0[4 * g + 1]); w.y = cvtpk_s(acc0[4 * g + 2], acc0[4 * g + 3]); *(u32x2h*)(dst + 8 * g) = w;
        w.x = cvtpk_s(acc1[4 * g], acc1[4 * g + 1]); w.y = cvtpk_s(acc1[4 * g + 2], acc1[4 * g + 3]); *(u32x2h*)(dst + 32 * 128 + 8 * g) = w;
    }
}
__device__ __forceinline__ void hgrn_c(int item, const us16* QH, const us16* EB, const us16* KT, const us16* VH, const us16* GH, const us16* UST, us16* OH, const float* hnw, float eps, HLAS unsigned char* lds) {
    int tid_l = threadIdx.x; asm volatile("" : "+v"(tid_l)); const int tid = tid_l, lane = tid & 63, wid = __builtin_amdgcn_readfirstlane(tid >> 6), hh = lane >> 5, r32 = lane & 31;
    const int bh = item >> 7, c = (item & 127) + 1, b = bh >> 3, h = bh & 7;
    const size_t r0 = (size_t)b * 8192 + 64 * (c - 1);
    const lds_cptr L = (lds_cptr)lds;
    __syncthreads();
    { const int r = tid >> 3, cc = (tid & 7) * 16; const size_t g = (r0 + r) * 1024 + h * 128 + cc, gv = ((size_t)b * 8256 + 64 * c + r) * 1024 + h * 128 + cc;
#pragma unroll
      for (int q2 = 0; q2 < 2; ++q2) {
          const u32x4 a = *(const u32x4*)(QH + g + 8 * q2), e = *(const u32x4*)(EB + g + 8 * q2);
          u32x4 w; w.x = cvtpk_s(blo_(a.x) * blo_(e.x), bhi_(a.x) * bhi_(e.x)); w.y = cvtpk_s(blo_(a.y) * blo_(e.y), bhi_(a.y) * bhi_(e.y));
          w.z = cvtpk_s(blo_(a.z) * blo_(e.z), bhi_(a.z) * bhi_(e.z)); w.w = cvtpk_s(blo_(a.w) * blo_(e.w), bhi_(a.w) * bhi_(e.w));
          *(HLAS u32x4*)(lds + HC_QE + r * RS + (cc + 8 * q2) * 2) = w;
          *(HLAS u32x4*)(lds + HC_KT + r * RS + (cc + 8 * q2) * 2) = *(const u32x4*)(KT + g + 8 * q2);
          *(HLAS u32x4*)(lds + HC_V + (cc >> 5) * 4096 + r * 64 + ((cc & 31) + 8 * q2) * 2) = *(const u32x4*)(VH + gv + 8 * q2); }
      const us16* sp = UST + ((size_t)bh * 129 + (c - 1)) * 16384;
#pragma unroll
      for (int i = 0; i < 4; ++i) { const int p = tid + 512 * i, row = p >> 4, ch = p & 15; *(HLAS u32x4*)(lds + HC_ST + row * RS + ch * 16) = *(const u32x4*)(sp + row * 128 + ch * 8); } }
    __syncthreads();
    const int tt = wid >> 2, vt = wid & 3;
    f32x16 o = {};
    const lds_cptr qrow = L + HC_QE + (32 * tt + r32) * RS + 16 * hh;
#pragma unroll
    for (int st = 0; st < 2; ++st) {
        if (st <= tt) {
            f32x16 p = {};
            const lds_cptr krow = L + HC_KT + (32 * st + r32) * RS + 16 * hh;
#pragma unroll
            for (int ks = 0; ks < 8; ++ks) { const bf16x8 a = *(const HLAS bf16x8*)(krow + 32 * ks), q = *(const HLAS bf16x8*)(qrow + 32 * ks); p = __builtin_amdgcn_mfma_f32_32x32x16_bf16(a, q, p, 0, 0, 0); }
            if (st == tt) {
#pragma unroll
                for (int r = 0; r < 16; ++r) { const int s = (r & 3) + 8 * (r >> 2) + 4 * hh; if (s > r32) p[r] = 0.f; }
            }
            u32x4 pw0, pw1;
            pw0.x = cvtpk_s(p[0], p[1]); pw0.y = cvtpk_s(p[2], p[3]); pw0.z = cvtpk_s(p[4], p[5]); pw0.w = cvtpk_s(p[6], p[7]);
            pw1.x = cvtpk_s(p[8], p[9]); pw1.y = cvtpk_s(p[10], p[11]); pw1.z = cvtpk_s(p[12], p[13]); pw1.w = cvtpk_s(p[14], p[15]);
            const bf16x8 v0 = trfrag(L + HC_V + vt * 4096, 32 * st, lane), v1 = trfrag(L + HC_V + vt * 4096, 32 * st + 16, lane);
            o = __builtin_amdgcn_mfma_f32_32x32x16_bf16(__builtin_bit_cast(bf16x8, pw0), v0, o, 0, 0, 0);
            o = __builtin_amdgcn_mfma_f32_32x32x16_bf16(__builtin_bit_cast(bf16x8, pw1), v1, o, 0, 0, 0);
        }
    }
    { const lds_cptr srow = L + HC_ST + (32 * vt + r32) * RS + 16 * hh;
#pragma unroll
      for (int ks = 0; ks < 8; ++ks) { const bf16x8 a = *(const HLAS bf16x8*)(qrow + 32 * ks), s = *(const HLAS bf16x8*)(srow + 32 * ks); o = __builtin_amdgcn_mfma_f32_32x32x16_bf16(a, s, o, 0, 0, 0); } }
    float sq[16];
#pragma unroll
    for (int r = 0; r < 16; ++r) { float s = o[r] * o[r]; s += __shfl_xor(s, 1); s += __shfl_xor(s, 2); s += __shfl_xor(s, 4); s += __shfl_xor(s, 8); s += __shfl_xor(s, 16); sq[r] = s; }
    if (r32 == 0) {
#pragma unroll
        for (int r = 0; r < 16; ++r) *(HLAS float*)(lds + HC_PS + ((32 * tt + (r & 3) + 8 * (r >> 2) + 4 * hh) * 4 + vt) * 4) = sq[r];
    }
    __syncthreads();
#pragma unroll
    for (int r = 0; r < 16; ++r) { const int t = 32 * tt + (r & 3) + 8 * (r >> 2) + 4 * hh; const attn_body::f32x4g ps = *(const HLAS attn_body::f32x4g*)(lds + HC_PS + t * 16);
        const float rs = 1.0f / sqrtf(((ps.x + ps.y) + (ps.z + ps.w)) * (1.0f / 128.0f) + eps);
        *(HLAS us16*)(lds + HC_QE + t * RS + (32 * vt + r32) * 2) = (us16)(cvtpk_s(o[r] * rs, 0.f) & 0xffffu); }
    __syncthreads();
    { const int r = tid >> 3, cc = (tid & 7) * 16; const size_t go = (r0 + r) * 1024 + h * 128 + cc;
#pragma unroll
      for (int q2 = 0; q2 < 2; ++q2) {
          const u32x4 y = *(const HLAS u32x4*)(lds + HC_QE + r * RS + (cc + 8 * q2) * 2), g = *(const u32x4*)(GH + go + 8 * q2);
          const attn_body::f32x4g w0 = *(const attn_body::f32x4g*)(hnw + cc + 8 * q2), w1 = *(const attn_body::f32x4g*)(hnw + cc + 8 * q2 + 4);
          u32x4 w; w.x = cvtpk_s(blo_(y.x) * w0.x * blo_(g.x), bhi_(y.x) * w0.y * bhi_(g.x)); w.y = cvtpk_s(blo_(y.y) * w0.z * blo_(g.y), bhi_(y.y) * w0.w * bhi_(g.y));
          w.z = cvtpk_s(blo_(y.z) * w1.x * blo_(g.z), bhi_(y.z) * w1.y * bhi_(g.z)); w.w = cvtpk_s(blo_(y.w) * w1.z * blo_(g.w), bhi_(y.w) * w1.w * bhi_(g.w));
          *(u32x4*)(OH + go + 8 * q2) = w; } }
}
#undef HLAS
}
#define XB_TMO      128
#define XB_XCNT(j)  (256  + 64 * (j))
#define XB_XSUB(j)  (1280 + 64 * (j))
#define XB_XGEN(j)  (2304 + 64 * (j))
#define XB_TOP      3328
#define XB_TOPGEN   3392
#define XCD_BAR_WORDS 3456
#define XB_SPIN_CAP (1u << 18)

__device__ __forceinline__ unsigned xb_ld(unsigned* p)              { return __hip_atomic_load(p, __ATOMIC_RELAXED, __HIP_MEMORY_SCOPE_AGENT); }
__device__ __forceinline__ unsigned xb_add(unsigned* p, unsigned v) { return __hip_atomic_fetch_add(p, v, __ATOMIC_RELAXED, __HIP_MEMORY_SCOPE_AGENT); }
__device__ __forceinline__ unsigned xb_xcc_id() { return (unsigned)__builtin_amdgcn_s_getreg((3 << 11) | 20) & 0xFu; }
#define XB_SPIN(cond, bar) do { unsigned _sp = 0; while (cond) { __builtin_amdgcn_s_sleep(1); \
    if ((++_sp & 255u) == 0u) { if (xb_ld(&(bar)[XB_TMO])) break; if (_sp > XB_SPIN_CAP) { atomicAdd(&(bar)[XB_TMO], 1u); break; } } } } while (0)

struct XcdBarrier {
    unsigned* bar; unsigned x;
    volatile LAS unsigned* st;
};

__device__ __forceinline__ XcdBarrier xcd_barrier_post(unsigned* bar, volatile LAS unsigned* st) {
    XcdBarrier b; b.bar = bar; b.x = xb_xcc_id(); b.st = st;
    if (threadIdx.x == 0) (void)xb_add(&bar[XB_XCNT(b.x)], 1u);
    return b;
}
__device__ __forceinline__ void xcd_barrier_complete(unsigned* bar, unsigned x, unsigned& nloc, unsigned& nx) {
    const unsigned G = gridDim.x * gridDim.y * gridDim.z;
    unsigned sum, cnt, mine, sp = 0u;
    for (;;) {
        sum = 0u; cnt = 0u; mine = 0u;
#pragma unroll
        for (unsigned j = 0; j < 16; ++j) { const unsigned c = xb_ld(&bar[XB_XCNT(j)]); sum += c; cnt += (c > 0u) ? 1u : 0u; mine = (j == x) ? c : mine; }
        if (sum == G) break;
        __builtin_amdgcn_s_sleep(1);
        if ((++sp & 255u) == 0u) { if (xb_ld(&bar[XB_TMO])) break; if (sp > XB_SPIN_CAP) { atomicAdd(&bar[XB_TMO], 1u); break; } }
    }
    nloc = mine > 0u ? mine : 1u; nx = cnt > 0u ? cnt : 1u;
}

__device__ __forceinline__ void xcd_barrier(const XcdBarrier& b) {
    asm volatile("s_waitcnt vmcnt(0)" ::: "memory");
    __syncthreads();
    if (threadIdx.x == 0) {
        unsigned* bar = b.bar;
        __builtin_amdgcn_s_waitcnt(0);
        unsigned nloc = b.st[0], nx = b.st[1];
        if (nloc == 0u) { xcd_barrier_complete(bar, b.x, nloc, nx); b.st[0] = nloc; b.st[1] = nx; }
        const unsigned old = xb_add(&bar[XB_XSUB(b.x)], 1u);
        const unsigned gen = old / nloc;
        if (old + 1u == (gen + 1u) * nloc) {
            __builtin_amdgcn_fence(__ATOMIC_RELEASE, "agent");
            asm volatile("s_waitcnt vmcnt(0)" ::: "memory");
            const unsigned og = xb_add(&bar[XB_TOP], 1u);
            const unsigned tg = og / nx;
            if (og + 1u == (tg + 1u) * nx) xb_add(&bar[XB_TOPGEN], 1u);
            else XB_SPIN(xb_ld(&bar[XB_TOPGEN]) == tg, bar);
            __builtin_amdgcn_fence(__ATOMIC_ACQUIRE, "agent");
            xb_add(&bar[XB_XGEN(b.x)], 1u);
            asm volatile("s_waitcnt vmcnt(0)" ::: "memory");
        } else {
            XB_SPIN(xb_ld(&bar[XB_XGEN(b.x)]) == gen, bar);
            __builtin_amdgcn_fence(__ATOMIC_ACQUIRE, "agent");
            asm volatile("s_waitcnt vmcnt(0)" ::: "memory");
        }
    }
    __syncthreads();
}
struct Frame {
    LAS unsigned char* lds;
    volatile LAS unsigned* MISC;
    gu32* ctl;
    unsigned char* ws;
    int tid, lane, wave;
    int vcu, G;
    const float* in[18];
    float* out;
};
__device__ __forceinline__ float wave_sum(float v) {
#pragma unroll
    for (int o = 1; o < 64; o <<= 1) v += __shfl_xor(v, o);
    return v;
}

__device__ __forceinline__ void p0_transpose_item(const float* W, int ldw, int K, int ncols, bf16* WT, int mode, int row_off, LAS float* scr, int item, int lane) {
    const int nblk = ncols / 32, kb = item / nblk, nb = item % nblk, k0 = 64 * kb, n0 = 32 * nb;
    int d0 = row_off + n0;
    if (mode == 1) { d0 = (n0 < 512) ? (256 * (n0 >> 7) + (n0 & 127)) : (256 * ((n0 - 512) >> 7) + 128 + ((n0 - 512) & 127)); }
#pragma unroll 8
    for (int i = 0; i < 32; ++i) { const int kk = 2 * i + (lane >> 5); scr[kk * 33 + (lane & 31)] = W[(size_t)(k0 + kk) * ldw + n0 + (lane & 31)]; }
    LDS_WAIT(); asm volatile("" ::: "memory");
    const int c = lane & 7;
#pragma unroll
    for (int j = 0; j < 4; ++j) { const int n = (lane >> 3) + 8 * j; const LAS float* s = scr + (8 * c) * 33 + n;
        v4u o; o.x = pk2(s[0 * 33], s[1 * 33]); o.y = pk2(s[2 * 33], s[3 * 33]); o.z = pk2(s[4 * 33], s[5 * 33]); o.w = pk2(s[6 * 33], s[7 * 33]);
        *(GAS v4u*)(WT + (size_t)(d0 + n) * K + k0 + 8 * c) = o; }
    LDS_WAIT(); asm volatile("" ::: "memory");
}

__device__ __forceinline__ void p0_meta(Frame& F) {
    const float* meta = F.in[1]; const float* nw = F.in[2]; const float* Win = F.in[3];
    LAS float* um = (LAS float*)(F.lds + RING_OFF);
#pragma unroll
    for (int rr = 0; rr < 2; ++rr) {
        const int r = 2 * F.wave + rr;
        f32x4 v[4]; float ss = 0.f;
#pragma unroll
        for (int j = 0; j < 4; ++j) { v[j] = *(const f32x4*)(meta + (size_t)r * DM + 4 * F.lane + 256 * j); ss += (v[j].x * v[j].x + v[j].y * v[j].y) + (v[j].z * v[j].z + v[j].w * v[j].w); }
        const float rs = 1.0f / sqrtf(wave_sum(ss) * (1.0f / DM) + EPS);
#pragma unroll
        for (int j = 0; j < 4; ++j) { const f32x4 w = *(const f32x4*)(nw + 4 * F.lane + 256 * j); const int k = 4 * F.lane + 256 * j;
            um[(k + 0) * 16 + r] = v[j].x * rs * w.x; um[(k + 1) * 16 + r] = v[j].y * rs * w.y; um[(k + 2) * 16 + r] = v[j].z * rs * w.z; um[(k + 3) * 16 + r] = v[j].w * rs * w.w; }
    }
    __syncthreads();
    const int item = F.vcu * NWAVES + F.wave;
    if (item < 49) {
        int type, strip;
        if (item < 8) { type = 0; strip = item; } else if (item < 16) { type = 1; strip = item - 8; } else if (item < 32) { type = 2; strip = item - 16; } else if (item < 48) { type = 3; strip = item - 32; } else { type = 4; strip = 0; }
        int col;
        if (type == 0) col = 512 + 64 * strip + F.lane; else if (type == 1) col = 1024 + 64 * strip + F.lane; else if (type == 2) col = 2568 + 64 * strip + F.lane;
        else if (type == 3) col = 3592 + 64 * strip + F.lane; else col = 1536 + (F.lane & 7);
        float acc[16];
#pragma unroll
        for (int r = 0; r < 16; ++r) acc[r] = 0.f;
#pragma unroll 4
        for (int k = 0; k < DM; ++k) {
            const float w = Win[(size_t)k * INW + col];
            const LAS f32x4* up = (const LAS f32x4*)(um + k * 16);
            const f32x4 u0 = up[0], u1 = up[1], u2 = up[2], u3 = up[3];
            acc[0] += w * u0.x; acc[1] += w * u0.y; acc[2] += w * u0.z; acc[3] += w * u0.w;
            acc[4] += w * u1.x; acc[5] += w * u1.y; acc[6] += w * u1.z; acc[7] += w * u1.w;
            acc[8] += w * u2.x; acc[9] += w * u2.y; acc[10] += w * u2.z; acc[11] += w * u2.w;
            acc[12] += w * u3.x; acc[13] += w * u3.y; acc[14] += w * u3.z; acc[15] += w * u3.w;
        }
        const int c = 64 * strip + F.lane;
        if (type == 0 || type == 1) {
            bf16* dst = (bf16*)(F.ws + (type == 0 ? WS_KA : WS_VA));
#pragma unroll
            for (int b = 0; b < 2; ++b) {
#pragma unroll
                for (int r = 0; r < 16; ++r) dst[((size_t)b * KROWS + r) * AWID + c] = (bf16)f2bf(acc[r]);
                for (int r = 16; r < 128; ++r) dst[((size_t)b * KROWS + r) * AWID + c] = (bf16)0;
            }
        } else if (type == 3) {
            bf16* dst = (bf16*)(F.ws + WS_VH);
#pragma unroll
            for (int b = 0; b < 2; ++b) {
                for (int r = 0; r < 48; ++r) dst[((size_t)b * HROWS + r) * DM + c] = (bf16)0;
#pragma unroll
                for (int r = 0; r < 16; ++r) dst[((size_t)b * HROWS + 48 + r) * DM + c] = (bf16)f2bf(acc[r]);
            }
        } else if (type == 2) {
            const float* lbl = F.in[5];
            const float lb = 1.0f / (1.0f + __expf(lbl[1024 + c] - lbl[c]));
            float kk[16], bb[16]; float run = 0.f;
#pragma unroll
            for (int r = 0; r < 16; ++r) { const float f = lb + (1.0f - lb) * (1.0f / (1.0f + __expf(-acc[r]))); kk[r] = 1.0f - f; run += __logf(f); bb[r] = run; }
            bf16* dst = (bf16*)(F.ws + WS_KD);
#pragma unroll
            for (int b = 0; b < 2; ++b) {
                for (int r = 0; r < 48; ++r) dst[((size_t)b * HROWS + r) * DM + c] = (bf16)0;
#pragma unroll
                for (int r = 0; r < 16; ++r) dst[((size_t)b * HROWS + 48 + r) * DM + c] = (bf16)f2bf(kk[r] * __expf(run - bb[r]));
            }
        } else {
            if (F.lane < 8) { float* lfam = (float*)(F.ws + WS_LFAM); const float bias = F.in[4][F.lane];
#pragma unroll
                for (int r = 0; r < 16; ++r) lfam[r * 8 + F.lane] = log_sigmoid(acc[r] + bias); }
        }
    }
    __syncthreads();
}

__device__ __forceinline__ void p0_rows(Frame& F) {
    const float* x = F.in[0]; const float* nw = F.in[2]; const float* Win = F.in[3]; const float* afb = F.in[4];
    LAS float* wfa = (LAS float*)(F.lds + RING_OFF);
    for (int i = F.tid; i < 8 * DM; i += NWAVES * 64) { const int k = i >> 3, h = i & 7; wfa[h * DM + k] = nw[k] * Win[(size_t)k * INW + 1536 + h]; }
    __syncthreads();
    const int gw = F.vcu * NWAVES + F.wave, NGW = F.G * NWAVES;
    f32x4 wv[4];
#pragma unroll
    for (int j = 0; j < 4; ++j) wv[j] = *(const f32x4*)(nw + 4 * F.lane + 256 * j);
    bf16* U = (bf16*)(F.ws + WS_U); float* lfa = (float*)(F.ws + WS_LFA);
    for (int m = gw; m < MR; m += NGW) {
        f32x4 v[4]; float ss = 0.f;
#pragma unroll
        for (int j = 0; j < 4; ++j) { v[j] = *(const f32x4*)(x + (size_t)m * DM + 4 * F.lane + 256 * j); ss += (v[j].x * v[j].x + v[j].y * v[j].y) + (v[j].z * v[j].z + v[j].w * v[j].w); }
        const float rs = 1.0f / sqrtf(wave_sum(ss) * (1.0f / DM) + EPS);
        GAS unsigned long long* o8 = (GAS unsigned long long*)(U + (size_t)m * DM) + F.lane;
#pragma unroll
        for (int j = 0; j < 4; ++j) { const f32x4 u = v[j] * rs * wv[j]; o8[64 * j] = (unsigned long long)pk2(u.x, u.y) | ((unsigned long long)pk2(u.z, u.w) << 32); }
        float z[8];
#pragma unroll
        for (int h = 0; h < 8; ++h) { float s = 0.f;
#pragma unroll
            for (int j = 0; j < 4; ++j) { const f32x4 w = *(const LAS f32x4*)(wfa + h * DM + 4 * F.lane + 256 * j); s += (v[j].x * w.x + v[j].y * w.y) + (v[j].z * w.z + v[j].w * w.w); }
            z[h] = wave_sum(s); }
        float zz = z[0];
#pragma unroll
        for (int h = 1; h < 8; ++h) zz = (F.lane == h) ? z[h] : zz;
        if (F.lane < 8) lfa[(size_t)m * 8 + F.lane] = log_sigmoid(zz * rs + afb[F.lane]);
    }
    __syncthreads();
}

__device__ __forceinline__ void p0_weights(Frame& F) {
    LAS float* scr = (LAS float*)(F.lds + RING_OFF + F.wave * 16384);
    const int gw = F.vcu * NWAVES + F.wave, NGW = F.G * NWAVES;
    constexpr int I1 = 16 * 48, I2 = 16 * 192, IA = 8 * 32, IH = 16 * 32, IO = 16 * 32;
    constexpr int NIT = I1 + I2 + IA + IH + IO;
    bf16* win = (bf16*)(F.ws + WS_WIN);
    for (int it = gw; it < NIT; it += NGW) {
        int r = it;
        if (r < I1) { p0_transpose_item(F.in[3], INW, DM, 1536, win, 0, 0, scr, r, F.lane); continue; } r -= I1;
        if (r < I2) { p0_transpose_item(F.in[3] + 1544, INW, DM, 6144, win, 0, 1536, scr, r, F.lane); continue; } r -= I2;
        if (r < IA) { p0_transpose_item(F.in[7], DM, AWID, DM, (bf16*)(F.ws + WS_WA), 0, 0, scr, r, F.lane); continue; } r -= IA;
        if (r < IH) { p0_transpose_item(F.in[8], DM, DM, DM, (bf16*)(F.ws + WS_WH), 0, 0, scr, r, F.lane); continue; } r -= IH;
        p0_transpose_item(F.in[9], DM, DM, DM, (bf16*)(F.ws + WS_WO), 0, 0, scr, r, F.lane);
    }
}
__device__ __forceinline__ void p7_expert_weights(Frame& F) {
    LAS float* scr = (LAS float*)(F.lds + RING_OFF + F.wave * 16384);
    const int gw = F.vcu * NWAVES + F.wave, NGW = F.G * NWAVES;
    constexpr int I1 = 16 * 32, I2 = 8 * 32;
    for (int it = gw; it < NE * (I1 + I2); it += NGW) {
        const int e = it / (I1 + I2); int r = it % (I1 + I2);
        if (r < I1) p0_transpose_item(F.in[15] + (size_t)e * DM * DM, DM, DM, DM, (bf16*)(F.ws + WS_WE1) + (size_t)e * DM * DM, 1, 0, scr, r, F.lane);
        else p0_transpose_item(F.in[16] + (size_t)e * EFF * DM, DM, EFF, DM, (bf16*)(F.ws + WS_WE2) + (size_t)e * DM * EFF, 0, 0, scr, r - I1, F.lane);
    }
}

__device__ __forceinline__ void p1_cumsum(Frame& F, int bh) {
    const int b = bh >> 3, h = bh & 7;
    const float* lfa = (const float*)(F.ws + WS_LFA); const float* lfam = (const float*)(F.ws + WS_LFAM); float* cl = (float*)(F.ws + WS_CL) + (size_t)bh * KROWS;
    LAS float* wtot = (LAS float*)(F.lds + RING_OFF);
    float cm = 0.f;
    for (int r = 0; r < 16; ++r) { cm += lfam[r * 8 + h]; if (F.tid == r) cl[r] = cm * 1.4426950408889634f; }
    if (F.tid >= 16 && F.tid < 128) cl[F.tid] = 1e30f;
    float loc[16]; float run = 0.f;
#pragma unroll
    for (int i = 0; i < 16; ++i) { run += lfa[((size_t)b * SEQ + 16 * F.tid + i) * 8 + h]; loc[i] = run; }
    float inc = run;
#pragma unroll
    for (int o = 1; o < 64; o <<= 1) { const float t = __shfl_up(inc, o); if (F.lane >= o) inc += t; }
    if (F.lane == 63) wtot[F.wave] = inc;
    __syncthreads();
    float pre = cm + (inc - run);
    for (int w = 0; w < F.wave; ++w) pre += wtot[w];
#pragma unroll
    for (int i = 0; i < 16; ++i) cl[128 + 16 * F.tid + i] = (pre + loc[i]) * 1.4426950408889634f;
    __syncthreads();
}

__device__ __forceinline__ void attn_simple_unit(Frame& F, int bh, int qb) {
    const int tid = F.tid, row = tid & 255, p = tid >> 8, b = bh >> 3, h = bh & 7;
    const bf16* QA = (const bf16*)(F.ws + WS_QA); const bf16* KA = (const bf16*)(F.ws + WS_KA); const bf16* VA = (const bf16*)(F.ws + WS_VA);
    const float* CL = (const float*)(F.ws + WS_CL) + (size_t)bh * KROWS; bf16* OA = (bf16*)(F.ws + WS_OA);
    LAS bf16* Ks = (LAS bf16*)(F.lds + RING_OFF); LAS bf16* Vs = (LAS bf16*)(F.lds + RING_OFF + 8192);
    LAS float* cks = (LAS float*)(F.lds + RING_OFF + 16384); LAS float* cmb = (LAS float*)(F.lds + RING_OFF + 16640);
    float q[64], o[64];
    const size_t qrow = (size_t)b * SEQ + 256 * qb + row;
#pragma unroll
    for (int c = 0; c < 8; ++c) { const v4u w = *(const v4u*)(QA + qrow * AWID + h * 64 + 8 * c);
        q[8 * c + 0] = blo(w.x); q[8 * c + 1] = bhi(w.x); q[8 * c + 2] = blo(w.y); q[8 * c + 3] = bhi(w.y); q[8 * c + 4] = blo(w.z); q[8 * c + 5] = bhi(w.z); q[8 * c + 6] = blo(w.w); q[8 * c + 7] = bhi(w.w); }
#pragma unroll
    for (int d = 0; d < 64; ++d) o[d] = 0.f;
    const int qp = 128 + 256 * qb + row; const float clq = CL[qp];
    float mx = -1e30f, l = 0.f;
    const int NT = 4 * qb + 6;
    for (int t = 0; t < NT; ++t) {
        if (t == 1) continue;
        __syncthreads();
        { const int r = tid >> 3, ch = tid & 7; const size_t g = ((size_t)b * KROWS + 64 * t + r) * AWID + h * 64 + ch * 8;
          *(LAS v4u*)(Ks + r * 64 + ch * 8) = *(const v4u*)(KA + g); *(LAS v4u*)(Vs + r * 64 + ch * 8) = *(const v4u*)(VA + g);
          if (tid < 64) cks[tid] = CL[64 * t + tid]; }
        __syncthreads();
        const int smax = (t == 0) ? 16 : 64;
        for (int s = p; s < smax; s += 2) {
            const int kp = 64 * t + s;
            if (t >= 2 && kp > qp) continue;
            float dot = 0.f;
#pragma unroll
            for (int c = 0; c < 8; ++c) { const v4u w = *(const LAS v4u*)(Ks + s * 64 + 8 * c);
                dot += q[8 * c + 0] * blo(w.x) + q[8 * c + 1] * bhi(w.x) + q[8 * c + 2] * blo(w.y) + q[8 * c + 3] * bhi(w.y) + q[8 * c + 4] * blo(w.z) + q[8 * c + 5] * bhi(w.z) + q[8 * c + 6] * blo(w.w) + q[8 * c + 7] * bhi(w.w); }
            const float sc = dot + (clq - cks[s]);
            const float mn = fmaxf(mx, sc), al = ex2(mx - mn), pp = ex2(sc - mn);
            l = l * al + pp; mx = mn;
#pragma unroll
            for (int c = 0; c < 8; ++c) { const v4u w = *(const LAS v4u*)(Vs + s * 64 + 8 * c);
                o[8 * c + 0] = o[8 * c + 0] * al + pp * blo(w.x); o[8 * c + 1] = o[8 * c + 1] * al + pp * bhi(w.x); o[8 * c + 2] = o[8 * c + 2] * al + pp * blo(w.y); o[8 * c + 3] = o[8 * c + 3] * al + pp * bhi(w.y);
                o[8 * c + 4] = o[8 * c + 4] * al + pp * blo(w.z); o[8 * c + 5] = o[8 * c + 5] * al + pp * bhi(w.z); o[8 * c + 6] = o[8 * c + 6] * al + pp * blo(w.w); o[8 * c + 7] = o[8 * c + 7] * al + pp * bhi(w.w); }
        }
    }
    __syncthreads();
    if (p == 1) { cmb[row * 66 + 0] = mx; cmb[row * 66 + 1] = l;
#pragma unroll
        for (int d = 0; d < 64; ++d) cmb[row * 66 + 2 + d] = o[d]; }
    __syncthreads();
    if (p == 0) { const float m1 = cmb[row * 66 + 0], l1 = cmb[row * 66 + 1]; const float mn = fmaxf(mx, m1), a0 = ex2(mx - mn), a1 = ex2(m1 - mn); const float inv = 1.0f / (l * a0 + l1 * a1);
#pragma unroll
        for (int c = 0; c < 8; ++c) { float r8[8];
#pragma unroll
            for (int e = 0; e < 8; ++e) r8[e] = (o[8 * c + e] * a0 + cmb[row * 66 + 2 + 8 * c + e] * a1) * inv;
            v4u w; w.x = pk2(r8[0], r8[1]); w.y = pk2(r8[2], r8[3]); w.z = pk2(r8[4], r8[5]); w.w = pk2(r8[6], r8[7]);
            *(v4u*)(OA + qrow * AWID + h * 64 + 8 * c) = w; } }
    __syncthreads();
}

__device__ __forceinline__ void hgrn_a_simple(Frame& F, int item) {
    const int bh = item / NCH, c = item % NCH, b = bh >> 3, h = bh & 7, tid = F.tid;
    const bf16* KD = (const bf16*)(F.ws + WS_KD); const bf16* VH = (const bf16*)(F.ws + WS_VH); bf16* US = (bf16*)(F.ws + WS_US);
    LAS float* KDs = (LAS float*)(F.lds + RING_OFF); LAS float* Vs = KDs + 8192;
    __syncthreads();
    { const int r = tid >> 3, cc = (tid & 7) * 16; const size_t g = ((size_t)b * HROWS + 64 * c + r) * DM + h * 128 + cc;
#pragma unroll
      for (int q2 = 0; q2 < 2; ++q2) { const v4u a = *(const v4u*)(KD + g + 8 * q2), v = *(const v4u*)(VH + g + 8 * q2); LAS float* kd = KDs + r * 128 + cc + 8 * q2; LAS float* vs = Vs + r * 128 + cc + 8 * q2;
          kd[0] = blo(a.x); kd[1] = bhi(a.x); kd[2] = blo(a.y); kd[3] = bhi(a.y); kd[4] = blo(a.z); kd[5] = bhi(a.z); kd[6] = blo(a.w); kd[7] = bhi(a.w);
          vs[0] = blo(v.x); vs[1] = bhi(v.x); vs[2] = blo(v.y); vs[3] = bhi(v.y); vs[4] = blo(v.z); vs[5] = bhi(v.z); vs[6] = blo(v.w); vs[7] = bhi(v.w); } }
    __syncthreads();
    const int k = tid >> 2, vg = (tid & 3) * 32;
    float acc[32];
#pragma unroll
    for (int j = 0; j < 32; ++j) acc[j] = 0.f;
    for (int s = 0; s < 64; ++s) { const float kd = KDs[s * 128 + k];
#pragma unroll
        for (int j4 = 0; j4 < 8; ++j4) { const f32x4 v = *(const LAS f32x4*)(Vs + s * 128 + vg + 4 * j4); acc[4 * j4 + 0] += kd * v.x; acc[4 * j4 + 1] += kd * v.y; acc[4 * j4 + 2] += kd * v.z; acc[4 * j4 + 3] += kd * v.w; } }
    bf16* dst = US + (size_t)item * (HK * HV) + k * 128 + vg;
#pragma unroll
    for (int j8 = 0; j8 < 4; ++j8) { v4u w; w.x = pk2(acc[8 * j8 + 0], acc[8 * j8 + 1]); w.y = pk2(acc[8 * j8 + 2], acc[8 * j8 + 3]); w.z = pk2(acc[8 * j8 + 4], acc[8 * j8 + 5]); w.w = pk2(acc[8 * j8 + 6], acc[8 * j8 + 7]); *(v4u*)(dst + 8 * j8) = w; }
}
__device__ __forceinline__ void hgrn_scan(Frame& F) {
    const bf16* EB = (const bf16*)(F.ws + WS_EB); bf16* US = (bf16*)(F.ws + WS_US);
    for (int idx = blockIdx.x * (NWAVES * 64) + F.tid; idx < 16 * 128 * 64; idx += F.G * NWAVES * 64) {
        const int bh = idx >> 13, rem = idx & 8191, k = rem >> 6, vp = rem & 63, b = bh >> 3, h = bh & 7;
        unsigned* base = (unsigned*)(US + (size_t)bh * NCH * (HK * HV) + k * 128) + vp;
        unsigned w = base[0]; float s0 = blo(w), s1 = bhi(w);
        for (int c = 1; c < NCH - 1; ++c) {
            const float a = bf2f(EB[((size_t)b * SEQ + 64 * (c - 1) + 63) * DM + h * 128 + k]);
            const unsigned uw = base[(size_t)c * (HK * HV / 2)];
            s0 = a * s0 + blo(uw); s1 = a * s1 + bhi(uw);
            base[(size_t)c * (HK * HV / 2)] = pk2(s0, s1);
        }
    }
}
__device__ __forceinline__ void hgrn_scan_t(Frame& F) {
    const bf16* EB = (const bf16*)(F.ws + WS_EB); bf16* US = (bf16*)(F.ws + WS_US);
    for (int idx = blockIdx.x * (NWAVES * 64) + F.tid; idx < 16 * 128 * 64; idx += F.G * NWAVES * 64) {
        const int bh = idx >> 13, rem = idx & 8191, v = rem >> 6, kp = rem & 63, b = bh >> 3, h = bh & 7;
        unsigned* base = (unsigned*)(US + (size_t)bh * NCH * (HK * HV) + v * 128) + kp;
        const unsigned* ap = (const unsigned*)(EB + ((size_t)b * SEQ + 63) * DM + h * 128) + kp;
        unsigned w = base[0]; float s0 = blo(w), s1 = bhi(w);
        for (int c = 1; c < NCH - 1; ++c) {
            const unsigned aw = ap[(size_t)(c - 1) * 64 * (DM / 2)];
            const unsigned uw = base[(size_t)c * (HK * HV / 2)];
            s0 = blo(aw) * s0 + blo(uw); s1 = bhi(aw) * s1 + bhi(uw);
            base[(size_t)c * (HK * HV / 2)] = pk2(s0, s1);
        }
    }
}
__device__ __forceinline__ void hgrn_c_simple(Frame& F, int item) {
    const int bh = item >> 7, c = (item & 127) + 1, b = bh >> 3, h = bh & 7, tid = F.tid;
    const bf16* QH = (const bf16*)(F.ws + WS_QH); const bf16* EB = (const bf16*)(F.ws + WS_EB); const bf16* KT = (const bf16*)(F.ws + WS_KT); const bf16* VH = (const bf16*)(F.ws + WS_VH);
    const bf16* GH = (const bf16*)(F.ws + WS_GH); const bf16* US = (const bf16*)(F.ws + WS_US); bf16* OH = (bf16*)(F.ws + WS_OH); const float* hnw = F.in[6];
    LAS float* QE = (LAS float*)(F.lds + RING_OFF); LAS float* KTs = QE + 8192; LAS bf16* Ss = (LAS bf16*)(F.lds + RING_OFF + 65536); LAS bf16* Vs = (LAS bf16*)(F.lds + RING_OFF + 98304); LAS float* SC = (LAS float*)(F.lds + RING_OFF + 114688);
    const size_t r0 = (size_t)b * SEQ + 64 * (c - 1);
    __syncthreads();
    { const int r = tid >> 3, cc = (tid & 7) * 16; const size_t g = (r0 + r) * DM + h * 128 + cc; const size_t gv = ((size_t)b * HROWS + 64 * c + r) * DM + h * 128 + cc;
#pragma unroll
      for (int q2 = 0; q2 < 2; ++q2) { const v4u a = *(const v4u*)(QH + g + 8 * q2), e = *(const v4u*)(EB + g + 8 * q2), kt = *(const v4u*)(KT + g + 8 * q2);
          LAS float* qe = QE + r * 128 + cc + 8 * q2; LAS float* ks = KTs + r * 128 + cc + 8 * q2;
          qe[0] = blo(a.x) * blo(e.x); qe[1] = bhi(a.x) * bhi(e.x); qe[2] = blo(a.y) * blo(e.y); qe[3] = bhi(a.y) * bhi(e.y); qe[4] = blo(a.z) * blo(e.z); qe[5] = bhi(a.z) * bhi(e.z); qe[6] = blo(a.w) * blo(e.w); qe[7] = bhi(a.w) * bhi(e.w);
          ks[0] = blo(kt.x); ks[1] = bhi(kt.x); ks[2] = blo(kt.y); ks[3] = bhi(kt.y); ks[4] = blo(kt.z); ks[5] = bhi(kt.z); ks[6] = blo(kt.w); ks[7] = bhi(kt.w);
          *(LAS v4u*)(Vs + r * 128 + cc + 8 * q2) = *(const v4u*)(VH + gv + 8 * q2); }
      const bf16* sp = US + ((size_t)bh * NCH + (c - 1)) * (HK * HV);
#pragma unroll
      for (int i = 0; i < 4; ++i) *(LAS v4u*)(Ss + (tid + 512 * i) * 8) = *(const v4u*)(sp + (tid + 512 * i) * 8); }
    __syncthreads();
    const int t = tid >> 3, g8 = tid & 7;
#pragma unroll
    for (int j = 0; j < 8; ++j) { const int s = g8 * 8 + j; float d = 0.f;
        if (s <= t) { for (int k = 0; k < 128; k += 4) { const f32x4 a = *(const LAS f32x4*)(QE + t * 128 + k), kb = *(const LAS f32x4*)(KTs + s * 128 + k); d += (a.x * kb.x + a.y * kb.y) + (a.z * kb.z + a.w * kb.w); } }
        SC[t * 64 + s] = d; }
    __syncthreads();
    const int v0 = g8 * 16;
    float o[16];
#pragma unroll
    for (int j = 0; j < 16; ++j) o[j] = 0.f;
    for (int s = 0; s <= t; ++s) { const float sc = SC[t * 64 + s]; const v4u w0 = *(const LAS v4u*)(Vs + s * 128 + v0), w1 = *(const LAS v4u*)(Vs + s * 128 + v0 + 8);
        o[0] += sc * blo(w0.x); o[1] += sc * bhi(w0.x); o[2] += sc * blo(w0.y); o[3] += sc * bhi(w0.y); o[4] += sc * blo(w0.z); o[5] += sc * bhi(w0.z); o[6] += sc * blo(w0.w); o[7] += sc * bhi(w0.w);
        o[8] += sc * blo(w1.x); o[9] += sc * bhi(w1.x); o[10] += sc * blo(w1.y); o[11] += sc * bhi(w1.y); o[12] += sc * blo(w1.z); o[13] += sc * bhi(w1.z); o[14] += sc * blo(w1.w); o[15] += sc * bhi(w1.w); }
    for (int k = 0; k < 128; ++k) { const float qe = QE[t * 128 + k]; const v4u w0 = *(const LAS v4u*)(Ss + k * 128 + v0), w1 = *(const LAS v4u*)(Ss + k * 128 + v0 + 8);
        o[0] += qe * blo(w0.x); o[1] += qe * bhi(w0.x); o[2] += qe * blo(w0.y); o[3] += qe * bhi(w0.y); o[4] += qe * blo(w0.z); o[5] += qe * bhi(w0.z); o[6] += qe * blo(w0.w); o[7] += qe * bhi(w0.w);
        o[8] += qe * blo(w1.x); o[9] += qe * bhi(w1.x); o[10] += qe * blo(w1.y); o[11] += qe * bhi(w1.y); o[12] += qe * blo(w1.z); o[13] += qe * bhi(w1.z); o[14] += qe * blo(w1.w); o[15] += qe * bhi(w1.w); }
    float ss = 0.f;
#pragma unroll
    for (int j = 0; j < 16; ++j) ss += o[j] * o[j];
    ss += __shfl_xor(ss, 1); ss += __shfl_xor(ss, 2); ss += __shfl_xor(ss, 4);
    const float rs = 1.0f / sqrtf(ss * (1.0f / HV) + EPS);
    const size_t go = (r0 + t) * DM + h * 128 + v0;
    const v4u g0 = *(const v4u*)(GH + go), g1 = *(const v4u*)(GH + go + 8);
    float gg[16] = {blo(g0.x), bhi(g0.x), blo(g0.y), bhi(g0.y), blo(g0.z), bhi(g0.z), blo(g0.w), bhi(g0.w), blo(g1.x), bhi(g1.x), blo(g1.y), bhi(g1.y), blo(g1.z), bhi(g1.z), blo(g1.w), bhi(g1.w)};
    float y[16];
#pragma unroll
    for (int j = 0; j < 16; ++j) y[j] = o[j] * rs * hnw[v0 + j] * gg[j];
    v4u w; w.x = pk2(y[0], y[1]); w.y = pk2(y[2], y[3]); w.z = pk2(y[4], y[5]); w.w = pk2(y[6], y[7]); *(v4u*)(OH + go) = w;
    w.x = pk2(y[8], y[9]); w.y = pk2(y[10], y[11]); w.z = pk2(y[12], y[13]); w.w = pk2(y[14], y[15]); *(v4u*)(OH + go + 8) = w;
}

__device__ __forceinline__ void p7_router(Frame& F) {
    const float* h1 = F.out; const float* nfw = F.in[10]; const float* wrg = F.in[11]; const float* brg = F.in[12]; const float* wre = F.in[13]; const float* bre = F.in[14];
    bf16* XN = (bf16*)(F.ws + WS_XN); unsigned* ASG = (unsigned*)(F.ws + WS_ASG); float* GATE = (float*)(F.ws + WS_GATE);
    LAS float* T = (LAS float*)(F.lds + RING_OFF);
    for (int rb = F.vcu; rb < MR / 32; rb += F.G) {
        const int rowb = rb * 32 + F.wave * 4;
        float acc[4][36]; float ss[4];
#pragma unroll
        for (int r = 0; r < 4; ++r) { ss[r] = 0.f;
#pragma unroll
            for (int j = 0; j < 36; ++j) acc[r][j] = 0.f; }
        for (int q = 0; q < 4; ++q) {
            __syncthreads();
            for (int i = F.tid; i < 36 * 256; i += NWAVES * 64) { const int kk = i / 36, j = i % 36, k = 256 * q + kk;
                T[j * 256 + kk] = nfw[k] * (j < 4 ? wrg[k * 4 + j] : wre[k * 32 + (j - 4)]); }
            __syncthreads();
            f32x4 x[4];
#pragma unroll
            for (int r = 0; r < 4; ++r) { x[r] = *(const f32x4*)(h1 + (size_t)(rowb + r) * DM + 256 * q + 4 * F.lane); ss[r] += (x[r].x * x[r].x + x[r].y * x[r].y) + (x[r].z * x[r].z + x[r].w * x[r].w); }
#pragma unroll
            for (int j = 0; j < 36; ++j) { const f32x4 w = *(const LAS f32x4*)(T + j * 256 + 4 * F.lane);
#pragma unroll
                for (int r = 0; r < 4; ++r) acc[r][j] += (x[r].x * w.x + x[r].y * w.y) + (x[r].z * w.z + x[r].w * w.w); }
        }
#pragma unroll
        for (int r = 0; r < 4; ++r) {
            const int row = rowb + r;
            const float rs = 1.0f / sqrtf(wave_sum(ss[r]) * (1.0f / DM) + EPS);
            float lg[36];
#pragma unroll
            for (int j = 0; j < 36; ++j) lg[j] = wave_sum(acc[r][j]) * rs + (j < 4 ? brg[j] : bre[j - 4]);
            { GAS unsigned long long* o8 = (GAS unsigned long long*)(XN + (size_t)row * DM) + F.lane;
#pragma unroll
              for (int j = 0; j < 4; ++j) { const f32x4 v = *(const f32x4*)(h1 + (size_t)row * DM + 4 * F.lane + 256 * j); const f32x4 w = *(const f32x4*)(nfw + 4 * F.lane + 256 * j); const f32x4 u = v * rs * w;
                  o8[64 * j] = (unsigned long long)pk2(u.x, u.y) | ((unsigned long long)pk2(u.z, u.w) << 32); } }
            int g = 0; float gm = lg[0];
#pragma unroll
            for (int j = 1; j < 4; ++j) if (lg[j] > gm) { gm = lg[j]; g = j; }
            float gs = 0.f;
#pragma unroll
            for (int j = 0; j < 4; ++j) gs += __expf(lg[j] - gm);
            const float pg = 1.0f / gs;
            float es[8];
#pragma unroll
            for (int i = 0; i < 8; ++i) es[i] = (g == 0) ? lg[4 + i] : (g == 1) ? lg[12 + i] : (g == 2) ? lg[20 + i] : lg[28 + i];
            int i1 = 0; float v1 = es[0];
#pragma unroll
            for (int i = 1; i < 8; ++i) if (es[i] > v1) { v1 = es[i]; i1 = i; }
            int i2 = -1; float v2 = -3.0e38f;
#pragma unroll
            for (int i = 0; i < 8; ++i) if (i != i1 && es[i] > v2) { v2 = es[i]; i2 = i; }
            const float s1 = 1.0f / (1.0f + __expf(v2 - v1));
            if (F.lane == 0) {
                const unsigned e1 = (unsigned)(g * 8 + i1), e2 = (unsigned)(g * 8 + i2);
                const unsigned p1 = __hip_atomic_fetch_add((unsigned*)(F.ctl + CW_CNT + e1), 1u, RLX_AGENT), p2 = __hip_atomic_fetch_add((unsigned*)(F.ctl + CW_CNT + e2), 1u, RLX_AGENT);
                ASG[2 * row] = (e1 << 16) | p1; ASG[2 * row + 1] = (e2 << 16) | p2; GATE[2 * row] = pg * s1; GATE[2 * row + 1] = pg * (1.0f - s1);
            }
        }
    }
    __syncthreads();
}
__device__ __forceinline__ void p8_permute(Frame& F) {
    LAS unsigned* pst = (LAS unsigned*)(F.lds + RING_OFF);
    if (F.wave == 0) {
        const unsigned cnt = F.lane < NE ? ald((const unsigned*)(F.ctl + CW_CNT + F.lane)) : 0u; const unsigned nt = (cnt + 255u) >> 8;
        unsigned inc = nt;
#pragma unroll
        for (int o = 1; o < 64; o <<= 1) { const unsigned t = __shfl_up(inc, o); if (F.lane >= o) inc += t; }
        const unsigned excl = inc - nt;
        if (F.lane < NE) pst[F.lane] = excl * 256u;
        if (blockIdx.x == 0) {
            if (F.lane == NE - 1) __hip_atomic_store((unsigned*)(F.ctl + CW_NT), inc, RLX_AGENT);
            if (F.lane < NE) for (unsigned t = 0; t < nt; ++t) __hip_atomic_store((unsigned*)(F.ctl + CW_TILEE + excl + t), (unsigned)F.lane, RLX_AGENT);
        }
    }
    __syncthreads();
    const unsigned* ASG = (const unsigned*)(F.ws + WS_ASG); unsigned* SLOT = (unsigned*)(F.ws + WS_SLOT); const bf16* XN = (const bf16*)(F.ws + WS_XN); bf16* XS = (bf16*)(F.ws + WS_XS);
    const int gw = F.vcu * NWAVES + F.wave, NGW = F.G * NWAVES;
    for (int a = gw; a < 2 * MR; a += NGW) {
        const unsigned w = ald(ASG + a); const unsigned e = w >> 16, pos = w & 0xffffu; const unsigned slot = pst[e] + pos;
        if (F.lane == 0) SLOT[a] = slot;
        const v4u* src = (const v4u*)(XN + (size_t)(a >> 1) * DM); v4u* dst = (v4u*)(XS + (size_t)slot * DM);
        dst[F.lane] = src[F.lane]; dst[64 + F.lane] = src[64 + F.lane];
    }
    __syncthreads();
}
__device__ __forceinline__ void p11_final(Frame& F) {
    const unsigned* SLOT = (const unsigned*)(F.ws + WS_SLOT); const float* GATE = (const float*)(F.ws + WS_GATE); const bf16* Y = (const bf16*)(F.ws + WS_Y); const float* fw = F.in[17];
    const int gw = F.vcu * NWAVES + F.wave, NGW = F.G * NWAVES;
    for (int m = gw; m < MR; m += NGW) {
        const unsigned s0 = ald(SLOT + 2 * m), s1 = ald(SLOT + 2 * m + 1); const float g0 = aldf(GATE + 2 * m), g1 = aldf(GATE + 2 * m + 1);
        f32x4 v[4]; float ss = 0.f;
#pragma unroll
        for (int j = 0; j < 4; ++j) { v[j] = *(const f32x4*)(F.out + (size_t)m * DM + 4 * F.lane + 256 * j);
            const v2u y0 = *(const v2u*)(Y + (size_t)s0 * DM + 4 * F.lane + 256 * j), y1 = *(const v2u*)(Y + (size_t)s1 * DM + 4 * F.lane + 256 * j);
            v[j].x += g0 * blo(y0.x) + g1 * blo(y1.x); v[j].y += g0 * bhi(y0.x) + g1 * bhi(y1.x); v[j].z += g0 * blo(y0.y) + g1 * blo(y1.y); v[j].w += g0 * bhi(y0.y) + g1 * bhi(y1.y);
            ss += (v[j].x * v[j].x + v[j].y * v[j].y) + (v[j].z * v[j].z + v[j].w * v[j].w); }
        const float rs = 1.0f / sqrtf(wave_sum(ss) * (1.0f / DM) + EPS);
#pragma unroll
        for (int j = 0; j < 4; ++j) { const f32x4 w = *(const f32x4*)(fw + 4 * F.lane + 256 * j); *(f32x4*)(F.out + (size_t)m * DM + 4 * F.lane + 256 * j) = v[j] * rs * w; }
    }
}

struct Args { const float* in[18]; float* out; unsigned char* ws; int ph_lo, ph_hi, li, pad; };
__global__ void __launch_bounds__(NWAVES * 64, 2) fwd(Args args) {
    extern __shared__ __attribute__((aligned(16))) unsigned char lds[];
    Frame F;
    F.lds = (LAS unsigned char*)lds;
    F.MISC = (volatile LAS unsigned*)(F.lds + MISC_OFF);
    F.tid = threadIdx.x; F.lane = F.tid & 63; F.wave = __builtin_amdgcn_readfirstlane(F.tid >> 6);
    F.G = gridDim.x; { const int bx = blockIdx.x; F.vcu = (F.G % 8 == 0) ? (bx % 8) * (F.G / 8) + bx / 8 : bx; }
    F.ws = args.ws; F.ctl = (gu32*)(args.ws + WS_CTL); F.out = args.out;
#pragma unroll
    for (int i = 0; i < 18; ++i) F.in[i] = args.in[i];
    for (int u = F.tid; u < (LDS_BYTES - LDSCTL_OFF) / 4; u += NWAVES * 64) ((LAS unsigned*)(F.lds + LDSCTL_OFF))[u] = 0u;
    __syncthreads();
    const int bli = (N_LAUNCHES == NPHASE) ? 0 : args.li;
    XcdBarrier bar; bar.bar = (unsigned*)(F.ctl + CW_BAR) + bli * XCD_BAR_WORDS; bar.x = 0; bar.st = nullptr;
    if (N_LAUNCHES != NPHASE) bar = xcd_barrier_post((unsigned*)(F.ctl + CW_BAR) + bli * XCD_BAR_WORDS, F.MISC + 8);
#define GRID_BAR(seam) do { if (N_LAUNCHES == NPHASE) { if (F.tid == 0) __hip_atomic_store(F.ctl + CW_TMO, 0xBADBA0u | (unsigned)(seam), RLX_AGENT); } else { xcd_barrier(bar); } } while (0)
    const int lo = args.ph_lo, hi = args.ph_hi;
#define IN(k) (lo <= (k) && (k) < hi)
#define PHASE_BEGIN() do { int t_ = threadIdx.x; asm volatile("" : "+v"(t_)); F.tid = t_; F.lane = t_ & 63; } while (0)
#define BOTH(k) (IN(k) && IN((k) + 1))
    unsigned char* ws = args.ws;

    if (IN(0)) { PHASE_BEGIN();
        if (F.vcu < 7) p0_meta(F);
        p0_rows(F);
        p0_weights(F);
        if (BOTH(0)) GRID_BAR(0);
    }
    if (IN(1)) { PHASE_BEGIN();
        pg8::Gemm g{(const bf16*)(ws + WS_U), (const bf16*)(ws + WS_WIN), MR, NPROJ, DM, 0};
        pg8::StaticOrder S; S.init(MR, NPROJ, F.G, (int)blockIdx.x);
        pg8::EpiProj E{(bf16*)(ws + WS_QA), (bf16*)(ws + WS_KA), (bf16*)(ws + WS_VA), (bf16*)(ws + WS_QH), (bf16*)(ws + WS_EB), (bf16*)(ws + WS_KT), (bf16*)(ws + WS_KD), (bf16*)(ws + WS_VH),
                       (bf16*)(ws + WS_GH), (bf16*)(ws + WS_GA), (bf16*)(ws + WS_GT), F.in[5]};
        pg8::gemm_phase<pg8::EpiProj, pg8::StaticOrder, true, true>(F.lds + RING_OFF, g, S, E);
        __syncthreads();
        for (int bh = blockIdx.x; bh < 16; bh += F.G) p1_cumsum(F, bh);
        if (BOTH(1)) GRID_BAR(1);
    }
    if (IN(2)) { PHASE_BEGIN();
#if defined(ATTN_SIMPLE)
        for (int pid = F.vcu; pid < 256; pid += F.G) { const int bh = pid >> 4, s = pid & 15; attn_simple_unit(F, bh, s); attn_simple_unit(F, bh, 31 - s); }
#else
        static_assert(attn_body::ATTN_LDS_BYTES <= RING_BYTES, "attention LDS");
        for (int pid = F.vcu; pid < 256; pid += F.G) { const int bh = pid >> 4, s = pid & 15;
            for (int i = 0; i < 2; ++i)
                attn_body::attn_unit<8>(bh >> 3, bh & 7, i ? 31 - s : s, (const attn_body::bf16*)(ws + WS_QA), (const attn_body::bf16*)(ws + WS_KA), (const attn_body::bf16*)(ws + WS_VA), (attn_body::bf16*)(ws + WS_OA),
                                        (const float*)(ws + WS_CL) + (size_t)bh * KROWS, (char*)lds + RING_OFF); }
        __syncthreads();
#endif
#if defined(HGRN_SIMPLE)
        for (int it = F.vcu; it < 16 * NCH; it += F.G) hgrn_a_simple(F, it);
#else
        for (int it = F.vcu; it < 16 * NCH; it += F.G) hg::hgrn_a(it, (const bf16*)(ws + WS_KD), (const bf16*)(ws + WS_VH), (bf16*)(ws + WS_US), F.lds + RING_OFF);
#endif
        if (BOTH(2)) GRID_BAR(2);
    }
#if defined(HGRN_SIMPLE)
    if (IN(3)) { PHASE_BEGIN(); hgrn_scan(F); if (BOTH(3)) GRID_BAR(3); }
#else
    if (IN(3)) { PHASE_BEGIN(); hgrn_scan_t(F); if (BOTH(3)) GRID_BAR(3); }
#endif
    if (IN(4)) { PHASE_BEGIN();
#if defined(HGRN_SIMPLE)
        for (int it = F.vcu; it < 16 * 128; it += F.G) hgrn_c_simple(F, it);
#else
        static_assert(hg::HC_END <= RING_BYTES, "hgrn LDS");
        for (int it = F.vcu; it < 16 * 128; it += F.G)
            hg::hgrn_c(it, (const bf16*)(ws + WS_QH), (const bf16*)(ws + WS_EB), (const bf16*)(ws + WS_KT), (const bf16*)(ws + WS_VH), (const bf16*)(ws + WS_GH), (const bf16*)(ws + WS_US), (bf16*)(ws + WS_OH), F.in[6], EPS, F.lds + RING_OFF);
#endif
        if (BOTH(4)) GRID_BAR(4);
    }
    if (IN(5)) { PHASE_BEGIN();
        { pg8::Gemm g{(const bf16*)(ws + WS_OA), (const bf16*)(ws + WS_WA), MR, DM, AWID, 0}; pg8::StaticOrder S; S.init(MR, DM, F.G, (int)blockIdx.x);
          pg8::EpiYa E{(const bf16*)(ws + WS_GA), (float*)(ws + WS_YA)};
          pg8::gemm_phase<pg8::EpiYa, pg8::StaticOrder, true, true>(F.lds + RING_OFF, g, S, E); }
        __syncthreads();
        { pg8::Gemm g{(const bf16*)(ws + WS_OH), (const bf16*)(ws + WS_WH), MR, DM, DM, 0}; pg8::StaticOrder S; S.init(MR, DM, F.G, (int)blockIdx.x);
          pg8::EpiMixed E{(const bf16*)(ws + WS_GT), (const float*)(ws + WS_YA), (bf16*)(ws + WS_MIX)};
          pg8::gemm_phase<pg8::EpiMixed, pg8::StaticOrder, true, true>(F.lds + RING_OFF, g, S, E); }
        if (BOTH(5)) GRID_BAR(5);
    }
    if (IN(6)) { PHASE_BEGIN();
        pg8::Gemm g{(const bf16*)(ws + WS_MIX), (const bf16*)(ws + WS_WO), MR, DM, DM, 0}; pg8::StaticOrder S; S.init(MR, DM, F.G, (int)blockIdx.x);
        pg8::EpiRes E{F.in[0], F.out};
        pg8::gemm_phase<pg8::EpiRes, pg8::StaticOrder, true, true>(F.lds + RING_OFF, g, S, E);
        if (BOTH(6)) GRID_BAR(6);
    }
    if (IN(7)) { PHASE_BEGIN(); p7_router(F); p7_expert_weights(F); if (BOTH(7)) GRID_BAR(7); }
    if (IN(8)) { PHASE_BEGIN(); p8_permute(F); if (BOTH(8)) GRID_BAR(8); }
    if (IN(9)) { PHASE_BEGIN();
        const int ntile = (int)__builtin_amdgcn_readfirstlane(ald((const unsigned*)(F.ctl + CW_NT)));
        pg8::Gemm g{(const bf16*)(ws + WS_XS), (const bf16*)(ws + WS_WE1), APAD, DM, DM, (size_t)DM * DM * 2};
        pg8::MoeOrder S{ntile * 4, F.G, F.vcu, (const unsigned*)(F.ctl + CW_TILEE)};
        pg8::EpiSwiglu E{(bf16*)(ws + WS_ACT)};
        pg8::gemm_phase<pg8::EpiSwiglu, pg8::MoeOrder, true, true>(F.lds + RING_OFF, g, S, E);
        if (BOTH(9)) GRID_BAR(9);
    }
    if (IN(10)) { PHASE_BEGIN();
        const int ntile = (int)__builtin_amdgcn_readfirstlane(ald((const unsigned*)(F.ctl + CW_NT)));
        pg8::Gemm g{(const bf16*)(ws + WS_ACT), (const bf16*)(ws + WS_WE2), APAD, DM, EFF, (size_t)DM * EFF * 2};
        pg8::MoeOrder S{ntile * 4, F.G, F.vcu, (const unsigned*)(F.ctl + CW_TILEE)};
        pg8::EpiPlain E{(bf16*)(ws + WS_Y), DM};
        pg8::gemm_phase<pg8::EpiPlain, pg8::MoeOrder, true, true>(F.lds + RING_OFF, g, S, E);
        if (BOTH(10)) GRID_BAR(10);
    }
    if (IN(11)) { PHASE_BEGIN(); p11_final(F); }
#undef IN
#undef BOTH
}

extern "C" void kernel_launch(void* const* d_in, const int* in_sizes, int n_in, void* d_out, int out_size, void* d_ws, size_t ws_size, hipStream_t stream) {
    static int grid = 0;
    if (grid == 0) {
        if (n_in != 18 || in_sizes[0] != MR * DM || out_size != MR * DM || ws_size < WS_END) {
            fprintf(stderr, "kernel_launch: unexpected problem: n_in %d in0 %d out %d ws %zu (need %zu); nothing launched\n", n_in, n_in > 0 ? in_sizes[0] : -1, out_size, ws_size, (size_t)WS_END); grid = -1; return; }
        int dev = 0, cus = 0, per_cu = 0;
        if (hipGetDevice(&dev) != hipSuccess || hipDeviceGetAttribute(&cus, hipDeviceAttributeMultiprocessorCount, dev) != hipSuccess) { grid = -1; return; }
        if (hipFuncSetAttribute((const void*)fwd, hipFuncAttributeMaxDynamicSharedMemorySize, LDS_BYTES) != hipSuccess) { fprintf(stderr, "kernel_launch: hipFuncSetAttribute failed\n"); grid = -1; return; }
        if (hipOccupancyMaxActiveBlocksPerMultiprocessor(&per_cu, (const void*)fwd, NWAVES * 64, LDS_BYTES) != hipSuccess || per_cu < 1)
            fprintf(stderr, "kernel_launch: note: occupancy query reports %d workgroups per CU\n", per_cu);
        (void)hipGetLastError();
        grid = cus;
    }
    if (grid < 0) return;
    if (hipMemsetAsync((char*)d_ws + WS_CTL, 0, CTL_ZERO_BYTES, stream) != hipSuccess) { fprintf(stderr, "kernel_launch: memset failed\n"); return; }
    Args a{};
    for (int i = 0; i < 18; ++i) a.in[i] = (const float*)d_in[i];
    a.out = (float*)d_out; a.ws = (unsigned char*)d_ws;
    for (int li = 0; li < N_LAUNCHES; ++li) {
        if (N_LAUNCHES == NPHASE) { a.ph_lo = li; a.ph_hi = li + 1; } else { a.ph_lo = 0; a.ph_hi = NPHASE; }
        a.li = li;
        hipLaunchKernelGGL(fwd, dim3(grid), dim3(NWAVES * 64), LDS_BYTES, stream, a);
        const hipError_t le = hipPeekAtLastError();
        if (le != hipSuccess) { fprintf(stderr, "kernel_launch: launch %d failed: %s\n", li, hipGetErrorName(le)); break; }
    }
}
```

```cpp
#include <hip/hip_runtime.h>
#include <hip/hip_bf16.h>
#include <cmath>
#include <cstdio>
#include <cstdint>

#ifndef MK_N_LAUNCHES
#define MK_N_LAUNCHES 1
#endif

namespace pg8 {
#define PG8_LAS __attribute__((address_space(3)))
typedef unsigned short bf16_t;
typedef short bf16x8 __attribute__((ext_vector_type(8)));
typedef float f32x4 __attribute__((ext_vector_type(4)));
typedef unsigned u32x4 __attribute__((ext_vector_type(4)));
typedef unsigned u32x2 __attribute__((ext_vector_type(2)));
constexpr int BM = 256, BK = 64, HALF = 128, HTB = HALF * BK * 2  , STAGE_BYTES = 8 * HTB, NXCD = 8, WGM = 8;

__host__ __device__ __forceinline__ int lds_byte(int r, int c) { const int st = (r >> 4) * 2 + (c >> 5), rr = r & 15, cc = c & 31, ob = rr * 64 + cc * 2; return st * 1024 + (ob ^ (((ob >> 9) & 1) << 5)); }
__host__ __device__ __forceinline__ void stage_rc(int b, int& R, int& C) { const int st = b / 1024, sb = b % 1024, swz = sb ^ (((sb >> 9) & 1) << 5); R = (st >> 1) * 16 + swz / 64; C = (st & 1) * 32 + (swz % 64) / 2; }
__host__ __device__ __forceinline__ int perm32(int rho) { const int n = rho >> 4, i = rho & 15; return 8 * (i >> 2) + 4 * n + (i & 3); }

struct Unit { int pm, pn, e; };
struct Gemm { const bf16_t* A; const bf16_t* Bt; int M, N, K; size_t bexp; };

struct StaticOrder {
    int nM, nN, nwg, G, c;
    __host__ __device__ void init(int M, int N, int G_, int c_) { nM = M / BM; nN = N / BM; nwg = nM * nN; G = G_; c = c_; }
    __host__ __device__ bool next(int i, Unit& u) const {
        const long L = (long)i * G + c; if (L >= nwg) return false;
        int wgid = (int)L; { const int q = nwg / NXCD, r = nwg % NXCD, xcd = wgid % NXCD, off = wgid / NXCD; wgid = (xcd < r ? xcd * (q + 1) : r * (q + 1) + (xcd - r) * q) + off; }
        const int nig = WGM * nN, gid = wgid / nig, fm = gid * WGM, gsz = (nM - fm) < WGM ? (nM - fm) : WGM;
        u.pm = fm + ((wgid % nig) % gsz); u.pn = (wgid % nig) / gsz; u.e = 0; return true;
    }
    __device__ __forceinline__ void a_ready(const Unit&) const {}
    __device__ __forceinline__ void done(const Unit&) const {}
};
struct MoeOrder {
    int ntu, G, c; const unsigned* tile_e;
    __device__ bool next(int i, Unit& u) const {
        const long L = (long)i * G + c; if (L >= ntu) return false;
        u.pm = (int)(L >> 2); u.pn = (int)(L & 3);
        u.e = (int)__builtin_amdgcn_readfirstlane(__hip_atomic_load(tile_e + u.pm, __ATOMIC_RELAXED, __HIP_MEMORY_SCOPE_AGENT)); return true;
    }
    __device__ __forceinline__ void a_ready(const Unit&) const {}
    __device__ __forceinline__ void done(const Unit&) const {}
};

__device__ __forceinline__ unsigned cvt_pk_bf16(float lo, float hi) { unsigned r; asm volatile("v_cvt_pk_bf16_f32 %0, %1, %2" : "=v"(r) : "v"(lo), "v"(hi)); return r; }
__device__ __forceinline__ float fsig(float x) { return __builtin_amdgcn_rcpf(1.0f + __builtin_amdgcn_exp2f(-1.4426950408889634f * x)); }
__device__ __forceinline__ float bflo(unsigned w) { return __builtin_bit_cast(float, w << 16); }
__device__ __forceinline__ float bfhi(unsigned w) { return __builtin_bit_cast(float, w & 0xffff0000u); }
__device__ __forceinline__ float dpp_shr(float v, int) { return v; }
#define PG8_SCAN16(v) do { \
    v += __builtin_bit_cast(float, __builtin_amdgcn_update_dpp(0, __builtin_bit_cast(int, v), 0x111, 0xf, 0xf, true)); \
    v += __builtin_bit_cast(float, __builtin_amdgcn_update_dpp(0, __builtin_bit_cast(int, v), 0x112, 0xf, 0xf, true)); \
    v += __builtin_bit_cast(float, __builtin_amdgcn_update_dpp(0, __builtin_bit_cast(int, v), 0x114, 0xf, 0xf, true)); \
    v += __builtin_bit_cast(float, __builtin_amdgcn_update_dpp(0, __builtin_bit_cast(int, v), 0x118, 0xf, 0xf, true)); } while (0)

constexpr float ATT_C2 = 0.125f * 1.4426950408889634f;
constexpr float HG_QS = 0.08838834764831845f;

struct EpiProj {
    static constexpr bool PERM = true, AFTER_DRAIN = false;
    bf16_t *QA, *KA, *VA, *QH, *EB, *KT, *KD, *VH, *GH, *GA, *GT; const float* lbl;
    __device__ __forceinline__ void operator()(const f32x4 (&acc)[2][2][4][2], const Unit& u, int wr, int wc, int fr, int fq) const {
        const int pn = u.pn, b = u.pm >> 5;
        const int cofs = wc * 32 + 8 * fq;
        const int row0 = u.pm * BM + wr * 64 + fr;
        if (pn >= 10 && pn < 14) {
            const int colbase = 256 * (pn - 10), lane = fq * 16 + fr, srcl = (lane & 48) | 15;
#pragma unroll
            for (int ai = 0; ai < 2; ++ai)
#pragma unroll
                for (int bj = 0; bj < 2; ++bj)
#pragma unroll
                    for (int n = 0; n < 2; ++n) {
                        const int c0 = colbase + 128 * bj + cofs + 4 * n;
                        const f32x4 l0 = *(const f32x4*)(lbl + c0), l1 = *(const f32x4*)(lbl + 1024 + c0);
                        float eb[4][4], kt[4][4], kd[4][4];
#pragma unroll
                        for (int e = 0; e < 4; ++e) {
                            const float lb = __builtin_amdgcn_rcpf(1.0f + __builtin_amdgcn_exp2f((l1[e] - l0[e]) * 1.4426950408889634f));
                            float lf[4], kk[4];
#pragma unroll
                            for (int m = 0; m < 4; ++m) { const float f = lb + (1.0f - lb) * fsig(acc[ai][bj][m][n][e]); kk[m] = 1.0f - f; lf[m] = __builtin_amdgcn_logf(f); }
#pragma unroll
                            for (int m = 0; m < 4; ++m) PG8_SCAN16(lf[m]);
                            float run = 0.f, bb[4];
#pragma unroll
                            for (int m = 0; m < 4; ++m) { const float tot = __shfl(lf[m], srcl); bb[m] = lf[m] + run; run += tot; }
#pragma unroll
                            for (int m = 0; m < 4; ++m) { eb[m][e] = __builtin_amdgcn_exp2f(bb[m]); kt[m][e] = kk[m] * __builtin_amdgcn_exp2f(-bb[m]); kd[m][e] = kk[m] * __builtin_amdgcn_exp2f(run - bb[m]); }
                        }
#pragma unroll
                        for (int m = 0; m < 4; ++m) {
                            const size_t r = (size_t)(row0 + ai * HALF + m * 16);
                            u32x2 w;
                            w.x = cvt_pk_bf16(eb[m][0], eb[m][1]); w.y = cvt_pk_bf16(eb[m][2], eb[m][3]); *(u32x2*)(EB + r * 1024 + c0) = w;
                            w.x = cvt_pk_bf16(kt[m][0], kt[m][1]); w.y = cvt_pk_bf16(kt[m][2], kt[m][3]); *(u32x2*)(KT + r * 1024 + c0) = w;
                            w.x = cvt_pk_bf16(kd[m][0], kd[m][1]); w.y = cvt_pk_bf16(kd[m][2], kd[m][3]); *(u32x2*)(KD + (r + 64 * (b + 1)) * 1024 + c0) = w;
                        }
                    }
            return;
        }
        bf16_t* base; int ld = 1024, radd = 0, cb; int mode = 0; float sc = 1.f;
        if (pn < 2) { base = QA; ld = 512; cb = 256 * pn; sc = ATT_C2; }
        else if (pn < 4) { base = KA; ld = 512; cb = 256 * (pn - 2); radd = 128 * (b + 1); }
        else if (pn < 6) { base = VA; ld = 512; cb = 256 * (pn - 4); radd = 128 * (b + 1); }
        else if (pn < 10) { base = QH; cb = 256 * (pn - 6); sc = HG_QS; }
        else if (pn < 18) { base = VH; cb = 256 * (pn - 14); radd = 64 * (b + 1); }
        else if (pn < 22) { base = GH; cb = 256 * (pn - 18); mode = 1; }
        else if (pn < 26) { base = GA; cb = 256 * (pn - 22); mode = 1; }
        else { base = GT; cb = 256 * (pn - 26); mode = 1; }
#pragma unroll
        for (int ai = 0; ai < 2; ++ai)
#pragma unroll
            for (int m = 0; m < 4; ++m) { bf16_t* rowp = base + (size_t)(row0 + ai * HALF + m * 16 + radd) * ld + cb + cofs;
#pragma unroll
                for (int bj = 0; bj < 2; ++bj) { f32x4 v0 = acc[ai][bj][m][0], v1 = acc[ai][bj][m][1];
                    if (mode) {
#pragma unroll
                        for (int e = 0; e < 4; ++e) { v0[e] = fsig(v0[e]); v1[e] = fsig(v1[e]); }
                    } else { v0 = v0 * sc; v1 = v1 * sc; }
                    u32x4 w; w.x = cvt_pk_bf16(v0[0], v0[1]); w.y = cvt_pk_bf16(v0[2], v0[3]); w.z = cvt_pk_bf16(v1[0], v1[1]); w.w = cvt_pk_bf16(v1[2], v1[3]);
                    *(u32x4*)(rowp + bj * HALF) = w; } }
    }
};
struct EpiYa {
    static constexpr bool PERM = true, AFTER_DRAIN = false;
    const bf16_t* G; float* Y;
    __device__ __forceinline__ void operator()(const f32x4 (&acc)[2][2][4][2], const Unit& u, int wr, int wc, int fr, int fq) const {
        const int row0 = u.pm * BM + wr * 64 + fr, col0 = u.pn * BM + wc * 32 + 8 * fq;
#pragma unroll
        for (int ai = 0; ai < 2; ++ai)
#pragma unroll
            for (int m = 0; m < 4; ++m) { const size_t off = (size_t)(row0 + ai * HALF + m * 16) * 1024 + col0;
#pragma unroll
                for (int bj = 0; bj < 2; ++bj) { const u32x4 g = *(const u32x4*)(G + off + bj * HALF);
                    f32x4 v0 = acc[ai][bj][m][0], v1 = acc[ai][bj][m][1];
                    v0[0] *= bflo(g.x); v0[1] *= bfhi(g.x); v0[2] *= bflo(g.y); v0[3] *= bfhi(g.y); v1[0] *= bflo(g.z); v1[1] *= bfhi(g.z); v1[2] *= bflo(g.w); v1[3] *= bfhi(g.w);
                    *(f32x4*)(Y + off + bj * HALF) = v0; *(f32x4*)(Y + off + bj * HALF + 4) = v1; } }
    }
};
struct EpiMixed {
    static constexpr bool PERM = true, AFTER_DRAIN = false;
    const bf16_t* G; const float* Y; bf16_t* O;
    __device__ __forceinline__ void operator()(const f32x4 (&acc)[2][2][4][2], const Unit& u, int wr, int wc, int fr, int fq) const {
        const int row0 = u.pm * BM + wr * 64 + fr, col0 = u.pn * BM + wc * 32 + 8 * fq;
#pragma unroll
        for (int ai = 0; ai < 2; ++ai)
#pragma unroll
            for (int m = 0; m < 4; ++m) { const size_t off = (size_t)(row0 + ai * HALF + m * 16) * 1024 + col0;
#pragma unroll
                for (int bj = 0; bj < 2; ++bj) { const u32x4 g = *(const u32x4*)(G + off + bj * HALF);
                    const f32x4 y0 = *(const f32x4*)(Y + off + bj * HALF), y1 = *(const f32x4*)(Y + off + bj * HALF + 4);
                    f32x4 v0 = acc[ai][bj][m][0], v1 = acc[ai][bj][m][1];
                    v0[0] = y0[0] + v0[0] * bflo(g.x); v0[1] = y0[1] + v0[1] * bfhi(g.x); v0[2] = y0[2] + v0[2] * bflo(g.y); v0[3] = y0[3] + v0[3] * bfhi(g.y);
                    v1[0] = y1[0] + v1[0] * bflo(g.z); v1[1] = y1[1] + v1[1] * bfhi(g.z); v1[2] = y1[2] + v1[2] * bflo(g.w); v1[3] = y1[3] + v1[3] * bfhi(g.w);
                    u32x4 w; w.x = cvt_pk_bf16(v0[0], v0[1]); w.y = cvt_pk_bf16(v0[2], v0[3]); w.z = cvt_pk_bf16(v1[0], v1[1]); w.w = cvt_pk_bf16(v1[2], v1[3]);
                    *(u32x4*)(O + off + bj * HALF) = w; } }
    }
};
struct EpiRes {
    static constexpr bool PERM = true, AFTER_DRAIN = false;
    const float* X; float* O;
    __device__ __forceinline__ void operator()(const f32x4 (&acc)[2][2][4][2], const Unit& u, int wr, int wc, int fr, int fq) const {
        const int row0 = u.pm * BM + wr * 64 + fr, col0 = u.pn * BM + wc * 32 + 8 * fq;
#pragma unroll
        for (int ai = 0; ai < 2; ++ai)
#pragma unroll
            for (int m = 0; m < 4; ++m) { const size_t off = (size_t)(row0 + ai * HALF + m * 16) * 1024 + col0;
#pragma unroll
                for (int bj = 0; bj < 2; ++bj) {
                    const f32x4 x0 = *(const f32x4*)(X + off + bj * HALF), x1 = *(const f32x4*)(X + off + bj * HALF + 4);
                    *(f32x4*)(O + off + bj * HALF) = x0 + acc[ai][bj][m][0]; *(f32x4*)(O + off + bj * HALF + 4) = x1 + acc[ai][bj][m][1]; } }
    }
};
struct EpiSwiglu {
    static constexpr bool PERM = true, AFTER_DRAIN = false;
    bf16_t* O;
    __device__ __forceinline__ void operator()(const f32x4 (&acc)[2][2][4][2], const Unit& u, int wr, int wc, int fr, int fq) const {
        const int row0 = u.pm * BM + wr * 64 + fr, col0 = u.pn * HALF + wc * 32 + 8 * fq;
#pragma unroll
        for (int ai = 0; ai < 2; ++ai)
#pragma unroll
            for (int m = 0; m < 4; ++m) { const size_t off = (size_t)(row0 + ai * HALF + m * 16) * 512 + col0;
                f32x4 v0, v1;
#pragma unroll
                for (int e = 0; e < 4; ++e) { const float a0 = acc[ai][0][m][0][e], a1 = acc[ai][0][m][1][e];
                    v0[e] = a0 * fsig(a0) * acc[ai][1][m][0][e]; v1[e] = a1 * fsig(a1) * acc[ai][1][m][1][e]; }
                u32x4 w; w.x = cvt_pk_bf16(v0[0], v0[1]); w.y = cvt_pk_bf16(v0[2], v0[3]); w.z = cvt_pk_bf16(v1[0], v1[1]); w.w = cvt_pk_bf16(v1[2], v1[3]);
                *(u32x4*)(O + off) = w; }
    }
};
struct EpiPlain {
    static constexpr bool PERM = true, AFTER_DRAIN = false;
    bf16_t* O; int ldc;
    __device__ __forceinline__ void operator()(const f32x4 (&acc)[2][2][4][2], const Unit& u, int wr, int wc, int fr, int fq) const {
        const int row0 = u.pm * BM + wr * 64 + fr, col0 = u.pn * BM + wc * 32 + 8 * fq;
#pragma unroll
        for (int ai = 0; ai < 2; ++ai)
#pragma unroll
            for (int m = 0; m < 4; ++m) { const size_t off = (size_t)(row0 + ai * HALF + m * 16) * ldc + col0;
#pragma unroll
                for (int bj = 0; bj < 2; ++bj) { const f32x4 v0 = acc[ai][bj][m][0], v1 = acc[ai][bj][m][1];
                    u32x4 w; w.x = cvt_pk_bf16(v0[0], v0[1]); w.y = cvt_pk_bf16(v0[2], v0[3]); w.z = cvt_pk_bf16(v1[0], v1[1]); w.w = cvt_pk_bf16(v1[2], v1[3]);
                    *(u32x4*)(O + off + bj * HALF) = w; } }
    }
};

template <class Epi, class Sched, bool ALIGN_EPI = false, bool SP2 = false>
__device__ __forceinline__ void gemm_phase(PG8_LAS unsigned char* lds, const Gemm g, const Sched& S, const Epi& E) {
    int tid_l = threadIdx.x; asm volatile("" : "+v"(tid_l));
    const int tid = tid_l, wid = __builtin_amdgcn_readfirstlane(tid >> 6), lane = tid & 63, wr = wid >> 2, wc = wid & 3, fr = lane & 15, fq = lane >> 4;
    const int K = g.K, nt = K / BK;
    unsigned voffA[2], voffB[2];
#pragma unroll
    for (int i = 0; i < 2; ++i) { int R, C; stage_rc(tid * 16 + i * 8192, R, C); const int Rb = Epi::PERM ? ((R & ~31) + perm32(R & 31)) : R;
        voffA[i] = (unsigned)(R * K + C) * 2u; voffB[i] = (unsigned)(Rb * K + C) * 2u; }
    const size_t kstep = (size_t)(BK * 2);
    const size_t hstep = (size_t)HALF * K * 2;
    const size_t tstep = 2 * hstep;
    const unsigned ldsw = (unsigned)wid * 1024u;
    const int aoff = lds_byte(wr * 64 + fr, fq * 8), boff = lds_byte(wc * 32 + fr, fq * 8);
#define PG8_SA(b, h) (((b) * 2 + (h)) * HTB)
#define PG8_SB(b, h) ((4 + (b) * 2 + (h)) * HTB)
#define PG8_STAGE(bufoff, gbase, voff) do { _Pragma("unroll") for (int _i = 0; _i < 2; ++_i) \
        __builtin_amdgcn_global_load_lds((const unsigned*)((const char*)(gbase) + (voff)[_i]), (PG8_LAS unsigned*)(lds + (bufoff) + ldsw + _i * 8192), 16, 0, 0); } while (0)
#define PG8_LDA(dst, b, h) do { _Pragma("unroll") for (int m = 0; m < 4; ++m) _Pragma("unroll") for (int k = 0; k < 2; ++k) dst[m][k] = *(const PG8_LAS bf16x8*)(lds + PG8_SA(b, h) + aoff + m * 2048 + k * 1024); } while (0)
#define PG8_LDB(dst, b, h) do { _Pragma("unroll") for (int n = 0; n < 2; ++n) _Pragma("unroll") for (int k = 0; k < 2; ++k) dst[n][k] = *(const PG8_LAS bf16x8*)(lds + PG8_SB(b, h) + boff + n * 2048 + k * 1024); } while (0)
#define PG8_MMA(ai, bj, At, Bt) do { __builtin_amdgcn_s_setprio(1); _Pragma("unroll") for (int m = 0; m < 4; ++m) _Pragma("unroll") for (int n = 0; n < 2; ++n) _Pragma("unroll") for (int k = 0; k < 2; ++k) \
        acc[ai][bj][m][n] = __builtin_amdgcn_mfma_f32_16x16x32_bf16(Bt[n][k], At[m][k], acc[ai][bj][m][n], 0, 0, 0); __builtin_amdgcn_s_setprio(0); } while (0)
#define PG8_WAIT_V(n) asm volatile("s_waitcnt vmcnt(" #n ")" ::: "memory")
#define PG8_WAIT_L(n) asm volatile("s_waitcnt lgkmcnt(" #n ")" ::: "memory")
#define PG8_BAR __builtin_amdgcn_s_barrier()
#define PG8_SCHED __builtin_amdgcn_sched_barrier(0)
    Unit cur, nxt; int ui = 0;
    if (!S.next(0, cur)) return;
    f32x4 acc[2][2][4][2];
#pragma unroll
    for (int a = 0; a < 2; ++a)
#pragma unroll
        for (int b = 0; b < 2; ++b)
#pragma unroll
            for (int m = 0; m < 4; ++m)
#pragma unroll
                for (int n = 0; n < 2; ++n) acc[a][b][m][n] = (f32x4){0.f, 0.f, 0.f, 0.f};
    bf16x8 At[4][2], B0[2][2], B1[2][2];
    const char* cA = (const char*)g.A + (size_t)cur.pm * tstep; const char* cB = (const char*)g.Bt + (size_t)cur.e * g.bexp + (size_t)cur.pn * tstep;
    S.a_ready(cur);
    if constexpr (SP2) {
        PG8_STAGE(PG8_SB(0, 0), cB, voffB); PG8_STAGE(PG8_SB(0, 1), cB + hstep, voffB); PG8_STAGE(PG8_SA(0, 0), cA, voffA); PG8_STAGE(PG8_SA(0, 1), cA + hstep, voffA);
        if (wr == 1) PG8_BAR;
        PG8_WAIT_V(2); PG8_BAR;
        PG8_STAGE(PG8_SB(1, 0), cB + kstep, voffB); PG8_STAGE(PG8_SA(1, 0), cA + kstep, voffA); PG8_STAGE(PG8_SB(1, 1), cB + hstep + kstep, voffB);
        PG8_WAIT_V(6); PG8_BAR;
    } else {
        PG8_STAGE(PG8_SB(0, 0), cB, voffB); PG8_STAGE(PG8_SA(0, 0), cA, voffA); PG8_STAGE(PG8_SB(0, 1), cB + hstep, voffB); PG8_STAGE(PG8_SA(0, 1), cA + hstep, voffA);
        if (wr == 1) PG8_BAR;
        PG8_WAIT_V(4); PG8_BAR;
        PG8_STAGE(PG8_SB(1, 0), cB + kstep, voffB); PG8_STAGE(PG8_SA(1, 0), cA + kstep, voffA); PG8_STAGE(PG8_SB(1, 1), cB + hstep + kstep, voffB);
        PG8_WAIT_V(6); PG8_BAR;
    }
    for (;;) {
        const bool has_next = S.next(ui + 1, nxt);
        const char* nA = has_next ? (const char*)g.A + (size_t)nxt.pm * tstep : cA; const char* nB = has_next ? (const char*)g.Bt + (size_t)nxt.e * g.bexp + (size_t)nxt.pn * tstep : cB;
        for (int t = 0; t < nt; t += 2) {
            const bool last = (t == nt - 2);
            const char* a1 = cA + (size_t)(t + 1) * kstep;
            const char* a2 = last ? nA : cA + (size_t)(t + 2) * kstep; const char* b2 = last ? nB : cB + (size_t)(t + 2) * kstep;
            const char* a3 = a2 + kstep; const char* b3 = b2 + kstep;
            if (last && has_next) S.a_ready(nxt);
            if constexpr (SP2) {
            PG8_LDB(B0, 0, 0); PG8_LDB(B1, 0, 1); PG8_SCHED; PG8_LDA(At, 0, 0); PG8_STAGE(PG8_SA(1, 1), a1 + hstep, voffA);
            PG8_WAIT_V(8); PG8_WAIT_L(0); PG8_BAR; PG8_MMA(0, 0, At, B0); PG8_MMA(0, 1, At, B1); PG8_BAR; PG8_SCHED;
            PG8_LDA(At, 0, 1); PG8_STAGE(PG8_SB(0, 0), b2, voffB); PG8_STAGE(PG8_SB(0, 1), b2 + hstep, voffB); PG8_STAGE(PG8_SA(0, 0), a2, voffA);
            PG8_WAIT_V(8); PG8_WAIT_L(0); PG8_BAR; PG8_MMA(1, 0, At, B0); PG8_MMA(1, 1, At, B1); PG8_BAR; PG8_SCHED;
            PG8_LDB(B0, 1, 0); PG8_LDB(B1, 1, 1); PG8_SCHED; PG8_LDA(At, 1, 0); PG8_STAGE(PG8_SA(0, 1), a2 + hstep, voffA);
            PG8_WAIT_V(8); PG8_WAIT_L(0); PG8_BAR; PG8_MMA(0, 0, At, B0); PG8_MMA(0, 1, At, B1); PG8_BAR; PG8_SCHED;
            PG8_LDA(At, 1, 1); PG8_STAGE(PG8_SB(1, 0), b3, voffB); PG8_STAGE(PG8_SB(1, 1), b3 + hstep, voffB); PG8_STAGE(PG8_SA(1, 0), a3, voffA);
            PG8_WAIT_V(8); PG8_WAIT_L(0); PG8_BAR; PG8_MMA(1, 0, At, B0); PG8_MMA(1, 1, At, B1); PG8_BAR; PG8_SCHED;
            } else {
            PG8_LDB(B0, 0, 0); PG8_SCHED; PG8_LDA(At, 0, 0); PG8_STAGE(PG8_SA(1, 1), a1 + hstep, voffA);
            PG8_WAIT_L(8); PG8_BAR; PG8_WAIT_L(0); PG8_MMA(0, 0, At, B0); PG8_BAR; PG8_SCHED;
            PG8_LDB(B1, 0, 1); PG8_STAGE(PG8_SB(0, 0), b2, voffB);
            PG8_BAR; PG8_WAIT_L(0); PG8_MMA(0, 1, At, B1); PG8_BAR;
            PG8_LDA(At, 0, 1); PG8_STAGE(PG8_SA(0, 0), a2, voffA);
            PG8_BAR; PG8_WAIT_L(0); PG8_MMA(1, 0, At, B0); PG8_BAR; PG8_SCHED;
            PG8_STAGE(PG8_SB(0, 1), b2 + hstep, voffB);
            PG8_WAIT_V(6); PG8_BAR; PG8_MMA(1, 1, At, B1); PG8_BAR;
            PG8_LDB(B0, 1, 0); PG8_SCHED; PG8_LDA(At, 1, 0); PG8_STAGE(PG8_SA(0, 1), a2 + hstep, voffA);
            PG8_WAIT_L(8); PG8_BAR; PG8_WAIT_L(0); PG8_MMA(0, 0, At, B0); PG8_BAR; PG8_SCHED;
            PG8_LDB(B1, 1, 1); PG8_STAGE(PG8_SB(1, 0), b3, voffB);
            PG8_BAR; PG8_WAIT_L(0); PG8_MMA(0, 1, At, B1); PG8_BAR;
            PG8_LDA(At, 1, 1); PG8_STAGE(PG8_SA(1, 0), a3, voffA);
            PG8_BAR; PG8_WAIT_L(0); PG8_MMA(1, 0, At, B0); PG8_BAR; PG8_SCHED;
            PG8_STAGE(PG8_SB(1, 1), b3 + hstep, voffB);
            PG8_WAIT_V(6); PG8_BAR; PG8_MMA(1, 1, At, B1); PG8_BAR;
            }
        }
        if constexpr (ALIGN_EPI) { if (wr == 0) PG8_BAR; }
        if constexpr (!Epi::AFTER_DRAIN) { E(acc, cur, wr, wc, fr, fq); S.done(cur); }
        if (!has_next) break;
#pragma unroll
        for (int a = 0; a < 2; ++a)
#pragma unroll
            for (int b = 0; b < 2; ++b)
#pragma unroll
                for (int m = 0; m < 4; ++m)
#pragma unroll
                    for (int n = 0; n < 2; ++n) acc[a][b][m][n] = (f32x4){0.f, 0.f, 0.f, 0.f};
        cur = nxt; cA = nA; cB = nB; ++ui;
        if constexpr (ALIGN_EPI) { if (wr == 1) PG8_BAR; }
    }
    PG8_WAIT_V(0);
    if constexpr (!ALIGN_EPI) { if (wr == 0) PG8_BAR; }
    PG8_BAR;
    if constexpr (Epi::AFTER_DRAIN) { E.fused(acc, cur, wr, wc, fr, fq, lds, wid, lane); S.done(cur); }
#undef PG8_SA
#undef PG8_SB
#undef PG8_STAGE
#undef PG8_LDA
#undef PG8_LDB
#undef PG8_MMA
#undef PG8_WAIT_V
#undef PG8_WAIT_L
#undef PG8_BAR
#undef PG8_SCHED
}
}

constexpr int NWAVES = 8;
constexpr int NB = 2, SEQ = 8192, DM = 1024, MR = NB * SEQ;
constexpr int NMETA = 16, INW = 7688, NPROJ = 7680;
constexpr int AH = 8, ADH = 64, AWID = 512, KROWS = SEQ + 128;
constexpr int HH = 8, HK = 128, HV = 128, HROWS = SEQ + 64, NCH = 129;
constexpr int NE = 32, EFF = 512, APAD = 40960;
constexpr float EPS = 1e-6f;
constexpr int N_LAUNCHES = MK_N_LAUNCHES;
constexpr int NPHASE = 12;

constexpr size_t MiB = 1u << 20;
constexpr size_t WS_CTL = 0, CTL_ZERO_BYTES = 1 * MiB;
constexpr size_t WS_WIN = 1 * MiB, WS_WA = 16 * MiB, WS_WH = 17 * MiB, WS_WO = 19 * MiB;
constexpr size_t WS_LFA = 21 * MiB, WS_LFAM = WS_LFA + 512 * 1024, WS_CL = 22 * MiB, WS_ASG = 23 * MiB, WS_GATE = WS_ASG + 128 * 1024, WS_SLOT = WS_GATE + 128 * 1024, WS_TR = 24 * MiB;
constexpr size_t WS_U = 26 * MiB;
constexpr size_t WS_OA = 26 * MiB;
constexpr size_t WS_QA = 58 * MiB, WS_KA = 74 * MiB, WS_VA = 90 * MiB + 512 * 1024;
constexpr size_t WS_QH = 107 * MiB, WS_EB = 139 * MiB, WS_KT = 171 * MiB, WS_KD = 203 * MiB, WS_VH = 235 * MiB + 512 * 1024;
constexpr size_t WS_GH = 268 * MiB, WS_GA = 300 * MiB, WS_GT = 332 * MiB;
constexpr size_t WS_US = 364 * MiB;
constexpr size_t WS_OH = 429 * MiB;
constexpr size_t WS_YA = 107 * MiB;
constexpr size_t WS_MIX = 171 * MiB;
constexpr size_t WS_XN = 26 * MiB, WS_WE1 = 58 * MiB, WS_WE2 = 122 * MiB, WS_XS = 154 * MiB, WS_ACT = 234 * MiB, WS_Y = 274 * MiB;
constexpr size_t WS_END = 461 * MiB;
static_assert(WS_KA + (size_t)2 * KROWS * AWID * 2 <= WS_VA && WS_VA + (size_t)2 * KROWS * AWID * 2 <= WS_QH && WS_KD + (size_t)2 * HROWS * DM * 2 <= WS_VH && WS_VH + (size_t)2 * HROWS * DM * 2 <= WS_GH, "ws map");
static_assert(WS_US + (size_t)16 * NCH * HK * HV * 2 <= WS_OH && WS_OH + (size_t)MR * DM * 2 <= WS_END && WS_Y + (size_t)APAD * DM * 2 <= WS_END && WS_XS + (size_t)APAD * DM * 2 <= WS_ACT && WS_ACT + (size_t)APAD * EFF * 2 <= WS_Y, "ws map 2");
constexpr int CW_TMO = 0, CW_CODE = 1;
constexpr int CW_CNT = 1024;
constexpr int CW_NT = 2048;
constexpr int CW_TILEE = 2112;
constexpr int CW_BAR = 4096;

constexpr int RING_OFF = 0, RING_BYTES = 147456;
constexpr int LDSCTL_OFF = RING_BYTES, MISC_OFF = LDSCTL_OFF + 320;
constexpr int LDS_BYTES = 148480;

#define GAS __attribute__((address_space(1)))
#define LAS __attribute__((address_space(3)))
typedef unsigned short bf16;
typedef unsigned v4u __attribute__((ext_vector_type(4)));
typedef unsigned v2u __attribute__((ext_vector_type(2)));
typedef float f32x4 __attribute__((ext_vector_type(4)));
typedef short bf16x8 __attribute__((ext_vector_type(8)));
typedef GAS unsigned gu32;
typedef GAS unsigned long long gu64;
#define RLX_AGENT __ATOMIC_RELAXED, __HIP_MEMORY_SCOPE_AGENT
#define LDS_WAIT() asm volatile("s_waitcnt lgkmcnt(0)" ::: "memory")
#define VM_WAIT() asm volatile("s_waitcnt vmcnt(0)" ::: "memory")
__device__ __forceinline__ unsigned f2bf(float f) { unsigned u = __builtin_bit_cast(unsigned, f); return (u + 0x7fffu + ((u >> 16) & 1u)) >> 16; }
__device__ __forceinline__ unsigned pk2(float lo, float hi) { return f2bf(lo) | (f2bf(hi) << 16); }
__device__ __forceinline__ float bf2f(unsigned short h) { return __builtin_bit_cast(float, (unsigned)h << 16); }
__device__ __forceinline__ float blo(unsigned w) { return __builtin_bit_cast(float, w << 16); }
__device__ __forceinline__ float bhi(unsigned w) { return __builtin_bit_cast(float, w & 0xffff0000u); }
__device__ __forceinline__ float ex2(float x) { return __builtin_amdgcn_exp2f(x); }
__device__ __forceinline__ float sigm(float x) { return __builtin_amdgcn_rcpf(1.0f + ex2(-1.4426950408889634f * x)); }
__device__ __forceinline__ unsigned ald(const unsigned* p) { return __hip_atomic_load(p, __ATOMIC_RELAXED, __HIP_MEMORY_SCOPE_AGENT); }
__device__ __forceinline__ float aldf(const float* p) { return __builtin_bit_cast(float, __hip_atomic_load((const unsigned*)p, __ATOMIC_RELAXED, __HIP_MEMORY_SCOPE_AGENT)); }
__device__ __forceinline__ float log_sigmoid(float z) { const float a = fabsf(z); return fminf(z, 0.f) - __logf(1.0f + __expf(-a)); }

namespace attn_body {
using bf16=__hip_bfloat16;
using bf16x8=__attribute__((ext_vector_type(8)))short;
using s16x4=__attribute__((ext_vector_type(4)))short;
using f32x16=__attribute__((ext_vector_type(16)))float;
using u32x4=__attribute__((ext_vector_type(4)))unsigned;
using f32x4g=__attribute__((ext_vector_type(4)))float;
constexpr int BATCH=2,NHEAD=8,SEQ=8192,D=64,DM=NHEAD*D;
constexpr int KFRONT=128,KSEQ=SEQ+KFRONT;
constexpr int NW=8,QBLK=32,QB=QBLK*NW,KVBLK=64,NQB=SEQ/QB;
constexpr int ATTN_PITCH=DM, ATTN_UNIT_ROWS=QB;
__device__ __forceinline__ int crow(int r,int hi){return (r&3)+8*(r>>2)+4*hi;}
#define SBAR() __builtin_amdgcn_sched_barrier(0)
__device__ __forceinline__ void cmask(f32x16&p0,f32x16&p1,int jb,int qrel,int hi){
  const float NEG=-INFINITY; int kb=64*jb+4*hi;
  #pragma unroll
  for(int r=0;r<16;++r){int kv=kb+(r&3)+8*(r>>2); if(kv>qrel)p0[r]=NEG; if(kv+32>qrel)p1[r]=NEG;}
}

constexpr int NSLOT=3, SLOTB=8192;
constexpr int LDS_K=0, LDS_V=NSLOT*SLOTB, LDS_WS=2*NSLOT*SLOTB, LDS_OST=LDS_WS+NW*64*4, LDS_CLK=LDS_OST+NW*4096, LDS_BYTES=LDS_CLK+KSEQ*4;
constexpr float C2=0.125f*1.4426950408889634f;
__device__ __forceinline__ void glds16(const void*gsrc,unsigned lds_dst){unsigned keep;
  asm volatile("s_mov_b32 %0, m0\n\ts_mov_b32 m0, %2\n\ts_nop 0\n\tglobal_load_lds_dwordx4 %1, off\n\ts_mov_b32 m0, %0":"=&s"(keep):"v"(gsrc),"s"(lds_dst):"memory");}
__device__ __forceinline__ float max3f(float a,float b,float c){float r;asm("v_max3_f32 %0, %1, %2, %3":"=v"(r):"v"(a),"v"(b),"v"(c));return r;}
__device__ __forceinline__ float max2f(float a,float b){float r;asm("v_max_f32_e32 %0, %1, %2":"=v"(r):"v"(a),"v"(b));return r;}
__device__ __forceinline__ float fadd_s(float a,float b){float r;asm("v_add_f32_e32 %0, %1, %2":"=v"(r):"v"(a),"v"(b));return r;}
__device__ __forceinline__ float fsub_s(float a,float b){float r;asm("v_sub_f32_e32 %0, %1, %2":"=v"(r):"v"(a),"v"(b));return r;}
typedef float f32x2_t __attribute__((ext_vector_type(2))); typedef __bf16 bf16x2_t __attribute__((ext_vector_type(2)));
__device__ __forceinline__ unsigned cvtpk_s(float lo,float hi){f32x2_t v={lo,hi};bf16x2_t b=__builtin_convertvector(v,bf16x2_t);return __builtin_bit_cast(unsigned,b);}
#define WAIT_BAR(N) asm volatile("s_waitcnt vmcnt(" #N ") lgkmcnt(0)\n\ts_barrier":::"memory")

__device__ __forceinline__ void qkt(f32x16&p0,f32x16&p1,const char*Kslot,const bf16x8*qr,int r32,int hi){
  const char*kb=Kslot+hi*1024+r32*16;
  #pragma unroll
  for(int d0=0;d0<4;++d0){
    const bf16x8 b0=*reinterpret_cast<const bf16x8*>(kb+d0*2048);
    const bf16x8 b1=*reinterpret_cast<const bf16x8*>(kb+d0*2048+512);
    p0=__builtin_amdgcn_mfma_f32_32x32x16_bf16(b0,qr[d0],p0,0,0,0);p1=__builtin_amdgcn_mfma_f32_32x32x16_bf16(b1,qr[d0],p1,0,0,0);}
}
typedef __attribute__((address_space(3))) const char* lds_cptr;
typedef short v4i16_t __attribute__((ext_vector_type(4)));
__device__ __forceinline__ void kload8(bf16x8*kf,lds_cptr kp){
  kf[0]=*(const __attribute__((address_space(3))) bf16x8*)(kp);      kf[1]=*(const __attribute__((address_space(3))) bf16x8*)(kp+512);
  kf[2]=*(const __attribute__((address_space(3))) bf16x8*)(kp+2048); kf[3]=*(const __attribute__((address_space(3))) bf16x8*)(kp+2560);
  kf[4]=*(const __attribute__((address_space(3))) bf16x8*)(kp+4096); kf[5]=*(const __attribute__((address_space(3))) bf16x8*)(kp+4608);
  kf[6]=*(const __attribute__((address_space(3))) bf16x8*)(kp+6144); kf[7]=*(const __attribute__((address_space(3))) bf16x8*)(kp+6656);
}
__device__ __forceinline__ void kload2(bf16x8*kf,lds_cptr kp,int j){ kf[2*j]=*(const __attribute__((address_space(3))) bf16x8*)(kp+j*2048); kf[2*j+1]=*(const __attribute__((address_space(3))) bf16x8*)(kp+j*2048+512); }
__device__ __forceinline__ s16x4 vtr(lds_cptr p){ return __builtin_bit_cast(s16x4,__builtin_amdgcn_ds_read_tr16_b64_v4i16((__attribute__((address_space(3))) v4i16_t*)p)); }
__device__ __forceinline__ float rowmax(const f32x16&p0,const f32x16&p1){
  float a=max3f(p0[0],p0[1],p1[0]),b=max3f(p0[2],p0[3],p1[1]);a=max3f(a,p1[2],p1[3]);
  #pragma unroll
  for(int r=4;r<16;r+=4){a=max3f(a,p0[r],p0[r+1]);b=max3f(b,p0[r+2],p0[r+3]);a=max3f(a,p1[r],p1[r+1]);b=max3f(b,p1[r+2],p1[r+3]);}
  const float m=max2f(a,b);
  auto rr=__builtin_amdgcn_permlane32_swap(__float_as_uint(m),__float_as_uint(m),false,false);
  return max2f(__uint_as_float(rr[0]),__uint_as_float(rr[1]));
}
__device__ __forceinline__ void pv(f32x16*o,int vb,bf16x8 pa0,bf16x8 pa1,bf16x8 pa2,bf16x8 pa3){
  #pragma unroll
  for(int d0=0;d0<2;++d0){s16x4 lo[4],hi[4];
    #pragma unroll
    for(int ks=0;ks<4;++ks){
      asm volatile("ds_read_b64_tr_b16 %0,%1 offset:%c2":"=&v"(lo[ks]):"v"(vb),"i"(d0*4096+ks*1024):"memory");
      asm volatile("ds_read_b64_tr_b16 %0,%1 offset:%c2":"=&v"(hi[ks]):"v"(vb),"i"(d0*4096+ks*1024+512):"memory");}
    asm volatile("s_waitcnt lgkmcnt(0)":::"memory");SBAR();
    #define PK(k) (bf16x8){lo[k][0],lo[k][1],lo[k][2],lo[k][3],hi[k][0],hi[k][1],hi[k][2],hi[k][3]}
    o[d0]=__builtin_amdgcn_mfma_f32_32x32x16_bf16(pa0,PK(0),o[d0],0,0,0);
    o[d0]=__builtin_amdgcn_mfma_f32_32x32x16_bf16(pa1,PK(1),o[d0],0,0,0);
    o[d0]=__builtin_amdgcn_mfma_f32_32x32x16_bf16(pa2,PK(2),o[d0],0,0,0);
    o[d0]=__builtin_amdgcn_mfma_f32_32x32x16_bf16(pa3,PK(3),o[d0],0,0,0);
    #undef PK
  }
}

#ifndef ATTN_STORE16
#define ATTN_STORE16(p,v) (*(u32x4*)(p)=(v))
#endif
template<int THRL> __device__ __forceinline__ void attn_unit(int b,int h,int qb,const bf16*Q,const bf16*__restrict__ K,const bf16*__restrict__ V,bf16*O,const float*CLg,char*shm){
  int tid_l=threadIdx.x; asm volatile("":"+v"(tid_l)); const int tid=tid_l,lane=tid&63,r32=lane&31,hi=lane>>5; const int wid=__builtin_amdgcn_readfirstlane(tid>>6);
  const long rowbase=(long)b*SEQ; const int q0=qb*QB;
  const bf16*Qw=Q+(rowbase+q0+wid*QBLK)*DM+h*D;
  const bf16*Kh=K+(long)b*KSEQ*DM+h*D,*Vh=V+(long)b*KSEQ*DM+h*D;
  const unsigned lds0=(unsigned)(uintptr_t)shm;
  float*wsf=(float*)(shm+LDS_WS)+wid*64;
  const bf16*ksrc=Kh+(long)lane*DM+wid*8;
  const bf16*vsrc=Vh+(long)(16*(wid&3)+(lane>>2))*DM+(wid>>2)*32+(lane&3)*8;
  const unsigned kdst=lds0+LDS_K+wid*1024, vdst=lds0+LDS_V+wid*1024;
  #define DMA_K(t,slot) glds16(ksrc+(long)(t)*KVBLK*DM,(unsigned)__builtin_amdgcn_readfirstlane(kdst+(slot)))
  #define DMA_V(t,slot) glds16(vsrc+(long)(t)*KVBLK*DM,(unsigned)__builtin_amdgcn_readfirstlane(vdst+(slot)))
  const int vb0=(int)(lds0+LDS_V)+((lane>>4)&1)*32+(lane&3)*8+(4*hi+((lane&15)>>2))*64;
  const char*Kbase=shm+LDS_K; bf16x8 kf[8];
  const lds_cptr shm3=(lds_cptr)shm; const lds_cptr kp0=shm3+LDS_K+hi*1024+r32*16; const lds_cptr vp0=shm3+LDS_V+((lane>>4)&1)*32+(lane&3)*8+(4*hi+((lane&15)>>2))*64;
  const int NT=(KFRONT+q0+QB)/KVBLK;
  DMA_K(0,0);DMA_V(0,0);DMA_K(1,SLOTB);
  bf16x8 qr[4];
  #pragma unroll
  for(int d0=0;d0<4;++d0)qr[d0]=*reinterpret_cast<const bf16x8*>(&Qw[(long)r32*DM+d0*16+hi*8]);
  { const f32x4g*src=(const f32x4g*)CLg; __attribute__((address_space(3))) f32x4g*dst=(__attribute__((address_space(3))) f32x4g*)(shm3+LDS_CLK);
    for(int i=tid;i<NT*16;i+=NW*64)dst[i]=src[i]; }
  const float clq=CLg[KFRONT+q0+wid*QBLK+r32];
  const __attribute__((address_space(3))) float*clkp=(const __attribute__((address_space(3))) float*)(shm3+LDS_CLK)+4*hi;
  float mhat=0.f,l_reg=0.f;f32x16 o[2];o[0]=f32x16{};o[1]=f32x16{};
  const int qrel=wid*QBLK+r32;
  #define CMASK(P0,P1,t) do{int jb_=(t)-(NT-4); if(jb_>=0)cmask(P0,P1,jb_,qrel,hi);}while(0)
  #define BRD(X0,X1,tt) do{ const __attribute__((address_space(3))) float*c_=clkp+(tt)*KVBLK; \
    _Pragma("unroll") for(int g_=0;g_<4;++g_){ const f32x4g a_=*(const __attribute__((address_space(3))) f32x4g*)(c_+8*g_), b_=*(const __attribute__((address_space(3))) f32x4g*)(c_+32+8*g_); \
      X0[4*g_]=a_.x;X0[4*g_+1]=a_.y;X0[4*g_+2]=a_.z;X0[4*g_+3]=a_.w; X1[4*g_]=b_.x;X1[4*g_+1]=b_.y;X1[4*g_+2]=b_.z;X1[4*g_+3]=b_.w; } }while(0)
  #define BSUB(X,g,nb) do{ X[4*(g)]=(nb)-X[4*(g)]; X[4*(g)+1]=(nb)-X[4*(g)+1]; X[4*(g)+2]=(nb)-X[4*(g)+2]; X[4*(g)+3]=(nb)-X[4*(g)+3]; }while(0)
  #define BFULL(X0,X1,tt,nb) do{ BRD(X0,X1,tt); _Pragma("unroll") for(int g_=0;g_<4;++g_){ BSUB(X0,g_,nb); BSUB(X1,g_,nb); } }while(0)
  bool resc=false;
  #define START(P0,P1) do{ const float rm=rowmax(P0,P1); resc=false; \
    { const float dl=rm; mhat=fadd_s(mhat,dl); \
      _Pragma("unroll") for(int r=0;r<16;++r){P0[r]=fsub_s(P0[r],dl);P1[r]=fsub_s(P1[r],dl);} } \
    _Pragma("unroll") for(int r=0;r<16;++r)P0[r]=__builtin_amdgcn_exp2f(P0[r]); }while(0)
  #define RESC() do{ if(resc){ asm volatile("s_waitcnt lgkmcnt(0)":::"memory"); \
      _Pragma("unroll") for(int d_=0;d_<2;++d_) _Pragma("unroll") for(int r=0;r<16;++r)o[d_][r]*=wsf[crow(r,hi)]; } }while(0)
  f32x16 pA0,pA1,pB0,pB1;
  int sl_prev=0,sl_cur=0,sl_next=SLOTB;
  #define ROT() do{sl_prev=sl_cur;sl_cur=sl_next;sl_next=(sl_next==(NSLOT-1)*SLOTB)?0:sl_next+SLOTB;}while(0)
  DMA_K(2,2*SLOTB);
  WAIT_BAR(3);
  BFULL(pA0,pA1,0,clq);
  qkt(pA0,pA1,Kbase,qr,r32,hi);asm volatile("s_nop 15\n\ts_nop 7":"+v"(pA0),"+v"(pA1));CMASK(pA0,pA1,0);
  START(pA0,pA1);
  { const float nb0_=clq-mhat; BFULL(pB0,pB1,1,nb0_); }
  _Pragma("unroll") for(int r=0;r<16;++r)pA1[r]=__builtin_amdgcn_exp2f(pA1[r]);
  WAIT_BAR(0);
  DMA_K(3,0);DMA_V(1,SLOTB);
  ROT();
  kload8(kf,kp0+sl_cur);
  WAIT_BAR(2);
  s16x4 vlo[8],vhi[8]; u32x4 pw0,pw1,pw2,pw3;
  #define PKW(P,B) cvtpk_s(P[B],P[B+1])
  #define PAF(k) __builtin_bit_cast(bf16x8,pw##k)
  #define VFR(i) (bf16x8){vlo[i][0],vlo[i][1],vlo[i][2],vlo[i][3],vhi[i][0],vhi[i][1],vhi[i][2],vhi[i][3]}
  #define PIN(x) asm volatile("":"+v"(x))
  #define MX3(a,b,c) __builtin_fmaxf(__builtin_fmaxf((a),(b)),(c))
  #define GAPA(MF,A0,A1,A2,A3,W0,W1,PW) do{ MF; sacc+=A0; sacc+=A1; sacc+=A2; sacc+=A3; PIN(sacc); W0; W1; PIN(PW); SBAR(); }while(0)
  #define EX(v) __builtin_amdgcn_exp2f(v)
  #define GAPB(MF,X,B,G,PX,g,OFS) do{ f32x4g c4_; if(G){ c4_=*(const __attribute__((address_space(3))) f32x4g*)(cn_+(OFS)+8*(g)); } MF; X[B]=EX(X[B]); X[B+1]=EX(X[B+1]); X[B+2]=EX(X[B+2]); X[B+3]=EX(X[B+3]); PIN(X); \
    if(G){ PX[4*(g)]=nb_-c4_.x; PX[4*(g)+1]=nb_-c4_.y; PX[4*(g)+2]=nb_-c4_.z; PX[4*(g)+3]=nb_-c4_.w; PIN(PX); } SBAR(); }while(0)
  #define VRD(i) do{ vlo[i]=vtr(vp_+(((i)>>2)*4096+((i)&3)*1024)); vhi[i]=vtr(vp_+(((i)>>2)*4096+((i)&3)*1024+512)); }while(0)
  #define KRD(G,j) do{ if(G){ kload2(kf,kp0+sl_next,j); SBAR(); } }while(0)
  #define STEP(C0,C1,P0,P1,t,GK,GV,GL) do{ SBAR(); \
    const lds_cptr vp_=vp0+sl_prev; \
    VRD(0); SBAR(); float sacc=(P0[0]+P0[1]); \
    GAPA(C0=__builtin_amdgcn_mfma_f32_32x32x16_bf16(kf[0],qr[0],C0,0,0,0), P0[2],P0[3],P0[4],P0[5],     pw0[0]=PKW(P0,0), pw0[1]=PKW(P0,2), pw0); \
    VRD(4); SBAR(); GAPA(C1=__builtin_amdgcn_mfma_f32_32x32x16_bf16(kf[1],qr[0],C1,0,0,0), P0[6],P0[7],P0[8],P0[9],     pw0[2]=PKW(P0,4), pw0[3]=PKW(P0,6), pw0); \
    VRD(1); SBAR(); GAPA(C0=__builtin_amdgcn_mfma_f32_32x32x16_bf16(kf[2],qr[1],C0,0,0,0),   P0[10],P0[11],P0[12],P0[13], pw1[0]=PKW(P0,8), pw1[1]=PKW(P0,10), pw1); \
    VRD(5); SBAR(); GAPA(C1=__builtin_amdgcn_mfma_f32_32x32x16_bf16(kf[3],qr[1],C1,0,0,0),   P0[14],P0[15],P1[0],P1[1],   pw1[2]=PKW(P0,12),pw1[3]=PKW(P0,14), pw1); \
    VRD(2); SBAR(); GAPA(C0=__builtin_amdgcn_mfma_f32_32x32x16_bf16(kf[4],qr[2],C0,0,0,0),   P1[2],P1[3],P1[4],P1[5],     pw2[0]=PKW(P1,0), pw2[1]=PKW(P1,2), pw2); \
    VRD(6); SBAR(); GAPA(C1=__builtin_amdgcn_mfma_f32_32x32x16_bf16(kf[5],qr[2],C1,0,0,0),   P1[6],P1[7],P1[8],P1[9],     pw2[2]=PKW(P1,4), pw2[3]=PKW(P1,6), pw2); \
    VRD(3); SBAR(); GAPA(C0=__builtin_amdgcn_mfma_f32_32x32x16_bf16(kf[6],qr[3],C0,0,0,0),   P1[10],P1[11],P1[12],P1[13], pw3[0]=PKW(P1,8), pw3[1]=PKW(P1,10), pw3); \
    VRD(7); SBAR(); GAPA(C1=__builtin_amdgcn_mfma_f32_32x32x16_bf16(kf[7],qr[3],C1,0,0,0),   P1[14],P1[15],0.f,0.f,       pw3[2]=PKW(P1,12),pw3[3]=PKW(P1,14), pw3); \
    l_reg+=sacc; \
    if(GK){DMA_K((t)+3,sl_cur);} if(GV){DMA_V((t)+1,sl_next);} \
    CMASK(C0,C1,t); \
    { float a=MX3(C0[0],C0[1],C1[0]),b=MX3(C0[2],C0[3],C1[1]); a=MX3(a,C1[2],C1[3]); \
      _Pragma("unroll") for(int r=4;r<16;r+=4){a=MX3(a,C0[r],C0[r+1]);b=MX3(b,C0[r+2],C0[r+3]);a=MX3(a,C1[r],C1[r+1]);b=MX3(b,C1[r+2],C1[r+3]);} \
      float rm=__builtin_fmaxf(a,b); { auto rr=__builtin_amdgcn_permlane32_swap(__float_as_uint(rm),__float_as_uint(rm),false,false); rm=__builtin_fmaxf(__uint_as_float(rr[0]),__uint_as_float(rr[1])); } \
      resc=false; \
      if(__builtin_expect(__any(rm>(float)THRL),0)){ const float dl=__builtin_fmaxf(rm,0.f); mhat+=dl; \
        _Pragma("unroll") for(int r=0;r<16;++r){C0[r]-=dl;C1[r]-=dl;} \
        const float f=__builtin_amdgcn_exp2f(-dl); l_reg*=f; if(hi==0)wsf[r32]=f; resc=true; } } \
    const float nb_=clq-mhat; const __attribute__((address_space(3))) float*cn_=clkp+((t)+1)*KVBLK; \
    SBAR(); \
    GAPB(o[0]=__builtin_amdgcn_mfma_f32_32x32x16_bf16(PAF(0),VFR(0),o[0],0,0,0), C0,0,GL,P0,0,0); \
    GAPB(o[1]=__builtin_amdgcn_mfma_f32_32x32x16_bf16(PAF(0),VFR(4),o[1],0,0,0), C0,4,GL,P0,1,0); \
    KRD(GL,0); GAPB(o[0]=__builtin_amdgcn_mfma_f32_32x32x16_bf16(PAF(1),VFR(1),o[0],0,0,0), C0,8,GL,P0,2,0); \
    KRD(GL,1); GAPB(o[1]=__builtin_amdgcn_mfma_f32_32x32x16_bf16(PAF(1),VFR(5),o[1],0,0,0), C0,12,GL,P0,3,0); \
    KRD(GL,2); GAPB(o[0]=__builtin_amdgcn_mfma_f32_32x32x16_bf16(PAF(2),VFR(2),o[0],0,0,0), C1,0,GL,P1,0,32); \
    KRD(GL,3); GAPB(o[1]=__builtin_amdgcn_mfma_f32_32x32x16_bf16(PAF(2),VFR(6),o[1],0,0,0), C1,4,GL,P1,1,32); \
    GAPB(o[0]=__builtin_amdgcn_mfma_f32_32x32x16_bf16(PAF(3),VFR(3),o[0],0,0,0), C1,8,GL,P1,2,32); \
    GAPB(o[1]=__builtin_amdgcn_mfma_f32_32x32x16_bf16(PAF(3),VFR(7),o[1],0,0,0), C1,12,GL,P1,3,32); \
    }while(0)
  int t=1;
  #undef CMASK
  #define CMASK(P0,P1,t) do{}while(0)
  for(;t+5<NT;t+=2){
    STEP(pB0,pB1,pA0,pA1,t,true,true,true);     WAIT_BAR(2); RESC(); ROT();
    STEP(pA0,pA1,pB0,pB1,t+1,true,true,true);   WAIT_BAR(2); RESC(); ROT();
  }
  #undef CMASK
  #define CMASK(P0,P1,t) do{int jb_=(t)-(NT-4); if(jb_>=0)cmask(P0,P1,jb_,qrel,hi);}while(0)
  #define ENDW(tt) do{ if((tt)+3<NT){WAIT_BAR(2);} else if((tt)+2<NT){WAIT_BAR(1);} else {WAIT_BAR(0);} }while(0)
  for(;t+1<NT;t+=2){
    STEP(pB0,pB1,pA0,pA1,t,(t+3<NT),(t+1<NT),(t+1<NT));       ENDW(t);   RESC(); ROT();
    STEP(pA0,pA1,pB0,pB1,t+1,(t+4<NT),(t+2<NT),(t+2<NT));     ENDW(t+1); RESC(); ROT();
  }
  STEP(pB0,pB1,pA0,pA1,NT-1,false,false,false); RESC();
  { float sacc=pB0[0]+pB0[1]; _Pragma("unroll") for(int r=2;r<16;++r)sacc+=pB0[r]; _Pragma("unroll") for(int r=0;r<16;++r)sacc+=pB1[r]; l_reg+=sacc;
    pw0=(u32x4){PKW(pB0,0),PKW(pB0,2),PKW(pB0,4),PKW(pB0,6)};pw1=(u32x4){PKW(pB0,8),PKW(pB0,10),PKW(pB0,12),PKW(pB0,14)};pw2=(u32x4){PKW(pB1,0),PKW(pB1,2),PKW(pB1,4),PKW(pB1,6)};pw3=(u32x4){PKW(pB1,8),PKW(pB1,10),PKW(pB1,12),PKW(pB1,14)};
    SBAR(); pv(o,vb0+sl_cur,PAF(0),PAF(1),PAF(2),PAF(3)); }
  #undef PKW
  #undef PAF
  #undef VFR
  #undef PIN
  #undef MX3
  #undef GAPA
  #undef GAPB
  #undef EX
  #undef VRD
  #undef KRD
  #undef STEP
  #undef ENDW
  {auto rr=__builtin_amdgcn_permlane32_swap(__float_as_uint(l_reg),__float_as_uint(l_reg),false,false);l_reg=__uint_as_float(rr[0])+__uint_as_float(rr[1]);}
  if(hi==0)wsf[32+r32]=l_reg;asm volatile("s_waitcnt lgkmcnt(0)":::"memory");
  float rli[16];
  #pragma unroll
  for(int r=0;r<16;++r)rli[r]=__builtin_amdgcn_rcpf(wsf[32+crow(r,hi)]);
  bf16*Ow=O+(rowbase+q0+wid*QBLK)*DM+h*D;
  { bf16*stg=(bf16*)(shm+LDS_OST)+wid*2048;
    #pragma unroll
    for(int r=0;r<16;++r){const int orow=crow(r,hi);
      #pragma unroll
      for(int d0=0;d0<2;++d0)stg[orow*64+d0*32+r32]=__float2bfloat16(o[d0][r]*rli[r]);}
    asm volatile("s_waitcnt lgkmcnt(0)":::"memory");
    #pragma unroll
    for(int i=0;i<4;++i){const int row=i*8+(lane>>3),ch=lane&7; const u32x4 v=*(const u32x4*)(stg+row*64+ch*8); ATTN_STORE16(Ow+(long)row*DM+ch*8,v);} }
  asm volatile("s_waitcnt lgkmcnt(0)\n\ts_barrier":::"memory");
  #undef BRD
  #undef BSUB
  #undef BFULL
  #undef DMA_K
  #undef DMA_V
  #undef CMASK
  #undef START
  #undef RESC
  #undef ROT
}
constexpr int ATTN_LDS_BYTES=LDS_BYTES;
#undef SBAR
#undef WAIT_BAR
}
namespace hg {
using attn_body::bf16x8; using attn_body::s16x4; using attn_body::f32x16; using attn_body::u32x4; using attn_body::lds_cptr; using attn_body::vtr; using attn_body::cvtpk_s;
typedef unsigned short us16;
typedef unsigned u32x2h __attribute__((ext_vector_type(2)));
#define HLAS __attribute__((address_space(3)))
constexpr int RS = 272;
constexpr int HC_QE = 0, HC_KT = 64 * RS, HC_V = 2 * 64 * RS, HC_ST = HC_V + 16384, HC_PS = HC_ST + 128 * RS, HC_END = HC_PS + 1024;
__device__ __forceinline__ float blo_(unsigned w) { return __builtin_bit_cast(float, w << 16); }
__device__ __forceinline__ float bhi_(unsigned w) { return __builtin_bit_cast(float, w & 0xffff0000u); }
__device__ __forceinline__ bf16x8 trfrag(lds_cptr blk, int s0, int lane) {
    const int hh = lane >> 5; const lds_cptr p = blk + ((lane >> 4) & 1) * 32 + (lane & 3) * 8 + (s0 + 4 * hh + ((lane & 15) >> 2)) * 64;
    const s16x4 lo = vtr(p), hi = vtr(p + 512);
    return (bf16x8){lo[0], lo[1], lo[2], lo[3], hi[0], hi[1], hi[2], hi[3]};
}
__device__ __forceinline__ void hgrn_a(int item, const us16* KD, const us16* VH, us16* UST, HLAS unsigned char* lds) {
    int tid_l = threadIdx.x; asm volatile("" : "+v"(tid_l)); const int tid = tid_l, lane = tid & 63, wid = __builtin_amdgcn_readfirstlane(tid >> 6), hh = lane >> 5;
    const int bh = item / 129, c = item % 129, b = bh >> 3, h = bh & 7;
    const lds_cptr KDi = (lds_cptr)lds, Vi = (lds_cptr)lds + 16384;
    __syncthreads();
    { const int r = tid >> 3, cc = (tid & 7) * 16; const size_t g = ((size_t)b * 8256 + 64 * c + r) * 1024 + h * 128 + cc;
#pragma unroll
      for (int q2 = 0; q2 < 2; ++q2) { const int off = (cc >> 5) * 4096 + r * 64 + ((cc & 31) + 8 * q2) * 2;
          *(HLAS u32x4*)(lds + off) = *(const u32x4*)(KD + g + 8 * q2); *(HLAS u32x4*)(lds + 16384 + off) = *(const u32x4*)(VH + g + 8 * q2); } }
    __syncthreads();
    const int kt = wid >> 1, vt0 = (wid & 1) * 2;
    f32x16 acc0 = {}, acc1 = {};
#pragma unroll
    for (int ks = 0; ks < 4; ++ks) {
        const bf16x8 a = trfrag(KDi + kt * 4096, 16 * ks, lane), b0 = trfrag(Vi + vt0 * 4096, 16 * ks, lane), b1 = trfrag(Vi + (vt0 + 1) * 4096, 16 * ks, lane);
        acc0 = __builtin_amdgcn_mfma_f32_32x32x16_bf16(a, b0, acc0, 0, 0, 0); acc1 = __builtin_amdgcn_mfma_f32_32x32x16_bf16(a, b1, acc1, 0, 0, 0);
    }
    us16* dst = UST + (size_t)item * 16384 + (size_t)(32 * vt0 + (lane & 31)) * 128 + 32 * kt + 4 * hh;
#pragma unroll
    for (int g = 0; g < 4; ++g) {
        u32x2h w; w.x = cvtpk_s(acc0[4 * g], acc0[4 * g + 1]); w.y = cvtpk_s(acc0[4 * g + 2], acc0[4 * g + 3]); *(u32x2h*)(dst + 8 * g) = w;
        w.x = cvtpk_s(acc1[4 * g], acc1[4 * g + 1]); w.y = cvtpk_s(acc1[4 * g + 2], acc1[4 * g + 3]); *(u32x2h*)(dst + 32 * 128 + 8 * g) = w;
    }
}
__device__ __forceinline__ void hgrn_c(int item, const us16* QH, const us16* EB, const us16* KT, const us16* VH, const us16* GH, const us16* UST, us16* OH, const float* hnw, float eps, HLAS unsigned char* lds) {
    int tid_l = threadIdx.x; asm volatile("" : "+v"(tid_l)); const int tid = tid_l, lane = tid & 63, wid = __builtin_amdgcn_readfirstlane(tid >> 6), hh = lane >> 5, r32 = lane & 31;
    const int bh = item >> 7, c = (item & 127) + 1, b = bh >> 3, h = bh & 7;
    const size_t r0 = (size_t)b * 8192 + 64 * (c - 1);
    const lds_cptr L = (lds_cptr)lds;
    __syncthreads();
    { const int r = tid >> 3, cc = (tid & 7) * 16; const size_t g = (r0 + r) * 1024 + h * 128 + cc, gv = ((size_t)b * 8256 + 64 * c + r) * 1024 + h * 128 + cc;
#pragma unroll
      for (int q2 = 0; q2 < 2; ++q2) {
          const u32x4 a = *(const u32x4*)(QH + g + 8 * q2), e = *(const u32x4*)(EB + g + 8 * q2);
          u32x4 w; w.x = cvtpk_s(blo_(a.x) * blo_(e.x), bhi_(a.x) * bhi_(e.x)); w.y = cvtpk_s(blo_(a.y) * blo_(e.y), bhi_(a.y) * bhi_(e.y));
          w.z = cvtpk_s(blo_(a.z) * blo_(e.z), bhi_(a.z) * bhi_(e.z)); w.w = cvtpk_s(blo_(a.w) * blo_(e.w), bhi_(a.w) * bhi_(e.w));
          *(HLAS u32x4*)(lds + HC_QE + r * RS + (cc + 8 * q2) * 2) = w;
          *(HLAS u32x4*)(lds + HC_KT + r * RS + (cc + 8 * q2) * 2) = *(const u32x4*)(KT + g + 8 * q2);
          *(HLAS u32x4*)(lds + HC_V + (cc >> 5) * 4096 + r * 64 + ((cc & 31) + 8 * q2) * 2) = *(const u32x4*)(VH + gv + 8 * q2); }
      const us16* sp = UST + ((size_t)bh * 129 + (c - 1)) * 16384;
#pragma unroll
      for (int i = 0; i < 4; ++i) { const int p = tid + 512 * i, row = p >> 4, ch = p & 15; *(HLAS u32x4*)(lds + HC_ST + row * RS + ch * 16) = *(const u32x4*)(sp + row * 128 + ch * 8); } }
    __syncthreads();
    const int tt = wid >> 2, vt = wid & 3;
    f32x16 o = {};
    const lds_cptr qrow = L + HC_QE + (32 * tt + r32) * RS + 16 * hh;
#pragma unroll
    for (int st = 0; st < 2; ++st) {
        if (st <= tt) {
            f32x16 p = {};
            const lds_cptr krow = L + HC_KT + (32 * st + r32) * RS + 16 * hh;
#pragma unroll
            for (int ks = 0; ks < 8; ++ks) { const bf16x8 a = *(const HLAS bf16x8*)(krow + 32 * ks), q = *(const HLAS bf16x8*)(qrow + 32 * ks); p = __builtin_amdgcn_mfma_f32_32x32x16_bf16(a, q, p, 0, 0, 0); }
            if (st == tt) {
#pragma unroll
                for (int r = 0; r < 16; ++r) { const int s = (r & 3) + 8 * (r >> 2) + 4 * hh; if (s > r32) p[r] = 0.f; }
            }
            u32x4 pw0, pw1;
            pw0.x = cvtpk_s(p[0], p[1]); pw0.y = cvtpk_s(p[2], p[3]); pw0.z = cvtpk_s(p[4], p[5]); pw0.w = cvtpk_s(p[6], p[7]);
            pw1.x = cvtpk_s(p[8], p[9]); pw1.y = cvtpk_s(p[10], p[11]); pw1.z = cvtpk_s(p[12], p[13]); pw1.w = cvtpk_s(p[14], p[15]);
            const bf16x8 v0 = trfrag(L + HC_V + vt * 4096, 32 * st, lane), v1 = trfrag(L + HC_V + vt * 4096, 32 * st + 16, lane);
            o = __builtin_amdgcn_mfma_f32_32x32x16_bf16(__builtin_bit_cast(bf16x8, pw0), v0, o, 0, 0, 0);
            o = __builtin_amdgcn_mfma_f32_32x32x16_bf16(__builtin_bit_cast(bf16x8, pw1), v1, o, 0, 0, 0);
        }
    }
    { const lds_cptr srow = L + HC_ST + (32 * vt + r32) * RS + 16 * hh;
#pragma unroll
      for (int ks = 0; ks < 8; ++ks) { const bf16x8 a = *(const HLAS bf16x8*)(qrow + 32 * ks), s = *(const HLAS bf16x8*)(srow + 32 * ks); o = __builtin_amdgcn_mfma_f32_32x32x16_bf16(a, s, o, 0, 0, 0); } }
    float sq[16];
#pragma unroll
    for (int r = 0; r < 16; ++r) { float s = o[r] * o[r]; s += __shfl_xor(s, 1); s += __shfl_xor(s, 2); s += __shfl_xor(s, 4); s += __shfl_xor(s, 8); s += __shfl_xor(s, 16); sq[r] = s; }
    if (r32 == 0) {
#pragma unroll
        for (int r = 0; r < 16; ++r) *(HLAS float*)(lds + HC_PS + ((32 * tt + (r & 3) + 8 * (r >> 2) + 4 * hh) * 4 + vt) * 4) = sq[r];
    }
    __syncthreads();
#pragma unroll
    for (int r = 0; r < 16; ++r) { const int t = 32 * tt + (r & 3) + 8 * (r >> 2) + 4 * hh; const attn_body::f32x4g ps = *(const HLAS attn_body::f32x4g*)(lds + HC_PS + t * 16);
        const float rs = 1.0f / sqrtf(((ps.x + ps.y) + (ps.z + ps.w)) * (1.0f / 128.0f) + eps);
        *(HLAS us16*)(lds + HC_QE + t * RS + (32 * vt + r32) * 2) = (us16)(cvtpk_s(o[r] * rs, 0.f) & 0xffffu); }
    __syncthreads();
    { const int r = tid >> 3, cc = (tid & 7) * 16; const size_t go = (r0 + r) * 1024 + h * 128 + cc;
#pragma unroll
      for (int q2 = 0; q2 < 2; ++q2) {
          const u32x4 y = *(const HLAS u32x4*)(lds + HC_QE + r * RS + (cc + 8 * q2) * 2), g = *(const u32x4*)(GH + go + 8 * q2);
          const attn_body::f32x4g w0 = *(const attn_body::f32x4g*)(hnw + cc + 8 * q2), w1 = *(const attn_body::f32x4g*)(hnw + cc + 8 * q2 + 4);
          u32x4 w; w.x = cvtpk_s(blo_(y.x) * w0.x * blo_(g.x), bhi_(y.x) * w0.y * bhi_(g.x)); w.y = cvtpk_s(blo_(y.y) * w0.z * blo_(g.y), bhi_(y.y) * w0.w * bhi_(g.y));
          w.z = cvtpk_s(blo_(y.z) * w1.x * blo_(g.z), bhi_(y.z) * w1.y * bhi_(g.z)); w.w = cvtpk_s(blo_(y.w) * w1.z * blo_(g.w), bhi_(y.w) * w1.w * bhi_(g.w));
          *(u32x4*)(OH + go + 8 * q2) = w; } }
}
#undef HLAS
}
#define XB_TMO      128
#define XB_XCNT(j)  (256  + 64 * (j))
#define XB_XSUB(j)  (1280 + 64 * (j))
#define XB_XGEN(j)  (2304 + 64 * (j))
#define XB_TOP      3328
#define XB_TOPGEN   3392
#define XCD_BAR_WORDS 3456
#define XB_SPIN_CAP (1u << 18)

__device__ __forceinline__ unsigned xb_ld(unsigned* p)              { return __hip_atomic_load(p, __ATOMIC_RELAXED, __HIP_MEMORY_SCOPE_AGENT); }
__device__ __forceinline__ unsigned xb_add(unsigned* p, unsigned v) { return __hip_atomic_fetch_add(p, v, __ATOMIC_RELAXED, __HIP_MEMORY_SCOPE_AGENT); }
__device__ __forceinline__ unsigned xb_xcc_id() { return (unsigned)__builtin_amdgcn_s_getreg((3 << 11) | 20) & 0xFu; }
#define XB_SPIN(cond, bar) do { unsigned _sp = 0; while (cond) { __builtin_amdgcn_s_sleep(1); \
    if ((++_sp & 255u) == 0u) { if (xb_ld(&(bar)[XB_TMO])) break; if (_sp > XB_SPIN_CAP) { atomicAdd(&(bar)[XB_TMO], 1u); break; } } } } while (0)

struct XcdBarrier {
    unsigned* bar; unsigned x;
    volatile LAS unsigned* st;
};

__device__ __forceinline__ XcdBarrier xcd_barrier_post(unsigned* bar, volatile LAS unsigned* st) {
    XcdBarrier b; b.bar = bar; b.x = xb_xcc_id(); b.st = st;
    if (threadIdx.x == 0) (void)xb_add(&bar[XB_XCNT(b.x)], 1u);
    return b;
}
__device__ __forceinline__ void xcd_barrier_complete(unsigned* bar, unsigned x, unsigned& nloc, unsigned& nx) {
    const unsigned G = gridDim.x * gridDim.y * gridDim.z;
    unsigned sum, cnt, mine, sp = 0u;
    for (;;) {
        sum = 0u; cnt = 0u; mine = 0u;
#pragma unroll
        for (unsigned j = 0; j < 16; ++j) { const unsigned c = xb_ld(&bar[XB_XCNT(j)]); sum += c; cnt += (c > 0u) ? 1u : 0u; mine = (j == x) ? c : mine; }
        if (sum == G) break;
        __builtin_amdgcn_s_sleep(1);
        if ((++sp & 255u) == 0u) { if (xb_ld(&bar[XB_TMO])) break; if (sp > XB_SPIN_CAP) { atomicAdd(&bar[XB_TMO], 1u); break; } }
    }
    nloc = mine > 0u ? mine : 1u; nx = cnt > 0u ? cnt : 1u;
}

__device__ __forceinline__ void xcd_barrier(const XcdBarrier& b) {
    asm volatile("s_waitcnt vmcnt(0)" ::: "memory");
    __syncthreads();
    if (threadIdx.x == 0) {
        unsigned* bar = b.bar;
        __builtin_amdgcn_s_waitcnt(0);
        unsigned nloc = b.st[0], nx = b.st[1];
        if (nloc == 0u) { xcd_barrier_complete(bar, b.x, nloc, nx); b.st[0] = nloc; b.st[1] = nx; }
        const unsigned old = xb_add(&bar[XB_XSUB(b.x)], 1u);
        const unsigned gen = old / nloc;
        if (old + 1u == (gen + 1u) * nloc) {
            __builtin_amdgcn_fence(__ATOMIC_RELEASE, "agent");
            asm volatile("s_waitcnt vmcnt(0)" ::: "memory");
            const unsigned og = xb_add(&bar[XB_TOP], 1u);
            const unsigned tg = og / nx;
            if (og + 1u == (tg + 1u) * nx) xb_add(&bar[XB_TOPGEN], 1u);
            else XB_SPIN(xb_ld(&bar[XB_TOPGEN]) == tg, bar);
            __builtin_amdgcn_fence(__ATOMIC_ACQUIRE, "agent");
            xb_add(&bar[XB_XGEN(b.x)], 1u);
            asm volatile("s_waitcnt vmcnt(0)" ::: "memory");
        } else {
            XB_SPIN(xb_ld(&bar[XB_XGEN(b.x)]) == gen, bar);
            __builtin_amdgcn_fence(__ATOMIC_ACQUIRE, "agent");
            asm volatile("s_waitcnt vmcnt(0)" ::: "memory");
        }
    }
    __syncthreads();
}
struct Frame {
    LAS unsigned char* lds;
    volatile LAS unsigned* MISC;
    gu32* ctl;
    unsigned char* ws;
    int tid, lane, wave;
    int vcu, G;
    const float* in[18];
    float* out;
};
__device__ __forceinline__ float wave_sum(float v) {
#pragma unroll
    for (int o = 1; o < 64; o <<= 1) v += __shfl_xor(v, o);
    return v;
}

__device__ __forceinline__ void p0_transpose_item(const float* W, int ldw, int K, int ncols, bf16* WT, int mode, int row_off, LAS float* scr, int item, int lane) {
    const int nblk = ncols / 32, kb = item / nblk, nb = item % nblk, k0 = 64 * kb, n0 = 32 * nb;
    int d0 = row_off + n0;
    if (mode == 1) { d0 = (n0 < 512) ? (256 * (n0 >> 7) + (n0 & 127)) : (256 * ((n0 - 512) >> 7) + 128 + ((n0 - 512) & 127)); }
#pragma unroll 8
    for (int i = 0; i < 32; ++i) { const int kk = 2 * i + (lane >> 5); scr[kk * 33 + (lane & 31)] = W[(size_t)(k0 + kk) * ldw + n0 + (lane & 31)]; }
    LDS_WAIT(); asm volatile("" ::: "memory");
    const int c = lane & 7;
#pragma unroll
    for (int j = 0; j < 4; ++j) { const int n = (lane >> 3) + 8 * j; const LAS float* s = scr + (8 * c) * 33 + n;
        v4u o; o.x = pk2(s[0 * 33], s[1 * 33]); o.y = pk2(s[2 * 33], s[3 * 33]); o.z = pk2(s[4 * 33], s[5 * 33]); o.w = pk2(s[6 * 33], s[7 * 33]);
        *(GAS v4u*)(WT + (size_t)(d0 + n) * K + k0 + 8 * c) = o; }
    LDS_WAIT(); asm volatile("" ::: "memory");
}

__device__ __forceinline__ void p0_meta(Frame& F) {
    const float* meta = F.in[1]; const float* nw = F.in[2]; const float* Win = F.in[3];
    LAS float* um = (LAS float*)(F.lds + RING_OFF);
    LAS float* part = (LAS float*)(F.lds + RING_OFF + 65536);
#pragma unroll
    for (int rr = 0; rr < 2; ++rr) {
        const int r = 2 * F.wave + rr;
        f32x4 v[4]; float ss = 0.f;
#pragma unroll
        for (int j = 0; j < 4; ++j) { v[j] = *(const f32x4*)(meta + (size_t)r * DM + 4 * F.lane + 256 * j); ss += (v[j].x * v[j].x + v[j].y * v[j].y) + (v[j].z * v[j].z + v[j].w * v[j].w); }
        const float rs = 1.0f / sqrtf(wave_sum(ss) * (1.0f / DM) + EPS);
#pragma unroll
        for (int j = 0; j < 4; ++j) { const f32x4 w = *(const f32x4*)(nw + 4 * F.lane + 256 * j); const int k = 4 * F.lane + 256 * j;
            um[(k + 0) * 16 + r] = v[j].x * rs * w.x; um[(k + 1) * 16 + r] = v[j].y * rs * w.y; um[(k + 2) * 16 + r] = v[j].z * rs * w.z; um[(k + 3) * 16 + r] = v[j].w * rs * w.w; }
    }
    __syncthreads();
    const int item = F.vcu;
    int type, strip;
    if (item < 8) { type = 0; strip = item; } else if (item < 16) { type = 1; strip = item - 8; } else if (item < 32) { type = 2; strip = item - 16; } else if (item < 48) { type = 3; strip = item - 32; } else { type = 4; strip = 0; }
    int col;
    if (type == 0) col = 512 + 64 * strip + F.lane; else if (type == 1) col = 1024 + 64 * strip + F.lane; else if (type == 2) col = 2568 + 64 * strip + F.lane;
    else if (type == 3) col = 3592 + 64 * strip + F.lane; else col = 1536 + (F.lane & 7);
    float acc[16];
#pragma unroll
    for (int r = 0; r < 16; ++r) acc[r] = 0.f;
    const int k0 = 128 * F.wave;
#pragma unroll 1
    for (int kb = 0; kb < 128; kb += 8) {
        float w[8];
#pragma unroll
        for (int i = 0; i < 8; ++i) w[i] = Win[(size_t)(k0 + kb + i) * INW + col];
#pragma unroll
        for (int i = 0; i < 8; ++i) {
            const LAS f32x4* up = (const LAS f32x4*)(um + (k0 + kb + i) * 16);
            const f32x4 u0 = up[0], u1 = up[1], u2 = up[2], u3 = up[3];
            acc[0] += w[i] * u0.x; acc[1] += w[i] * u0.y; acc[2] += w[i] * u0.z; acc[3] += w[i] * u0.w;
            acc[4] += w[i] * u1.x; acc[5] += w[i] * u1.y; acc[6] += w[i] * u1.z; acc[7] += w[i] * u1.w;
            acc[8] += w[i] * u2.x; acc[9] += w[i] * u2.y; acc[10] += w[i] * u2.z; acc[11] += w[i] * u2.w;
            acc[12] += w[i] * u3.x; acc[13] += w[i] * u3.y; acc[14] += w[i] * u3.z; acc[15] += w[i] * u3.w;
        }
    }
#pragma unroll
    for (int r = 0; r < 16; ++r) part[(F.wave * 16 + r) * 64 + F.lane] = acc[r];
    __syncthreads();
    if (F.wave == 0) {
#pragma unroll
        for (int r = 0; r < 16; ++r) { float s = 0.f;
#pragma unroll
            for (int w8 = 0; w8 < 8; ++w8) s += part[(w8 * 16 + r) * 64 + F.lane];
            acc[r] = s; }
        const int c = 64 * strip + F.lane;
        if (type == 0 || type == 1) {
            bf16* dst = (bf16*)(F.ws + (type == 0 ? WS_KA : WS_VA));
#pragma unroll
            for (int b = 0; b < 2; ++b) {
#pragma unroll
                for (int r = 0; r < 16; ++r) dst[((size_t)b * KROWS + r) * AWID + c] = (bf16)f2bf(acc[r]);
                for (int r = 16; r < 128; ++r) dst[((size_t)b * KROWS + r) * AWID + c] = (bf16)0;
            }
        } else if (type == 3) {
            bf16* dst = (bf16*)(F.ws + WS_VH);
#pragma unroll
            for (int b = 0; b < 2; ++b) {
                for (int r = 0; r < 48; ++r) dst[((size_t)b * HROWS + r) * DM + c] = (bf16)0;
#pragma unroll
                for (int r = 0; r < 16; ++r) dst[((size_t)b * HROWS + 48 + r) * DM + c] = (bf16)f2bf(acc[r]);
            }
        } else if (type == 2) {
            const float* lbl = F.in[5];
            const float lb = 1.0f / (1.0f + __expf(lbl[1024 + c] - lbl[c]));
            float kk[16], bb[16]; float run = 0.f;
#pragma unroll
            for (int r = 0; r < 16; ++r) { const float f = lb + (1.0f - lb) * (1.0f / (1.0f + __expf(-acc[r]))); kk[r] = 1.0f - f; run += __logf(f); bb[r] = run; }
            bf16* dst = (bf16*)(F.ws + WS_KD);
#pragma unroll
            for (int b = 0; b < 2; ++b) {
                for (int r = 0; r < 48; ++r) dst[((size_t)b * HROWS + r) * DM + c] = (bf16)0;
#pragma unroll
                for (int r = 0; r < 16; ++r) dst[((size_t)b * HROWS + 48 + r) * DM + c] = (bf16)f2bf(kk[r] * __expf(run - bb[r]));
            }
        } else {
            if (F.lane < 8) { float* lfam = (float*)(F.ws + WS_LFAM); const float bias = F.in[4][F.lane];
#pragma unroll
                for (int r = 0; r < 16; ++r) lfam[r * 8 + F.lane] = log_sigmoid(acc[r] + bias); }
        }
    }
    __syncthreads();
}

__device__ __forceinline__ void p0_rows(Frame& F) {
    const float* x = F.in[0]; const float* nw = F.in[2]; const float* Win = F.in[3]; const float* afb = F.in[4];
    LAS float* wfa = (LAS float*)(F.lds + RING_OFF);
    for (int i = F.tid; i < 8 * DM; i += NWAVES * 64) { const int k = i >> 3, h = i & 7; wfa[h * DM + k] = nw[k] * Win[(size_t)k * INW + 1536 + h]; }
    __syncthreads();
    const int gw = F.vcu * NWAVES + F.wave, NGW = F.G * NWAVES;
    f32x4 wv[4];
#pragma unroll
    for (int j = 0; j < 4; ++j) wv[j] = *(const f32x4*)(nw + 4 * F.lane + 256 * j);
    bf16* U = (bf16*)(F.ws + WS_U); float* lfa = (float*)(F.ws + WS_LFA);
    for (int m = gw; m < MR; m += NGW) {
        f32x4 v[4]; float ss = 0.f;
#pragma unroll
        for (int j = 0; j < 4; ++j) { v[j] = *(const f32x4*)(x + (size_t)m * DM + 4 * F.lane + 256 * j); ss += (v[j].x * v[j].x + v[j].y * v[j].y) + (v[j].z * v[j].z + v[j].w * v[j].w); }
        const float rs = 1.0f / sqrtf(wave_sum(ss) * (1.0f / DM) + EPS);
        GAS unsigned long long* o8 = (GAS unsigned long long*)(U + (size_t)m * DM) + F.lane;
#pragma unroll
        for (int j = 0; j < 4; ++j) { const f32x4 u = v[j] * rs * wv[j]; o8[64 * j] = (unsigned long long)pk2(u.x, u.y) | ((unsigned long long)pk2(u.z, u.w) << 32); }
        float z[8];
#pragma unroll
        for (int h = 0; h < 8; ++h) { float s = 0.f;
#pragma unroll
            for (int j = 0; j < 4; ++j) { const f32x4 w = *(const LAS f32x4*)(wfa + h * DM + 4 * F.lane + 256 * j); s += (v[j].x * w.x + v[j].y * w.y) + (v[j].z * w.z + v[j].w * w.w); }
            z[h] = wave_sum(s); }
        float zz = z[0];
#pragma unroll
        for (int h = 1; h < 8; ++h) zz = (F.lane == h) ? z[h] : zz;
        if (F.lane < 8) lfa[(size_t)m * 8 + F.lane] = log_sigmoid(zz * rs + afb[F.lane]);
    }
    __syncthreads();
}

__device__ __forceinline__ void p0_weights(Frame& F) {
    LAS float* scr = (LAS float*)(F.lds + RING_OFF + F.wave * 16384);
    const int gw = F.vcu * NWAVES + F.wave, NGW = F.G * NWAVES;
    constexpr int I1 = 16 * 48, I2 = 16 * 192, IA = 8 * 32, IH = 16 * 32, IO = 16 * 32;
    constexpr int NIT = I1 + I2 + IA + IH + IO;
    bf16* win = (bf16*)(F.ws + WS_WIN);
    for (int it = gw; it < NIT; it += NGW) {
        int r = it;
        if (r < I1) { p0_transpose_item(F.in[3], INW, DM, 1536, win, 0, 0, scr, r, F.lane); continue; } r -= I1;
        if (r < I2) { p0_transpose_item(F.in[3] + 1544, INW, DM, 6144, win, 0, 1536, scr, r, F.lane); continue; } r -= I2;
        if (r < IA) { p0_transpose_item(F.in[7], DM, AWID, DM, (bf16*)(F.ws + WS_WA), 0, 0, scr, r, F.lane); continue; } r -= IA;
        if (r < IH) { p0_transpose_item(F.in[8], DM, DM, DM, (bf16*)(F.ws + WS_WH), 0, 0, scr, r, F.lane); continue; } r -= IH;
        p0_transpose_item(F.in[9], DM, DM, DM, (bf16*)(F.ws + WS_WO), 0, 0, scr, r, F.lane);
    }
}
__device__ __forceinline__ void p7_expert_weights(Frame& F) {
    LAS float* scr = (LAS float*)(F.lds + RING_OFF + F.wave * 16384);
    const int gw = F.vcu * NWAVES + F.wave, NGW = F.G * NWAVES;
    constexpr int I1 = 16 * 32, I2 = 8 * 32;
    for (int it = gw; it < NE * (I1 + I2); it += NGW) {
        const int e = it / (I1 + I2); int r = it % (I1 + I2);
        if (r < I1) p0_transpose_item(F.in[15] + (size_t)e * DM * DM, DM, DM, DM, (bf16*)(F.ws + WS_WE1) + (size_t)e * DM * DM, 1, 0, scr, r, F.lane);
        else p0_transpose_item(F.in[16] + (size_t)e * EFF * DM, DM, EFF, DM, (bf16*)(F.ws + WS_WE2) + (size_t)e * DM * EFF, 0, 0, scr, r - I1, F.lane);
    }
}

__device__ __forceinline__ void p1_cumsum(Frame& F, int bh) {
    const int b = bh >> 3, h = bh & 7;
    const float* lfa = (const float*)(F.ws + WS_LFA); const float* lfam = (const float*)(F.ws + WS_LFAM); float* cl = (float*)(F.ws + WS_CL) + (size_t)bh * KROWS;
    LAS float* wtot = (LAS float*)(F.lds + RING_OFF);
    float cm = 0.f;
    for (int r = 0; r < 16; ++r) { cm += lfam[r * 8 + h]; if (F.tid == r) cl[r] = cm * 1.4426950408889634f; }
    if (F.tid >= 16 && F.tid < 128) cl[F.tid] = 1e30f;
    float loc[16]; float run = 0.f;
#pragma unroll
    for (int i = 0; i < 16; ++i) { run += lfa[((size_t)b * SEQ + 16 * F.tid + i) * 8 + h]; loc[i] = run; }
    float inc = run;
#pragma unroll
    for (int o = 1; o < 64; o <<= 1) { const float t = __shfl_up(inc, o); if (F.lane >= o) inc += t; }
    if (F.lane == 63) wtot[F.wave] = inc;
    __syncthreads();
    float pre = cm + (inc - run);
    for (int w = 0; w < F.wave; ++w) pre += wtot[w];
#pragma unroll
    for (int i = 0; i < 16; ++i) cl[128 + 16 * F.tid + i] = (pre + loc[i]) * 1.4426950408889634f;
    __syncthreads();
}

__device__ __forceinline__ void attn_simple_unit(Frame& F, int bh, int qb) {
    const int tid = F.tid, row = tid & 255, p = tid >> 8, b = bh >> 3, h = bh & 7;
    const bf16* QA = (const bf16*)(F.ws + WS_QA); const bf16* KA = (const bf16*)(F.ws + WS_KA); const bf16* VA = (const bf16*)(F.ws + WS_VA);
    const float* CL = (const float*)(F.ws + WS_CL) + (size_t)bh * KROWS; bf16* OA = (bf16*)(F.ws + WS_OA);
    LAS bf16* Ks = (LAS bf16*)(F.lds + RING_OFF); LAS bf16* Vs = (LAS bf16*)(F.lds + RING_OFF + 8192);
    LAS float* cks = (LAS float*)(F.lds + RING_OFF + 16384); LAS float* cmb = (LAS float*)(F.lds + RING_OFF + 16640);
    float q[64], o[64];
    const size_t qrow = (size_t)b * SEQ + 256 * qb + row;
#pragma unroll
    for (int c = 0; c < 8; ++c) { const v4u w = *(const v4u*)(QA + qrow * AWID + h * 64 + 8 * c);
        q[8 * c + 0] = blo(w.x); q[8 * c + 1] = bhi(w.x); q[8 * c + 2] = blo(w.y); q[8 * c + 3] = bhi(w.y); q[8 * c + 4] = blo(w.z); q[8 * c + 5] = bhi(w.z); q[8 * c + 6] = blo(w.w); q[8 * c + 7] = bhi(w.w); }
#pragma unroll
    for (int d = 0; d < 64; ++d) o[d] = 0.f;
    const int qp = 128 + 256 * qb + row; const float clq = CL[qp];
    float mx = -1e30f, l = 0.f;
    const int NT = 4 * qb + 6;
    for (int t = 0; t < NT; ++t) {
        if (t == 1) continue;
        __syncthreads();
        { const int r = tid >> 3, ch = tid & 7; const size_t g = ((size_t)b * KROWS + 64 * t + r) * AWID + h * 64 + ch * 8;
          *(LAS v4u*)(Ks + r * 64 + ch * 8) = *(const v4u*)(KA + g); *(LAS v4u*)(Vs + r * 64 + ch * 8) = *(const v4u*)(VA + g);
          if (tid < 64) cks[tid] = CL[64 * t + tid]; }
        __syncthreads();
        const int smax = (t == 0) ? 16 : 64;
        for (int s = p; s < smax; s += 2) {
            const int kp = 64 * t + s;
            if (t >= 2 && kp > qp) continue;
            float dot = 0.f;
#pragma unroll
            for (int c = 0; c < 8; ++c) { const v4u w = *(const LAS v4u*)(Ks + s * 64 + 8 * c);
                dot += q[8 * c + 0] * blo(w.x) + q[8 * c + 1] * bhi(w.x) + q[8 * c + 2] * blo(w.y) + q[8 * c + 3] * bhi(w.y) + q[8 * c + 4] * blo(w.z) + q[8 * c + 5] * bhi(w.z) + q[8 * c + 6] * blo(w.w) + q[8 * c + 7] * bhi(w.w); }
            const float sc = dot + (clq - cks[s]);
            const float mn = fmaxf(mx, sc), al = ex2(mx - mn), pp = ex2(sc - mn);
            l = l * al + pp; mx = mn;
#pragma unroll
            for (int c = 0; c < 8; ++c) { const v4u w = *(const LAS v4u*)(Vs + s * 64 + 8 * c);
                o[8 * c + 0] = o[8 * c + 0] * al + pp * blo(w.x); o[8 * c + 1] = o[8 * c + 1] * al + pp * bhi(w.x); o[8 * c + 2] = o[8 * c + 2] * al + pp * blo(w.y); o[8 * c + 3] = o[8 * c + 3] * al + pp * bhi(w.y);
                o[8 * c + 4] = o[8 * c + 4] * al + pp * blo(w.z); o[8 * c + 5] = o[8 * c + 5] * al + pp * bhi(w.z); o[8 * c + 6] = o[8 * c + 6] * al + pp * blo(w.w); o[8 * c + 7] = o[8 * c + 7] * al + pp * bhi(w.w); }
        }
    }
    __syncthreads();
    if (p == 1) { cmb[row * 66 + 0] = mx; cmb[row * 66 + 1] = l;
#pragma unroll
        for (int d = 0; d < 64; ++d) cmb[row * 66 + 2 + d] = o[d]; }
    __syncthreads();
    if (p == 0) { const float m1 = cmb[row * 66 + 0], l1 = cmb[row * 66 + 1]; const float mn = fmaxf(mx, m1), a0 = ex2(mx - mn), a1 = ex2(m1 - mn); const float inv = 1.0f / (l * a0 + l1 * a1);
#pragma unroll
        for (int c = 0; c < 8; ++c) { float r8[8];
#pragma unroll
            for (int e = 0; e < 8; ++e) r8[e] = (o[8 * c + e] * a0 + cmb[row * 66 + 2 + 8 * c + e] * a1) * inv;
            v4u w; w.x = pk2(r8[0], r8[1]); w.y = pk2(r8[2], r8[3]); w.z = pk2(r8[4], r8[5]); w.w = pk2(r8[6], r8[7]);
            *(v4u*)(OA + qrow * AWID + h * 64 + 8 * c) = w; } }
    __syncthreads();
}

__device__ __forceinline__ void hgrn_a_simple(Frame& F, int item) {
    const int bh = item / NCH, c = item % NCH, b = bh >> 3, h = bh & 7, tid = F.tid;
    const bf16* KD = (const bf16*)(F.ws + WS_KD); const bf16* VH = (const bf16*)(F.ws + WS_VH); bf16* US = (bf16*)(F.ws + WS_US);
    LAS float* KDs = (LAS float*)(F.lds + RING_OFF); LAS float* Vs = KDs + 8192;
    __syncthreads();
    { const int r = tid >> 3, cc = (tid & 7) * 16; const size_t g = ((size_t)b * HROWS + 64 * c + r) * DM + h * 128 + cc;
#pragma unroll
      for (int q2 = 0; q2 < 2; ++q2) { const v4u a = *(const v4u*)(KD + g + 8 * q2), v = *(const v4u*)(VH + g + 8 * q2); LAS float* kd = KDs + r * 128 + cc + 8 * q2; LAS float* vs = Vs + r * 128 + cc + 8 * q2;
          kd[0] = blo(a.x); kd[1] = bhi(a.x); kd[2] = blo(a.y); kd[3] = bhi(a.y); kd[4] = blo(a.z); kd[5] = bhi(a.z); kd[6] = blo(a.w); kd[7] = bhi(a.w);
          vs[0] = blo(v.x); vs[1] = bhi(v.x); vs[2] = blo(v.y); vs[3] = bhi(v.y); vs[4] = blo(v.z); vs[5] = bhi(v.z); vs[6] = blo(v.w); vs[7] = bhi(v.w); } }
    __syncthreads();
    const int k = tid >> 2, vg = (tid & 3) * 32;
    float acc[32];
#pragma unroll
    for (int j = 0; j < 32; ++j) acc[j] = 0.f;
    for (int s = 0; s < 64; ++s) { const float kd = KDs[s * 128 + k];
#pragma unroll
        for (int j4 = 0; j4 < 8; ++j4) { const f32x4 v = *(const LAS f32x4*)(Vs + s * 128 + vg + 4 * j4); acc[4 * j4 + 0] += kd * v.x; acc[4 * j4 + 1] += kd * v.y; acc[4 * j4 + 2] += kd * v.z; acc[4 * j4 + 3] += kd * v.w; } }
    bf16* dst = US + (size_t)item * (HK * HV) + k * 128 + vg;
#pragma unroll
    for (int j8 = 0; j8 < 4; ++j8) { v4u w; w.x = pk2(acc[8 * j8 + 0], acc[8 * j8 + 1]); w.y = pk2(acc[8 * j8 + 2], acc[8 * j8 + 3]); w.z = pk2(acc[8 * j8 + 4], acc[8 * j8 + 5]); w.w = pk2(acc[8 * j8 + 6], acc[8 * j8 + 7]); *(v4u*)(dst + 8 * j8) = w; }
}
__device__ __forceinline__ void hgrn_scan(Frame& F) {
    const bf16* EB = (const bf16*)(F.ws + WS_EB); bf16* US = (bf16*)(F.ws + WS_US);
    for (int idx = blockIdx.x * (NWAVES * 64) + F.tid; idx < 16 * 128 * 64; idx += F.G * NWAVES * 64) {
        const int bh = idx >> 13, rem = idx & 8191, k = rem >> 6, vp = rem & 63, b = bh >> 3, h = bh & 7;
        unsigned* base = (unsigned*)(US + (size_t)bh * NCH * (HK * HV) + k * 128) + vp;
        unsigned w = base[0]; float s0 = blo(w), s1 = bhi(w);
        for (int c = 1; c < NCH - 1; ++c) {
            const float a = bf2f(EB[((size_t)b * SEQ + 64 * (c - 1) + 63) * DM + h * 128 + k]);
            const unsigned uw = base[(size_t)c * (HK * HV / 2)];
            s0 = a * s0 + blo(uw); s1 = a * s1 + bhi(uw);
            base[(size_t)c * (HK * HV / 2)] = pk2(s0, s1);
        }
    }
}
__device__ __forceinline__ void hgrn_scan_t(Frame& F) {
    const bf16* EB = (const bf16*)(F.ws + WS_EB); bf16* US = (bf16*)(F.ws + WS_US);
    for (int idx = blockIdx.x * (NWAVES * 64) + F.tid; idx < 16 * 128 * 64; idx += F.G * NWAVES * 64) {
        const int bh = idx >> 13, rem = idx & 8191, v = rem >> 6, kp = rem & 63, b = bh >> 3, h = bh & 7;
        unsigned* base = (unsigned*)(US + (size_t)bh * NCH * (HK * HV) + v * 128) + kp;
        const unsigned* ap = (const unsigned*)(EB + ((size_t)b * SEQ + 63) * DM + h * 128) + kp;
        unsigned w = base[0]; float s0 = blo(w), s1 = bhi(w);
        for (int c0 = 1; c0 < NCH; c0 += 16) {
            unsigned aw[16], uw[16];
#pragma unroll
            for (int i = 0; i < 16; ++i) { aw[i] = ap[(size_t)(c0 - 1 + i) * 64 * (DM / 2)]; uw[i] = base[(size_t)(c0 + i) * (HK * HV / 2)]; }
#pragma unroll
            for (int i = 0; i < 16; ++i) { s0 = blo(aw[i]) * s0 + blo(uw[i]); s1 = bhi(aw[i]) * s1 + bhi(uw[i]); base[(size_t)(c0 + i) * (HK * HV / 2)] = pk2(s0, s1); }
        }
    }
}
__device__ __forceinline__ void hgrn_c_simple(Frame& F, int item) {
    const int bh = item >> 7, c = (item & 127) + 1, b = bh >> 3, h = bh & 7, tid = F.tid;
    const bf16* QH = (const bf16*)(F.ws + WS_QH); const bf16* EB = (const bf16*)(F.ws + WS_EB); const bf16* KT = (const bf16*)(F.ws + WS_KT); const bf16* VH = (const bf16*)(F.ws + WS_VH);
    const bf16* GH = (const bf16*)(F.ws + WS_GH); const bf16* US = (const bf16*)(F.ws + WS_US); bf16* OH = (bf16*)(F.ws + WS_OH); const float* hnw = F.in[6];
    LAS float* QE = (LAS float*)(F.lds + RING_OFF); LAS float* KTs = QE + 8192; LAS bf16* Ss = (LAS bf16*)(F.lds + RING_OFF + 65536); LAS bf16* Vs = (LAS bf16*)(F.lds + RING_OFF + 98304); LAS float* SC = (LAS float*)(F.lds + RING_OFF + 114688);
    const size_t r0 = (size_t)b * SEQ + 64 * (c - 1);
    __syncthreads();
    { const int r = tid >> 3, cc = (tid & 7) * 16; const size_t g = (r0 + r) * DM + h * 128 + cc; const size_t gv = ((size_t)b * HROWS + 64 * c + r) * DM + h * 128 + cc;
#pragma unroll
      for (int q2 = 0; q2 < 2; ++q2) { const v4u a = *(const v4u*)(QH + g + 8 * q2), e = *(const v4u*)(EB + g + 8 * q2), kt = *(const v4u*)(KT + g + 8 * q2);
          LAS float* qe = QE + r * 128 + cc + 8 * q2; LAS float* ks = KTs + r * 128 + cc + 8 * q2;
          qe[0] = blo(a.x) * blo(e.x); qe[1] = bhi(a.x) * bhi(e.x); qe[2] = blo(a.y) * blo(e.y); qe[3] = bhi(a.y) * bhi(e.y); qe[4] = blo(a.z) * blo(e.z); qe[5] = bhi(a.z) * bhi(e.z); qe[6] = blo(a.w) * blo(e.w); qe[7] = bhi(a.w) * bhi(e.w);
          ks[0] = blo(kt.x); ks[1] = bhi(kt.x); ks[2] = blo(kt.y); ks[3] = bhi(kt.y); ks[4] = blo(kt.z); ks[5] = bhi(kt.z); ks[6] = blo(kt.w); ks[7] = bhi(kt.w);
          *(LAS v4u*)(Vs + r * 128 + cc + 8 * q2) = *(const v4u*)(VH + gv + 8 * q2); }
      const bf16* sp = US + ((size_t)bh * NCH + (c - 1)) * (HK * HV);
#pragma unroll
      for (int i = 0; i < 4; ++i) *(LAS v4u*)(Ss + (tid + 512 * i) * 8) = *(const v4u*)(sp + (tid + 512 * i) * 8); }
    __syncthreads();
    const int t = tid >> 3, g8 = tid & 7;
#pragma unroll
    for (int j = 0; j < 8; ++j) { const int s = g8 * 8 + j; float d = 0.f;
        if (s <= t) { for (int k = 0; k < 128; k += 4) { const f32x4 a = *(const LAS f32x4*)(QE + t * 128 + k), kb = *(const LAS f32x4*)(KTs + s * 128 + k); d += (a.x * kb.x + a.y * kb.y) + (a.z * kb.z + a.w * kb.w); } }
        SC[t * 64 + s] = d; }
    __syncthreads();
    const int v0 = g8 * 16;
    float o[16];
#pragma unroll
    for (int j = 0; j < 16; ++j) o[j] = 0.f;
    for (int s = 0; s <= t; ++s) { const float sc = SC[t * 64 + s]; const v4u w0 = *(const LAS v4u*)(Vs + s * 128 + v0), w1 = *(const LAS v4u*)(Vs + s * 128 + v0 + 8);
        o[0] += sc * blo(w0.x); o[1] += sc * bhi(w0.x); o[2] += sc * blo(w0.y); o[3] += sc * bhi(w0.y); o[4] += sc * blo(w0.z); o[5] += sc * bhi(w0.z); o[6] += sc * blo(w0.w); o[7] += sc * bhi(w0.w);
        o[8] += sc * blo(w1.x); o[9] += sc * bhi(w1.x); o[10] += sc * blo(w1.y); o[11] += sc * bhi(w1.y); o[12] += sc * blo(w1.z); o[13] += sc * bhi(w1.z); o[14] += sc * blo(w1.w); o[15] += sc * bhi(w1.w); }
    for (int k = 0; k < 128; ++k) { const float qe = QE[t * 128 + k]; const v4u w0 = *(const LAS v4u*)(Ss + k * 128 + v0), w1 = *(const LAS v4u*)(Ss + k * 128 + v0 + 8);
        o[0] += qe * blo(w0.x); o[1] += qe * bhi(w0.x); o[2] += qe * blo(w0.y); o[3] += qe * bhi(w0.y); o[4] += qe * blo(w0.z); o[5] += qe * bhi(w0.z); o[6] += qe * blo(w0.w); o[7] += qe * bhi(w0.w);
        o[8] += qe * blo(w1.x); o[9] += qe * bhi(w1.x); o[10] += qe * blo(w1.y); o[11] += qe * bhi(w1.y); o[12] += qe * blo(w1.z); o[13] += qe * bhi(w1.z); o[14] += qe * blo(w1.w); o[15] += qe * bhi(w1.w); }
    float ss = 0.f;
#pragma unroll
    for (int j = 0; j < 16; ++j) ss += o[j] * o[j];
    ss += __shfl_xor(ss, 1); ss += __shfl_xor(ss, 2); ss += __shfl_xor(ss, 4);
    const float rs = 1.0f / sqrtf(ss * (1.0f / HV) + EPS);
    const size_t go = (r0 + t) * DM + h * 128 + v0;
    const v4u g0 = *(const v4u*)(GH + go), g1 = *(const v4u*)(GH + go + 8);
    float gg[16] = {blo(g0.x), bhi(g0.x), blo(g0.y), bhi(g0.y), blo(g0.z), bhi(g0.z), blo(g0.w), bhi(g0.w), blo(g1.x), bhi(g1.x), blo(g1.y), bhi(g1.y), blo(g1.z), bhi(g1.z), blo(g1.w), bhi(g1.w)};
    float y[16];
#pragma unroll
    for (int j = 0; j < 16; ++j) y[j] = o[j] * rs * hnw[v0 + j] * gg[j];
    v4u w; w.x = pk2(y[0], y[1]); w.y = pk2(y[2], y[3]); w.z = pk2(y[4], y[5]); w.w = pk2(y[6], y[7]); *(v4u*)(OH + go) = w;
    w.x = pk2(y[8], y[9]); w.y = pk2(y[10], y[11]); w.z = pk2(y[12], y[13]); w.w = pk2(y[14], y[15]); *(v4u*)(OH + go + 8) = w;
}

__device__ __forceinline__ float row16_sum(float v) {
    v += __builtin_bit_cast(float, __builtin_amdgcn_update_dpp(0, __builtin_bit_cast(int, v), 0xB1, 0xf, 0xf, true));
    v += __builtin_bit_cast(float, __builtin_amdgcn_update_dpp(0, __builtin_bit_cast(int, v), 0x4E, 0xf, 0xf, true));
    v += __builtin_bit_cast(float, __builtin_amdgcn_update_dpp(0, __builtin_bit_cast(int, v), 0x141, 0xf, 0xf, true));
    v += __builtin_bit_cast(float, __builtin_amdgcn_update_dpp(0, __builtin_bit_cast(int, v), 0x140, 0xf, 0xf, true));
    return v;
}
__device__ __forceinline__ float wave_sum2(float v) { v = row16_sum(v); v += __shfl_xor(v, 16); v += __shfl_xor(v, 32); return v; }
__device__ __forceinline__ void p0_router_table(Frame& F) {
    const float* nfw = F.in[10]; const float* wrg = F.in[11]; const float* wre = F.in[13]; float* TR = (float*)(F.ws + WS_TR);
    for (int i = blockIdx.x * (NWAVES * 64) + F.tid; i < 36 * DM; i += F.G * NWAVES * 64) { const int j = i >> 10, k = i & 1023; TR[i] = nfw[k] * (j < 4 ? wrg[k * 4 + j] : wre[k * 32 + (j - 4)]); }
}
__device__ __forceinline__ void p7_router(Frame& F) {
    const float* h1 = F.out; const float* nfw = F.in[10]; const float* brg = F.in[12]; const float* bre = F.in[14];
    bf16* XN = (bf16*)(F.ws + WS_XN); unsigned* ASG = (unsigned*)(F.ws + WS_ASG); float* GATE = (float*)(F.ws + WS_GATE);
    LAS float* T = (LAS float*)(F.lds + RING_OFF);
    { const f32x4* src = (const f32x4*)(F.ws + WS_TR); for (int i = F.tid; i < 36 * DM / 4; i += NWAVES * 64) ((LAS f32x4*)T)[i] = src[i]; }
    __syncthreads();
    const int gw = F.vcu * NWAVES + F.wave, NGW = F.G * NWAVES;
    for (int g4 = gw; g4 < MR / 4; g4 += NGW) {
        const int rowb = g4 * 4;
        f32x4 x[4][4]; float ss[4];
#pragma unroll
        for (int r = 0; r < 4; ++r) { ss[r] = 0.f;
#pragma unroll
            for (int q = 0; q < 4; ++q) { x[r][q] = *(const f32x4*)(h1 + (size_t)(rowb + r) * DM + 256 * q + 4 * F.lane); ss[r] += (x[r][q].x * x[r][q].x + x[r][q].y * x[r][q].y) + (x[r][q].z * x[r][q].z + x[r][q].w * x[r][q].w); } }
        float mylg[4] = {0.f, 0.f, 0.f, 0.f};
#pragma unroll 1
        for (int j = 0; j < 36; ++j) {
            float a4[4] = {0.f, 0.f, 0.f, 0.f};
#pragma unroll
            for (int q = 0; q < 4; ++q) { const f32x4 w = *(const LAS f32x4*)(T + j * DM + 256 * q + 4 * F.lane);
#pragma unroll
                for (int r = 0; r < 4; ++r) a4[r] += (x[r][q].x * w.x + x[r][q].y * w.y) + (x[r][q].z * w.z + x[r][q].w * w.w); }
#pragma unroll
            for (int r = 0; r < 4; ++r) { const float s = wave_sum2(a4[r]); mylg[r] = (F.lane == j) ? s : mylg[r]; }
        }
        const float mybias = F.lane < 4 ? brg[F.lane & 3] : (F.lane < 36 ? bre[(F.lane - 4) & 31] : 0.f);
        unsigned myE = 0u; float myG = 0.f;
#pragma unroll
        for (int r = 0; r < 4; ++r) {
            const int row = rowb + r;
            const float rs = 1.0f / sqrtf(wave_sum2(ss[r]) * (1.0f / DM) + EPS);
            const float lgv = mylg[r] * rs + mybias;
            float lg[4];
#pragma unroll
            for (int j = 0; j < 4; ++j) lg[j] = __builtin_bit_cast(float, __builtin_amdgcn_readlane(__builtin_bit_cast(int, lgv), j));
            { GAS unsigned long long* o8 = (GAS unsigned long long*)(XN + (size_t)row * DM) + F.lane;
#pragma unroll
              for (int q = 0; q < 4; ++q) { const f32x4 w = *(const f32x4*)(nfw + 4 * F.lane + 256 * q); const f32x4 u = x[r][q] * rs * w;
                  o8[64 * q] = (unsigned long long)pk2(u.x, u.y) | ((unsigned long long)pk2(u.z, u.w) << 32); } }
            int g = 0; float gm = lg[0];
#pragma unroll
            for (int j = 1; j < 4; ++j) if (lg[j] > gm) { gm = lg[j]; g = j; }
            float gs = 0.f;
#pragma unroll
            for (int j = 0; j < 4; ++j) gs += __expf(lg[j] - gm);
            const float pg = 1.0f / gs;
            float es[8];
#pragma unroll
            for (int i = 0; i < 8; ++i) es[i] = __builtin_bit_cast(float, __builtin_amdgcn_readlane(__builtin_bit_cast(int, lgv), 4 + 8 * g + i));
            int i1 = 0; float v1 = es[0];
#pragma unroll
            for (int i = 1; i < 8; ++i) if (es[i] > v1) { v1 = es[i]; i1 = i; }
            int i2 = -1; float v2 = -3.0e38f;
#pragma unroll
            for (int i = 0; i < 8; ++i) if (i != i1 && es[i] > v2) { v2 = es[i]; i2 = i; }
            const float s1 = 1.0f / (1.0f + __expf(v2 - v1));
            if (F.lane == 2 * r) { myE = (unsigned)(g * 8 + i1); myG = pg * s1; }
            if (F.lane == 2 * r + 1) { myE = (unsigned)(g * 8 + i2); myG = pg * (1.0f - s1); }
        }
        if (F.lane < 8) {
            const unsigned pos = __hip_atomic_fetch_add((unsigned*)(F.ctl + CW_CNT + myE), 1u, RLX_AGENT);
            ASG[2 * rowb + F.lane] = (myE << 16) | pos; GATE[2 * rowb + F.lane] = myG;
        }
    }
    __syncthreads();
}
__device__ __forceinline__ void p8_permute(Frame& F) {
    LAS unsigned* pst = (LAS unsigned*)(F.lds + RING_OFF);
    if (F.wave == 0) {
        const unsigned cnt = F.lane < NE ? ald((const unsigned*)(F.ctl + CW_CNT + F.lane)) : 0u; const unsigned nt = (cnt + 255u) >> 8;
        unsigned inc = nt;
#pragma unroll
        for (int o = 1; o < 64; o <<= 1) { const unsigned t = __shfl_up(inc, o); if (F.lane >= o) inc += t; }
        const unsigned excl = inc - nt;
        if (F.lane < NE) pst[F.lane] = excl * 256u;
        if (blockIdx.x == 0) {
            if (F.lane == NE - 1) __hip_atomic_store((unsigned*)(F.ctl + CW_NT), inc, RLX_AGENT);
            if (F.lane < NE) for (unsigned t = 0; t < nt; ++t) __hip_atomic_store((unsigned*)(F.ctl + CW_TILEE + excl + t), (unsigned)F.lane, RLX_AGENT);
        }
    }
    __syncthreads();
    const unsigned* ASG = (const unsigned*)(F.ws + WS_ASG); unsigned* SLOT = (unsigned*)(F.ws + WS_SLOT); const bf16* XN = (const bf16*)(F.ws + WS_XN); bf16* XS = (bf16*)(F.ws + WS_XS);
    const int gw = F.vcu * NWAVES + F.wave, NGW = F.G * NWAVES;
    for (int a = gw; a < 2 * MR; a += NGW) {
        const unsigned w = ald(ASG + a); const unsigned e = w >> 16, pos = w & 0xffffu; const unsigned slot = pst[e] + pos;
        if (F.lane == 0) SLOT[a] = slot;
        const v4u* src = (const v4u*)(XN + (size_t)(a >> 1) * DM); v4u* dst = (v4u*)(XS + (size_t)slot * DM);
        dst[F.lane] = src[F.lane]; dst[64 + F.lane] = src[64 + F.lane];
    }
    __syncthreads();
}
__device__ __forceinline__ void p11_final(Frame& F) {
    const unsigned* SLOT = (const unsigned*)(F.ws + WS_SLOT); const float* GATE = (const float*)(F.ws + WS_GATE); const bf16* Y = (const bf16*)(F.ws + WS_Y); const float* fw = F.in[17];
    const int gw = F.vcu * NWAVES + F.wave, NGW = F.G * NWAVES;
    f32x4 wv[4];
#pragma unroll
    for (int j = 0; j < 4; ++j) wv[j] = *(const f32x4*)(fw + 4 * F.lane + 256 * j);
    for (int m0 = gw * 8; m0 < MR; m0 += NGW * 8) {
        const unsigned sl = ald(SLOT + 2 * m0 + (F.lane & 15)); const float gt = aldf(GATE + 2 * m0 + (F.lane & 15));
#pragma unroll
        for (int rr = 0; rr < 8; rr += 2) {
            f32x4 v[2][4]; float ss[2];
#pragma unroll
            for (int t = 0; t < 2; ++t) {
                const int m = m0 + rr + t;
                const unsigned s0 = __shfl(sl, 2 * (rr + t)), s1 = __shfl(sl, 2 * (rr + t) + 1); const float g0 = __shfl(gt, 2 * (rr + t)), g1 = __shfl(gt, 2 * (rr + t) + 1);
                ss[t] = 0.f;
#pragma unroll
                for (int j = 0; j < 4; ++j) { v[t][j] = *(const f32x4*)(F.out + (size_t)m * DM + 4 * F.lane + 256 * j);
                    const v2u y0 = *(const v2u*)(Y + (size_t)s0 * DM + 4 * F.lane + 256 * j), y1 = *(const v2u*)(Y + (size_t)s1 * DM + 4 * F.lane + 256 * j);
                    v[t][j].x += g0 * blo(y0.x) + g1 * blo(y1.x); v[t][j].y += g0 * bhi(y0.x) + g1 * bhi(y1.x); v[t][j].z += g0 * blo(y0.y) + g1 * blo(y1.y); v[t][j].w += g0 * bhi(y0.y) + g1 * bhi(y1.y);
                    ss[t] += (v[t][j].x * v[t][j].x + v[t][j].y * v[t][j].y) + (v[t][j].z * v[t][j].z + v[t][j].w * v[t][j].w); }
            }
#pragma unroll
            for (int t = 0; t < 2; ++t) { const float rs = 1.0f / sqrtf(wave_sum(ss[t]) * (1.0f / DM) + EPS);
#pragma unroll
                for (int j = 0; j < 4; ++j) *(f32x4*)(F.out + (size_t)(m0 + rr + t) * DM + 4 * F.lane + 256 * j) = v[t][j] * rs * wv[j]; }
        }
    }
}

struct Args { const float* in[18]; float* out; unsigned char* ws; int ph_lo, ph_hi, li, pad; };
__global__ void __launch_bounds__(NWAVES * 64, 2) fwd(Args args) {
    extern __shared__ __attribute__((aligned(16))) unsigned char lds[];
    Frame F;
    F.lds = (LAS unsigned char*)lds;
    F.MISC = (volatile LAS unsigned*)(F.lds + MISC_OFF);
    F.tid = threadIdx.x; F.lane = F.tid & 63; F.wave = __builtin_amdgcn_readfirstlane(F.tid >> 6);
    F.G = gridDim.x; { const int bx = blockIdx.x; F.vcu = (F.G % 8 == 0) ? (bx % 8) * (F.G / 8) + bx / 8 : bx; }
    F.ws = args.ws; F.ctl = (gu32*)(args.ws + WS_CTL); F.out = args.out;
#pragma unroll
    for (int i = 0; i < 18; ++i) F.in[i] = args.in[i];
    for (int u = F.tid; u < (LDS_BYTES - LDSCTL_OFF) / 4; u += NWAVES * 64) ((LAS unsigned*)(F.lds + LDSCTL_OFF))[u] = 0u;
    __syncthreads();
    const int bli = (N_LAUNCHES == NPHASE) ? 0 : args.li;
    XcdBarrier bar; bar.bar = (unsigned*)(F.ctl + CW_BAR) + bli * XCD_BAR_WORDS; bar.x = 0; bar.st = nullptr;
    if (N_LAUNCHES != NPHASE) bar = xcd_barrier_post((unsigned*)(F.ctl + CW_BAR) + bli * XCD_BAR_WORDS, F.MISC + 8);
#define GRID_BAR(seam) do { if (N_LAUNCHES == NPHASE) { if (F.tid == 0) __hip_atomic_store(F.ctl + CW_TMO, 0xBADBA0u | (unsigned)(seam), RLX_AGENT); } else { xcd_barrier(bar); } } while (0)
    const int lo = args.ph_lo, hi = args.ph_hi;
#define IN(k) (lo <= (k) && (k) < hi)
#define PHASE_BEGIN() do { int t_ = threadIdx.x; asm volatile("" : "+v"(t_)); F.tid = t_; F.lane = t_ & 63; } while (0)
#define BOTH(k) (IN(k) && IN((k) + 1))
    unsigned char* ws = args.ws;

    if (IN(0)) { PHASE_BEGIN();
        if (F.vcu < 49) p0_meta(F);
        p0_router_table(F);
        p0_rows(F);
        p0_weights(F);
        if (BOTH(0)) GRID_BAR(0);
    }
    if (IN(1)) { PHASE_BEGIN();
        pg8::Gemm g{(const bf16*)(ws + WS_U), (const bf16*)(ws + WS_WIN), MR, NPROJ, DM, 0};
        pg8::StaticOrder S; S.init(MR, NPROJ, F.G, (int)blockIdx.x);
        pg8::EpiProj E{(bf16*)(ws + WS_QA), (bf16*)(ws + WS_KA), (bf16*)(ws + WS_VA), (bf16*)(ws + WS_QH), (bf16*)(ws + WS_EB), (bf16*)(ws + WS_KT), (bf16*)(ws + WS_KD), (bf16*)(ws + WS_VH),
                       (bf16*)(ws + WS_GH), (bf16*)(ws + WS_GA), (bf16*)(ws + WS_GT), F.in[5]};
        pg8::gemm_phase<pg8::EpiProj, pg8::StaticOrder, true, true>(F.lds + RING_OFF, g, S, E);
        __syncthreads();
        for (int bh = blockIdx.x; bh < 16; bh += F.G) p1_cumsum(F, bh);
        if (BOTH(1)) GRID_BAR(1);
    }
    if (IN(2)) { PHASE_BEGIN();
#if defined(ATTN_SIMPLE)
        for (int pid = F.vcu; pid < 256; pid += F.G) { const int bh = pid >> 4, s = pid & 15; attn_simple_unit(F, bh, s); attn_simple_unit(F, bh, 31 - s); }
#else
        static_assert(attn_body::ATTN_LDS_BYTES <= RING_BYTES, "attention LDS");
        for (int pid = F.vcu; pid < 256; pid += F.G) { const int bh = pid >> 4, s = pid & 15;
            for (int i = 0; i < 2; ++i)
                attn_body::attn_unit<8>(bh >> 3, bh & 7, i ? 31 - s : s, (const attn_body::bf16*)(ws + WS_QA), (const attn_body::bf16*)(ws + WS_KA), (const attn_body::bf16*)(ws + WS_VA), (attn_body::bf16*)(ws + WS_OA),
                                        (const float*)(ws + WS_CL) + (size_t)bh * KROWS, (char*)lds + RING_OFF); }
        __syncthreads();
#endif
#if defined(HGRN_SIMPLE)
        for (int it = F.vcu; it < 16 * NCH; it += F.G) hgrn_a_simple(F, it);
#else
        for (int it = F.vcu; it < 16 * NCH; it += F.G) hg::hgrn_a(it, (const bf16*)(ws + WS_KD), (const bf16*)(ws + WS_VH), (bf16*)(ws + WS_US), F.lds + RING_OFF);
#endif
        if (BOTH(2)) GRID_BAR(2);
    }
#if defined(HGRN_SIMPLE)
    if (IN(3)) { PHASE_BEGIN(); hgrn_scan(F); if (BOTH(3)) GRID_BAR(3); }
#else
    if (IN(3)) { PHASE_BEGIN(); hgrn_scan_t(F); if (BOTH(3)) GRID_BAR(3); }
#endif
    if (IN(4)) { PHASE_BEGIN();
#if defined(HGRN_SIMPLE)
        for (int it = F.vcu; it < 16 * 128; it += F.G) hgrn_c_simple(F, it);
#else
        static_assert(hg::HC_END <= RING_BYTES, "hgrn LDS");
        for (int it = F.vcu; it < 16 * 128; it += F.G)
            hg::hgrn_c(it, (const bf16*)(ws + WS_QH), (const bf16*)(ws + WS_EB), (const bf16*)(ws + WS_KT), (const bf16*)(ws + WS_VH), (const bf16*)(ws + WS_GH), (const bf16*)(ws + WS_US), (bf16*)(ws + WS_OH), F.in[6], EPS, F.lds + RING_OFF);
#endif
        if (BOTH(4)) GRID_BAR(4);
    }
    if (IN(5)) { PHASE_BEGIN();
        { pg8::Gemm g{(const bf16*)(ws + WS_OA), (const bf16*)(ws + WS_WA), MR, DM, AWID, 0}; pg8::StaticOrder S; S.init(MR, DM, F.G, (int)blockIdx.x);
          pg8::EpiYa E{(const bf16*)(ws + WS_GA), (float*)(ws + WS_YA)};
          pg8::gemm_phase<pg8::EpiYa, pg8::StaticOrder, true, true>(F.lds + RING_OFF, g, S, E); }
        __syncthreads();
        { pg8::Gemm g{(const bf16*)(ws + WS_OH), (const bf16*)(ws + WS_WH), MR, DM, DM, 0}; pg8::StaticOrder S; S.init(MR, DM, F.G, (int)blockIdx.x);
          pg8::EpiMixed E{(const bf16*)(ws + WS_GT), (const float*)(ws + WS_YA), (bf16*)(ws + WS_MIX)};
          pg8::gemm_phase<pg8::EpiMixed, pg8::StaticOrder, true, true>(F.lds + RING_OFF, g, S, E); }
        if (BOTH(5)) GRID_BAR(5);
    }
    if (IN(6)) { PHASE_BEGIN();
        pg8::Gemm g{(const bf16*)(ws + WS_MIX), (const bf16*)(ws + WS_WO), MR, DM, DM, 0}; pg8::StaticOrder S; S.init(MR, DM, F.G, (int)blockIdx.x);
        pg8::EpiRes E{F.in[0], F.out};
        pg8::gemm_phase<pg8::EpiRes, pg8::StaticOrder, true, true>(F.lds + RING_OFF, g, S, E);
        if (BOTH(6)) GRID_BAR(6);
    }
    if (IN(7)) { PHASE_BEGIN(); p7_router(F); p7_expert_weights(F); if (BOTH(7)) GRID_BAR(7); }
    if (IN(8)) { PHASE_BEGIN(); p8_permute(F); if (BOTH(8)) GRID_BAR(8); }
    if (IN(9)) { PHASE_BEGIN();
        const int ntile = (int)__builtin_amdgcn_readfirstlane(ald((const unsigned*)(F.ctl + CW_NT)));
        pg8::Gemm g{(const bf16*)(ws + WS_XS), (const bf16*)(ws + WS_WE1), APAD, DM, DM, (size_t)DM * DM * 2};
        pg8::MoeOrder S{ntile * 4, F.G, F.vcu, (const unsigned*)(F.ctl + CW_TILEE)};
        pg8::EpiSwiglu E{(bf16*)(ws + WS_ACT)};
        pg8::gemm_phase<pg8::EpiSwiglu, pg8::MoeOrder, true, true>(F.lds + RING_OFF, g, S, E);
        if (BOTH(9)) GRID_BAR(9);
    }
    if (IN(10)) { PHASE_BEGIN();
        const int ntile = (int)__builtin_amdgcn_readfirstlane(ald((const unsigned*)(F.ctl + CW_NT)));
        pg8::Gemm g{(const bf16*)(ws + WS_ACT), (const bf16*)(ws + WS_WE2), APAD, DM, EFF, (size_t)DM * EFF * 2};
        pg8::MoeOrder S{ntile * 4, F.G, F.vcu, (const unsigned*)(F.ctl + CW_TILEE)};
        pg8::EpiPlain E{(bf16*)(ws + WS_Y), DM};
        pg8::gemm_phase<pg8::EpiPlain, pg8::MoeOrder, true, true>(F.lds + RING_OFF, g, S, E);
        if (BOTH(10)) GRID_BAR(10);
    }
    if (IN(11)) { PHASE_BEGIN(); p11_final(F); }
#undef IN
#undef BOTH
}

extern "C" void kernel_launch(void* const* d_in, const int* in_sizes, int n_in, void* d_out, int out_size, void* d_ws, size_t ws_size, hipStream_t stream) {
    static int grid = 0;
    if (grid == 0) {
        if (n_in != 18 || in_sizes[0] != MR * DM || out_size != MR * DM || ws_size < WS_END) {
            fprintf(stderr, "kernel_launch: unexpected problem: n_in %d in0 %d out %d ws %zu (need %zu); nothing launched\n", n_in, n_in > 0 ? in_sizes[0] : -1, out_size, ws_size, (size_t)WS_END); grid = -1; return; }
        int dev = 0, cus = 0, per_cu = 0;
        if (hipGetDevice(&dev) != hipSuccess || hipDeviceGetAttribute(&cus, hipDeviceAttributeMultiprocessorCount, dev) != hipSuccess) { grid = -1; return; }
        if (hipFuncSetAttribute((const void*)fwd, hipFuncAttributeMaxDynamicSharedMemorySize, LDS_BYTES) != hipSuccess) { fprintf(stderr, "kernel_launch: hipFuncSetAttribute failed\n"); grid = -1; return; }
        if (hipOccupancyMaxActiveBlocksPerMultiprocessor(&per_cu, (const void*)fwd, NWAVES * 64, LDS_BYTES) != hipSuccess || per_cu < 1)
            fprintf(stderr, "kernel_launch: note: occupancy query reports %d workgroups per CU\n", per_cu);
        (void)hipGetLastError();
        grid = cus;
    }
    if (grid < 0) return;
    if (hipMemsetAsync((char*)d_ws + WS_CTL, 0, CTL_ZERO_BYTES, stream) != hipSuccess) { fprintf(stderr, "kernel_launch: memset failed\n"); return; }
    Args a{};
    for (int i = 0; i < 18; ++i) a.in[i] = (const float*)d_in[i];
    a.out = (float*)d_out; a.ws = (unsigned char*)d_ws;
    for (int li = 0; li < N_LAUNCHES; ++li) {
        if (N_LAUNCHES == NPHASE) { a.ph_lo = li; a.ph_hi = li + 1; } else { a.ph_lo = 0; a.ph_hi = NPHASE; }
        a.li = li;
        hipLaunchKernelGGL(fwd, dim3(grid), dim3(NWAVES * 64), LDS_BYTES, stream, a);
        const hipError_t le = hipPeekAtLastError();
        if (le != hipSuccess) { fprintf(stderr, "kernel_launch: launch %d failed: %s\n", li, hipGetErrorName(le)); break; }
    }
}
```

```cpp
#include <hip/hip_runtime.h>
#include <hip/hip_bf16.h>
#include <cmath>
#include <cstdio>
#include <cstdint>

#ifndef MK_N_LAUNCHES
#define MK_N_LAUNCHES 1
#endif

namespace pg8 {
#define PG8_LAS __attribute__((address_space(3)))
typedef unsigned short bf16_t;
typedef short bf16x8 __attribute__((ext_vector_type(8)));
typedef float f32x4 __attribute__((ext_vector_type(4)));
typedef unsigned u32x4 __attribute__((ext_vector_type(4)));
typedef unsigned u32x2 __attribute__((ext_vector_type(2)));
constexpr int BM = 256, BK = 64, HALF = 128, HTB = HALF * BK * 2  , STAGE_BYTES = 8 * HTB, NXCD = 8, WGM = 8;

__host__ __device__ __forceinline__ int lds_byte(int r, int c) { const int st = (r >> 4) * 2 + (c >> 5), rr = r & 15, cc = c & 31, ob = rr * 64 + cc * 2; return st * 1024 + (ob ^ (((ob >> 9) & 1) << 5)); }
__host__ __device__ __forceinline__ void stage_rc(int b, int& R, int& C) { const int st = b / 1024, sb = b % 1024, swz = sb ^ (((sb >> 9) & 1) << 5); R = (st >> 1) * 16 + swz / 64; C = (st & 1) * 32 + (swz % 64) / 2; }
__host__ __device__ __forceinline__ int perm32(int rho) { const int n = rho >> 4, i = rho & 15; return 8 * (i >> 2) + 4 * n + (i & 3); }

struct Unit { int pm, pn, e; };
struct Gemm { const bf16_t* A; const bf16_t* Bt; int M, N, K; size_t bexp; };

struct StaticOrder {
    int nM, nN, nwg, G, c;
    __host__ __device__ void init(int M, int N, int G_, int c_) { nM = M / BM; nN = N / BM; nwg = nM * nN; G = G_; c = c_; }
    __host__ __device__ bool next(int i, Unit& u) const {
        const long L = (long)i * G + c; if (L >= nwg) return false;
        int wgid = (int)L; { const int q = nwg / NXCD, r = nwg % NXCD, xcd = wgid % NXCD, off = wgid / NXCD; wgid = (xcd < r ? xcd * (q + 1) : r * (q + 1) + (xcd - r) * q) + off; }
        const int nig = WGM * nN, gid = wgid / nig, fm = gid * WGM, gsz = (nM - fm) < WGM ? (nM - fm) : WGM;
        u.pm = fm + ((wgid % nig) % gsz); u.pn = (wgid % nig) / gsz; u.e = 0; return true;
    }
    __device__ __forceinline__ void a_ready(const Unit&) const {}
    __device__ __forceinline__ void done(const Unit&) const {}
};
struct MoeOrder {
    int ntu, G, c; const unsigned* tile_e;
    __device__ bool next(int i, Unit& u) const {
        const long L = (long)i * G + c; if (L >= ntu) return false;
        u.pm = (int)(L >> 2); u.pn = (int)(L & 3);
        u.e = (int)__builtin_amdgcn_readfirstlane(__hip_atomic_load(tile_e + u.pm, __ATOMIC_RELAXED, __HIP_MEMORY_SCOPE_AGENT)); return true;
    }
    __device__ __forceinline__ void a_ready(const Unit&) const {}
    __device__ __forceinline__ void done(const Unit&) const {}
};

__device__ __forceinline__ unsigned cvt_pk_bf16(float lo, float hi) { unsigned r; asm volatile("v_cvt_pk_bf16_f32 %0, %1, %2" : "=v"(r) : "v"(lo), "v"(hi)); return r; }
__device__ __forceinline__ float fsig(float x) { return __builtin_amdgcn_rcpf(1.0f + __builtin_amdgcn_exp2f(-1.4426950408889634f * x)); }
__device__ __forceinline__ float bflo(unsigned w) { return __builtin_bit_cast(float, w << 16); }
__device__ __forceinline__ float bfhi(unsigned w) { return __builtin_bit_cast(float, w & 0xffff0000u); }
__device__ __forceinline__ float dpp_shr(float v, int) { return v; }
#define PG8_SCAN16(v) do { \
    v += __builtin_bit_cast(float, __builtin_amdgcn_update_dpp(0, __builtin_bit_cast(int, v), 0x111, 0xf, 0xf, true)); \
    v += __builtin_bit_cast(float, __builtin_amdgcn_update_dpp(0, __builtin_bit_cast(int, v), 0x112, 0xf, 0xf, true)); \
    v += __builtin_bit_cast(float, __builtin_amdgcn_update_dpp(0, __builtin_bit_cast(int, v), 0x114, 0xf, 0xf, true)); \
    v += __builtin_bit_cast(float, __builtin_amdgcn_update_dpp(0, __builtin_bit_cast(int, v), 0x118, 0xf, 0xf, true)); } while (0)

constexpr float ATT_C2 = 0.125f * 1.4426950408889634f;
constexpr float HG_QS = 0.08838834764831845f;

struct EpiProj {
    static constexpr bool PERM = true, AFTER_DRAIN = false;
    bf16_t *QA, *KA, *VA, *QH, *EB, *KT, *KD, *VH, *GH, *GA, *GT; const float* lbl;
    __device__ __forceinline__ void operator()(const f32x4 (&acc)[2][2][4][2], const Unit& u, int wr, int wc, int fr, int fq) const {
        const int pn = u.pn, b = u.pm >> 5;
        const int cofs = wc * 32 + 8 * fq;
        const int row0 = u.pm * BM + wr * 64 + fr;
        if (pn >= 10 && pn < 14) {
            const int colbase = 256 * (pn - 10), lane = fq * 16 + fr, srcl = (lane & 48) | 15;
#pragma unroll
            for (int ai = 0; ai < 2; ++ai)
#pragma unroll
                for (int bj = 0; bj < 2; ++bj)
#pragma unroll
                    for (int n = 0; n < 2; ++n) {
                        const int c0 = colbase + 128 * bj + cofs + 4 * n;
                        const f32x4 l0 = *(const f32x4*)(lbl + c0), l1 = *(const f32x4*)(lbl + 1024 + c0);
                        float eb[4][4], kt[4][4], kd[4][4];
#pragma unroll
                        for (int e = 0; e < 4; ++e) {
                            const float lb = __builtin_amdgcn_rcpf(1.0f + __builtin_amdgcn_exp2f((l1[e] - l0[e]) * 1.4426950408889634f));
                            float lf[4], kk[4];
#pragma unroll
                            for (int m = 0; m < 4; ++m) { const float f = lb + (1.0f - lb) * fsig(acc[ai][bj][m][n][e]); kk[m] = 1.0f - f; lf[m] = __builtin_amdgcn_logf(f); }
#pragma unroll
                            for (int m = 0; m < 4; ++m) PG8_SCAN16(lf[m]);
                            float run = 0.f, bb[4];
#pragma unroll
                            for (int m = 0; m < 4; ++m) { const float tot = __shfl(lf[m], srcl); bb[m] = lf[m] + run; run += tot; }
#pragma unroll
                            for (int m = 0; m < 4; ++m) { eb[m][e] = __builtin_amdgcn_exp2f(bb[m]); kt[m][e] = kk[m] * __builtin_amdgcn_exp2f(-bb[m]); kd[m][e] = kk[m] * __builtin_amdgcn_exp2f(run - bb[m]); }
                        }
#pragma unroll
                        for (int m = 0; m < 4; ++m) {
                            const size_t r = (size_t)(row0 + ai * HALF + m * 16);
                            u32x2 w;
                            w.x = cvt_pk_bf16(eb[m][0], eb[m][1]); w.y = cvt_pk_bf16(eb[m][2], eb[m][3]); *(u32x2*)(EB + r * 1024 + c0) = w;
                            w.x = cvt_pk_bf16(kt[m][0], kt[m][1]); w.y = cvt_pk_bf16(kt[m][2], kt[m][3]); *(u32x2*)(KT + r * 1024 + c0) = w;
                            w.x = cvt_pk_bf16(kd[m][0], kd[m][1]); w.y = cvt_pk_bf16(kd[m][2], kd[m][3]); *(u32x2*)(KD + (r + 64 * (b + 1)) * 1024 + c0) = w;
                        }
                    }
            return;
        }
        bf16_t* base; int ld = 1024, radd = 0, cb; int mode = 0; float sc = 1.f;
        if (pn < 2) { base = QA; ld = 512; cb = 256 * pn; sc = ATT_C2; }
        else if (pn < 4) { base = KA; ld = 512; cb = 256 * (pn - 2); radd = 128 * (b + 1); }
        else if (pn < 6) { base = VA; ld = 512; cb = 256 * (pn - 4); radd = 128 * (b + 1); }
        else if (pn < 10) { base = QH; cb = 256 * (pn - 6); sc = HG_QS; }
        else if (pn < 18) { base = VH; cb = 256 * (pn - 14); radd = 64 * (b + 1); }
        else if (pn < 22) { base = GH; cb = 256 * (pn - 18); mode = 1; }
        else if (pn < 26) { base = GA; cb = 256 * (pn - 22); mode = 1; }
        else { base = GT; cb = 256 * (pn - 26); mode = 1; }
#pragma unroll
        for (int ai = 0; ai < 2; ++ai)
#pragma unroll
            for (int m = 0; m < 4; ++m) { bf16_t* rowp = base + (size_t)(row0 + ai * HALF + m * 16 + radd) * ld + cb + cofs;
#pragma unroll
                for (int bj = 0; bj < 2; ++bj) { f32x4 v0 = acc[ai][bj][m][0], v1 = acc[ai][bj][m][1];
                    if (mode) {
#pragma unroll
                        for (int e = 0; e < 4; ++e) { v0[e] = fsig(v0[e]); v1[e] = fsig(v1[e]); }
                    } else { v0 = v0 * sc; v1 = v1 * sc; }
                    u32x4 w; w.x = cvt_pk_bf16(v0[0], v0[1]); w.y = cvt_pk_bf16(v0[2], v0[3]); w.z = cvt_pk_bf16(v1[0], v1[1]); w.w = cvt_pk_bf16(v1[2], v1[3]);
                    *(u32x4*)(rowp + bj * HALF) = w; } }
    }
};
struct EpiYa {
    static constexpr bool PERM = true, AFTER_DRAIN = false;
    const bf16_t* G; float* Y;
    __device__ __forceinline__ void operator()(const f32x4 (&acc)[2][2][4][2], const Unit& u, int wr, int wc, int fr, int fq) const {
        const int row0 = u.pm * BM + wr * 64 + fr, col0 = u.pn * BM + wc * 32 + 8 * fq;
#pragma unroll
        for (int ai = 0; ai < 2; ++ai)
#pragma unroll
            for (int m = 0; m < 4; ++m) { const size_t off = (size_t)(row0 + ai * HALF + m * 16) * 1024 + col0;
#pragma unroll
                for (int bj = 0; bj < 2; ++bj) { const u32x4 g = *(const u32x4*)(G + off + bj * HALF);
                    f32x4 v0 = acc[ai][bj][m][0], v1 = acc[ai][bj][m][1];
                    v0[0] *= bflo(g.x); v0[1] *= bfhi(g.x); v0[2] *= bflo(g.y); v0[3] *= bfhi(g.y); v1[0] *= bflo(g.z); v1[1] *= bfhi(g.z); v1[2] *= bflo(g.w); v1[3] *= bfhi(g.w);
                    *(f32x4*)(Y + off + bj * HALF) = v0; *(f32x4*)(Y + off + bj * HALF + 4) = v1; } }
    }
};
struct EpiMixed {
    static constexpr bool PERM = true, AFTER_DRAIN = false;
    const bf16_t* G; const float* Y; bf16_t* O;
    __device__ __forceinline__ void operator()(const f32x4 (&acc)[2][2][4][2], const Unit& u, int wr, int wc, int fr, int fq) const {
        const int row0 = u.pm * BM + wr * 64 + fr, col0 = u.pn * BM + wc * 32 + 8 * fq;
#pragma unroll
        for (int ai = 0; ai < 2; ++ai)
#pragma unroll
            for (int m = 0; m < 4; ++m) { const size_t off = (size_t)(row0 + ai * HALF + m * 16) * 1024 + col0;
#pragma unroll
                for (int bj = 0; bj < 2; ++bj) { const u32x4 g = *(const u32x4*)(G + off + bj * HALF);
                    const f32x4 y0 = *(const f32x4*)(Y + off + bj * HALF), y1 = *(const f32x4*)(Y + off + bj * HALF + 4);
                    f32x4 v0 = acc[ai][bj][m][0], v1 = acc[ai][bj][m][1];
                    v0[0] = y0[0] + v0[0] * bflo(g.x); v0[1] = y0[1] + v0[1] * bfhi(g.x); v0[2] = y0[2] + v0[2] * bflo(g.y); v0[3] = y0[3] + v0[3] * bfhi(g.y);
                    v1[0] = y1[0] + v1[0] * bflo(g.z); v1[1] = y1[1] + v1[1] * bfhi(g.z); v1[2] = y1[2] + v1[2] * bflo(g.w); v1[3] = y1[3] + v1[3] * bfhi(g.w);
                    u32x4 w; w.x = cvt_pk_bf16(v0[0], v0[1]); w.y = cvt_pk_bf16(v0[2], v0[3]); w.z = cvt_pk_bf16(v1[0], v1[1]); w.w = cvt_pk_bf16(v1[2], v1[3]);
                    *(u32x4*)(O + off + bj * HALF) = w; } }
    }
};
struct EpiRes {
    static constexpr bool PERM = true, AFTER_DRAIN = false;
    const float* X; float* O;
    __device__ __forceinline__ void operator()(const f32x4 (&acc)[2][2][4][2], const Unit& u, int wr, int wc, int fr, int fq) const {
        const int row0 = u.pm * BM + wr * 64 + fr, col0 = u.pn * BM + wc * 32 + 8 * fq;
#pragma unroll
        for (int ai = 0; ai < 2; ++ai)
#pragma unroll
            for (int m = 0; m < 4; ++m) { const size_t off = (size_t)(row0 + ai * HALF + m * 16) * 1024 + col0;
#pragma unroll
                for (int bj = 0; bj < 2; ++bj) {
                    const f32x4 x0 = *(const f32x4*)(X + off + bj * HALF), x1 = *(const f32x4*)(X + off + bj * HALF + 4);
                    *(f32x4*)(O + off + bj * HALF) = x0 + acc[ai][bj][m][0]; *(f32x4*)(O + off + bj * HALF + 4) = x1 + acc[ai][bj][m][1]; } }
    }
};
struct EpiSwiglu {
    static constexpr bool PERM = true, AFTER_DRAIN = false;
    bf16_t* O;
    __device__ __forceinline__ void operator()(const f32x4 (&acc)[2][2][4][2], const Unit& u, int wr, int wc, int fr, int fq) const {
        const int row0 = u.pm * BM + wr * 64 + fr, col0 = u.pn * HALF + wc * 32 + 8 * fq;
#pragma unroll
        for (int ai = 0; ai < 2; ++ai)
#pragma unroll
            for (int m = 0; m < 4; ++m) { const size_t off = (size_t)(row0 + ai * HALF + m * 16) * 512 + col0;
                f32x4 v0, v1;
#pragma unroll
                for (int e = 0; e < 4; ++e) { const float a0 = acc[ai][0][m][0][e], a1 = acc[ai][0][m][1][e];
                    v0[e] = a0 * fsig(a0) * acc[ai][1][m][0][e]; v1[e] = a1 * fsig(a1) * acc[ai][1][m][1][e]; }
                u32x4 w; w.x = cvt_pk_bf16(v0[0], v0[1]); w.y = cvt_pk_bf16(v0[2], v0[3]); w.z = cvt_pk_bf16(v1[0], v1[1]); w.w = cvt_pk_bf16(v1[2], v1[3]);
                *(u32x4*)(O + off) = w; }
    }
};
struct EpiPlain {
    static constexpr bool PERM = true, AFTER_DRAIN = false;
    bf16_t* O; int ldc;
    __device__ __forceinline__ void operator()(const f32x4 (&acc)[2][2][4][2], const Unit& u, int wr, int wc, int fr, int fq) const {
        const int row0 = u.pm * BM + wr * 64 + fr, col0 = u.pn * BM + wc * 32 + 8 * fq;
#pragma unroll
        for (int ai = 0; ai < 2; ++ai)
#pragma unroll
            for (int m = 0; m < 4; ++m) { const size_t off = (size_t)(row0 + ai * HALF + m * 16) * ldc + col0;
#pragma unroll
                for (int bj = 0; bj < 2; ++bj) { const f32x4 v0 = acc[ai][bj][m][0], v1 = acc[ai][bj][m][1];
                    u32x4 w; w.x = cvt_pk_bf16(v0[0], v0[1]); w.y = cvt_pk_bf16(v0[2], v0[3]); w.z = cvt_pk_bf16(v1[0], v1[1]); w.w = cvt_pk_bf16(v1[2], v1[3]);
                    *(u32x4*)(O + off + bj * HALF) = w; } }
    }
};

template <class Epi, class Sched, bool ALIGN_EPI = false, bool SP2 = false>
__device__ __forceinline__ void gemm_phase(PG8_LAS unsigned char* lds, const Gemm g, const Sched& S, const Epi& E) {
    int tid_l = threadIdx.x; asm volatile("" : "+v"(tid_l));
    const int tid = tid_l, wid = __builtin_amdgcn_readfirstlane(tid >> 6), lane = tid & 63, wr = wid >> 2, wc = wid & 3, fr = lane & 15, fq = lane >> 4;
    const int K = g.K, nt = K / BK;
    unsigned voffA[2], voffB[2];
#pragma unroll
    for (int i = 0; i < 2; ++i) { int R, C; stage_rc(tid * 16 + i * 8192, R, C); const int Rb = Epi::PERM ? ((R & ~31) + perm32(R & 31)) : R;
        voffA[i] = (unsigned)(R * K + C) * 2u; voffB[i] = (unsigned)(Rb * K + C) * 2u; }
    const size_t kstep = (size_t)(BK * 2);
    const size_t hstep = (size_t)HALF * K * 2;
    const size_t tstep = 2 * hstep;
    const unsigned ldsw = (unsigned)wid * 1024u;
    const int aoff = lds_byte(wr * 64 + fr, fq * 8), boff = lds_byte(wc * 32 + fr, fq * 8);
#define PG8_SA(b, h) (((b) * 2 + (h)) * HTB)
#define PG8_SB(b, h) ((4 + (b) * 2 + (h)) * HTB)
#define PG8_STAGE(bufoff, gbase, voff) do { _Pragma("unroll") for (int _i = 0; _i < 2; ++_i) \
        __builtin_amdgcn_global_load_lds((const unsigned*)((const char*)(gbase) + (voff)[_i]), (PG8_LAS unsigned*)(lds + (bufoff) + ldsw + _i * 8192), 16, 0, 0); } while (0)
#define PG8_LDA(dst, b, h) do { _Pragma("unroll") for (int m = 0; m < 4; ++m) _Pragma("unroll") for (int k = 0; k < 2; ++k) dst[m][k] = *(const PG8_LAS bf16x8*)(lds + PG8_SA(b, h) + aoff + m * 2048 + k * 1024); } while (0)
#define PG8_LDB(dst, b, h) do { _Pragma("unroll") for (int n = 0; n < 2; ++n) _Pragma("unroll") for (int k = 0; k < 2; ++k) dst[n][k] = *(const PG8_LAS bf16x8*)(lds + PG8_SB(b, h) + boff + n * 2048 + k * 1024); } while (0)
#define PG8_MMA(ai, bj, At, Bt) do { __builtin_amdgcn_s_setprio(1); _Pragma("unroll") for (int m = 0; m < 4; ++m) _Pragma("unroll") for (int n = 0; n < 2; ++n) _Pragma("unroll") for (int k = 0; k < 2; ++k) \
        acc[ai][bj][m][n] = __builtin_amdgcn_mfma_f32_16x16x32_bf16(Bt[n][k], At[m][k], acc[ai][bj][m][n], 0, 0, 0); __builtin_amdgcn_s_setprio(0); } while (0)
#define PG8_WAIT_V(n) asm volatile("s_waitcnt vmcnt(" #n ")" ::: "memory")
#define PG8_WAIT_L(n) asm volatile("s_waitcnt lgkmcnt(" #n ")" ::: "memory")
#define PG8_BAR __builtin_amdgcn_s_barrier()
#define PG8_SCHED __builtin_amdgcn_sched_barrier(0)
    Unit cur, nxt; int ui = 0;
    if (!S.next(0, cur)) return;
    f32x4 acc[2][2][4][2];
#pragma unroll
    for (int a = 0; a < 2; ++a)
#pragma unroll
        for (int b = 0; b < 2; ++b)
#pragma unroll
            for (int m = 0; m < 4; ++m)
#pragma unroll
                for (int n = 0; n < 2; ++n) acc[a][b][m][n] = (f32x4){0.f, 0.f, 0.f, 0.f};
    bf16x8 At[4][2], B0[2][2], B1[2][2];
    const char* cA = (const char*)g.A + (size_t)cur.pm * tstep; const char* cB = (const char*)g.Bt + (size_t)cur.e * g.bexp + (size_t)cur.pn * tstep;
    S.a_ready(cur);
    if constexpr (SP2) {
        PG8_STAGE(PG8_SB(0, 0), cB, voffB); PG8_STAGE(PG8_SB(0, 1), cB + hstep, voffB); PG8_STAGE(PG8_SA(0, 0), cA, voffA); PG8_STAGE(PG8_SA(0, 1), cA + hstep, voffA);
        if (wr == 1) PG8_BAR;
        PG8_WAIT_V(2); PG8_BAR;
        PG8_STAGE(PG8_SB(1, 0), cB + kstep, voffB); PG8_STAGE(PG8_SA(1, 0), cA + kstep, voffA); PG8_STAGE(PG8_SB(1, 1), cB + hstep + kstep, voffB);
        PG8_WAIT_V(6); PG8_BAR;
    } else {
        PG8_STAGE(PG8_SB(0, 0), cB, voffB); PG8_STAGE(PG8_SA(0, 0), cA, voffA); PG8_STAGE(PG8_SB(0, 1), cB + hstep, voffB); PG8_STAGE(PG8_SA(0, 1), cA + hstep, voffA);
        if (wr == 1) PG8_BAR;
        PG8_WAIT_V(4); PG8_BAR;
        PG8_STAGE(PG8_SB(1, 0), cB + kstep, voffB); PG8_STAGE(PG8_SA(1, 0), cA + kstep, voffA); PG8_STAGE(PG8_SB(1, 1), cB + hstep + kstep, voffB);
        PG8_WAIT_V(6); PG8_BAR;
    }
    for (;;) {
        const bool has_next = S.next(ui + 1, nxt);
        const char* nA = has_next ? (const char*)g.A + (size_t)nxt.pm * tstep : cA; const char* nB = has_next ? (const char*)g.Bt + (size_t)nxt.e * g.bexp + (size_t)nxt.pn * tstep : cB;
        for (int t = 0; t < nt; t += 2) {
            const bool last = (t == nt - 2);
            const char* a1 = cA + (size_t)(t + 1) * kstep;
            const char* a2 = last ? nA : cA + (size_t)(t + 2) * kstep; const char* b2 = last ? nB : cB + (size_t)(t + 2) * kstep;
            const char* a3 = a2 + kstep; const char* b3 = b2 + kstep;
            if (last && has_next) S.a_ready(nxt);
            if constexpr (SP2) {
            PG8_LDB(B0, 0, 0); PG8_LDB(B1, 0, 1); PG8_SCHED; PG8_LDA(At, 0, 0); PG8_STAGE(PG8_SA(1, 1), a1 + hstep, voffA);
            PG8_WAIT_V(8); PG8_WAIT_L(0); PG8_BAR; PG8_MMA(0, 0, At, B0); PG8_MMA(0, 1, At, B1); PG8_BAR; PG8_SCHED;
            PG8_LDA(At, 0, 1); PG8_STAGE(PG8_SB(0, 0), b2, voffB); PG8_STAGE(PG8_SB(0, 1), b2 + hstep, voffB); PG8_STAGE(PG8_SA(0, 0), a2, voffA);
            PG8_WAIT_V(8); PG8_WAIT_L(0); PG8_BAR; PG8_MMA(1, 0, At, B0); PG8_MMA(1, 1, At, B1); PG8_BAR; PG8_SCHED;
            PG8_LDB(B0, 1, 0); PG8_LDB(B1, 1, 1); PG8_SCHED; PG8_LDA(At, 1, 0); PG8_STAGE(PG8_SA(0, 1), a2 + hstep, voffA);
            PG8_WAIT_V(8); PG8_WAIT_L(0); PG8_BAR; PG8_MMA(0, 0, At, B0); PG8_MMA(0, 1, At, B1); PG8_BAR; PG8_SCHED;
            PG8_LDA(At, 1, 1); PG8_STAGE(PG8_SB(1, 0), b3, voffB); PG8_STAGE(PG8_SB(1, 1), b3 + hstep, voffB); PG8_STAGE(PG8_SA(1, 0), a3, voffA);
            PG8_WAIT_V(8); PG8_WAIT_L(0); PG8_BAR; PG8_MMA(1, 0, At, B0); PG8_MMA(1, 1, At, B1); PG8_BAR; PG8_SCHED;
            } else {
            PG8_LDB(B0, 0, 0); PG8_SCHED; PG8_LDA(At, 0, 0); PG8_STAGE(PG8_SA(1, 1), a1 + hstep, voffA);
            PG8_WAIT_L(8); PG8_BAR; PG8_WAIT_L(0); PG8_MMA(0, 0, At, B0); PG8_BAR; PG8_SCHED;
            PG8_LDB(B1, 0, 1); PG8_STAGE(PG8_SB(0, 0), b2, voffB);
            PG8_BAR; PG8_WAIT_L(0); PG8_MMA(0, 1, At, B1); PG8_BAR;
            PG8_LDA(At, 0, 1); PG8_STAGE(PG8_SA(0, 0), a2, voffA);
            PG8_BAR; PG8_WAIT_L(0); PG8_MMA(1, 0, At, B0); PG8_BAR; PG8_SCHED;
            PG8_STAGE(PG8_SB(0, 1), b2 + hstep, voffB);
            PG8_WAIT_V(6); PG8_BAR; PG8_MMA(1, 1, At, B1); PG8_BAR;
            PG8_LDB(B0, 1, 0); PG8_SCHED; PG8_LDA(At, 1, 0); PG8_STAGE(PG8_SA(0, 1), a2 + hstep, voffA);
            PG8_WAIT_L(8); PG8_BAR; PG8_WAIT_L(0); PG8_MMA(0, 0, At, B0); PG8_BAR; PG8_SCHED;
            PG8_LDB(B1, 1, 1); PG8_STAGE(PG8_SB(1, 0), b3, voffB);
            PG8_BAR; PG8_WAIT_L(0); PG8_MMA(0, 1, At, B1); PG8_BAR;
            PG8_LDA(At, 1, 1); PG8_STAGE(PG8_SA(1, 0), a3, voffA);
            PG8_BAR; PG8_WAIT_L(0); PG8_MMA(1, 0, At, B0); PG8_BAR; PG8_SCHED;
            PG8_STAGE(PG8_SB(1, 1), b3 + hstep, voffB);
            PG8_WAIT_V(6); PG8_BAR; PG8_MMA(1, 1, At, B1); PG8_BAR;
            }
        }
        if constexpr (ALIGN_EPI) { if (wr == 0) PG8_BAR; }
        if constexpr (!Epi::AFTER_DRAIN) { E(acc, cur, wr, wc, fr, fq); S.done(cur); }
        if (!has_next) break;
#pragma unroll
        for (int a = 0; a < 2; ++a)
#pragma unroll
            for (int b = 0; b < 2; ++b)
#pragma unroll
                for (int m = 0; m < 4; ++m)
#pragma unroll
                    for (int n = 0; n < 2; ++n) acc[a][b][m][n] = (f32x4){0.f, 0.f, 0.f, 0.f};
        cur = nxt; cA = nA; cB = nB; ++ui;
        if constexpr (ALIGN_EPI) { if (wr == 1) PG8_BAR; }
    }
    PG8_WAIT_V(0);
    if constexpr (!ALIGN_EPI) { if (wr == 0) PG8_BAR; }
    PG8_BAR;
    if constexpr (Epi::AFTER_DRAIN) { E.fused(acc, cur, wr, wc, fr, fq, lds, wid, lane); S.done(cur); }
#undef PG8_SA
#undef PG8_SB
#undef PG8_STAGE
#undef PG8_LDA
#undef PG8_LDB
#undef PG8_MMA
#undef PG8_WAIT_V
#undef PG8_WAIT_L
#undef PG8_BAR
#undef PG8_SCHED
}
}

constexpr int NWAVES = 8;
constexpr int NB = 2, SEQ = 8192, DM = 1024, MR = NB * SEQ;
constexpr int NMETA = 16, INW = 7688, NPROJ = 7680;
constexpr int AH = 8, ADH = 64, AWID = 512, KROWS = SEQ + 128;
constexpr int HH = 8, HK = 128, HV = 128, HROWS = SEQ + 64, NCH = 129;
constexpr int NE = 32, EFF = 512, APAD = 40960;
constexpr float EPS = 1e-6f;
constexpr int N_LAUNCHES = MK_N_LAUNCHES;
constexpr int NPHASE = 12;

constexpr size_t MiB = 1u << 20;
constexpr size_t WS_CTL = 0, CTL_ZERO_BYTES = 1 * MiB;
constexpr size_t WS_WIN = 1 * MiB, WS_WA = 16 * MiB, WS_WH = 17 * MiB, WS_WO = 19 * MiB;
constexpr size_t WS_LFA = 21 * MiB, WS_LFAM = WS_LFA + 512 * 1024, WS_CL = 22 * MiB, WS_ASG = 23 * MiB, WS_GATE = WS_ASG + 128 * 1024, WS_SLOT = WS_GATE + 128 * 1024, WS_TR = 24 * MiB;
constexpr size_t WS_U = 26 * MiB;
constexpr size_t WS_OA = 26 * MiB;
constexpr size_t WS_QA = 58 * MiB, WS_KA = 74 * MiB, WS_VA = 90 * MiB + 512 * 1024;
constexpr size_t WS_QH = 107 * MiB, WS_EB = 139 * MiB, WS_KT = 171 * MiB, WS_KD = 203 * MiB, WS_VH = 235 * MiB + 512 * 1024;
constexpr size_t WS_GH = 268 * MiB, WS_GA = 300 * MiB, WS_GT = 332 * MiB;
constexpr size_t WS_US = 364 * MiB;
constexpr size_t WS_OH = 429 * MiB;
constexpr size_t WS_YA = 107 * MiB;
constexpr size_t WS_MIX = 171 * MiB;
constexpr size_t WS_XN = 26 * MiB, WS_WE1 = 58 * MiB, WS_WE2 = 122 * MiB, WS_XS = 154 * MiB, WS_ACT = 234 * MiB, WS_Y = 274 * MiB;
constexpr size_t WS_END = 461 * MiB;
static_assert(WS_KA + (size_t)2 * KROWS * AWID * 2 <= WS_VA && WS_VA + (size_t)2 * KROWS * AWID * 2 <= WS_QH && WS_KD + (size_t)2 * HROWS * DM * 2 <= WS_VH && WS_VH + (size_t)2 * HROWS * DM * 2 <= WS_GH, "ws map");
static_assert(WS_US + (size_t)16 * NCH * HK * HV * 2 <= WS_OH && WS_OH + (size_t)MR * DM * 2 <= WS_END && WS_Y + (size_t)APAD * DM * 2 <= WS_END && WS_XS + (size_t)APAD * DM * 2 <= WS_ACT && WS_ACT + (size_t)APAD * EFF * 2 <= WS_Y, "ws map 2");
constexpr int CW_TMO = 0, CW_CODE = 1;
constexpr int CW_CNT = 8192;
constexpr int CW_NT = 2048;
constexpr int CW_TILEE = 2112;
constexpr int CW_BAR = 4096;

constexpr int RING_OFF = 0, RING_BYTES = 147456;
constexpr int LDSCTL_OFF = RING_BYTES, MISC_OFF = LDSCTL_OFF + 320;
constexpr int LDS_BYTES = 148480;

#define GAS __attribute__((address_space(1)))
#define LAS __attribute__((address_space(3)))
typedef unsigned short bf16;
typedef unsigned v4u __attribute__((ext_vector_type(4)));
typedef unsigned v2u __attribute__((ext_vector_type(2)));
typedef float f32x4 __attribute__((ext_vector_type(4)));
typedef short bf16x8 __attribute__((ext_vector_type(8)));
typedef GAS unsigned gu32;
typedef GAS unsigned long long gu64;
#define RLX_AGENT __ATOMIC_RELAXED, __HIP_MEMORY_SCOPE_AGENT
#define LDS_WAIT() asm volatile("s_waitcnt lgkmcnt(0)" ::: "memory")
#define VM_WAIT() asm volatile("s_waitcnt vmcnt(0)" ::: "memory")
__device__ __forceinline__ unsigned f2bf(float f) { unsigned u = __builtin_bit_cast(unsigned, f); return (u + 0x7fffu + ((u >> 16) & 1u)) >> 16; }
__device__ __forceinline__ unsigned pk2(float lo, float hi) { return f2bf(lo) | (f2bf(hi) << 16); }
__device__ __forceinline__ float bf2f(unsigned short h) { return __builtin_bit_cast(float, (unsigned)h << 16); }
__device__ __forceinline__ float blo(unsigned w) { return __builtin_bit_cast(float, w << 16); }
__device__ __forceinline__ float bhi(unsigned w) { return __builtin_bit_cast(float, w & 0xffff0000u); }
__device__ __forceinline__ float ex2(float x) { return __builtin_amdgcn_exp2f(x); }
__device__ __forceinline__ float sigm(float x) { return __builtin_amdgcn_rcpf(1.0f + ex2(-1.4426950408889634f * x)); }
__device__ __forceinline__ unsigned ald(const unsigned* p) { return __hip_atomic_load(p, __ATOMIC_RELAXED, __HIP_MEMORY_SCOPE_AGENT); }
__device__ __forceinline__ float aldf(const float* p) { return __builtin_bit_cast(float, __hip_atomic_load((const unsigned*)p, __ATOMIC_RELAXED, __HIP_MEMORY_SCOPE_AGENT)); }
__device__ __forceinline__ float log_sigmoid(float z) { const float a = fabsf(z); return fminf(z, 0.f) - __logf(1.0f + __expf(-a)); }

namespace attn_body {
using bf16=__hip_bfloat16;
using bf16x8=__attribute__((ext_vector_type(8)))short;
using s16x4=__attribute__((ext_vector_type(4)))short;
using f32x16=__attribute__((ext_vector_type(16)))float;
using u32x4=__attribute__((ext_vector_type(4)))unsigned;
using f32x4g=__attribute__((ext_vector_type(4)))float;
constexpr int BATCH=2,NHEAD=8,SEQ=8192,D=64,DM=NHEAD*D;
constexpr int KFRONT=128,KSEQ=SEQ+KFRONT;
constexpr int NW=8,QBLK=32,QB=QBLK*NW,KVBLK=64,NQB=SEQ/QB;
constexpr int ATTN_PITCH=DM, ATTN_UNIT_ROWS=QB;
__device__ __forceinline__ int crow(int r,int hi){return (r&3)+8*(r>>2)+4*hi;}
#define SBAR() __builtin_amdgcn_sched_barrier(0)
__device__ __forceinline__ void cmask(f32x16&p0,f32x16&p1,int jb,int qrel,int hi){
  const float NEG=-INFINITY; int kb=64*jb+4*hi;
  #pragma unroll
  for(int r=0;r<16;++r){int kv=kb+(r&3)+8*(r>>2); if(kv>qrel)p0[r]=NEG; if(kv+32>qrel)p1[r]=NEG;}
}

constexpr int NSLOT=3, SLOTB=8192;
constexpr int LDS_K=0, LDS_V=NSLOT*SLOTB, LDS_WS=2*NSLOT*SLOTB, LDS_OST=LDS_WS+NW*64*4, LDS_CLK=LDS_OST+NW*4096, LDS_BYTES=LDS_CLK+KSEQ*4;
constexpr float C2=0.125f*1.4426950408889634f;
__device__ __forceinline__ void glds16s(unsigned voff,const void*sbase,unsigned lds_dst){unsigned keep;
  asm volatile("s_mov_b32 %0, m0\n\ts_mov_b32 m0, %3\n\ts_nop 0\n\tglobal_load_lds_dwordx4 %1, %2\n\ts_mov_b32 m0, %0":"=&s"(keep):"v"(voff),"s"(sbase),"s"(lds_dst):"memory");}
__device__ __forceinline__ void glds16(const void*gsrc,unsigned lds_dst){unsigned keep;
  asm volatile("s_mov_b32 %0, m0\n\ts_mov_b32 m0, %2\n\ts_nop 0\n\tglobal_load_lds_dwordx4 %1, off\n\ts_mov_b32 m0, %0":"=&s"(keep):"v"(gsrc),"s"(lds_dst):"memory");}
__device__ __forceinline__ float max3f(float a,float b,float c){float r;asm("v_max3_f32 %0, %1, %2, %3":"=v"(r):"v"(a),"v"(b),"v"(c));return r;}
__device__ __forceinline__ float max2f(float a,float b){float r;asm("v_max_f32_e32 %0, %1, %2":"=v"(r):"v"(a),"v"(b));return r;}
__device__ __forceinline__ float fadd_s(float a,float b){float r;asm("v_add_f32_e32 %0, %1, %2":"=v"(r):"v"(a),"v"(b));return r;}
__device__ __forceinline__ float fsub_s(float a,float b){float r;asm("v_sub_f32_e32 %0, %1, %2":"=v"(r):"v"(a),"v"(b));return r;}
typedef float f32x2_t __attribute__((ext_vector_type(2))); typedef __bf16 bf16x2_t __attribute__((ext_vector_type(2)));
__device__ __forceinline__ unsigned cvtpk_s(float lo,float hi){f32x2_t v={lo,hi};bf16x2_t b=__builtin_convertvector(v,bf16x2_t);return __builtin_bit_cast(unsigned,b);}
#define WAIT_BAR(N) asm volatile("s_waitcnt vmcnt(" #N ") lgkmcnt(0)\n\ts_barrier":::"memory")

__device__ __forceinline__ void qkt(f32x16&p0,f32x16&p1,const char*Kslot,const bf16x8*qr,int r32,int hi){
  const char*kb=Kslot+hi*1024+r32*16;
  #pragma unroll
  for(int d0=0;d0<4;++d0){
    const bf16x8 b0=*reinterpret_cast<const bf16x8*>(kb+d0*2048);
    const bf16x8 b1=*reinterpret_cast<const bf16x8*>(kb+d0*2048+512);
    p0=__builtin_amdgcn_mfma_f32_32x32x16_bf16(b0,qr[d0],p0,0,0,0);p1=__builtin_amdgcn_mfma_f32_32x32x16_bf16(b1,qr[d0],p1,0,0,0);}
}
typedef __attribute__((address_space(3))) const char* lds_cptr;
typedef short v4i16_t __attribute__((ext_vector_type(4)));
__device__ __forceinline__ void kload8(bf16x8*kf,lds_cptr kp){
  kf[0]=*(const __attribute__((address_space(3))) bf16x8*)(kp);      kf[1]=*(const __attribute__((address_space(3))) bf16x8*)(kp+512);
  kf[2]=*(const __attribute__((address_space(3))) bf16x8*)(kp+2048); kf[3]=*(const __attribute__((address_space(3))) bf16x8*)(kp+2560);
  kf[4]=*(const __attribute__((address_space(3))) bf16x8*)(kp+4096); kf[5]=*(const __attribute__((address_space(3))) bf16x8*)(kp+4608);
  kf[6]=*(const __attribute__((address_space(3))) bf16x8*)(kp+6144); kf[7]=*(const __attribute__((address_space(3))) bf16x8*)(kp+6656);
}
__device__ __forceinline__ void kload2(bf16x8*kf,lds_cptr kp,int j){ kf[2*j]=*(const __attribute__((address_space(3))) bf16x8*)(kp+j*2048); kf[2*j+1]=*(const __attribute__((address_space(3))) bf16x8*)(kp+j*2048+512); }
__device__ __forceinline__ s16x4 vtr(lds_cptr p){ return __builtin_bit_cast(s16x4,__builtin_amdgcn_ds_read_tr16_b64_v4i16((__attribute__((address_space(3))) v4i16_t*)p)); }
__device__ __forceinline__ float rowmax(const f32x16&p0,const f32x16&p1){
  float a=max3f(p0[0],p0[1],p1[0]),b=max3f(p0[2],p0[3],p1[1]);a=max3f(a,p1[2],p1[3]);
  #pragma unroll
  for(int r=4;r<16;r+=4){a=max3f(a,p0[r],p0[r+1]);b=max3f(b,p0[r+2],p0[r+3]);a=max3f(a,p1[r],p1[r+1]);b=max3f(b,p1[r+2],p1[r+3]);}
  const float m=max2f(a,b);
  auto rr=__builtin_amdgcn_permlane32_swap(__float_as_uint(m),__float_as_uint(m),false,false);
  return max2f(__uint_as_float(rr[0]),__uint_as_float(rr[1]));
}
__device__ __forceinline__ void pv(f32x16*o,int vb,bf16x8 pa0,bf16x8 pa1,bf16x8 pa2,bf16x8 pa3){
  #pragma unroll
  for(int d0=0;d0<2;++d0){s16x4 lo[4],hi[4];
    #pragma unroll
    for(int ks=0;ks<4;++ks){
      asm volatile("ds_read_b64_tr_b16 %0,%1 offset:%c2":"=&v"(lo[ks]):"v"(vb),"i"(d0*4096+ks*1024):"memory");
      asm volatile("ds_read_b64_tr_b16 %0,%1 offset:%c2":"=&v"(hi[ks]):"v"(vb),"i"(d0*4096+ks*1024+512):"memory");}
    asm volatile("s_waitcnt lgkmcnt(0)":::"memory");SBAR();
    #define PK(k) (bf16x8){lo[k][0],lo[k][1],lo[k][2],lo[k][3],hi[k][0],hi[k][1],hi[k][2],hi[k][3]}
    o[d0]=__builtin_amdgcn_mfma_f32_32x32x16_bf16(pa0,PK(0),o[d0],0,0,0);
    o[d0]=__builtin_amdgcn_mfma_f32_32x32x16_bf16(pa1,PK(1),o[d0],0,0,0);
    o[d0]=__builtin_amdgcn_mfma_f32_32x32x16_bf16(pa2,PK(2),o[d0],0,0,0);
    o[d0]=__builtin_amdgcn_mfma_f32_32x32x16_bf16(pa3,PK(3),o[d0],0,0,0);
    #undef PK
  }
}

#ifndef ATTN_STORE16
#define ATTN_STORE16(p,v) (*(u32x4*)(p)=(v))
#endif
template<int THRL> __device__ __forceinline__ void attn_unit(int b,int h,int qb,const bf16*Q,const bf16*__restrict__ K,const bf16*__restrict__ V,bf16*O,const float*CLg,char*shm){
  int tid_l=threadIdx.x; asm volatile("":"+v"(tid_l)); const int tid=tid_l,lane=tid&63,r32=lane&31,hi=lane>>5; const int wid=__builtin_amdgcn_readfirstlane(tid>>6);
  const long rowbase=(long)b*SEQ; const int q0=qb*QB;
  const bf16*Qw=Q+(rowbase+q0+wid*QBLK)*DM+h*D;
  const bf16*Kh=K+(long)b*KSEQ*DM+h*D,*Vh=V+(long)b*KSEQ*DM+h*D;
  const unsigned lds0=(unsigned)(uintptr_t)shm;
  float*wsf=(float*)(shm+LDS_WS)+wid*64;
  const unsigned koff=(unsigned)((lane*DM+wid*8)*2);
  const unsigned voff=(unsigned)(((16*(wid&3)+(lane>>2))*DM+(wid>>2)*32+(lane&3)*8)*2);
  const unsigned kdst=lds0+LDS_K+wid*1024, vdst=lds0+LDS_V+wid*1024;
  #define DMA_K(t,slot) glds16s(koff,Kh+(long)(t)*KVBLK*DM,(unsigned)__builtin_amdgcn_readfirstlane(kdst+(slot)))
  #define DMA_V(t,slot) glds16s(voff,Vh+(long)(t)*KVBLK*DM,(unsigned)__builtin_amdgcn_readfirstlane(vdst+(slot)))
  const int vb0=(int)(lds0+LDS_V)+((lane>>4)&1)*32+(lane&3)*8+(4*hi+((lane&15)>>2))*64;
  const char*Kbase=shm+LDS_K; bf16x8 kf[8];
  const lds_cptr shm3=(lds_cptr)shm; const lds_cptr kp0=shm3+LDS_K+hi*1024+r32*16; const lds_cptr vp0=shm3+LDS_V+((lane>>4)&1)*32+(lane&3)*8+(4*hi+((lane&15)>>2))*64;
  const int NT=(KFRONT+q0+QB)/KVBLK;
  DMA_K(0,0);DMA_V(0,0);DMA_K(1,SLOTB);
  bf16x8 qr[4];
  #pragma unroll
  for(int d0=0;d0<4;++d0)qr[d0]=*reinterpret_cast<const bf16x8*>(&Qw[(long)r32*DM+d0*16+hi*8]);
  { const f32x4g*src=(const f32x4g*)CLg; __attribute__((address_space(3))) f32x4g*dst=(__attribute__((address_space(3))) f32x4g*)(shm3+LDS_CLK);
    for(int i=tid;i<NT*16;i+=NW*64)dst[i]=src[i]; }
  const float clq=CLg[KFRONT+q0+wid*QBLK+r32];
  const __attribute__((address_space(3))) float*clkp=(const __attribute__((address_space(3))) float*)(shm3+LDS_CLK)+4*hi;
  float mhat=0.f,l_reg=0.f;f32x16 o[2];o[0]=f32x16{};o[1]=f32x16{};
  const int qrel=wid*QBLK+r32;
  #define CMASK(P0,P1,t) do{int jb_=(t)-(NT-4); if(jb_>=0)cmask(P0,P1,jb_,qrel,hi);}while(0)
  #define BRD(X0,X1,tt) do{ const __attribute__((address_space(3))) float*c_=clkp+(tt)*KVBLK; \
    _Pragma("unroll") for(int g_=0;g_<4;++g_){ const f32x4g a_=*(const __attribute__((address_space(3))) f32x4g*)(c_+8*g_), b_=*(const __attribute__((address_space(3))) f32x4g*)(c_+32+8*g_); \
      X0[4*g_]=a_.x;X0[4*g_+1]=a_.y;X0[4*g_+2]=a_.z;X0[4*g_+3]=a_.w; X1[4*g_]=b_.x;X1[4*g_+1]=b_.y;X1[4*g_+2]=b_.z;X1[4*g_+3]=b_.w; } }while(0)
  #define BSUB(X,g,nb) do{ X[4*(g)]=(nb)-X[4*(g)]; X[4*(g)+1]=(nb)-X[4*(g)+1]; X[4*(g)+2]=(nb)-X[4*(g)+2]; X[4*(g)+3]=(nb)-X[4*(g)+3]; }while(0)
  #define BFULL(X0,X1,tt,nb) do{ BRD(X0,X1,tt); _Pragma("unroll") for(int g_=0;g_<4;++g_){ BSUB(X0,g_,nb); BSUB(X1,g_,nb); } }while(0)
  bool resc=false;
  #define START(P0,P1) do{ const float rm=rowmax(P0,P1); resc=false; \
    { const float dl=rm; mhat=fadd_s(mhat,dl); \
      _Pragma("unroll") for(int r=0;r<16;++r){P0[r]=fsub_s(P0[r],dl);P1[r]=fsub_s(P1[r],dl);} } \
    _Pragma("unroll") for(int r=0;r<16;++r)P0[r]=__builtin_amdgcn_exp2f(P0[r]); }while(0)
  #define RESC() do{ if(resc){ asm volatile("s_waitcnt lgkmcnt(0)":::"memory"); \
      _Pragma("unroll") for(int d_=0;d_<2;++d_) _Pragma("unroll") for(int r=0;r<16;++r)o[d_][r]*=wsf[crow(r,hi)]; } }while(0)
  f32x16 pA0,pA1,pB0,pB1;
  int sl_prev=0,sl_cur=0,sl_next=SLOTB;
  #define ROT() do{sl_prev=sl_cur;sl_cur=sl_next;sl_next=(sl_next==(NSLOT-1)*SLOTB)?0:sl_next+SLOTB;}while(0)
  DMA_K(2,2*SLOTB);
  WAIT_BAR(3);
  BFULL(pA0,pA1,0,clq);
  qkt(pA0,pA1,Kbase,qr,r32,hi);asm volatile("s_nop 15\n\ts_nop 7":"+v"(pA0),"+v"(pA1));CMASK(pA0,pA1,0);
  START(pA0,pA1);
  { const float nb0_=clq-mhat; BFULL(pB0,pB1,1,nb0_); }
  _Pragma("unroll") for(int r=0;r<16;++r)pA1[r]=__builtin_amdgcn_exp2f(pA1[r]);
  WAIT_BAR(0);
  DMA_K(3,0);DMA_V(1,SLOTB);
  ROT();
  kload8(kf,kp0+sl_cur);
  WAIT_BAR(2);
  s16x4 vlo[8],vhi[8]; u32x4 pw0,pw1,pw2,pw3;
  #define PKW(P,B) cvtpk_s(P[B],P[B+1])
  #define PAF(k) __builtin_bit_cast(bf16x8,pw##k)
  #define VFR(i) (bf16x8){vlo[i][0],vlo[i][1],vlo[i][2],vlo[i][3],vhi[i][0],vhi[i][1],vhi[i][2],vhi[i][3]}
  #define PIN(x) asm volatile("":"+v"(x))
  #define MX3(a,b,c) __builtin_fmaxf(__builtin_fmaxf((a),(b)),(c))
  #define GAPA(MF,A0,A1,A2,A3,W0,W1,PW) do{ MF; sacc+=A0; sacc+=A1; sacc+=A2; sacc+=A3; PIN(sacc); W0; W1; PIN(PW); SBAR(); }while(0)
  #define EX(v) __builtin_amdgcn_exp2f(v)
  #define GAPB(MF,X,B,G,PX,g,OFS) do{ f32x4g c4_; if(G){ c4_=*(const __attribute__((address_space(3))) f32x4g*)(cn_+(OFS)+8*(g)); } MF; X[B]=EX(X[B]); X[B+1]=EX(X[B+1]); X[B+2]=EX(X[B+2]); X[B+3]=EX(X[B+3]); PIN(X); \
    if(G){ PX[4*(g)]=nb_-c4_.x; PX[4*(g)+1]=nb_-c4_.y; PX[4*(g)+2]=nb_-c4_.z; PX[4*(g)+3]=nb_-c4_.w; PIN(PX); } SBAR(); }while(0)
  #define VRD(i) do{ vlo[i]=vtr(vp_+(((i)>>2)*4096+((i)&3)*1024)); vhi[i]=vtr(vp_+(((i)>>2)*4096+((i)&3)*1024+512)); }while(0)
  #define KRD(G,j) do{ if(G){ kload2(kf,kp0+sl_next,j); SBAR(); } }while(0)
  #define STEP(C0,C1,P0,P1,t,GK,GV,GL) do{ SBAR(); \
    const lds_cptr vp_=vp0+sl_prev; \
    VRD(0); SBAR(); float sacc=(P0[0]+P0[1]); \
    GAPA(C0=__builtin_amdgcn_mfma_f32_32x32x16_bf16(kf[0],qr[0],C0,0,0,0), P0[2],P0[3],P0[4],P0[5],     pw0[0]=PKW(P0,0), pw0[1]=PKW(P0,2), pw0); \
    VRD(4); SBAR(); GAPA(C1=__builtin_amdgcn_mfma_f32_32x32x16_bf16(kf[1],qr[0],C1,0,0,0), P0[6],P0[7],P0[8],P0[9],     pw0[2]=PKW(P0,4), pw0[3]=PKW(P0,6), pw0); \
    VRD(1); SBAR(); GAPA(C0=__builtin_amdgcn_mfma_f32_32x32x16_bf16(kf[2],qr[1],C0,0,0,0),   P0[10],P0[11],P0[12],P0[13], pw1[0]=PKW(P0,8), pw1[1]=PKW(P0,10), pw1); \
    VRD(5); SBAR(); GAPA(C1=__builtin_amdgcn_mfma_f32_32x32x16_bf16(kf[3],qr[1],C1,0,0,0),   P0[14],P0[15],P1[0],P1[1],   pw1[2]=PKW(P0,12),pw1[3]=PKW(P0,14), pw1); \
    VRD(2); SBAR(); GAPA(C0=__builtin_amdgcn_mfma_f32_32x32x16_bf16(kf[4],qr[2],C0,0,0,0),   P1[2],P1[3],P1[4],P1[5],     pw2[0]=PKW(P1,0), pw2[1]=PKW(P1,2), pw2); \
    VRD(6); SBAR(); GAPA(C1=__builtin_amdgcn_mfma_f32_32x32x16_bf16(kf[5],qr[2],C1,0,0,0),   P1[6],P1[7],P1[8],P1[9],     pw2[2]=PKW(P1,4), pw2[3]=PKW(P1,6), pw2); \
    VRD(3); SBAR(); GAPA(C0=__builtin_amdgcn_mfma_f32_32x32x16_bf16(kf[6],qr[3],C0,0,0,0),   P1[10],P1[11],P1[12],P1[13], pw3[0]=PKW(P1,8), pw3[1]=PKW(P1,10), pw3); \
    VRD(7); SBAR(); GAPA(C1=__builtin_amdgcn_mfma_f32_32x32x16_bf16(kf[7],qr[3],C1,0,0,0),   P1[14],P1[15],0.f,0.f,       pw3[2]=PKW(P1,12),pw3[3]=PKW(P1,14), pw3); \
    l_reg+=sacc; \
    if(GK){DMA_K((t)+3,sl_cur);} if(GV){DMA_V((t)+1,sl_next);} \
    CMASK(C0,C1,t); \
    { float a=MX3(C0[0],C0[1],C1[0]),b=MX3(C0[2],C0[3],C1[1]); a=MX3(a,C1[2],C1[3]); \
      _Pragma("unroll") for(int r=4;r<16;r+=4){a=MX3(a,C0[r],C0[r+1]);b=MX3(b,C0[r+2],C0[r+3]);a=MX3(a,C1[r],C1[r+1]);b=MX3(b,C1[r+2],C1[r+3]);} \
      float rm=__builtin_fmaxf(a,b); { auto rr=__builtin_amdgcn_permlane32_swap(__float_as_uint(rm),__float_as_uint(rm),false,false); rm=__builtin_fmaxf(__uint_as_float(rr[0]),__uint_as_float(rr[1])); } \
      resc=false; \
      if(__builtin_expect(__any(rm>(float)THRL),0)){ const float dl=__builtin_fmaxf(rm,0.f); mhat+=dl; \
        _Pragma("unroll") for(int r=0;r<16;++r){C0[r]-=dl;C1[r]-=dl;} \
        const float f=__builtin_amdgcn_exp2f(-dl); l_reg*=f; if(hi==0)wsf[r32]=f; resc=true; } } \
    const float nb_=clq-mhat; const __attribute__((address_space(3))) float*cn_=clkp+((t)+1)*KVBLK; \
    SBAR(); \
    GAPB(o[0]=__builtin_amdgcn_mfma_f32_32x32x16_bf16(PAF(0),VFR(0),o[0],0,0,0), C0,0,GL,P0,0,0); \
    GAPB(o[1]=__builtin_amdgcn_mfma_f32_32x32x16_bf16(PAF(0),VFR(4),o[1],0,0,0), C0,4,GL,P0,1,0); \
    KRD(GL,0); GAPB(o[0]=__builtin_amdgcn_mfma_f32_32x32x16_bf16(PAF(1),VFR(1),o[0],0,0,0), C0,8,GL,P0,2,0); \
    KRD(GL,1); GAPB(o[1]=__builtin_amdgcn_mfma_f32_32x32x16_bf16(PAF(1),VFR(5),o[1],0,0,0), C0,12,GL,P0,3,0); \
    KRD(GL,2); GAPB(o[0]=__builtin_amdgcn_mfma_f32_32x32x16_bf16(PAF(2),VFR(2),o[0],0,0,0), C1,0,GL,P1,0,32); \
    KRD(GL,3); GAPB(o[1]=__builtin_amdgcn_mfma_f32_32x32x16_bf16(PAF(2),VFR(6),o[1],0,0,0), C1,4,GL,P1,1,32); \
    GAPB(o[0]=__builtin_amdgcn_mfma_f32_32x32x16_bf16(PAF(3),VFR(3),o[0],0,0,0), C1,8,GL,P1,2,32); \
    GAPB(o[1]=__builtin_amdgcn_mfma_f32_32x32x16_bf16(PAF(3),VFR(7),o[1],0,0,0), C1,12,GL,P1,3,32); \
    }while(0)
  int t=1;
  #undef CMASK
  #define CMASK(P0,P1,t) do{}while(0)
  for(;t+5<NT;t+=2){
    STEP(pB0,pB1,pA0,pA1,t,true,true,true);     WAIT_BAR(2); RESC(); ROT();
    STEP(pA0,pA1,pB0,pB1,t+1,true,true,true);   WAIT_BAR(2); RESC(); ROT();
  }
  #undef CMASK
  #define CMASK(P0,P1,t) do{int jb_=(t)-(NT-4); if(jb_>=0)cmask(P0,P1,jb_,qrel,hi);}while(0)
  #define ENDW(tt) do{ if((tt)+3<NT){WAIT_BAR(2);} else if((tt)+2<NT){WAIT_BAR(1);} else {WAIT_BAR(0);} }while(0)
  for(;t+1<NT;t+=2){
    STEP(pB0,pB1,pA0,pA1,t,(t+3<NT),(t+1<NT),(t+1<NT));       ENDW(t);   RESC(); ROT();
    STEP(pA0,pA1,pB0,pB1,t+1,(t+4<NT),(t+2<NT),(t+2<NT));     ENDW(t+1); RESC(); ROT();
  }
  STEP(pB0,pB1,pA0,pA1,NT-1,false,false,false); RESC();
  { float sacc=pB0[0]+pB0[1]; _Pragma("unroll") for(int r=2;r<16;++r)sacc+=pB0[r]; _Pragma("unroll") for(int r=0;r<16;++r)sacc+=pB1[r]; l_reg+=sacc;
    pw0=(u32x4){PKW(pB0,0),PKW(pB0,2),PKW(pB0,4),PKW(pB0,6)};pw1=(u32x4){PKW(pB0,8),PKW(pB0,10),PKW(pB0,12),PKW(pB0,14)};pw2=(u32x4){PKW(pB1,0),PKW(pB1,2),PKW(pB1,4),PKW(pB1,6)};pw3=(u32x4){PKW(pB1,8),PKW(pB1,10),PKW(pB1,12),PKW(pB1,14)};
    SBAR(); pv(o,vb0+sl_cur,PAF(0),PAF(1),PAF(2),PAF(3)); }
  #undef PKW
  #undef PAF
  #undef VFR
  #undef PIN
  #undef MX3
  #undef GAPA
  #undef GAPB
  #undef EX
  #undef VRD
  #undef KRD
  #undef STEP
  #undef ENDW
  {auto rr=__builtin_amdgcn_permlane32_swap(__float_as_uint(l_reg),__float_as_uint(l_reg),false,false);l_reg=__uint_as_float(rr[0])+__uint_as_float(rr[1]);}
  if(hi==0)wsf[32+r32]=l_reg;asm volatile("s_waitcnt lgkmcnt(0)":::"memory");
  float rli[16];
  #pragma unroll
  for(int r=0;r<16;++r)rli[r]=__builtin_amdgcn_rcpf(wsf[32+crow(r,hi)]);
  bf16*Ow=O+(rowbase+q0+wid*QBLK)*DM+h*D;
  { bf16*stg=(bf16*)(shm+LDS_OST)+wid*2048;
    #pragma unroll
    for(int r=0;r<16;++r){const int orow=crow(r,hi);
      #pragma unroll
      for(int d0=0;d0<2;++d0)stg[orow*64+d0*32+r32]=__float2bfloat16(o[d0][r]*rli[r]);}
    asm volatile("s_waitcnt lgkmcnt(0)":::"memory");
    #pragma unroll
    for(int i=0;i<4;++i){const int row=i*8+(lane>>3),ch=lane&7; const u32x4 v=*(const u32x4*)(stg+row*64+ch*8); ATTN_STORE16(Ow+(long)row*DM+ch*8,v);} }
  asm volatile("s_waitcnt lgkmcnt(0)\n\ts_barrier":::"memory");
  #undef BRD
  #undef BSUB
  #undef BFULL
  #undef DMA_K
  #undef DMA_V
  #undef CMASK
  #undef START
  #undef RESC
  #undef ROT
}
constexpr int ATTN_LDS_BYTES=LDS_BYTES;
#undef SBAR
#undef WAIT_BAR
}
namespace hg {
using attn_body::bf16x8; using attn_body::s16x4; using attn_body::f32x16; using attn_body::u32x4; using attn_body::lds_cptr; using attn_body::vtr; using attn_body::cvtpk_s;
typedef unsigned short us16;
typedef unsigned u32x2h __attribute__((ext_vector_type(2)));
#define HLAS __attribute__((address_space(3)))
constexpr int RS = 272;
constexpr int HC_QE = 0, HC_KT = 64 * RS, HC_V = 2 * 64 * RS, HC_ST = HC_V + 16384, HC_PS = HC_ST + 128 * RS, HC_END = HC_PS + 1024;
__device__ __forceinline__ float blo_(unsigned w) { return __builtin_bit_cast(float, w << 16); }
__device__ __forceinline__ float bhi_(unsigned w) { return __builtin_bit_cast(float, w & 0xffff0000u); }
__device__ __forceinline__ bf16x8 trfrag(lds_cptr blk, int s0, int lane) {
    const int hh = lane >> 5; const lds_cptr p = blk + ((lane >> 4) & 1) * 32 + (lane & 3) * 8 + (s0 + 4 * hh + ((lane & 15) >> 2)) * 64;
    const s16x4 lo = vtr(p), hi = vtr(p + 512);
    return (bf16x8){lo[0], lo[1], lo[2], lo[3], hi[0], hi[1], hi[2], hi[3]};
}
__device__ __forceinline__ void hgrn_a(int item, const us16* KD, const us16* VH, us16* UST, HLAS unsigned char* lds) {
    int tid_l = threadIdx.x; asm volatile("" : "+v"(tid_l)); const int tid = tid_l, lane = tid & 63, wid = __builtin_amdgcn_readfirstlane(tid >> 6), hh = lane >> 5;
    const int bh = item / 129, c = item % 129, b = bh >> 3, h = bh & 7;
    const lds_cptr KDi = (lds_cptr)lds, Vi = (lds_cptr)lds + 16384;
    __syncthreads();
    { const int r = tid >> 3, cc = (tid & 7) * 16; const size_t g = ((size_t)b * 8256 + 64 * c + r) * 1024 + h * 128 + cc;
#pragma unroll
      for (int q2 = 0; q2 < 2; ++q2) { const int off = (cc >> 5) * 4096 + r * 64 + ((cc & 31) + 8 * q2) * 2;
          *(HLAS u32x4*)(lds + off) = *(const u32x4*)(KD + g + 8 * q2); *(HLAS u32x4*)(lds + 16384 + off) = *(const u32x4*)(VH + g + 8 * q2); } }
    __syncthreads();
    const int kt = wid >> 1, vt0 = (wid & 1) * 2;
    f32x16 acc0 = {}, acc1 = {};
#pragma unroll
    for (int ks = 0; ks < 4; ++ks) {
        const bf16x8 a = trfrag(KDi + kt * 4096, 16 * ks, lane), b0 = trfrag(Vi + vt0 * 4096, 16 * ks, lane), b1 = trfrag(Vi + (vt0 + 1) * 4096, 16 * ks, lane);
        acc0 = __builtin_amdgcn_mfma_f32_32x32x16_bf16(a, b0, acc0, 0, 0, 0); acc1 = __builtin_amdgcn_mfma_f32_32x32x16_bf16(a, b1, acc1, 0, 0, 0);
    }
    us16* dst = UST + (size_t)item * 16384 + (size_t)(32 * vt0 + (lane & 31)) * 128 + 32 * kt + 4 * hh;
#pragma unroll
    for (int g = 0; g < 4; ++g) {
        u32x2h w; w.x = cvtpk_s(acc0[4 * g], acc0[4 * g + 1]); w.y = cvtpk_s(acc0[4 * g + 2], acc0[4 * g + 3]); *(u32x2h*)(dst + 8 * g) = w;
        w.x = cvtpk_s(acc1[4 * g], acc1[4 * g + 1]); w.y = cvtpk_s(acc1[4 * g + 2], acc1[4 * g + 3]); *(u32x2h*)(dst + 32 * 128 + 8 * g) = w;
    }
}
__device__ __forceinline__ void hgrn_c(int item, const us16* QH, const us16* EB, const us16* KT, const us16* VH, const us16* GH, const us16* UST, us16* OH, const float* hnw, float eps, HLAS unsigned char* lds) {
    int tid_l = threadIdx.x; asm volatile("" : "+v"(tid_l)); const int tid = tid_l, lane = tid & 63, wid = __builtin_amdgcn_readfirstlane(tid >> 6), hh = lane >> 5, r32 = lane & 31;
    const int bh = item >> 7, c = (item & 127) + 1, b = bh >> 3, h = bh & 7;
    const size_t r0 = (size_t)b * 8192 + 64 * (c - 1);
    const lds_cptr L = (lds_cptr)lds;
    __syncthreads();
    { const int r = tid >> 3, cc = (tid & 7) * 16; const size_t g = (r0 + r) * 1024 + h * 128 + cc, gv = ((size_t)b * 8256 + 64 * c + r) * 1024 + h * 128 + cc;
#pragma unroll
      for (int q2 = 0; q2 < 2; ++q2) {
          const u32x4 a = *(const u32x4*)(QH + g + 8 * q2), e = *(const u32x4*)(EB + g + 8 * q2);
          u32x4 w; w.x = cvtpk_s(blo_(a.x) * blo_(e.x), bhi_(a.x) * bhi_(e.x)); w.y = cvtpk_s(blo_(a.y) * blo_(e.y), bhi_(a.y) * bhi_(e.y));
          w.z = cvtpk_s(blo_(a.z) * blo_(e.z), bhi_(a.z) * bhi_(e.z)); w.w = cvtpk_s(blo_(a.w) * blo_(e.w), bhi_(a.w) * bhi_(e.w));
          *(HLAS u32x4*)(lds + HC_QE + r * RS + (cc + 8 * q2) * 2) = w;
          *(HLAS u32x4*)(lds + HC_KT + r * RS + (cc + 8 * q2) * 2) = *(const u32x4*)(KT + g + 8 * q2);
          *(HLAS u32x4*)(lds + HC_V + (cc >> 5) * 4096 + r * 64 + ((cc & 31) + 8 * q2) * 2) = *(const u32x4*)(VH + gv + 8 * q2); }
      const us16* sp = UST + ((size_t)bh * 129 + (c - 1)) * 16384;
#pragma unroll
      for (int i = 0; i < 4; ++i) { const int p = tid + 512 * i, row = p >> 4, ch = p & 15; *(HLAS u32x4*)(lds + HC_ST + row * RS + ch * 16) = *(const u32x4*)(sp + row * 128 + ch * 8); } }
    __syncthreads();
    const int tt = wid >> 2, vt = wid & 3;
    f32x16 o = {};
    const lds_cptr qrow = L + HC_QE + (32 * tt + r32) * RS + 16 * hh;
#pragma unroll
    for (int st = 0; st < 2; ++st) {
        if (st <= tt) {
            f32x16 p = {};
            const lds_cptr krow = L + HC_KT + (32 * st + r32) * RS + 16 * hh;
#pragma unroll
            for (int ks = 0; ks < 8; ++ks) { const bf16x8 a = *(const HLAS bf16x8*)(krow + 32 * ks), q = *(const HLAS bf16x8*)(qrow + 32 * ks); p = __builtin_amdgcn_mfma_f32_32x32x16_bf16(a, q, p, 0, 0, 0); }
            if (st == tt) {
#pragma unroll
                for (int r = 0; r < 16; ++r) { const int s = (r & 3) + 8 * (r >> 2) + 4 * hh; if (s > r32) p[r] = 0.f; }
            }
            u32x4 pw0, pw1;
            pw0.x = cvtpk_s(p[0], p[1]); pw0.y = cvtpk_s(p[2], p[3]); pw0.z = cvtpk_s(p[4], p[5]); pw0.w = cvtpk_s(p[6], p[7]);
            pw1.x = cvtpk_s(p[8], p[9]); pw1.y = cvtpk_s(p[10], p[11]); pw1.z = cvtpk_s(p[12], p[13]); pw1.w = cvtpk_s(p[14], p[15]);
            const bf16x8 v0 = trfrag(L + HC_V + vt * 4096, 32 * st, lane), v1 = trfrag(L + HC_V + vt * 4096, 32 * st + 16, lane);
            o = __builtin_amdgcn_mfma_f32_32x32x16_bf16(__builtin_bit_cast(bf16x8, pw0), v0, o, 0, 0, 0);
            o = __builtin_amdgcn_mfma_f32_32x32x16_bf16(__builtin_bit_cast(bf16x8, pw1), v1, o, 0, 0, 0);
        }
    }
    { const lds_cptr srow = L + HC_ST + (32 * vt + r32) * RS + 16 * hh;
#pragma unroll
      for (int ks = 0; ks < 8; ++ks) { const bf16x8 a = *(const HLAS bf16x8*)(qrow + 32 * ks), s = *(const HLAS bf16x8*)(srow + 32 * ks); o = __builtin_amdgcn_mfma_f32_32x32x16_bf16(a, s, o, 0, 0, 0); } }
    float sq[16];
#pragma unroll
    for (int r = 0; r < 16; ++r) { float s = o[r] * o[r]; s += __shfl_xor(s, 1); s += __shfl_xor(s, 2); s += __shfl_xor(s, 4); s += __shfl_xor(s, 8); s += __shfl_xor(s, 16); sq[r] = s; }
    if (r32 == 0) {
#pragma unroll
        for (int r = 0; r < 16; ++r) *(HLAS float*)(lds + HC_PS + ((32 * tt + (r & 3) + 8 * (r >> 2) + 4 * hh) * 4 + vt) * 4) = sq[r];
    }
    __syncthreads();
#pragma unroll
    for (int r = 0; r < 16; ++r) { const int t = 32 * tt + (r & 3) + 8 * (r >> 2) + 4 * hh; const attn_body::f32x4g ps = *(const HLAS attn_body::f32x4g*)(lds + HC_PS + t * 16);
        const float rs = 1.0f / sqrtf(((ps.x + ps.y) + (ps.z + ps.w)) * (1.0f / 128.0f) + eps);
        *(HLAS us16*)(lds + HC_QE + t * RS + (32 * vt + r32) * 2) = (us16)(cvtpk_s(o[r] * rs, 0.f) & 0xffffu); }
    __syncthreads();
    { const int r = tid >> 3, cc = (tid & 7) * 16; const size_t go = (r0 + r) * 1024 + h * 128 + cc;
#pragma unroll
      for (int q2 = 0; q2 < 2; ++q2) {
          const u32x4 y = *(const HLAS u32x4*)(lds + HC_QE + r * RS + (cc + 8 * q2) * 2), g = *(const u32x4*)(GH + go + 8 * q2);
          const attn_body::f32x4g w0 = *(const attn_body::f32x4g*)(hnw + cc + 8 * q2), w1 = *(const attn_body::f32x4g*)(hnw + cc + 8 * q2 + 4);
          u32x4 w; w.x = cvtpk_s(blo_(y.x) * w0.x * blo_(g.x), bhi_(y.x) * w0.y * bhi_(g.x)); w.y = cvtpk_s(blo_(y.y) * w0.z * blo_(g.y), bhi_(y.y) * w0.w * bhi_(g.y));
          w.z = cvtpk_s(blo_(y.z) * w1.x * blo_(g.z), bhi_(y.z) * w1.y * bhi_(g.z)); w.w = cvtpk_s(blo_(y.w) * w1.z * blo_(g.w), bhi_(y.w) * w1.w * bhi_(g.w));
          *(u32x4*)(OH + go + 8 * q2) = w; } }
}
#undef HLAS
}
#define XB_TMO      128
#define XB_XCNT(j)  (256  + 64 * (j))
#define XB_XSUB(j)  (1280 + 64 * (j))
#define XB_XGEN(j)  (2304 + 64 * (j))
#define XB_TOP      3328
#define XB_TOPGEN   3392
#define XCD_BAR_WORDS 3456
#define XB_SPIN_CAP (1u << 18)

__device__ __forceinline__ unsigned xb_ld(unsigned* p)              { return __hip_atomic_load(p, __ATOMIC_RELAXED, __HIP_MEMORY_SCOPE_AGENT); }
__device__ __forceinline__ unsigned xb_add(unsigned* p, unsigned v) { return __hip_atomic_fetch_add(p, v, __ATOMIC_RELAXED, __HIP_MEMORY_SCOPE_AGENT); }
__device__ __forceinline__ unsigned xb_xcc_id() { return (unsigned)__builtin_amdgcn_s_getreg((3 << 11) | 20) & 0xFu; }
#define XB_SPIN(cond, bar) do { unsigned _sp = 0; while (cond) { __builtin_amdgcn_s_sleep(1); \
    if ((++_sp & 255u) == 0u) { if (xb_ld(&(bar)[XB_TMO])) break; if (_sp > XB_SPIN_CAP) { atomicAdd(&(bar)[XB_TMO], 1u); break; } } } } while (0)

struct XcdBarrier {
    unsigned* bar; unsigned x;
    volatile LAS unsigned* st;
};

__device__ __forceinline__ XcdBarrier xcd_barrier_post(unsigned* bar, volatile LAS unsigned* st) {
    XcdBarrier b; b.bar = bar; b.x = xb_xcc_id(); b.st = st;
    if (threadIdx.x == 0) (void)xb_add(&bar[XB_XCNT(b.x)], 1u);
    return b;
}
__device__ __forceinline__ void xcd_barrier_complete(unsigned* bar, unsigned x, unsigned& nloc, unsigned& nx) {
    const unsigned G = gridDim.x * gridDim.y * gridDim.z;
    unsigned sum, cnt, mine, sp = 0u;
    for (;;) {
        sum = 0u; cnt = 0u; mine = 0u;
#pragma unroll
        for (unsigned j = 0; j < 16; ++j) { const unsigned c = xb_ld(&bar[XB_XCNT(j)]); sum += c; cnt += (c > 0u) ? 1u : 0u; mine = (j == x) ? c : mine; }
        if (sum == G) break;
        __builtin_amdgcn_s_sleep(1);
        if ((++sp & 255u) == 0u) { if (xb_ld(&bar[XB_TMO])) break; if (sp > XB_SPIN_CAP) { atomicAdd(&bar[XB_TMO], 1u); break; } }
    }
    nloc = mine > 0u ? mine : 1u; nx = cnt > 0u ? cnt : 1u;
}

__device__ __forceinline__ void xcd_barrier(const XcdBarrier& b) {
    asm volatile("s_waitcnt vmcnt(0)" ::: "memory");
    __syncthreads();
    if (threadIdx.x == 0) {
        unsigned* bar = b.bar;
        __builtin_amdgcn_s_waitcnt(0);
        unsigned nloc = b.st[0], nx = b.st[1];
        if (nloc == 0u) { xcd_barrier_complete(bar, b.x, nloc, nx); b.st[0] = nloc; b.st[1] = nx; }
        const unsigned old = xb_add(&bar[XB_XSUB(b.x)], 1u);
        const unsigned gen = old / nloc;
        if (old + 1u == (gen + 1u) * nloc) {
            __builtin_amdgcn_fence(__ATOMIC_RELEASE, "agent");
            asm volatile("s_waitcnt vmcnt(0)" ::: "memory");
            const unsigned og = xb_add(&bar[XB_TOP], 1u);
            const unsigned tg = og / nx;
            if (og + 1u == (tg + 1u) * nx) xb_add(&bar[XB_TOPGEN], 1u);
            else XB_SPIN(xb_ld(&bar[XB_TOPGEN]) == tg, bar);
            __builtin_amdgcn_fence(__ATOMIC_ACQUIRE, "agent");
            xb_add(&bar[XB_XGEN(b.x)], 1u);
            asm volatile("s_waitcnt vmcnt(0)" ::: "memory");
        } else {
            XB_SPIN(xb_ld(&bar[XB_XGEN(b.x)]) == gen, bar);
            __builtin_amdgcn_fence(__ATOMIC_ACQUIRE, "agent");
            asm volatile("s_waitcnt vmcnt(0)" ::: "memory");
        }
    }
    __syncthreads();
}
struct Frame {
    LAS unsigned char* lds;
    volatile LAS unsigned* MISC;
    gu32* ctl;
    unsigned char* ws;
    int tid, lane, wave;
    int vcu, G;
    const float* in[18];
    float* out;
};
#ifndef PROBE_MASK
#define PROBE_MASK 0
#endif
#define STAMP(k) do { if (PROBE_MASK != 0 && blockIdx.x == 0 && F.wave == 0) ((volatile LAS unsigned*)(F.lds + MISC_OFF))[16 + (k)] = (unsigned)__builtin_amdgcn_s_memrealtime(); } while (0)
__device__ __forceinline__ float wave_sum(float v) {
#pragma unroll
    for (int o = 1; o < 64; o <<= 1) v += __shfl_xor(v, o);
    return v;
}

__device__ __forceinline__ void p0_transpose_item(const float* W, int ldw, int K, int ncols, bf16* WT, int mode, int row_off, LAS float* scr, int item, int lane) {
    const int nblk = ncols / 64, kb = item / nblk, nb = item % nblk, k0 = 64 * kb, n0 = 64 * nb;
    int d0 = row_off + n0;
    if (mode == 1) { d0 = (n0 < 512) ? (256 * (n0 >> 7) + (n0 & 127)) : (256 * ((n0 - 512) >> 7) + 128 + ((n0 - 512) & 127)); }
    const int kr = lane >> 4, nc = 4 * (lane & 15);
    f32x4 v[16];
#pragma unroll
    for (int i = 0; i < 16; ++i) v[i] = *(const f32x4*)(W + (size_t)(k0 + 4 * i + kr) * ldw + n0 + nc);
#pragma unroll
    for (int i = 0; i < 16; ++i) { LAS float* s = scr + (4 * i + kr) * 65 + nc; s[0] = v[i].x; s[1] = v[i].y; s[2] = v[i].z; s[3] = v[i].w; }
    LDS_WAIT(); asm volatile("" ::: "memory");
    const int c = lane & 7;
#pragma unroll
    for (int j = 0; j < 8; ++j) { const int n = (lane >> 3) + 8 * j; const LAS float* s = scr + (8 * c) * 65 + n;
        v4u o; o.x = pk2(s[0 * 65], s[1 * 65]); o.y = pk2(s[2 * 65], s[3 * 65]); o.z = pk2(s[4 * 65], s[5 * 65]); o.w = pk2(s[6 * 65], s[7 * 65]);
        *(GAS v4u*)(WT + (size_t)(d0 + n) * K + k0 + 8 * c) = o; }
    LDS_WAIT(); asm volatile("" ::: "memory");
}

__device__ __forceinline__ void p0_meta(Frame& F) {
    const float* meta = F.in[1]; const float* nw = F.in[2]; const float* Win = F.in[3];
    LAS float* um = (LAS float*)(F.lds + RING_OFF);
    LAS float* part = (LAS float*)(F.lds + RING_OFF + 65536);
#pragma unroll
    for (int rr = 0; rr < 2; ++rr) {
        const int r = 2 * F.wave + rr;
        f32x4 v[4]; float ss = 0.f;
#pragma unroll
        for (int j = 0; j < 4; ++j) { v[j] = *(const f32x4*)(meta + (size_t)r * DM + 4 * F.lane + 256 * j); ss += (v[j].x * v[j].x + v[j].y * v[j].y) + (v[j].z * v[j].z + v[j].w * v[j].w); }
        const float rs = 1.0f / sqrtf(wave_sum(ss) * (1.0f / DM) + EPS);
#pragma unroll
        for (int j = 0; j < 4; ++j) { const f32x4 w = *(const f32x4*)(nw + 4 * F.lane + 256 * j); const int k = 4 * F.lane + 256 * j;
            um[(k + 0) * 16 + r] = v[j].x * rs * w.x; um[(k + 1) * 16 + r] = v[j].y * rs * w.y; um[(k + 2) * 16 + r] = v[j].z * rs * w.z; um[(k + 3) * 16 + r] = v[j].w * rs * w.w; }
    }
    __syncthreads();
    const int item = F.vcu;
    int type, strip;
    if (item < 8) { type = 0; strip = item; } else if (item < 16) { type = 1; strip = item - 8; } else if (item < 32) { type = 2; strip = item - 16; } else if (item < 48) { type = 3; strip = item - 32; } else { type = 4; strip = 0; }
    int col;
    if (type == 0) col = 512 + 64 * strip + F.lane; else if (type == 1) col = 1024 + 64 * strip + F.lane; else if (type == 2) col = 2568 + 64 * strip + F.lane;
    else if (type == 3) col = 3592 + 64 * strip + F.lane; else col = 1536 + (F.lane & 7);
    float acc[16];
#pragma unroll
    for (int r = 0; r < 16; ++r) acc[r] = 0.f;
    const int k0 = 128 * F.wave;
#pragma unroll 1
    for (int kb = 0; kb < 128; kb += 8) {
        float w[8];
#pragma unroll
        for (int i = 0; i < 8; ++i) w[i] = Win[(size_t)(k0 + kb + i) * INW + col];
#pragma unroll
        for (int i = 0; i < 8; ++i) {
            const LAS f32x4* up = (const LAS f32x4*)(um + (k0 + kb + i) * 16);
            const f32x4 u0 = up[0], u1 = up[1], u2 = up[2], u3 = up[3];
            acc[0] += w[i] * u0.x; acc[1] += w[i] * u0.y; acc[2] += w[i] * u0.z; acc[3] += w[i] * u0.w;
            acc[4] += w[i] * u1.x; acc[5] += w[i] * u1.y; acc[6] += w[i] * u1.z; acc[7] += w[i] * u1.w;
            acc[8] += w[i] * u2.x; acc[9] += w[i] * u2.y; acc[10] += w[i] * u2.z; acc[11] += w[i] * u2.w;
            acc[12] += w[i] * u3.x; acc[13] += w[i] * u3.y; acc[14] += w[i] * u3.z; acc[15] += w[i] * u3.w;
        }
    }
#pragma unroll
    for (int r = 0; r < 16; ++r) part[(F.wave * 16 + r) * 64 + F.lane] = acc[r];
    __syncthreads();
    if (F.wave == 0) {
#pragma unroll
        for (int r = 0; r < 16; ++r) { float s = 0.f;
#pragma unroll
            for (int w8 = 0; w8 < 8; ++w8) s += part[(w8 * 16 + r) * 64 + F.lane];
            acc[r] = s; }
        const int c = 64 * strip + F.lane;
        if (type == 0 || type == 1) {
            bf16* dst = (bf16*)(F.ws + (type == 0 ? WS_KA : WS_VA));
#pragma unroll
            for (int b = 0; b < 2; ++b) {
#pragma unroll
                for (int r = 0; r < 16; ++r) dst[((size_t)b * KROWS + r) * AWID + c] = (bf16)f2bf(acc[r]);
                for (int r = 16; r < 128; ++r) dst[((size_t)b * KROWS + r) * AWID + c] = (bf16)0;
            }
        } else if (type == 3) {
            bf16* dst = (bf16*)(F.ws + WS_VH);
#pragma unroll
            for (int b = 0; b < 2; ++b) {
                for (int r = 0; r < 48; ++r) dst[((size_t)b * HROWS + r) * DM + c] = (bf16)0;
#pragma unroll
                for (int r = 0; r < 16; ++r) dst[((size_t)b * HROWS + 48 + r) * DM + c] = (bf16)f2bf(acc[r]);
            }
        } else if (type == 2) {
            const float* lbl = F.in[5];
            const float lb = 1.0f / (1.0f + __expf(lbl[1024 + c] - lbl[c]));
            float kk[16], bb[16]; float run = 0.f;
#pragma unroll
            for (int r = 0; r < 16; ++r) { const float f = lb + (1.0f - lb) * (1.0f / (1.0f + __expf(-acc[r]))); kk[r] = 1.0f - f; run += __logf(f); bb[r] = run; }
            bf16* dst = (bf16*)(F.ws + WS_KD);
#pragma unroll
            for (int b = 0; b < 2; ++b) {
                for (int r = 0; r < 48; ++r) dst[((size_t)b * HROWS + r) * DM + c] = (bf16)0;
#pragma unroll
                for (int r = 0; r < 16; ++r) dst[((size_t)b * HROWS + 48 + r) * DM + c] = (bf16)f2bf(kk[r] * __expf(run - bb[r]));
            }
        } else {
            if (F.lane < 8) { float* lfam = (float*)(F.ws + WS_LFAM); const float bias = F.in[4][F.lane];
#pragma unroll
                for (int r = 0; r < 16; ++r) lfam[r * 8 + F.lane] = log_sigmoid(acc[r] + bias); }
        }
    }
    __syncthreads();
}

__device__ __forceinline__ void p0_rows(Frame& F) {
    const float* x = F.in[0]; const float* nw = F.in[2]; const float* Win = F.in[3]; const float* afb = F.in[4];
    LAS float* wfa = (LAS float*)(F.lds + RING_OFF);
    for (int i = F.tid; i < 8 * DM; i += NWAVES * 64) { const int k = i >> 3, h = i & 7; wfa[h * DM + k] = nw[k] * Win[(size_t)k * INW + 1536 + h]; }
    __syncthreads();
    const int gw = F.vcu * NWAVES + F.wave, NGW = F.G * NWAVES;
    f32x4 wv[4];
#pragma unroll
    for (int j = 0; j < 4; ++j) wv[j] = *(const f32x4*)(nw + 4 * F.lane + 256 * j);
    bf16* U = (bf16*)(F.ws + WS_U); float* lfa = (float*)(F.ws + WS_LFA);
    for (int m = gw; m < MR; m += NGW) {
        f32x4 v[4]; float ss = 0.f;
#pragma unroll
        for (int j = 0; j < 4; ++j) { v[j] = *(const f32x4*)(x + (size_t)m * DM + 4 * F.lane + 256 * j); ss += (v[j].x * v[j].x + v[j].y * v[j].y) + (v[j].z * v[j].z + v[j].w * v[j].w); }
        const float rs = 1.0f / sqrtf(wave_sum(ss) * (1.0f / DM) + EPS);
        GAS unsigned long long* o8 = (GAS unsigned long long*)(U + (size_t)m * DM) + F.lane;
#pragma unroll
        for (int j = 0; j < 4; ++j) { const f32x4 u = v[j] * rs * wv[j]; o8[64 * j] = (unsigned long long)pk2(u.x, u.y) | ((unsigned long long)pk2(u.z, u.w) << 32); }
        float z[8];
#pragma unroll
        for (int h = 0; h < 8; ++h) { float s = 0.f;
#pragma unroll
            for (int j = 0; j < 4; ++j) { const f32x4 w = *(const LAS f32x4*)(wfa + h * DM + 4 * F.lane + 256 * j); s += (v[j].x * w.x + v[j].y * w.y) + (v[j].z * w.z + v[j].w * w.w); }
            z[h] = wave_sum(s); }
        float zz = z[0];
#pragma unroll
        for (int h = 1; h < 8; ++h) zz = (F.lane == h) ? z[h] : zz;
        if (F.lane < 8) lfa[(size_t)m * 8 + F.lane] = log_sigmoid(zz * rs + afb[F.lane]);
    }
    __syncthreads();
}

__device__ __forceinline__ void p0_weights(Frame& F) {
    LAS float* scr = (LAS float*)(F.lds + RING_OFF + F.wave * 18432);
    const int gw = F.vcu * NWAVES + F.wave, NGW = F.G * NWAVES;
    constexpr int I1 = 16 * 24, I2 = 16 * 96, IA = 8 * 16, IH = 16 * 16, IO = 16 * 16;
    constexpr int NIT = I1 + I2 + IA + IH + IO;
    bf16* win = (bf16*)(F.ws + WS_WIN);
    for (int it = gw; it < NIT; it += NGW) {
        int r = it;
        if (r < I1) { p0_transpose_item(F.in[3], INW, DM, 1536, win, 0, 0, scr, r, F.lane); continue; } r -= I1;
        if (r < I2) { p0_transpose_item(F.in[3] + 1544, INW, DM, 6144, win, 0, 1536, scr, r, F.lane); continue; } r -= I2;
        if (r < IA) { p0_transpose_item(F.in[7], DM, AWID, DM, (bf16*)(F.ws + WS_WA), 0, 0, scr, r, F.lane); continue; } r -= IA;
        if (r < IH) { p0_transpose_item(F.in[8], DM, DM, DM, (bf16*)(F.ws + WS_WH), 0, 0, scr, r, F.lane); continue; } r -= IH;
        p0_transpose_item(F.in[9], DM, DM, DM, (bf16*)(F.ws + WS_WO), 0, 0, scr, r, F.lane);
    }
}
__device__ __forceinline__ void p7_expert_weights(Frame& F) {
    LAS float* scr = (LAS float*)(F.lds + RING_OFF + F.wave * 18432);
    const int gw = F.vcu * NWAVES + F.wave, NGW = F.G * NWAVES;
    constexpr int I1 = 16 * 16, I2 = 8 * 16;
    for (int it = gw; it < NE * (I1 + I2); it += NGW) {
        const int e = it / (I1 + I2); int r = it % (I1 + I2);
        if (r < I1) p0_transpose_item(F.in[15] + (size_t)e * DM * DM, DM, DM, DM, (bf16*)(F.ws + WS_WE1) + (size_t)e * DM * DM, 1, 0, scr, r, F.lane);
        else p0_transpose_item(F.in[16] + (size_t)e * EFF * DM, DM, EFF, DM, (bf16*)(F.ws + WS_WE2) + (size_t)e * DM * EFF, 0, 0, scr, r - I1, F.lane);
    }
}

__device__ __forceinline__ void p1_cumsum(Frame& F, int bh) {
    const int b = bh >> 3, h = bh & 7;
    const float* lfa = (const float*)(F.ws + WS_LFA); const float* lfam = (const float*)(F.ws + WS_LFAM); float* cl = (float*)(F.ws + WS_CL) + (size_t)bh * KROWS;
    LAS float* wtot = (LAS float*)(F.lds + RING_OFF);
    float cm = 0.f;
    for (int r = 0; r < 16; ++r) { cm += lfam[r * 8 + h]; if (F.tid == r) cl[r] = cm * 1.4426950408889634f; }
    if (F.tid >= 16 && F.tid < 128) cl[F.tid] = 1e30f;
    float loc[16]; float run = 0.f;
#pragma unroll
    for (int i = 0; i < 16; ++i) { run += lfa[((size_t)b * SEQ + 16 * F.tid + i) * 8 + h]; loc[i] = run; }
    float inc = run;
#pragma unroll
    for (int o = 1; o < 64; o <<= 1) { const float t = __shfl_up(inc, o); if (F.lane >= o) inc += t; }
    if (F.lane == 63) wtot[F.wave] = inc;
    __syncthreads();
    float pre = cm + (inc - run);
    for (int w = 0; w < F.wave; ++w) pre += wtot[w];
#pragma unroll
    for (int i = 0; i < 16; ++i) cl[128 + 16 * F.tid + i] = (pre + loc[i]) * 1.4426950408889634f;
    __syncthreads();
}

__device__ __forceinline__ void attn_simple_unit(Frame& F, int bh, int qb) {
    const int tid = F.tid, row = tid & 255, p = tid >> 8, b = bh >> 3, h = bh & 7;
    const bf16* QA = (const bf16*)(F.ws + WS_QA); const bf16* KA = (const bf16*)(F.ws + WS_KA); const bf16* VA = (const bf16*)(F.ws + WS_VA);
    const float* CL = (const float*)(F.ws + WS_CL) + (size_t)bh * KROWS; bf16* OA = (bf16*)(F.ws + WS_OA);
    LAS bf16* Ks = (LAS bf16*)(F.lds + RING_OFF); LAS bf16* Vs = (LAS bf16*)(F.lds + RING_OFF + 8192);
    LAS float* cks = (LAS float*)(F.lds + RING_OFF + 16384); LAS float* cmb = (LAS float*)(F.lds + RING_OFF + 16640);
    float q[64], o[64];
    const size_t qrow = (size_t)b * SEQ + 256 * qb + row;
#pragma unroll
    for (int c = 0; c < 8; ++c) { const v4u w = *(const v4u*)(QA + qrow * AWID + h * 64 + 8 * c);
        q[8 * c + 0] = blo(w.x); q[8 * c + 1] = bhi(w.x); q[8 * c + 2] = blo(w.y); q[8 * c + 3] = bhi(w.y); q[8 * c + 4] = blo(w.z); q[8 * c + 5] = bhi(w.z); q[8 * c + 6] = blo(w.w); q[8 * c + 7] = bhi(w.w); }
#pragma unroll
    for (int d = 0; d < 64; ++d) o[d] = 0.f;
    const int qp = 128 + 256 * qb + row; const float clq = CL[qp];
    float mx = -1e30f, l = 0.f;
    const int NT = 4 * qb + 6;
    for (int t = 0; t < NT; ++t) {
        if (t == 1) continue;
        __syncthreads();
        { const int r = tid >> 3, ch = tid & 7; const size_t g = ((size_t)b * KROWS + 64 * t + r) * AWID + h * 64 + ch * 8;
          *(LAS v4u*)(Ks + r * 64 + ch * 8) = *(const v4u*)(KA + g); *(LAS v4u*)(Vs + r * 64 + ch * 8) = *(const v4u*)(VA + g);
          if (tid < 64) cks[tid] = CL[64 * t + tid]; }
        __syncthreads();
        const int smax = (t == 0) ? 16 : 64;
        for (int s = p; s < smax; s += 2) {
            const int kp = 64 * t + s;
            if (t >= 2 && kp > qp) continue;
            float dot = 0.f;
#pragma unroll
            for (int c = 0; c < 8; ++c) { const v4u w = *(const LAS v4u*)(Ks + s * 64 + 8 * c);
                dot += q[8 * c + 0] * blo(w.x) + q[8 * c + 1] * bhi(w.x) + q[8 * c + 2] * blo(w.y) + q[8 * c + 3] * bhi(w.y) + q[8 * c + 4] * blo(w.z) + q[8 * c + 5] * bhi(w.z) + q[8 * c + 6] * blo(w.w) + q[8 * c + 7] * bhi(w.w); }
            const float sc = dot + (clq - cks[s]);
            const float mn = fmaxf(mx, sc), al = ex2(mx - mn), pp = ex2(sc - mn);
            l = l * al + pp; mx = mn;
#pragma unroll
            for (int c = 0; c < 8; ++c) { const v4u w = *(const LAS v4u*)(Vs + s * 64 + 8 * c);
                o[8 * c + 0] = o[8 * c + 0] * al + pp * blo(w.x); o[8 * c + 1] = o[8 * c + 1] * al + pp * bhi(w.x); o[8 * c + 2] = o[8 * c + 2] * al + pp * blo(w.y); o[8 * c + 3] = o[8 * c + 3] * al + pp * bhi(w.y);
                o[8 * c + 4] = o[8 * c + 4] * al + pp * blo(w.z); o[8 * c + 5] = o[8 * c + 5] * al + pp * bhi(w.z); o[8 * c + 6] = o[8 * c + 6] * al + pp * blo(w.w); o[8 * c + 7] = o[8 * c + 7] * al + pp * bhi(w.w); }
        }
    }
    __syncthreads();
    if (p == 1) { cmb[row * 66 + 0] = mx; cmb[row * 66 + 1] = l;
#pragma unroll
        for (int d = 0; d < 64; ++d) cmb[row * 66 + 2 + d] = o[d]; }
    __syncthreads();
    if (p == 0) { const float m1 = cmb[row * 66 + 0], l1 = cmb[row * 66 + 1]; const float mn = fmaxf(mx, m1), a0 = ex2(mx - mn), a1 = ex2(m1 - mn); const float inv = 1.0f / (l * a0 + l1 * a1);
#pragma unroll
        for (int c = 0; c < 8; ++c) { float r8[8];
#pragma unroll
            for (int e = 0; e < 8; ++e) r8[e] = (o[8 * c + e] * a0 + cmb[row * 66 + 2 + 8 * c + e] * a1) * inv;
            v4u w; w.x = pk2(r8[0], r8[1]); w.y = pk2(r8[2], r8[3]); w.z = pk2(r8[4], r8[5]); w.w = pk2(r8[6], r8[7]);
            *(v4u*)(OA + qrow * AWID + h * 64 + 8 * c) = w; } }
    __syncthreads();
}

__device__ __forceinline__ void hgrn_a_simple(Frame& F, int item) {
    const int bh = item / NCH, c = item % NCH, b = bh >> 3, h = bh & 7, tid = F.tid;
    const bf16* KD = (const bf16*)(F.ws + WS_KD); const bf16* VH = (const bf16*)(F.ws + WS_VH); bf16* US = (bf16*)(F.ws + WS_US);
    LAS float* KDs = (LAS float*)(F.lds + RING_OFF); LAS float* Vs = KDs + 8192;
    __syncthreads();
    { const int r = tid >> 3, cc = (tid & 7) * 16; const size_t g = ((size_t)b * HROWS + 64 * c + r) * DM + h * 128 + cc;
#pragma unroll
      for (int q2 = 0; q2 < 2; ++q2) { const v4u a = *(const v4u*)(KD + g + 8 * q2), v = *(const v4u*)(VH + g + 8 * q2); LAS float* kd = KDs + r * 128 + cc + 8 * q2; LAS float* vs = Vs + r * 128 + cc + 8 * q2;
          kd[0] = blo(a.x); kd[1] = bhi(a.x); kd[2] = blo(a.y); kd[3] = bhi(a.y); kd[4] = blo(a.z); kd[5] = bhi(a.z); kd[6] = blo(a.w); kd[7] = bhi(a.w);
          vs[0] = blo(v.x); vs[1] = bhi(v.x); vs[2] = blo(v.y); vs[3] = bhi(v.y); vs[4] = blo(v.z); vs[5] = bhi(v.z); vs[6] = blo(v.w); vs[7] = bhi(v.w); } }
    __syncthreads();
    const int k = tid >> 2, vg = (tid & 3) * 32;
    float acc[32];
#pragma unroll
    for (int j = 0; j < 32; ++j) acc[j] = 0.f;
    for (int s = 0; s < 64; ++s) { const float kd = KDs[s * 128 + k];
#pragma unroll
        for (int j4 = 0; j4 < 8; ++j4) { const f32x4 v = *(const LAS f32x4*)(Vs + s * 128 + vg + 4 * j4); acc[4 * j4 + 0] += kd * v.x; acc[4 * j4 + 1] += kd * v.y; acc[4 * j4 + 2] += kd * v.z; acc[4 * j4 + 3] += kd * v.w; } }
    bf16* dst = US + (size_t)item * (HK * HV) + k * 128 + vg;
#pragma unroll
    for (int j8 = 0; j8 < 4; ++j8) { v4u w; w.x = pk2(acc[8 * j8 + 0], acc[8 * j8 + 1]); w.y = pk2(acc[8 * j8 + 2], acc[8 * j8 + 3]); w.z = pk2(acc[8 * j8 + 4], acc[8 * j8 + 5]); w.w = pk2(acc[8 * j8 + 6], acc[8 * j8 + 7]); *(v4u*)(dst + 8 * j8) = w; }
}
__device__ __forceinline__ void hgrn_scan(Frame& F) {
    const bf16* EB = (const bf16*)(F.ws + WS_EB); bf16* US = (bf16*)(F.ws + WS_US);
    for (int idx = blockIdx.x * (NWAVES * 64) + F.tid; idx < 16 * 128 * 64; idx += F.G * NWAVES * 64) {
        const int bh = idx >> 13, rem = idx & 8191, k = rem >> 6, vp = rem & 63, b = bh >> 3, h = bh & 7;
        unsigned* base = (unsigned*)(US + (size_t)bh * NCH * (HK * HV) + k * 128) + vp;
        unsigned w = base[0]; float s0 = blo(w), s1 = bhi(w);
        for (int c = 1; c < NCH - 1; ++c) {
            const float a = bf2f(EB[((size_t)b * SEQ + 64 * (c - 1) + 63) * DM + h * 128 + k]);
            const unsigned uw = base[(size_t)c * (HK * HV / 2)];
            s0 = a * s0 + blo(uw); s1 = a * s1 + bhi(uw);
            base[(size_t)c * (HK * HV / 2)] = pk2(s0, s1);
        }
    }
}
__device__ __forceinline__ void hgrn_scan_t(Frame& F) {
    const bf16* EB = (const bf16*)(F.ws + WS_EB); bf16* US = (bf16*)(F.ws + WS_US);
    for (int idx = blockIdx.x * (NWAVES * 64) + F.tid; idx < 16 * 128 * 64; idx += F.G * NWAVES * 64) {
        const int bh = idx >> 13, rem = idx & 8191, v = rem >> 6, kp = rem & 63, b = bh >> 3, h = bh & 7;
        unsigned* base = (unsigned*)(US + (size_t)bh * NCH * (HK * HV) + v * 128) + kp;
        const unsigned* ap = (const unsigned*)(EB + ((size_t)b * SEQ + 63) * DM + h * 128) + kp;
        unsigned w = base[0]; float s0 = blo(w), s1 = bhi(w);
        for (int c0 = 1; c0 < NCH; c0 += 16) {
            unsigned aw[16], uw[16];
#pragma unroll
            for (int i = 0; i < 16; ++i) { aw[i] = ap[(size_t)(c0 - 1 + i) * 64 * (DM / 2)]; uw[i] = base[(size_t)(c0 + i) * (HK * HV / 2)]; }
#pragma unroll
            for (int i = 0; i < 16; ++i) { s0 = blo(aw[i]) * s0 + blo(uw[i]); s1 = bhi(aw[i]) * s1 + bhi(uw[i]); base[(size_t)(c0 + i) * (HK * HV / 2)] = pk2(s0, s1); }
        }
    }
}
__device__ __forceinline__ void hgrn_c_simple(Frame& F, int item) {
    const int bh = item >> 7, c = (item & 127) + 1, b = bh >> 3, h = bh & 7, tid = F.tid;
    const bf16* QH = (const bf16*)(F.ws + WS_QH); const bf16* EB = (const bf16*)(F.ws + WS_EB); const bf16* KT = (const bf16*)(F.ws + WS_KT); const bf16* VH = (const bf16*)(F.ws + WS_VH);
    const bf16* GH = (const bf16*)(F.ws + WS_GH); const bf16* US = (const bf16*)(F.ws + WS_US); bf16* OH = (bf16*)(F.ws + WS_OH); const float* hnw = F.in[6];
    LAS float* QE = (LAS float*)(F.lds + RING_OFF); LAS float* KTs = QE + 8192; LAS bf16* Ss = (LAS bf16*)(F.lds + RING_OFF + 65536); LAS bf16* Vs = (LAS bf16*)(F.lds + RING_OFF + 98304); LAS float* SC = (LAS float*)(F.lds + RING_OFF + 114688);
    const size_t r0 = (size_t)b * SEQ + 64 * (c - 1);
    __syncthreads();
    { const int r = tid >> 3, cc = (tid & 7) * 16; const size_t g = (r0 + r) * DM + h * 128 + cc; const size_t gv = ((size_t)b * HROWS + 64 * c + r) * DM + h * 128 + cc;
#pragma unroll
      for (int q2 = 0; q2 < 2; ++q2) { const v4u a = *(const v4u*)(QH + g + 8 * q2), e = *(const v4u*)(EB + g + 8 * q2), kt = *(const v4u*)(KT + g + 8 * q2);
          LAS float* qe = QE + r * 128 + cc + 8 * q2; LAS float* ks = KTs + r * 128 + cc + 8 * q2;
          qe[0] = blo(a.x) * blo(e.x); qe[1] = bhi(a.x) * bhi(e.x); qe[2] = blo(a.y) * blo(e.y); qe[3] = bhi(a.y) * bhi(e.y); qe[4] = blo(a.z) * blo(e.z); qe[5] = bhi(a.z) * bhi(e.z); qe[6] = blo(a.w) * blo(e.w); qe[7] = bhi(a.w) * bhi(e.w);
          ks[0] = blo(kt.x); ks[1] = bhi(kt.x); ks[2] = blo(kt.y); ks[3] = bhi(kt.y); ks[4] = blo(kt.z); ks[5] = bhi(kt.z); ks[6] = blo(kt.w); ks[7] = bhi(kt.w);
          *(LAS v4u*)(Vs + r * 128 + cc + 8 * q2) = *(const v4u*)(VH + gv + 8 * q2); }
      const bf16* sp = US + ((size_t)bh * NCH + (c - 1)) * (HK * HV);
#pragma unroll
      for (int i = 0; i < 4; ++i) *(LAS v4u*)(Ss + (tid + 512 * i) * 8) = *(const v4u*)(sp + (tid + 512 * i) * 8); }
    __syncthreads();
    const int t = tid >> 3, g8 = tid & 7;
#pragma unroll
    for (int j = 0; j < 8; ++j) { const int s = g8 * 8 + j; float d = 0.f;
        if (s <= t) { for (int k = 0; k < 128; k += 4) { const f32x4 a = *(const LAS f32x4*)(QE + t * 128 + k), kb = *(const LAS f32x4*)(KTs + s * 128 + k); d += (a.x * kb.x + a.y * kb.y) + (a.z * kb.z + a.w * kb.w); } }
        SC[t * 64 + s] = d; }
    __syncthreads();
    const int v0 = g8 * 16;
    float o[16];
#pragma unroll
    for (int j = 0; j < 16; ++j) o[j] = 0.f;
    for (int s = 0; s <= t; ++s) { const float sc = SC[t * 64 + s]; const v4u w0 = *(const LAS v4u*)(Vs + s * 128 + v0), w1 = *(const LAS v4u*)(Vs + s * 128 + v0 + 8);
        o[0] += sc * blo(w0.x); o[1] += sc * bhi(w0.x); o[2] += sc * blo(w0.y); o[3] += sc * bhi(w0.y); o[4] += sc * blo(w0.z); o[5] += sc * bhi(w0.z); o[6] += sc * blo(w0.w); o[7] += sc * bhi(w0.w);
        o[8] += sc * blo(w1.x); o[9] += sc * bhi(w1.x); o[10] += sc * blo(w1.y); o[11] += sc * bhi(w1.y); o[12] += sc * blo(w1.z); o[13] += sc * bhi(w1.z); o[14] += sc * blo(w1.w); o[15] += sc * bhi(w1.w); }
    for (int k = 0; k < 128; ++k) { const float qe = QE[t * 128 + k]; const v4u w0 = *(const LAS v4u*)(Ss + k * 128 + v0), w1 = *(const LAS v4u*)(Ss + k * 128 + v0 + 8);
        o[0] += qe * blo(w0.x); o[1] += qe * bhi(w0.x); o[2] += qe * blo(w0.y); o[3] += qe * bhi(w0.y); o[4] += qe * blo(w0.z); o[5] += qe * bhi(w0.z); o[6] += qe * blo(w0.w); o[7] += qe * bhi(w0.w);
        o[8] += qe * blo(w1.x); o[9] += qe * bhi(w1.x); o[10] += qe * blo(w1.y); o[11] += qe * bhi(w1.y); o[12] += qe * blo(w1.z); o[13] += qe * bhi(w1.z); o[14] += qe * blo(w1.w); o[15] += qe * bhi(w1.w); }
    float ss = 0.f;
#pragma unroll
    for (int j = 0; j < 16; ++j) ss += o[j] * o[j];
    ss += __shfl_xor(ss, 1); ss += __shfl_xor(ss, 2); ss += __shfl_xor(ss, 4);
    const float rs = 1.0f / sqrtf(ss * (1.0f / HV) + EPS);
    const size_t go = (r0 + t) * DM + h * 128 + v0;
    const v4u g0 = *(const v4u*)(GH + go), g1 = *(const v4u*)(GH + go + 8);
    float gg[16] = {blo(g0.x), bhi(g0.x), blo(g0.y), bhi(g0.y), blo(g0.z), bhi(g0.z), blo(g0.w), bhi(g0.w), blo(g1.x), bhi(g1.x), blo(g1.y), bhi(g1.y), blo(g1.z), bhi(g1.z), blo(g1.w), bhi(g1.w)};
    float y[16];
#pragma unroll
    for (int j = 0; j < 16; ++j) y[j] = o[j] * rs * hnw[v0 + j] * gg[j];
    v4u w; w.x = pk2(y[0], y[1]); w.y = pk2(y[2], y[3]); w.z = pk2(y[4], y[5]); w.w = pk2(y[6], y[7]); *(v4u*)(OH + go) = w;
    w.x = pk2(y[8], y[9]); w.y = pk2(y[10], y[11]); w.z = pk2(y[12], y[13]); w.w = pk2(y[14], y[15]); *(v4u*)(OH + go + 8) = w;
}

__device__ __forceinline__ float row16_sum(float v) {
    v += __builtin_bit_cast(float, __builtin_amdgcn_update_dpp(0, __builtin_bit_cast(int, v), 0xB1, 0xf, 0xf, true));
    v += __builtin_bit_cast(float, __builtin_amdgcn_update_dpp(0, __builtin_bit_cast(int, v), 0x4E, 0xf, 0xf, true));
    v += __builtin_bit_cast(float, __builtin_amdgcn_update_dpp(0, __builtin_bit_cast(int, v), 0x141, 0xf, 0xf, true));
    v += __builtin_bit_cast(float, __builtin_amdgcn_update_dpp(0, __builtin_bit_cast(int, v), 0x140, 0xf, 0xf, true));
    return v;
}
__device__ __forceinline__ float wave_sum2(float v) { v = row16_sum(v); v += __shfl_xor(v, 16); v += __shfl_xor(v, 32); return v; }
__device__ __forceinline__ void p0_router_table(Frame& F) {
    const float* nfw = F.in[10]; const float* wrg = F.in[11]; const float* wre = F.in[13]; float* TR = (float*)(F.ws + WS_TR);
    for (int i = blockIdx.x * (NWAVES * 64) + F.tid; i < 36 * DM; i += F.G * NWAVES * 64) { const int j = i >> 10, k = i & 1023; TR[i] = nfw[k] * (j < 4 ? wrg[k * 4 + j] : wre[k * 32 + (j - 4)]); }
}
__device__ __forceinline__ void p7_router(Frame& F) {
    const float* h1 = F.out; const float* nfw = F.in[10]; const float* brg = F.in[12]; const float* bre = F.in[14];
    bf16* XN = (bf16*)(F.ws + WS_XN); unsigned* ASG = (unsigned*)(F.ws + WS_ASG); float* GATE = (float*)(F.ws + WS_GATE);
    LAS float* T = (LAS float*)(F.lds + RING_OFF);
    { const f32x4* src = (const f32x4*)(F.ws + WS_TR); for (int i = F.tid; i < 36 * DM / 4; i += NWAVES * 64) ((LAS f32x4*)T)[i] = src[i]; }
    __syncthreads();
    STAMP(14);
    const int gw = F.vcu * NWAVES + F.wave, NGW = F.G * NWAVES;
    volatile LAS unsigned* lcnt = (volatile LAS unsigned*)(F.lds + MISC_OFF) + 64;
    volatile LAS unsigned* gbase = lcnt + 32;
    for (int pass = 0; pass * 2 * NGW < MR / 4; ++pass) {
    if (F.tid < 32) lcnt[F.tid] = 0u;
    __syncthreads();
    unsigned myE = 0u, myL = 0u; float myG = 0.f; int myrow = 0;
#pragma unroll 1
    for (int gi = 0; gi < 2; ++gi) {
        const int g4 = pass * 2 * NGW + 2 * gw + gi;
        if (g4 < MR / 4) {
        const int rowb = g4 * 4;
        f32x4 x[4][4]; float ss[4];
#pragma unroll
        for (int r = 0; r < 4; ++r) { ss[r] = 0.f;
#pragma unroll
            for (int q = 0; q < 4; ++q) { x[r][q] = *(const f32x4*)(h1 + (size_t)(rowb + r) * DM + 256 * q + 4 * F.lane); ss[r] += (x[r][q].x * x[r][q].x + x[r][q].y * x[r][q].y) + (x[r][q].z * x[r][q].z + x[r][q].w * x[r][q].w); } }
        float lgp[4][3];
#pragma unroll
        for (int r = 0; r < 4; ++r) { lgp[r][0] = 0.f; lgp[r][1] = 0.f; lgp[r][2] = 0.f; }
#pragma unroll
        for (int jb = 0; jb < 3; ++jb) {
#pragma unroll 1
            for (int jj = 0; jj < (jb == 2 ? 4 : 16); ++jj) {
                const int j = 16 * jb + jj;
                float a4[4] = {0.f, 0.f, 0.f, 0.f};
#pragma unroll
                for (int q = 0; q < 4; ++q) { const f32x4 w = *(const LAS f32x4*)(T + j * DM + 256 * q + 4 * F.lane);
#pragma unroll
                    for (int r = 0; r < 4; ++r) a4[r] += (x[r][q].x * w.x + x[r][q].y * w.y) + (x[r][q].z * w.z + x[r][q].w * w.w); }
#pragma unroll
                for (int r = 0; r < 4; ++r) { const float s = row16_sum(a4[r]); lgp[r][jb] = ((F.lane & 15) == jj) ? s : lgp[r][jb]; }
            }
        }
#pragma unroll
        for (int r = 0; r < 4; ++r)
#pragma unroll
            for (int jb = 0; jb < 3; ++jb) { float v = lgp[r][jb]; v += __shfl_xor(v, 16); v += __shfl_xor(v, 32); lgp[r][jb] = v; }
        float mybias[3];
        { const int l15 = F.lane & 15; mybias[0] = l15 < 4 ? brg[l15 & 3] : bre[(l15 - 4) & 31]; mybias[1] = bre[12 + l15]; mybias[2] = l15 < 4 ? bre[28 + l15] : 0.f; }
#pragma unroll
        for (int r = 0; r < 4; ++r) {
            const int row = rowb + r;
            const float rs = 1.0f / sqrtf(wave_sum2(ss[r]) * (1.0f / DM) + EPS);
            const float lgv0 = lgp[r][0] * rs + mybias[0], lgv1 = lgp[r][1] * rs + mybias[1], lgv2 = lgp[r][2] * rs + mybias[2];
            float lg[4];
#pragma unroll
            for (int j = 0; j < 4; ++j) lg[j] = __builtin_bit_cast(float, __builtin_amdgcn_readlane(__builtin_bit_cast(int, lgv0), j));
            { GAS unsigned long long* o8 = (GAS unsigned long long*)(XN + (size_t)row * DM) + F.lane;
#pragma unroll
              for (int q = 0; q < 4; ++q) { const f32x4 w = *(const f32x4*)(nfw + 4 * F.lane + 256 * q); const f32x4 u = x[r][q] * rs * w;
                  o8[64 * q] = (unsigned long long)pk2(u.x, u.y) | ((unsigned long long)pk2(u.z, u.w) << 32); } }
            int g = 0; float gm = lg[0];
#pragma unroll
            for (int j = 1; j < 4; ++j) if (lg[j] > gm) { gm = lg[j]; g = j; }
            float gs = 0.f;
#pragma unroll
            for (int j = 0; j < 4; ++j) gs += __expf(lg[j] - gm);
            const float pg = 1.0f / gs;
            float es[8];
#pragma unroll
            for (int i = 0; i < 8; ++i) { const int j = 4 + 8 * g + i, l = j & 15;
                const float e0 = __builtin_bit_cast(float, __builtin_amdgcn_readlane(__builtin_bit_cast(int, lgv0), l)), e1 = __builtin_bit_cast(float, __builtin_amdgcn_readlane(__builtin_bit_cast(int, lgv1), l)),
                            e2 = __builtin_bit_cast(float, __builtin_amdgcn_readlane(__builtin_bit_cast(int, lgv2), l));
                es[i] = j < 16 ? e0 : (j < 32 ? e1 : e2); }
            int i1 = 0; float v1 = es[0];
#pragma unroll
            for (int i = 1; i < 8; ++i) if (es[i] > v1) { v1 = es[i]; i1 = i; }
            int i2 = -1; float v2 = -3.0e38f;
#pragma unroll
            for (int i = 0; i < 8; ++i) if (i != i1 && es[i] > v2) { v2 = es[i]; i2 = i; }
            const float s1 = 1.0f / (1.0f + __expf(v2 - v1));
            if (F.lane == 8 * gi + 2 * r) { myE = (unsigned)(g * 8 + i1); myG = pg * s1; myrow = row; }
            if (F.lane == 8 * gi + 2 * r + 1) { myE = (unsigned)(g * 8 + i2); myG = pg * (1.0f - s1); myrow = row; }
        }
        if ((F.lane >> 3) == gi) myL = __hip_atomic_fetch_add((LAS unsigned*)(F.lds + MISC_OFF) + 64 + myE, 1u, __ATOMIC_RELAXED, __HIP_MEMORY_SCOPE_WORKGROUP);
        }
    }
    __syncthreads();
    if (F.tid < 32) { const unsigned n = lcnt[F.tid]; gbase[F.tid] = n ? __hip_atomic_fetch_add((unsigned*)(F.ctl + CW_CNT + 64 * F.tid), n, RLX_AGENT) : 0u; }
    __syncthreads();
    if (F.lane < 16 && pass * 2 * NGW + 2 * gw + (F.lane >> 3) < MR / 4) { const unsigned pos = gbase[myE] + myL; ASG[2 * myrow + (F.lane & 1)] = (myE << 16) | pos; GATE[2 * myrow + (F.lane & 1)] = myG; }
    __syncthreads();
    }
}
__device__ __forceinline__ void p8_permute(Frame& F) {
    LAS unsigned* pst = (LAS unsigned*)(F.lds + RING_OFF);
    if (F.wave == 0) {
        const unsigned cnt = F.lane < NE ? ald((const unsigned*)(F.ctl + CW_CNT + 64 * (F.lane & 31))) : 0u; const unsigned nt = (cnt + 255u) >> 8;
        unsigned inc = nt;
#pragma unroll
        for (int o = 1; o < 64; o <<= 1) { const unsigned t = __shfl_up(inc, o); if (F.lane >= o) inc += t; }
        const unsigned excl = inc - nt;
        if (F.lane < NE) pst[F.lane] = excl * 256u;
        if (blockIdx.x == 0) {
            if (F.lane == NE - 1) __hip_atomic_store((unsigned*)(F.ctl + CW_NT), inc, RLX_AGENT);
            if (F.lane < NE) for (unsigned t = 0; t < nt; ++t) __hip_atomic_store((unsigned*)(F.ctl + CW_TILEE + excl + t), (unsigned)F.lane, RLX_AGENT);
        }
    }
    __syncthreads();
    const unsigned* ASG = (const unsigned*)(F.ws + WS_ASG); unsigned* SLOT = (unsigned*)(F.ws + WS_SLOT); const bf16* XN = (const bf16*)(F.ws + WS_XN); bf16* XS = (bf16*)(F.ws + WS_XS);
    const int gw = F.vcu * NWAVES + F.wave, NGW = F.G * NWAVES;
    for (int a = gw; a < 2 * MR; a += NGW) {
        const unsigned w = ald(ASG + a); const unsigned e = w >> 16, pos = w & 0xffffu; const unsigned slot = pst[e] + pos;
        if (F.lane == 0) SLOT[a] = slot;
        const v4u* src = (const v4u*)(XN + (size_t)(a >> 1) * DM); v4u* dst = (v4u*)(XS + (size_t)slot * DM);
        dst[F.lane] = src[F.lane]; dst[64 + F.lane] = src[64 + F.lane];
    }
    __syncthreads();
}
__device__ __forceinline__ void p11_final(Frame& F) {
    const unsigned* SLOT = (const unsigned*)(F.ws + WS_SLOT); const float* GATE = (const float*)(F.ws + WS_GATE); const bf16* Y = (const bf16*)(F.ws + WS_Y); const float* fw = F.in[17];
    const int gw = F.vcu * NWAVES + F.wave, NGW = F.G * NWAVES;
    f32x4 wv[4];
#pragma unroll
    for (int j = 0; j < 4; ++j) wv[j] = *(const f32x4*)(fw + 4 * F.lane + 256 * j);
    for (int m0 = gw * 8; m0 < MR; m0 += NGW * 8) {
        const unsigned sl = ald(SLOT + 2 * m0 + (F.lane & 15)); const float gt = aldf(GATE + 2 * m0 + (F.lane & 15));
#pragma unroll
        for (int rr = 0; rr < 8; rr += 2) {
            f32x4 v[2][4]; float ss[2];
#pragma unroll
            for (int t = 0; t < 2; ++t) {
                const int m = m0 + rr + t;
                const unsigned s0 = __shfl(sl, 2 * (rr + t)), s1 = __shfl(sl, 2 * (rr + t) + 1); const float g0 = __shfl(gt, 2 * (rr + t)), g1 = __shfl(gt, 2 * (rr + t) + 1);
                ss[t] = 0.f;
#pragma unroll
                for (int j = 0; j < 4; ++j) { v[t][j] = *(const f32x4*)(F.out + (size_t)m * DM + 4 * F.lane + 256 * j);
                    const v2u y0 = *(const v2u*)(Y + (size_t)s0 * DM + 4 * F.lane + 256 * j), y1 = *(const v2u*)(Y + (size_t)s1 * DM + 4 * F.lane + 256 * j);
                    v[t][j].x += g0 * blo(y0.x) + g1 * blo(y1.x); v[t][j].y += g0 * bhi(y0.x) + g1 * bhi(y1.x); v[t][j].z += g0 * blo(y0.y) + g1 * blo(y1.y); v[t][j].w += g0 * bhi(y0.y) + g1 * bhi(y1.y);
                    ss[t] += (v[t][j].x * v[t][j].x + v[t][j].y * v[t][j].y) + (v[t][j].z * v[t][j].z + v[t][j].w * v[t][j].w); }
            }
#pragma unroll
            for (int t = 0; t < 2; ++t) { const float rs = 1.0f / sqrtf(wave_sum(ss[t]) * (1.0f / DM) + EPS);
#pragma unroll
                for (int j = 0; j < 4; ++j) *(f32x4*)(F.out + (size_t)(m0 + rr + t) * DM + 4 * F.lane + 256 * j) = v[t][j] * rs * wv[j]; }
        }
    }
}

struct Args { const float* in[18]; float* out; unsigned char* ws; int ph_lo, ph_hi, li, pad; };
__global__ void __launch_bounds__(NWAVES * 64, 2) fwd(Args args) {
    extern __shared__ __attribute__((aligned(16))) unsigned char lds[];
    Frame F;
    F.lds = (LAS unsigned char*)lds;
    F.MISC = (volatile LAS unsigned*)(F.lds + MISC_OFF);
    F.tid = threadIdx.x; F.lane = F.tid & 63; F.wave = __builtin_amdgcn_readfirstlane(F.tid >> 6);
    F.G = gridDim.x; { const int bx = blockIdx.x; F.vcu = (F.G % 8 == 0) ? (bx % 8) * (F.G / 8) + bx / 8 : bx; }
    F.ws = args.ws; F.ctl = (gu32*)(args.ws + WS_CTL); F.out = args.out;
#pragma unroll
    for (int i = 0; i < 18; ++i) F.in[i] = args.in[i];
    for (int u = F.tid; u < (LDS_BYTES - LDSCTL_OFF) / 4; u += NWAVES * 64) ((LAS unsigned*)(F.lds + LDSCTL_OFF))[u] = 0u;
    __syncthreads();
    const int bli = (N_LAUNCHES == NPHASE) ? 0 : args.li;
    XcdBarrier bar; bar.bar = (unsigned*)(F.ctl + CW_BAR) + bli * XCD_BAR_WORDS; bar.x = 0; bar.st = nullptr;
    if (N_LAUNCHES != NPHASE) bar = xcd_barrier_post((unsigned*)(F.ctl + CW_BAR) + bli * XCD_BAR_WORDS, F.MISC + 8);
#define GRID_BAR(seam) do { if (N_LAUNCHES == NPHASE) { if (F.tid == 0) __hip_atomic_store(F.ctl + CW_TMO, 0xBADBA0u | (unsigned)(seam), RLX_AGENT); } else { xcd_barrier(bar); } } while (0)
    const int lo = args.ph_lo, hi = args.ph_hi;
#define IN(k) (lo <= (k) && (k) < hi)
#define PHASE_BEGIN() do { int t_ = threadIdx.x; asm volatile("" : "+v"(t_)); F.tid = t_; F.lane = t_ & 63; } while (0)
#define BOTH(k) (IN(k) && IN((k) + 1))
    unsigned char* ws = args.ws;

    if (IN(0)) { PHASE_BEGIN(); STAMP(0);
        if (F.vcu < 49) p0_meta(F);
        p0_router_table(F);
        p0_rows(F);
        p0_weights(F);
        if (BOTH(0)) GRID_BAR(0);
    }
    if (IN(1)) { PHASE_BEGIN(); STAMP(1);
        pg8::Gemm g{(const bf16*)(ws + WS_U), (const bf16*)(ws + WS_WIN), MR, NPROJ, DM, 0};
        pg8::StaticOrder S; S.init(MR, NPROJ, F.G, (int)blockIdx.x);
        pg8::EpiProj E{(bf16*)(ws + WS_QA), (bf16*)(ws + WS_KA), (bf16*)(ws + WS_VA), (bf16*)(ws + WS_QH), (bf16*)(ws + WS_EB), (bf16*)(ws + WS_KT), (bf16*)(ws + WS_KD), (bf16*)(ws + WS_VH),
                       (bf16*)(ws + WS_GH), (bf16*)(ws + WS_GA), (bf16*)(ws + WS_GT), F.in[5]};
        pg8::gemm_phase<pg8::EpiProj, pg8::StaticOrder, true, true>(F.lds + RING_OFF, g, S, E);
        __syncthreads();
        for (int bh = blockIdx.x; bh < 16; bh += F.G) p1_cumsum(F, bh);
        if (BOTH(1)) GRID_BAR(1);
    }
    if (IN(2)) { PHASE_BEGIN(); STAMP(2);
#if defined(ATTN_SIMPLE)
        for (int pid = F.vcu; pid < 256; pid += F.G) { const int bh = pid >> 4, s = pid & 15; attn_simple_unit(F, bh, s); attn_simple_unit(F, bh, 31 - s); }
#else
        static_assert(attn_body::ATTN_LDS_BYTES <= RING_BYTES, "attention LDS");
        for (int pid = F.vcu; pid < 256; pid += F.G) { const int bh = pid >> 4, s = pid & 15;
            for (int i = 0; i < 2; ++i)
                attn_body::attn_unit<8>(bh >> 3, bh & 7, i ? 31 - s : s, (const attn_body::bf16*)(ws + WS_QA), (const attn_body::bf16*)(ws + WS_KA), (const attn_body::bf16*)(ws + WS_VA), (attn_body::bf16*)(ws + WS_OA),
                                        (const float*)(ws + WS_CL) + (size_t)bh * KROWS, (char*)lds + RING_OFF); }
        __syncthreads();
#endif
#if defined(HGRN_SIMPLE)
        for (int it = F.vcu; it < 16 * NCH; it += F.G) hgrn_a_simple(F, it);
#else
        for (int it = F.vcu; it < 16 * NCH; it += F.G) hg::hgrn_a(it, (const bf16*)(ws + WS_KD), (const bf16*)(ws + WS_VH), (bf16*)(ws + WS_US), F.lds + RING_OFF);
#endif
        if (BOTH(2)) GRID_BAR(2);
    }
#if defined(HGRN_SIMPLE)
    if (IN(3)) { PHASE_BEGIN(); STAMP(3); hgrn_scan(F); if (BOTH(3)) GRID_BAR(3); }
#else
    if (IN(3)) { PHASE_BEGIN(); STAMP(3); hgrn_scan_t(F); if (BOTH(3)) GRID_BAR(3); }
#endif
    if (IN(4)) { PHASE_BEGIN(); STAMP(4);
#if defined(HGRN_SIMPLE)
        for (int it = F.vcu; it < 16 * 128; it += F.G) hgrn_c_simple(F, it);
#else
        static_assert(hg::HC_END <= RING_BYTES, "hgrn LDS");
        for (int it = F.vcu; it < 16 * 128; it += F.G)
            hg::hgrn_c(it, (const bf16*)(ws + WS_QH), (const bf16*)(ws + WS_EB), (const bf16*)(ws + WS_KT), (const bf16*)(ws + WS_VH), (const bf16*)(ws + WS_GH), (const bf16*)(ws + WS_US), (bf16*)(ws + WS_OH), F.in[6], EPS, F.lds + RING_OFF);
#endif
        if (BOTH(4)) GRID_BAR(4);
    }
    if (IN(5)) { PHASE_BEGIN(); STAMP(5);
        { pg8::Gemm g{(const bf16*)(ws + WS_OA), (const bf16*)(ws + WS_WA), MR, DM, AWID, 0}; pg8::StaticOrder S; S.init(MR, DM, F.G, (int)blockIdx.x);
          pg8::EpiYa E{(const bf16*)(ws + WS_GA), (float*)(ws + WS_YA)};
          pg8::gemm_phase<pg8::EpiYa, pg8::StaticOrder, true, true>(F.lds + RING_OFF, g, S, E); }
        __syncthreads();
        { pg8::Gemm g{(const bf16*)(ws + WS_OH), (const bf16*)(ws + WS_WH), MR, DM, DM, 0}; pg8::StaticOrder S; S.init(MR, DM, F.G, (int)blockIdx.x);
          pg8::EpiMixed E{(const bf16*)(ws + WS_GT), (const float*)(ws + WS_YA), (bf16*)(ws + WS_MIX)};
          pg8::gemm_phase<pg8::EpiMixed, pg8::StaticOrder, true, true>(F.lds + RING_OFF, g, S, E); }
        if (BOTH(5)) GRID_BAR(5);
    }
    if (IN(6)) { PHASE_BEGIN(); STAMP(6);
        pg8::Gemm g{(const bf16*)(ws + WS_MIX), (const bf16*)(ws + WS_WO), MR, DM, DM, 0}; pg8::StaticOrder S; S.init(MR, DM, F.G, (int)blockIdx.x);
        pg8::EpiRes E{F.in[0], F.out};
        pg8::gemm_phase<pg8::EpiRes, pg8::StaticOrder, true, true>(F.lds + RING_OFF, g, S, E);
        if (BOTH(6)) GRID_BAR(6);
    }
    if (IN(7)) { PHASE_BEGIN(); STAMP(7); p7_router(F); STAMP(12); p7_expert_weights(F); STAMP(13); if (BOTH(7)) GRID_BAR(7); }
    if (IN(8)) { PHASE_BEGIN(); STAMP(8); p8_permute(F); if (BOTH(8)) GRID_BAR(8); }
    if (IN(9)) { PHASE_BEGIN(); STAMP(9);
        const int ntile = (int)__builtin_amdgcn_readfirstlane(ald((const unsigned*)(F.ctl + CW_NT)));
        pg8::Gemm g{(const bf16*)(ws + WS_XS), (const bf16*)(ws + WS_WE1), APAD, DM, DM, (size_t)DM * DM * 2};
        pg8::MoeOrder S{ntile * 4, F.G, F.vcu, (const unsigned*)(F.ctl + CW_TILEE)};
        pg8::EpiSwiglu E{(bf16*)(ws + WS_ACT)};
        pg8::gemm_phase<pg8::EpiSwiglu, pg8::MoeOrder, true, true>(F.lds + RING_OFF, g, S, E);
        if (BOTH(9)) GRID_BAR(9);
    }
    if (IN(10)) { PHASE_BEGIN(); STAMP(10);
        const int ntile = (int)__builtin_amdgcn_readfirstlane(ald((const unsigned*)(F.ctl + CW_NT)));
        pg8::Gemm g{(const bf16*)(ws + WS_ACT), (const bf16*)(ws + WS_WE2), APAD, DM, EFF, (size_t)DM * EFF * 2};
        pg8::MoeOrder S{ntile * 4, F.G, F.vcu, (const unsigned*)(F.ctl + CW_TILEE)};
        pg8::EpiPlain E{(bf16*)(ws + WS_Y), DM};
        pg8::gemm_phase<pg8::EpiPlain, pg8::MoeOrder, true, true>(F.lds + RING_OFF, g, S, E);
        if (BOTH(10)) GRID_BAR(10);
    }
    if (IN(11)) { PHASE_BEGIN(); STAMP(11); p11_final(F); }
    if (PROBE_MASK != 0 && blockIdx.x == 0 && F.wave == 0) {
        const unsigned tend = (unsigned)__builtin_amdgcn_s_memrealtime();
        const int A_ = (PROBE_MASK - 1) & 31, B_ = (PROBE_MASK - 1) >> 5;
        const unsigned tb = (B_ == 31) ? tend : ((volatile LAS unsigned*)(F.lds + MISC_OFF))[16 + B_];
        const unsigned extra = tb - ((volatile LAS unsigned*)(F.lds + MISC_OFF))[16 + A_];
        const unsigned long long t0 = __builtin_amdgcn_s_memrealtime();
        while (__builtin_amdgcn_s_memrealtime() - t0 < (unsigned long long)extra) __builtin_amdgcn_s_sleep(8);
    }
#undef IN
#undef BOTH
}

extern "C" void kernel_launch(void* const* d_in, const int* in_sizes, int n_in, void* d_out, int out_size, void* d_ws, size_t ws_size, hipStream_t stream) {
    static int grid = 0;
    if (grid == 0) {
        if (n_in != 18 || in_sizes[0] != MR * DM || out_size != MR * DM || ws_size < WS_END) {
            fprintf(stderr, "kernel_launch: unexpected problem: n_in %d in0 %d out %d ws %zu (need %zu); nothing launched\n", n_in, n_in > 0 ? in_sizes[0] : -1, out_size, ws_size, (size_t)WS_END); grid = -1; return; }
        int dev = 0, cus = 0, per_cu = 0;
        if (hipGetDevice(&dev) != hipSuccess || hipDeviceGetAttribute(&cus, hipDeviceAttributeMultiprocessorCount, dev) != hipSuccess) { grid = -1; return; }
        if (hipFuncSetAttribute((const void*)fwd, hipFuncAttributeMaxDynamicSharedMemorySize, LDS_BYTES) != hipSuccess) { fprintf(stderr, "kernel_launch: hipFuncSetAttribute failed\n"); grid = -1; return; }
        if (hipOccupancyMaxActiveBlocksPerMultiprocessor(&per_cu, (const void*)fwd, NWAVES * 64, LDS_BYTES) != hipSuccess || per_cu < 1)
            fprintf(stderr, "kernel_launch: note: occupancy query reports %d workgroups per CU\n", per_cu);
        (void)hipGetLastError();
        grid = cus;
    }
    if (grid < 0) return;
    if (hipMemsetAsync((char*)d_ws + WS_CTL, 0, CTL_ZERO_BYTES, stream) != hipSuccess) { fprintf(stderr, "kernel_launch: memset failed\n"); return; }
    Args a{};
    for (int i = 0; i < 18; ++i) a.in[i] = (const float*)d_in[i];
    a.out = (float*)d_out; a.ws = (unsigned char*)d_ws;
    for (int li = 0; li < N_LAUNCHES; ++li) {
        if (N_LAUNCHES == NPHASE) { a.ph_lo = li; a.ph_hi = li + 1; } else { a.ph_lo = 0; a.ph_hi = NPHASE; }
        a.li = li;
        hipLaunchKernelGGL(fwd, dim3(grid), dim3(NWAVES * 64), LDS_BYTES, stream, a);
        const hipError_t le = hipPeekAtLastError();
        if (le != hipSuccess) { fprintf(stderr, "kernel_launch: launch %d failed: %s\n", li, hipGetErrorName(le)); break; }
    }
}
```

```cpp
#include <hip/hip_runtime.h>
#include <hip/hip_bf16.h>
#include <cmath>
#include <cstdio>
#include <cstdint>

#ifndef MK_N_LAUNCHES
#define MK_N_LAUNCHES 1
#endif

namespace pg8 {
#define PG8_LAS __attribute__((address_space(3)))
typedef unsigned short bf16_t;
typedef short bf16x8 __attribute__((ext_vector_type(8)));
typedef float f32x4 __attribute__((ext_vector_type(4)));
typedef unsigned u32x4 __attribute__((ext_vector_type(4)));
typedef unsigned u32x2 __attribute__((ext_vector_type(2)));
constexpr int BM = 256, BK = 64, HALF = 128, HTB = HALF * BK * 2  , STAGE_BYTES = 8 * HTB, NXCD = 8, WGM = 8;

__host__ __device__ __forceinline__ int lds_byte(int r, int c) { const int st = (r >> 4) * 2 + (c >> 5), rr = r & 15, cc = c & 31, ob = rr * 64 + cc * 2; return st * 1024 + (ob ^ (((ob >> 9) & 1) << 5)); }
__host__ __device__ __forceinline__ void stage_rc(int b, int& R, int& C) { const int st = b / 1024, sb = b % 1024, swz = sb ^ (((sb >> 9) & 1) << 5); R = (st >> 1) * 16 + swz / 64; C = (st & 1) * 32 + (swz % 64) / 2; }
__host__ __device__ __forceinline__ int perm32(int rho) { const int n = rho >> 4, i = rho & 15; return 8 * (i >> 2) + 4 * n + (i & 3); }

struct Unit { int pm, pn, e; };
struct Gemm { const bf16_t* A; const bf16_t* Bt; int M, N, K; size_t bexp; };

struct StaticOrder {
    int nM, nN, nwg, G, c;
    __host__ __device__ void init(int M, int N, int G_, int c_) { nM = M / BM; nN = N / BM; nwg = nM * nN; G = G_; c = c_; }
    __host__ __device__ bool next(int i, Unit& u) const {
        const long L = (long)i * G + c; if (L >= nwg) return false;
        int wgid = (int)L; { const int q = nwg / NXCD, r = nwg % NXCD, xcd = wgid % NXCD, off = wgid / NXCD; wgid = (xcd < r ? xcd * (q + 1) : r * (q + 1) + (xcd - r) * q) + off; }
        const int nig = WGM * nN, gid = wgid / nig, fm = gid * WGM, gsz = (nM - fm) < WGM ? (nM - fm) : WGM;
        u.pm = fm + ((wgid % nig) % gsz); u.pn = (wgid % nig) / gsz; u.e = 0; return true;
    }
    __device__ __forceinline__ void a_ready(const Unit&) const {}
    __device__ __forceinline__ void done(const Unit&) const {}
};
struct MoeOrder {
    int ntu, G, c; const unsigned* tile_e;
    __device__ bool next(int i, Unit& u) const {
        const long L = (long)i * G + c; if (L >= ntu) return false;
        u.pm = (int)(L >> 2); u.pn = (int)(L & 3);
        u.e = (int)__builtin_amdgcn_readfirstlane(__hip_atomic_load(tile_e + u.pm, __ATOMIC_RELAXED, __HIP_MEMORY_SCOPE_AGENT)); return true;
    }
    __device__ __forceinline__ void a_ready(const Unit&) const {}
    __device__ __forceinline__ void done(const Unit&) const {}
};

__device__ __forceinline__ unsigned cvt_pk_bf16(float lo, float hi) { unsigned r; asm volatile("v_cvt_pk_bf16_f32 %0, %1, %2" : "=v"(r) : "v"(lo), "v"(hi)); return r; }
__device__ __forceinline__ float fsig(float x) { return __builtin_amdgcn_rcpf(1.0f + __builtin_amdgcn_exp2f(-1.4426950408889634f * x)); }
__device__ __forceinline__ float bflo(unsigned w) { return __builtin_bit_cast(float, w << 16); }
__device__ __forceinline__ float bfhi(unsigned w) { return __builtin_bit_cast(float, w & 0xffff0000u); }
__device__ __forceinline__ float dpp_shr(float v, int) { return v; }
#define PG8_SCAN16(v) do { \
    v += __builtin_bit_cast(float, __builtin_amdgcn_update_dpp(0, __builtin_bit_cast(int, v), 0x111, 0xf, 0xf, true)); \
    v += __builtin_bit_cast(float, __builtin_amdgcn_update_dpp(0, __builtin_bit_cast(int, v), 0x112, 0xf, 0xf, true)); \
    v += __builtin_bit_cast(float, __builtin_amdgcn_update_dpp(0, __builtin_bit_cast(int, v), 0x114, 0xf, 0xf, true)); \
    v += __builtin_bit_cast(float, __builtin_amdgcn_update_dpp(0, __builtin_bit_cast(int, v), 0x118, 0xf, 0xf, true)); } while (0)

constexpr float ATT_C2 = 0.125f * 1.4426950408889634f;
constexpr float HG_QS = 0.08838834764831845f;

struct EpiProj {
    static constexpr bool PERM = true, AFTER_DRAIN = false, HAS_MID = false;
    bf16_t *QA, *KA, *VA, *QH, *EB, *KT, *KD, *VH, *GH, *GA, *GT; const float* lbl;
    __device__ __forceinline__ void operator()(const f32x4 (&acc)[2][2][4][2], const Unit& u, int wr, int wc, int fr, int fq) const {
        const int pn = u.pn, b = u.pm >> 5;
        const int cofs = wc * 32 + 8 * fq;
        const int row0 = u.pm * BM + wr * 64 + fr;
        if (pn >= 10 && pn < 14) {
            const int colbase = 256 * (pn - 10), lane = fq * 16 + fr, srcl = (lane & 48) | 15;
#pragma unroll
            for (int ai = 0; ai < 2; ++ai)
#pragma unroll
                for (int bj = 0; bj < 2; ++bj)
#pragma unroll
                    for (int n = 0; n < 2; ++n) {
                        const int c0 = colbase + 128 * bj + cofs + 4 * n;
                        const f32x4 l0 = *(const f32x4*)(lbl + c0), l1 = *(const f32x4*)(lbl + 1024 + c0);
                        float eb[4][4], kt[4][4], kd[4][4];
#pragma unroll
                        for (int e = 0; e < 4; ++e) {
                            const float lb = __builtin_amdgcn_rcpf(1.0f + __builtin_amdgcn_exp2f((l1[e] - l0[e]) * 1.4426950408889634f));
                            float lf[4], kk[4];
#pragma unroll
                            for (int m = 0; m < 4; ++m) { const float f = lb + (1.0f - lb) * fsig(acc[ai][bj][m][n][e]); kk[m] = 1.0f - f; lf[m] = __builtin_amdgcn_logf(f); }
#pragma unroll
                            for (int m = 0; m < 4; ++m) PG8_SCAN16(lf[m]);
                            float run = 0.f, bb[4];
#pragma unroll
                            for (int m = 0; m < 4; ++m) { const float tot = __shfl(lf[m], srcl); bb[m] = lf[m] + run; run += tot; }
#pragma unroll
                            for (int m = 0; m < 4; ++m) { eb[m][e] = __builtin_amdgcn_exp2f(bb[m]); kt[m][e] = kk[m] * __builtin_amdgcn_exp2f(-bb[m]); kd[m][e] = kk[m] * __builtin_amdgcn_exp2f(run - bb[m]); }
                        }
#pragma unroll
                        for (int m = 0; m < 4; ++m) {
                            const size_t r = (size_t)(row0 + ai * HALF + m * 16);
                            u32x2 w;
                            w.x = cvt_pk_bf16(eb[m][0], eb[m][1]); w.y = cvt_pk_bf16(eb[m][2], eb[m][3]); *(u32x2*)(EB + r * 1024 + c0) = w;
                            w.x = cvt_pk_bf16(kt[m][0], kt[m][1]); w.y = cvt_pk_bf16(kt[m][2], kt[m][3]); *(u32x2*)(KT + r * 1024 + c0) = w;
                            w.x = cvt_pk_bf16(kd[m][0], kd[m][1]); w.y = cvt_pk_bf16(kd[m][2], kd[m][3]); *(u32x2*)(KD + (r + 64 * (b + 1)) * 1024 + c0) = w;
                        }
                    }
            return;
        }
        bf16_t* base; int ld = 1024, radd = 0, cb; int mode = 0; float sc = 1.f;
        if (pn < 2) { base = QA; ld = 512; cb = 256 * pn; sc = ATT_C2; }
        else if (pn < 4) { base = KA; ld = 512; cb = 256 * (pn - 2); radd = 128 * (b + 1); }
        else if (pn < 6) { base = VA; ld = 512; cb = 256 * (pn - 4); radd = 128 * (b + 1); }
        else if (pn < 10) { base = QH; cb = 256 * (pn - 6); sc = HG_QS; }
        else if (pn < 18) { base = VH; cb = 256 * (pn - 14); radd = 64 * (b + 1); }
        else if (pn < 22) { base = GH; cb = 256 * (pn - 18); mode = 1; }
        else if (pn < 26) { base = GA; cb = 256 * (pn - 22); mode = 1; }
        else { base = GT; cb = 256 * (pn - 26); mode = 1; }
#pragma unroll
        for (int ai = 0; ai < 2; ++ai)
#pragma unroll
            for (int m = 0; m < 4; ++m) { bf16_t* rowp = base + (size_t)(row0 + ai * HALF + m * 16 + radd) * ld + cb + cofs;
#pragma unroll
                for (int bj = 0; bj < 2; ++bj) { f32x4 v0 = acc[ai][bj][m][0], v1 = acc[ai][bj][m][1];
                    if (mode) {
#pragma unroll
                        for (int e = 0; e < 4; ++e) { v0[e] = fsig(v0[e]); v1[e] = fsig(v1[e]); }
                    } else { v0 = v0 * sc; v1 = v1 * sc; }
                    u32x4 w; w.x = cvt_pk_bf16(v0[0], v0[1]); w.y = cvt_pk_bf16(v0[2], v0[3]); w.z = cvt_pk_bf16(v1[0], v1[1]); w.w = cvt_pk_bf16(v1[2], v1[3]);
                    *(u32x4*)(rowp + bj * HALF) = w; } }
    }
};
struct EpiMixed {
    static constexpr bool PERM = true, AFTER_DRAIN = false, HAS_MID = true;
    const bf16_t* GA; const bf16_t* GT; bf16_t* O; int tmid;
    __device__ __forceinline__ void mid(f32x4 (&acc)[2][2][4][2], const Unit& u, int wr, int wc, int fr, int fq) const {
        const int row0 = u.pm * BM + wr * 64 + fr, col0 = u.pn * BM + wc * 32 + 8 * fq;
#pragma unroll
        for (int ai = 0; ai < 2; ++ai)
#pragma unroll
            for (int m = 0; m < 4; ++m) { unsigned off = (unsigned)((row0 + ai * HALF + m * 16) * 1024 + col0); asm volatile("" : "+v"(off));
#pragma unroll
                for (int bj = 0; bj < 2; ++bj) { const u32x4 a = *(const u32x4*)(GA + off + bj * HALF), h = *(const u32x4*)(GT + off + bj * HALF);
                    f32x4& v0 = acc[ai][bj][m][0]; f32x4& v1 = acc[ai][bj][m][1];
                    v0[0] *= bflo(a.x) * __builtin_amdgcn_rcpf(bflo(h.x)); v0[1] *= bfhi(a.x) * __builtin_amdgcn_rcpf(bfhi(h.x)); v0[2] *= bflo(a.y) * __builtin_amdgcn_rcpf(bflo(h.y)); v0[3] *= bfhi(a.y) * __builtin_amdgcn_rcpf(bfhi(h.y));
                    v1[0] *= bflo(a.z) * __builtin_amdgcn_rcpf(bflo(h.z)); v1[1] *= bfhi(a.z) * __builtin_amdgcn_rcpf(bfhi(h.z)); v1[2] *= bflo(a.w) * __builtin_amdgcn_rcpf(bflo(h.w)); v1[3] *= bfhi(a.w) * __builtin_amdgcn_rcpf(bfhi(h.w)); }
                asm volatile("" ::: "memory"); }
    }
    __device__ __forceinline__ void operator()(const f32x4 (&acc)[2][2][4][2], const Unit& u, int wr, int wc, int fr, int fq) const {
        const int row0 = u.pm * BM + wr * 64 + fr, col0 = u.pn * BM + wc * 32 + 8 * fq;
#pragma unroll
        for (int ai = 0; ai < 2; ++ai)
#pragma unroll
            for (int m = 0; m < 4; ++m) { const size_t off = (size_t)(row0 + ai * HALF + m * 16) * 1024 + col0;
#pragma unroll
                for (int bj = 0; bj < 2; ++bj) { const u32x4 g = *(const u32x4*)(GT + off + bj * HALF);
                    f32x4 v0 = acc[ai][bj][m][0], v1 = acc[ai][bj][m][1];
                    v0[0] *= bflo(g.x); v0[1] *= bfhi(g.x); v0[2] *= bflo(g.y); v0[3] *= bfhi(g.y); v1[0] *= bflo(g.z); v1[1] *= bfhi(g.z); v1[2] *= bflo(g.w); v1[3] *= bfhi(g.w);
                    u32x4 w; w.x = cvt_pk_bf16(v0[0], v0[1]); w.y = cvt_pk_bf16(v0[2], v0[3]); w.z = cvt_pk_bf16(v1[0], v1[1]); w.w = cvt_pk_bf16(v1[2], v1[3]);
                    *(u32x4*)(O + off + bj * HALF) = w; } }
    }
};
struct EpiRes {
    static constexpr bool PERM = true, AFTER_DRAIN = false, HAS_MID = false;
    const float* X; float* O;
    __device__ __forceinline__ void operator()(const f32x4 (&acc)[2][2][4][2], const Unit& u, int wr, int wc, int fr, int fq) const {
        const int row0 = u.pm * BM + wr * 64 + fr, col0 = u.pn * BM + wc * 32 + 8 * fq;
#pragma unroll
        for (int ai = 0; ai < 2; ++ai)
#pragma unroll
            for (int m = 0; m < 4; ++m) { const size_t off = (size_t)(row0 + ai * HALF + m * 16) * 1024 + col0;
#pragma unroll
                for (int bj = 0; bj < 2; ++bj) {
                    const f32x4 x0 = *(const f32x4*)(X + off + bj * HALF), x1 = *(const f32x4*)(X + off + bj * HALF + 4);
                    *(f32x4*)(O + off + bj * HALF) = x0 + acc[ai][bj][m][0]; *(f32x4*)(O + off + bj * HALF + 4) = x1 + acc[ai][bj][m][1]; } }
    }
};
struct EpiSwiglu {
    static constexpr bool PERM = true, AFTER_DRAIN = false, HAS_MID = false;
    bf16_t* O;
    __device__ __forceinline__ void operator()(const f32x4 (&acc)[2][2][4][2], const Unit& u, int wr, int wc, int fr, int fq) const {
        const int row0 = u.pm * BM + wr * 64 + fr, col0 = u.pn * HALF + wc * 32 + 8 * fq;
#pragma unroll
        for (int ai = 0; ai < 2; ++ai)
#pragma unroll
            for (int m = 0; m < 4; ++m) { const size_t off = (size_t)(row0 + ai * HALF + m * 16) * 512 + col0;
                f32x4 v0, v1;
#pragma unroll
                for (int e = 0; e < 4; ++e) { const float a0 = acc[ai][0][m][0][e], a1 = acc[ai][0][m][1][e];
                    v0[e] = a0 * fsig(a0) * acc[ai][1][m][0][e]; v1[e] = a1 * fsig(a1) * acc[ai][1][m][1][e]; }
                u32x4 w; w.x = cvt_pk_bf16(v0[0], v0[1]); w.y = cvt_pk_bf16(v0[2], v0[3]); w.z = cvt_pk_bf16(v1[0], v1[1]); w.w = cvt_pk_bf16(v1[2], v1[3]);
                *(u32x4*)(O + off) = w; }
    }
};
struct EpiPlain {
    static constexpr bool PERM = true, AFTER_DRAIN = false, HAS_MID = false;
    bf16_t* O; int ldc;
    __device__ __forceinline__ void operator()(const f32x4 (&acc)[2][2][4][2], const Unit& u, int wr, int wc, int fr, int fq) const {
        const int row0 = u.pm * BM + wr * 64 + fr, col0 = u.pn * BM + wc * 32 + 8 * fq;
#pragma unroll
        for (int ai = 0; ai < 2; ++ai)
#pragma unroll
            for (int m = 0; m < 4; ++m) { const size_t off = (size_t)(row0 + ai * HALF + m * 16) * ldc + col0;
#pragma unroll
                for (int bj = 0; bj < 2; ++bj) { const f32x4 v0 = acc[ai][bj][m][0], v1 = acc[ai][bj][m][1];
                    u32x4 w; w.x = cvt_pk_bf16(v0[0], v0[1]); w.y = cvt_pk_bf16(v0[2], v0[3]); w.z = cvt_pk_bf16(v1[0], v1[1]); w.w = cvt_pk_bf16(v1[2], v1[3]);
                    *(u32x4*)(O + off + bj * HALF) = w; } }
    }
};

template <class Epi, class Sched, bool ALIGN_EPI = false, bool SP2 = false>
__device__ __forceinline__ void gemm_phase(PG8_LAS unsigned char* lds, const Gemm g, const Sched& S, const Epi& E) {
    int tid_l = threadIdx.x; asm volatile("" : "+v"(tid_l));
    const int tid = tid_l, wid = __builtin_amdgcn_readfirstlane(tid >> 6), lane = tid & 63, wr = wid >> 2, wc = wid & 3, fr = lane & 15, fq = lane >> 4;
    const int K = g.K, nt = K / BK;
    unsigned voffA[2], voffB[2];
#pragma unroll
    for (int i = 0; i < 2; ++i) { int R, C; stage_rc(tid * 16 + i * 8192, R, C); const int Rb = Epi::PERM ? ((R & ~31) + perm32(R & 31)) : R;
        voffA[i] = (unsigned)(R * K + C) * 2u; voffB[i] = (unsigned)(Rb * K + C) * 2u; }
    const size_t kstep = (size_t)(BK * 2);
    const size_t hstep = (size_t)HALF * K * 2;
    const size_t tstep = 2 * hstep;
    const unsigned ldsw = (unsigned)wid * 1024u;
    const int aoff = lds_byte(wr * 64 + fr, fq * 8), boff = lds_byte(wc * 32 + fr, fq * 8);
#define PG8_SA(b, h) (((b) * 2 + (h)) * HTB)
#define PG8_SB(b, h) ((4 + (b) * 2 + (h)) * HTB)
#define PG8_STAGE(bufoff, gbase, voff) do { _Pragma("unroll") for (int _i = 0; _i < 2; ++_i) \
        __builtin_amdgcn_global_load_lds((const unsigned*)((const char*)(gbase) + (voff)[_i]), (PG8_LAS unsigned*)(lds + (bufoff) + ldsw + _i * 8192), 16, 0, 0); } while (0)
#define PG8_LDA(dst, b, h) do { _Pragma("unroll") for (int m = 0; m < 4; ++m) _Pragma("unroll") for (int k = 0; k < 2; ++k) dst[m][k] = *(const PG8_LAS bf16x8*)(lds + PG8_SA(b, h) + aoff + m * 2048 + k * 1024); } while (0)
#define PG8_LDB(dst, b, h) do { _Pragma("unroll") for (int n = 0; n < 2; ++n) _Pragma("unroll") for (int k = 0; k < 2; ++k) dst[n][k] = *(const PG8_LAS bf16x8*)(lds + PG8_SB(b, h) + boff + n * 2048 + k * 1024); } while (0)
#define PG8_MMA(ai, bj, At, Bt) do { __builtin_amdgcn_s_setprio(1); _Pragma("unroll") for (int m = 0; m < 4; ++m) _Pragma("unroll") for (int n = 0; n < 2; ++n) _Pragma("unroll") for (int k = 0; k < 2; ++k) \
        acc[ai][bj][m][n] = __builtin_amdgcn_mfma_f32_16x16x32_bf16(Bt[n][k], At[m][k], acc[ai][bj][m][n], 0, 0, 0); __builtin_amdgcn_s_setprio(0); } while (0)
#define PG8_WAIT_V(n) asm volatile("s_waitcnt vmcnt(" #n ")" ::: "memory")
#define PG8_WAIT_L(n) asm volatile("s_waitcnt lgkmcnt(" #n ")" ::: "memory")
#define PG8_BAR __builtin_amdgcn_s_barrier()
#define PG8_SCHED __builtin_amdgcn_sched_barrier(0)
    Unit cur, nxt; int ui = 0;
    if (!S.next(0, cur)) return;
    f32x4 acc[2][2][4][2];
#pragma unroll
    for (int a = 0; a < 2; ++a)
#pragma unroll
        for (int b = 0; b < 2; ++b)
#pragma unroll
            for (int m = 0; m < 4; ++m)
#pragma unroll
                for (int n = 0; n < 2; ++n) acc[a][b][m][n] = (f32x4){0.f, 0.f, 0.f, 0.f};
    bf16x8 At[4][2], B0[2][2], B1[2][2];
    const char* cA = (const char*)g.A + (size_t)cur.pm * tstep; const char* cB = (const char*)g.Bt + (size_t)cur.e * g.bexp + (size_t)cur.pn * tstep;
    S.a_ready(cur);
    if constexpr (SP2) {
        PG8_STAGE(PG8_SB(0, 0), cB, voffB); PG8_STAGE(PG8_SB(0, 1), cB + hstep, voffB); PG8_STAGE(PG8_SA(0, 0), cA, voffA); PG8_STAGE(PG8_SA(0, 1), cA + hstep, voffA);
        if (wr == 1) PG8_BAR;
        PG8_WAIT_V(2); PG8_BAR;
        PG8_STAGE(PG8_SB(1, 0), cB + kstep, voffB); PG8_STAGE(PG8_SA(1, 0), cA + kstep, voffA); PG8_STAGE(PG8_SB(1, 1), cB + hstep + kstep, voffB);
        PG8_WAIT_V(6); PG8_BAR;
    } else {
        PG8_STAGE(PG8_SB(0, 0), cB, voffB); PG8_STAGE(PG8_SA(0, 0), cA, voffA); PG8_STAGE(PG8_SB(0, 1), cB + hstep, voffB); PG8_STAGE(PG8_SA(0, 1), cA + hstep, voffA);
        if (wr == 1) PG8_BAR;
        PG8_WAIT_V(4); PG8_BAR;
        PG8_STAGE(PG8_SB(1, 0), cB + kstep, voffB); PG8_STAGE(PG8_SA(1, 0), cA + kstep, voffA); PG8_STAGE(PG8_SB(1, 1), cB + hstep + kstep, voffB);
        PG8_WAIT_V(6); PG8_BAR;
    }
    for (;;) {
        const bool has_next = S.next(ui + 1, nxt);
        const char* nA = has_next ? (const char*)g.A + (size_t)nxt.pm * tstep : cA; const char* nB = has_next ? (const char*)g.Bt + (size_t)nxt.e * g.bexp + (size_t)nxt.pn * tstep : cB;
        for (int t = 0; t < nt; t += 2) {
            if constexpr (Epi::HAS_MID) { if (t == E.tmid) E.mid(acc, cur, wr, wc, fr, fq); }
            const bool last = (t == nt - 2);
            const char* a1 = cA + (size_t)(t + 1) * kstep;
            const char* a2 = last ? nA : cA + (size_t)(t + 2) * kstep; const char* b2 = last ? nB : cB + (size_t)(t + 2) * kstep;
            const char* a3 = a2 + kstep; const char* b3 = b2 + kstep;
            if (last && has_next) S.a_ready(nxt);
            if constexpr (SP2) {
            PG8_LDB(B0, 0, 0); PG8_LDB(B1, 0, 1); PG8_SCHED; PG8_LDA(At, 0, 0); PG8_STAGE(PG8_SA(1, 1), a1 + hstep, voffA);
            PG8_WAIT_V(8); PG8_WAIT_L(0); PG8_BAR; PG8_MMA(0, 0, At, B0); PG8_MMA(0, 1, At, B1); PG8_BAR; PG8_SCHED;
            PG8_LDA(At, 0, 1); PG8_STAGE(PG8_SB(0, 0), b2, voffB); PG8_STAGE(PG8_SB(0, 1), b2 + hstep, voffB); PG8_STAGE(PG8_SA(0, 0), a2, voffA);
            PG8_WAIT_V(8); PG8_WAIT_L(0); PG8_BAR; PG8_MMA(1, 0, At, B0); PG8_MMA(1, 1, At, B1); PG8_BAR; PG8_SCHED;
            PG8_LDB(B0, 1, 0); PG8_LDB(B1, 1, 1); PG8_SCHED; PG8_LDA(At, 1, 0); PG8_STAGE(PG8_SA(0, 1), a2 + hstep, voffA);
            PG8_WAIT_V(8); PG8_WAIT_L(0); PG8_BAR; PG8_MMA(0, 0, At, B0); PG8_MMA(0, 1, At, B1); PG8_BAR; PG8_SCHED;
            PG8_LDA(At, 1, 1); PG8_STAGE(PG8_SB(1, 0), b3, voffB); PG8_STAGE(PG8_SB(1, 1), b3 + hstep, voffB); PG8_STAGE(PG8_SA(1, 0), a3, voffA);
            PG8_WAIT_V(8); PG8_WAIT_L(0); PG8_BAR; PG8_MMA(1, 0, At, B0); PG8_MMA(1, 1, At, B1); PG8_BAR; PG8_SCHED;
            } else {
            PG8_LDB(B0, 0, 0); PG8_SCHED; PG8_LDA(At, 0, 0); PG8_STAGE(PG8_SA(1, 1), a1 + hstep, voffA);
            PG8_WAIT_L(8); PG8_BAR; PG8_WAIT_L(0); PG8_MMA(0, 0, At, B0); PG8_BAR; PG8_SCHED;
            PG8_LDB(B1, 0, 1); PG8_STAGE(PG8_SB(0, 0), b2, voffB);
            PG8_BAR; PG8_WAIT_L(0); PG8_MMA(0, 1, At, B1); PG8_BAR;
            PG8_LDA(At, 0, 1); PG8_STAGE(PG8_SA(0, 0), a2, voffA);
            PG8_BAR; PG8_WAIT_L(0); PG8_MMA(1, 0, At, B0); PG8_BAR; PG8_SCHED;
            PG8_STAGE(PG8_SB(0, 1), b2 + hstep, voffB);
            PG8_WAIT_V(6); PG8_BAR; PG8_MMA(1, 1, At, B1); PG8_BAR;
            PG8_LDB(B0, 1, 0); PG8_SCHED; PG8_LDA(At, 1, 0); PG8_STAGE(PG8_SA(0, 1), a2 + hstep, voffA);
            PG8_WAIT_L(8); PG8_BAR; PG8_WAIT_L(0); PG8_MMA(0, 0, At, B0); PG8_BAR; PG8_SCHED;
            PG8_LDB(B1, 1, 1); PG8_STAGE(PG8_SB(1, 0), b3, voffB);
            PG8_BAR; PG8_WAIT_L(0); PG8_MMA(0, 1, At, B1); PG8_BAR;
            PG8_LDA(At, 1, 1); PG8_STAGE(PG8_SA(1, 0), a3, voffA);
            PG8_BAR; PG8_WAIT_L(0); PG8_MMA(1, 0, At, B0); PG8_BAR; PG8_SCHED;
            PG8_STAGE(PG8_SB(1, 1), b3 + hstep, voffB);
            PG8_WAIT_V(6); PG8_BAR; PG8_MMA(1, 1, At, B1); PG8_BAR;
            }
        }
        if constexpr (ALIGN_EPI) { if (wr == 0) PG8_BAR; }
        if constexpr (!Epi::AFTER_DRAIN) { E(acc, cur, wr, wc, fr, fq); S.done(cur); }
        if (!has_next) break;
#pragma unroll
        for (int a = 0; a < 2; ++a)
#pragma unroll
            for (int b = 0; b < 2; ++b)
#pragma unroll
                for (int m = 0; m < 4; ++m)
#pragma unroll
                    for (int n = 0; n < 2; ++n) acc[a][b][m][n] = (f32x4){0.f, 0.f, 0.f, 0.f};
        cur = nxt; cA = nA; cB = nB; ++ui;
        if constexpr (ALIGN_EPI) { if (wr == 1) PG8_BAR; }
    }
    PG8_WAIT_V(0);
    if constexpr (!ALIGN_EPI) { if (wr == 0) PG8_BAR; }
    PG8_BAR;
    if constexpr (Epi::AFTER_DRAIN) { E.fused(acc, cur, wr, wc, fr, fq, lds, wid, lane); S.done(cur); }
#undef PG8_SA
#undef PG8_SB
#undef PG8_STAGE
#undef PG8_LDA
#undef PG8_LDB
#undef PG8_MMA
#undef PG8_WAIT_V
#undef PG8_WAIT_L
#undef PG8_BAR
#undef PG8_SCHED
}
}

constexpr int NWAVES = 8;
constexpr int NB = 2, SEQ = 8192, DM = 1024, MR = NB * SEQ;
constexpr int NMETA = 16, INW = 7688, NPROJ = 7680;
constexpr int AH = 8, ADH = 64, AWID = 512, KROWS = SEQ + 128;
constexpr int HH = 8, HK = 128, HV = 128, HROWS = SEQ + 64, NCH = 129;
constexpr int NE = 32, EFF = 512, APAD = 40960;
constexpr float EPS = 1e-6f;
constexpr int N_LAUNCHES = MK_N_LAUNCHES;
constexpr int NPHASE = 12;

constexpr size_t MiB = 1u << 20;
constexpr size_t WS_CTL = 0, CTL_ZERO_BYTES = 1 * MiB;
constexpr size_t WS_WIN = 1 * MiB, WS_WAH = 16 * MiB, WS_WO = 19 * MiB;
constexpr size_t WS_LFA = 21 * MiB, WS_LFAM = WS_LFA + 512 * 1024, WS_CL = 22 * MiB, WS_ASG = 23 * MiB, WS_GATE = WS_ASG + 128 * 1024, WS_SLOT = WS_GATE + 128 * 1024, WS_TR = 24 * MiB;
constexpr size_t WS_U = 26 * MiB;
constexpr size_t WS_QA = 58 * MiB, WS_KA = 74 * MiB, WS_VA = 90 * MiB + 512 * 1024;
constexpr size_t WS_QH = 107 * MiB, WS_EB = 139 * MiB, WS_KT = 171 * MiB, WS_KD = 203 * MiB, WS_VH = 235 * MiB + 512 * 1024;
constexpr size_t WS_GH = 268 * MiB, WS_GA = 300 * MiB, WS_GT = 332 * MiB;
constexpr size_t WS_US = 364 * MiB;
constexpr size_t WS_OAH = 429 * MiB;
constexpr size_t WS_MIX = 171 * MiB;
constexpr size_t WS_XN = 26 * MiB, WS_WE1 = 58 * MiB, WS_WE2 = 122 * MiB, WS_XS = 154 * MiB, WS_ACT = 234 * MiB, WS_Y = 274 * MiB;
constexpr size_t WS_END = 477 * MiB;
static_assert(WS_KA + (size_t)2 * KROWS * AWID * 2 <= WS_VA && WS_VA + (size_t)2 * KROWS * AWID * 2 <= WS_QH && WS_KD + (size_t)2 * HROWS * DM * 2 <= WS_VH && WS_VH + (size_t)2 * HROWS * DM * 2 <= WS_GH, "ws map");
static_assert(WS_US + (size_t)16 * NCH * HK * HV * 2 <= WS_OAH && WS_OAH + (size_t)MR * (AWID + DM) * 2 <= WS_END && WS_Y + (size_t)APAD * DM * 2 <= WS_END && WS_XS + (size_t)APAD * DM * 2 <= WS_ACT && WS_ACT + (size_t)APAD * EFF * 2 <= WS_Y, "ws map 2");
constexpr int CW_TMO = 0, CW_CODE = 1;
constexpr int CW_CNT = 8192;
constexpr int CW_NT = 2048;
constexpr int CW_TILEE = 2112;
constexpr int CW_BAR = 4096;

constexpr int RING_OFF = 0, RING_BYTES = 147456;
constexpr int LDSCTL_OFF = RING_BYTES, MISC_OFF = LDSCTL_OFF + 320;
constexpr int LDS_BYTES = 148480;

#define GAS __attribute__((address_space(1)))
#define LAS __attribute__((address_space(3)))
typedef unsigned short bf16;
typedef unsigned v4u __attribute__((ext_vector_type(4)));
typedef unsigned v2u __attribute__((ext_vector_type(2)));
typedef float f32x4 __attribute__((ext_vector_type(4)));
typedef short bf16x8 __attribute__((ext_vector_type(8)));
typedef GAS unsigned gu32;
typedef GAS unsigned long long gu64;
#define RLX_AGENT __ATOMIC_RELAXED, __HIP_MEMORY_SCOPE_AGENT
#define LDS_WAIT() asm volatile("s_waitcnt lgkmcnt(0)" ::: "memory")
#define VM_WAIT() asm volatile("s_waitcnt vmcnt(0)" ::: "memory")
__device__ __forceinline__ unsigned f2bf(float f) { unsigned u = __builtin_bit_cast(unsigned, f); return (u + 0x7fffu + ((u >> 16) & 1u)) >> 16; }
__device__ __forceinline__ unsigned pk2(float lo, float hi) { return f2bf(lo) | (f2bf(hi) << 16); }
__device__ __forceinline__ float bf2f(unsigned short h) { return __builtin_bit_cast(float, (unsigned)h << 16); }
__device__ __forceinline__ float blo(unsigned w) { return __builtin_bit_cast(float, w << 16); }
__device__ __forceinline__ float bhi(unsigned w) { return __builtin_bit_cast(float, w & 0xffff0000u); }
__device__ __forceinline__ float ex2(float x) { return __builtin_amdgcn_exp2f(x); }
__device__ __forceinline__ float sigm(float x) { return __builtin_amdgcn_rcpf(1.0f + ex2(-1.4426950408889634f * x)); }
__device__ __forceinline__ unsigned ald(const unsigned* p) { return __hip_atomic_load(p, __ATOMIC_RELAXED, __HIP_MEMORY_SCOPE_AGENT); }
__device__ __forceinline__ float aldf(const float* p) { return __builtin_bit_cast(float, __hip_atomic_load((const unsigned*)p, __ATOMIC_RELAXED, __HIP_MEMORY_SCOPE_AGENT)); }
__device__ __forceinline__ float log_sigmoid(float z) { const float a = fabsf(z); return fminf(z, 0.f) - __logf(1.0f + __expf(-a)); }

namespace attn_body {
using bf16=__hip_bfloat16;
using bf16x8=__attribute__((ext_vector_type(8)))short;
using s16x4=__attribute__((ext_vector_type(4)))short;
using f32x16=__attribute__((ext_vector_type(16)))float;
using u32x4=__attribute__((ext_vector_type(4)))unsigned;
using f32x4g=__attribute__((ext_vector_type(4)))float;
constexpr int BATCH=2,NHEAD=8,SEQ=8192,D=64,DM=NHEAD*D;
constexpr int KFRONT=128,KSEQ=SEQ+KFRONT,OP=1536;
constexpr int NW=8,QBLK=32,QB=QBLK*NW,KVBLK=64,NQB=SEQ/QB;
constexpr int ATTN_PITCH=DM, ATTN_UNIT_ROWS=QB;
__device__ __forceinline__ int crow(int r,int hi){return (r&3)+8*(r>>2)+4*hi;}
#define SBAR() __builtin_amdgcn_sched_barrier(0)
__device__ __forceinline__ void cmask(f32x16&p0,f32x16&p1,int jb,int qrel,int hi){
  const float NEG=-INFINITY; int kb=64*jb+4*hi;
  #pragma unroll
  for(int r=0;r<16;++r){int kv=kb+(r&3)+8*(r>>2); if(kv>qrel)p0[r]=NEG; if(kv+32>qrel)p1[r]=NEG;}
}

constexpr int NSLOT=3, SLOTB=8192;
constexpr int LDS_K=0, LDS_V=NSLOT*SLOTB, LDS_WS=2*NSLOT*SLOTB, LDS_OST=LDS_WS+NW*64*4, LDS_CLK=LDS_OST+NW*4096, LDS_BYTES=LDS_CLK+KSEQ*4;
constexpr float C2=0.125f*1.4426950408889634f;
__device__ __forceinline__ void glds16s(unsigned voff,const void*sbase,unsigned lds_dst){unsigned keep;
  asm volatile("s_mov_b32 %0, m0\n\ts_mov_b32 m0, %3\n\ts_nop 0\n\tglobal_load_lds_dwordx4 %1, %2\n\ts_mov_b32 m0, %0":"=&s"(keep):"v"(voff),"s"(sbase),"s"(lds_dst):"memory");}
__device__ __forceinline__ void glds16(const void*gsrc,unsigned lds_dst){unsigned keep;
  asm volatile("s_mov_b32 %0, m0\n\ts_mov_b32 m0, %2\n\ts_nop 0\n\tglobal_load_lds_dwordx4 %1, off\n\ts_mov_b32 m0, %0":"=&s"(keep):"v"(gsrc),"s"(lds_dst):"memory");}
__device__ __forceinline__ float max3f(float a,float b,float c){float r;asm("v_max3_f32 %0, %1, %2, %3":"=v"(r):"v"(a),"v"(b),"v"(c));return r;}
__device__ __forceinline__ float max2f(float a,float b){float r;asm("v_max_f32_e32 %0, %1, %2":"=v"(r):"v"(a),"v"(b));return r;}
__device__ __forceinline__ float fadd_s(float a,float b){float r;asm("v_add_f32_e32 %0, %1, %2":"=v"(r):"v"(a),"v"(b));return r;}
__device__ __forceinline__ float fsub_s(float a,float b){float r;asm("v_sub_f32_e32 %0, %1, %2":"=v"(r):"v"(a),"v"(b));return r;}
typedef float f32x2_t __attribute__((ext_vector_type(2))); typedef __bf16 bf16x2_t __attribute__((ext_vector_type(2)));
__device__ __forceinline__ unsigned cvtpk_s(float lo,float hi){f32x2_t v={lo,hi};bf16x2_t b=__builtin_convertvector(v,bf16x2_t);return __builtin_bit_cast(unsigned,b);}
#define WAIT_BAR(N) asm volatile("s_waitcnt vmcnt(" #N ") lgkmcnt(0)\n\ts_barrier":::"memory")

__device__ __forceinline__ void qkt(f32x16&p0,f32x16&p1,const char*Kslot,const bf16x8*qr,int r32,int hi){
  const char*kb=Kslot+hi*1024+r32*16;
  #pragma unroll
  for(int d0=0;d0<4;++d0){
    const bf16x8 b0=*reinterpret_cast<const bf16x8*>(kb+d0*2048);
    const bf16x8 b1=*reinterpret_cast<const bf16x8*>(kb+d0*2048+512);
    p0=__builtin_amdgcn_mfma_f32_32x32x16_bf16(b0,qr[d0],p0,0,0,0);p1=__builtin_amdgcn_mfma_f32_32x32x16_bf16(b1,qr[d0],p1,0,0,0);}
}
typedef __attribute__((address_space(3))) const char* lds_cptr;
typedef short v4i16_t __attribute__((ext_vector_type(4)));
__device__ __forceinline__ void kload8(bf16x8*kf,lds_cptr kp){
  kf[0]=*(const __attribute__((address_space(3))) bf16x8*)(kp);      kf[1]=*(const __attribute__((address_space(3))) bf16x8*)(kp+512);
  kf[2]=*(const __attribute__((address_space(3))) bf16x8*)(kp+2048); kf[3]=*(const __attribute__((address_space(3))) bf16x8*)(kp+2560);
  kf[4]=*(const __attribute__((address_space(3))) bf16x8*)(kp+4096); kf[5]=*(const __attribute__((address_space(3))) bf16x8*)(kp+4608);
  kf[6]=*(const __attribute__((address_space(3))) bf16x8*)(kp+6144); kf[7]=*(const __attribute__((address_space(3))) bf16x8*)(kp+6656);
}
__device__ __forceinline__ void kload2(bf16x8*kf,lds_cptr kp,int j){ kf[2*j]=*(const __attribute__((address_space(3))) bf16x8*)(kp+j*2048); kf[2*j+1]=*(const __attribute__((address_space(3))) bf16x8*)(kp+j*2048+512); }
__device__ __forceinline__ s16x4 vtr(lds_cptr p){ return __builtin_bit_cast(s16x4,__builtin_amdgcn_ds_read_tr16_b64_v4i16((__attribute__((address_space(3))) v4i16_t*)p)); }
__device__ __forceinline__ float rowmax(const f32x16&p0,const f32x16&p1){
  float a=max3f(p0[0],p0[1],p1[0]),b=max3f(p0[2],p0[3],p1[1]);a=max3f(a,p1[2],p1[3]);
  #pragma unroll
  for(int r=4;r<16;r+=4){a=max3f(a,p0[r],p0[r+1]);b=max3f(b,p0[r+2],p0[r+3]);a=max3f(a,p1[r],p1[r+1]);b=max3f(b,p1[r+2],p1[r+3]);}
  const float m=max2f(a,b);
  auto rr=__builtin_amdgcn_permlane32_swap(__float_as_uint(m),__float_as_uint(m),false,false);
  return max2f(__uint_as_float(rr[0]),__uint_as_float(rr[1]));
}
__device__ __forceinline__ void pv(f32x16*o,int vb,bf16x8 pa0,bf16x8 pa1,bf16x8 pa2,bf16x8 pa3){
  #pragma unroll
  for(int d0=0;d0<2;++d0){s16x4 lo[4],hi[4];
    #pragma unroll
    for(int ks=0;ks<4;++ks){
      asm volatile("ds_read_b64_tr_b16 %0,%1 offset:%c2":"=&v"(lo[ks]):"v"(vb),"i"(d0*4096+ks*1024):"memory");
      asm volatile("ds_read_b64_tr_b16 %0,%1 offset:%c2":"=&v"(hi[ks]):"v"(vb),"i"(d0*4096+ks*1024+512):"memory");}
    asm volatile("s_waitcnt lgkmcnt(0)":::"memory");SBAR();
    #define PK(k) (bf16x8){lo[k][0],lo[k][1],lo[k][2],lo[k][3],hi[k][0],hi[k][1],hi[k][2],hi[k][3]}
    o[d0]=__builtin_amdgcn_mfma_f32_32x32x16_bf16(pa0,PK(0),o[d0],0,0,0);
    o[d0]=__builtin_amdgcn_mfma_f32_32x32x16_bf16(pa1,PK(1),o[d0],0,0,0);
    o[d0]=__builtin_amdgcn_mfma_f32_32x32x16_bf16(pa2,PK(2),o[d0],0,0,0);
    o[d0]=__builtin_amdgcn_mfma_f32_32x32x16_bf16(pa3,PK(3),o[d0],0,0,0);
    #undef PK
  }
}

#ifndef ATTN_STORE16
#define ATTN_STORE16(p,v) (*(u32x4*)(p)=(v))
#endif
template<int THRL> __device__ __forceinline__ void attn_unit(int b,int h,int qb,const bf16*Q,const bf16*__restrict__ K,const bf16*__restrict__ V,bf16*O,const float*CLg,char*shm){
  int tid_l=threadIdx.x; asm volatile("":"+v"(tid_l)); const int tid=tid_l,lane=tid&63,r32=lane&31,hi=lane>>5; const int wid=__builtin_amdgcn_readfirstlane(tid>>6);
  const long rowbase=(long)b*SEQ; const int q0=qb*QB;
  const bf16*Qw=Q+(rowbase+q0+wid*QBLK)*DM+h*D;
  const bf16*Kh=K+(long)b*KSEQ*DM+h*D,*Vh=V+(long)b*KSEQ*DM+h*D;
  const unsigned lds0=(unsigned)(uintptr_t)shm;
  float*wsf=(float*)(shm+LDS_WS)+wid*64;
  const unsigned koff=(unsigned)((lane*DM+wid*8)*2);
  const unsigned voff=(unsigned)(((16*(wid&3)+(lane>>2))*DM+(wid>>2)*32+(lane&3)*8)*2);
  const unsigned kdst=lds0+LDS_K+wid*1024, vdst=lds0+LDS_V+wid*1024;
  #define DMA_K(t,slot) glds16s(koff,Kh+(long)(t)*KVBLK*DM,(unsigned)__builtin_amdgcn_readfirstlane(kdst+(slot)))
  #define DMA_V(t,slot) glds16s(voff,Vh+(long)(t)*KVBLK*DM,(unsigned)__builtin_amdgcn_readfirstlane(vdst+(slot)))
  const int vb0=(int)(lds0+LDS_V)+((lane>>4)&1)*32+(lane&3)*8+(4*hi+((lane&15)>>2))*64;
  const char*Kbase=shm+LDS_K; bf16x8 kf[8];
  const lds_cptr shm3=(lds_cptr)shm; const lds_cptr kp0=shm3+LDS_K+hi*1024+r32*16; const lds_cptr vp0=shm3+LDS_V+((lane>>4)&1)*32+(lane&3)*8+(4*hi+((lane&15)>>2))*64;
  const int NT=(KFRONT+q0+QB)/KVBLK;
  DMA_K(0,0);DMA_V(0,0);DMA_K(1,SLOTB);
  bf16x8 qr[4];
  #pragma unroll
  for(int d0=0;d0<4;++d0)qr[d0]=*reinterpret_cast<const bf16x8*>(&Qw[(long)r32*DM+d0*16+hi*8]);
  { const f32x4g*src=(const f32x4g*)CLg; __attribute__((address_space(3))) f32x4g*dst=(__attribute__((address_space(3))) f32x4g*)(shm3+LDS_CLK);
    for(int i=tid;i<NT*16;i+=NW*64)dst[i]=src[i]; }
  const float clq=CLg[KFRONT+q0+wid*QBLK+r32];
  const __attribute__((address_space(3))) float*clkp=(const __attribute__((address_space(3))) float*)(shm3+LDS_CLK)+4*hi;
  float mhat=0.f,l_reg=0.f;f32x16 o[2];o[0]=f32x16{};o[1]=f32x16{};
  const int qrel=wid*QBLK+r32;
  #define CMASK(P0,P1,t) do{int jb_=(t)-(NT-4); if(jb_>=0)cmask(P0,P1,jb_,qrel,hi);}while(0)
  #define BRD(X0,X1,tt) do{ const __attribute__((address_space(3))) float*c_=clkp+(tt)*KVBLK; \
    _Pragma("unroll") for(int g_=0;g_<4;++g_){ const f32x4g a_=*(const __attribute__((address_space(3))) f32x4g*)(c_+8*g_), b_=*(const __attribute__((address_space(3))) f32x4g*)(c_+32+8*g_); \
      X0[4*g_]=a_.x;X0[4*g_+1]=a_.y;X0[4*g_+2]=a_.z;X0[4*g_+3]=a_.w; X1[4*g_]=b_.x;X1[4*g_+1]=b_.y;X1[4*g_+2]=b_.z;X1[4*g_+3]=b_.w; } }while(0)
  #define BSUB(X,g,nb) do{ X[4*(g)]=(nb)-X[4*(g)]; X[4*(g)+1]=(nb)-X[4*(g)+1]; X[4*(g)+2]=(nb)-X[4*(g)+2]; X[4*(g)+3]=(nb)-X[4*(g)+3]; }while(0)
  #define BFULL(X0,X1,tt,nb) do{ BRD(X0,X1,tt); _Pragma("unroll") for(int g_=0;g_<4;++g_){ BSUB(X0,g_,nb); BSUB(X1,g_,nb); } }while(0)
  bool resc=false;
  #define START(P0,P1) do{ const float rm=rowmax(P0,P1); resc=false; \
    { const float dl=rm; mhat=fadd_s(mhat,dl); \
      _Pragma("unroll") for(int r=0;r<16;++r){P0[r]=fsub_s(P0[r],dl);P1[r]=fsub_s(P1[r],dl);} } \
    _Pragma("unroll") for(int r=0;r<16;++r)P0[r]=__builtin_amdgcn_exp2f(P0[r]); }while(0)
  #define RESC() do{ if(resc){ asm volatile("s_waitcnt lgkmcnt(0)":::"memory"); \
      _Pragma("unroll") for(int d_=0;d_<2;++d_) _Pragma("unroll") for(int r=0;r<16;++r)o[d_][r]*=wsf[crow(r,hi)]; } }while(0)
  f32x16 pA0,pA1,pB0,pB1;
  int sl_prev=0,sl_cur=0,sl_next=SLOTB;
  #define ROT() do{sl_prev=sl_cur;sl_cur=sl_next;sl_next=(sl_next==(NSLOT-1)*SLOTB)?0:sl_next+SLOTB;}while(0)
  DMA_K(2,2*SLOTB);
  WAIT_BAR(3);
  BFULL(pA0,pA1,0,clq);
  qkt(pA0,pA1,Kbase,qr,r32,hi);asm volatile("s_nop 15\n\ts_nop 7":"+v"(pA0),"+v"(pA1));CMASK(pA0,pA1,0);
  START(pA0,pA1);
  { const float nb0_=clq-mhat; BFULL(pB0,pB1,1,nb0_); }
  _Pragma("unroll") for(int r=0;r<16;++r)pA1[r]=__builtin_amdgcn_exp2f(pA1[r]);
  WAIT_BAR(0);
  DMA_K(3,0);DMA_V(1,SLOTB);
  ROT();
  kload8(kf,kp0+sl_cur);
  WAIT_BAR(2);
  s16x4 vlo[8],vhi[8]; u32x4 pw0,pw1,pw2,pw3;
  #define PKW(P,B) cvtpk_s(P[B],P[B+1])
  #define PAF(k) __builtin_bit_cast(bf16x8,pw##k)
  #define VFR(i) (bf16x8){vlo[i][0],vlo[i][1],vlo[i][2],vlo[i][3],vhi[i][0],vhi[i][1],vhi[i][2],vhi[i][3]}
  #define PIN(x) asm volatile("":"+v"(x))
  #define MX3(a,b,c) __builtin_fmaxf(__builtin_fmaxf((a),(b)),(c))
  #define GAPA(MF,A0,A1,A2,A3,W0,W1,PW) do{ MF; sacc+=A0; sacc+=A1; sacc+=A2; sacc+=A3; PIN(sacc); W0; W1; PIN(PW); SBAR(); }while(0)
  #define EX(v) __builtin_amdgcn_exp2f(v)
  #define GAPB(MF,X,B,G,PX,g,OFS) do{ f32x4g c4_; if(G){ c4_=*(const __attribute__((address_space(3))) f32x4g*)(cn_+(OFS)+8*(g)); } MF; X[B]=EX(X[B]); X[B+1]=EX(X[B+1]); X[B+2]=EX(X[B+2]); X[B+3]=EX(X[B+3]); PIN(X); \
    if(G){ PX[4*(g)]=nb_-c4_.x; PX[4*(g)+1]=nb_-c4_.y; PX[4*(g)+2]=nb_-c4_.z; PX[4*(g)+3]=nb_-c4_.w; PIN(PX); } SBAR(); }while(0)
  #define VRD(i) do{ vlo[i]=vtr(vp_+(((i)>>2)*4096+((i)&3)*1024)); vhi[i]=vtr(vp_+(((i)>>2)*4096+((i)&3)*1024+512)); }while(0)
  #define KRD(G,j) do{ if(G){ kload2(kf,kp0+sl_next,j); SBAR(); } }while(0)
  #define STEP(C0,C1,P0,P1,t,GK,GV,GL) do{ SBAR(); \
    const lds_cptr vp_=vp0+sl_prev; \
    VRD(0); SBAR(); float sacc=(P0[0]+P0[1]); \
    GAPA(C0=__builtin_amdgcn_mfma_f32_32x32x16_bf16(kf[0],qr[0],C0,0,0,0), P0[2],P0[3],P0[4],P0[5],     pw0[0]=PKW(P0,0), pw0[1]=PKW(P0,2), pw0); \
    VRD(4); SBAR(); GAPA(C1=__builtin_amdgcn_mfma_f32_32x32x16_bf16(kf[1],qr[0],C1,0,0,0), P0[6],P0[7],P0[8],P0[9],     pw0[2]=PKW(P0,4), pw0[3]=PKW(P0,6), pw0); \
    VRD(1); SBAR(); GAPA(C0=__builtin_amdgcn_mfma_f32_32x32x16_bf16(kf[2],qr[1],C0,0,0,0),   P0[10],P0[11],P0[12],P0[13], pw1[0]=PKW(P0,8), pw1[1]=PKW(P0,10), pw1); \
    VRD(5); SBAR(); GAPA(C1=__builtin_amdgcn_mfma_f32_32x32x16_bf16(kf[3],qr[1],C1,0,0,0),   P0[14],P0[15],P1[0],P1[1],   pw1[2]=PKW(P0,12),pw1[3]=PKW(P0,14), pw1); \
    VRD(2); SBAR(); GAPA(C0=__builtin_amdgcn_mfma_f32_32x32x16_bf16(kf[4],qr[2],C0,0,0,0),   P1[2],P1[3],P1[4],P1[5],     pw2[0]=PKW(P1,0), pw2[1]=PKW(P1,2), pw2); \
    VRD(6); SBAR(); GAPA(C1=__builtin_amdgcn_mfma_f32_32x32x16_bf16(kf[5],qr[2],C1,0,0,0),   P1[6],P1[7],P1[8],P1[9],     pw2[2]=PKW(P1,4), pw2[3]=PKW(P1,6), pw2); \
    VRD(3); SBAR(); GAPA(C0=__builtin_amdgcn_mfma_f32_32x32x16_bf16(kf[6],qr[3],C0,0,0,0),   P1[10],P1[11],P1[12],P1[13], pw3[0]=PKW(P1,8), pw3[1]=PKW(P1,10), pw3); \
    VRD(7); SBAR(); GAPA(C1=__builtin_amdgcn_mfma_f32_32x32x16_bf16(kf[7],qr[3],C1,0,0,0),   P1[14],P1[15],0.f,0.f,       pw3[2]=PKW(P1,12),pw3[3]=PKW(P1,14), pw3); \
    l_reg+=sacc; \
    if(GK){DMA_K((t)+3,sl_cur);} if(GV){DMA_V((t)+1,sl_next);} \
    CMASK(C0,C1,t); \
    { float a=MX3(C0[0],C0[1],C1[0]),b=MX3(C0[2],C0[3],C1[1]); a=MX3(a,C1[2],C1[3]); \
      _Pragma("unroll") for(int r=4;r<16;r+=4){a=MX3(a,C0[r],C0[r+1]);b=MX3(b,C0[r+2],C0[r+3]);a=MX3(a,C1[r],C1[r+1]);b=MX3(b,C1[r+2],C1[r+3]);} \
      float rm=__builtin_fmaxf(a,b); { auto rr=__builtin_amdgcn_permlane32_swap(__float_as_uint(rm),__float_as_uint(rm),false,false); rm=__builtin_fmaxf(__uint_as_float(rr[0]),__uint_as_float(rr[1])); } \
      resc=false; \
      if(__builtin_expect(__any(rm>(float)THRL),0)){ const float dl=__builtin_fmaxf(rm,0.f); mhat+=dl; \
        _Pragma("unroll") for(int r=0;r<16;++r){C0[r]-=dl;C1[r]-=dl;} \
        const float f=__builtin_amdgcn_exp2f(-dl); l_reg*=f; if(hi==0)wsf[r32]=f; resc=true; } } \
    const float nb_=clq-mhat; const __attribute__((address_space(3))) float*cn_=clkp+((t)+1)*KVBLK; \
    SBAR(); \
    GAPB(o[0]=__builtin_amdgcn_mfma_f32_32x32x16_bf16(PAF(0),VFR(0),o[0],0,0,0), C0,0,GL,P0,0,0); \
    GAPB(o[1]=__builtin_amdgcn_mfma_f32_32x32x16_bf16(PAF(0),VFR(4),o[1],0,0,0), C0,4,GL,P0,1,0); \
    KRD(GL,0); GAPB(o[0]=__builtin_amdgcn_mfma_f32_32x32x16_bf16(PAF(1),VFR(1),o[0],0,0,0), C0,8,GL,P0,2,0); \
    KRD(GL,1); GAPB(o[1]=__builtin_amdgcn_mfma_f32_32x32x16_bf16(PAF(1),VFR(5),o[1],0,0,0), C0,12,GL,P0,3,0); \
    KRD(GL,2); GAPB(o[0]=__builtin_amdgcn_mfma_f32_32x32x16_bf16(PAF(2),VFR(2),o[0],0,0,0), C1,0,GL,P1,0,32); \
    KRD(GL,3); GAPB(o[1]=__builtin_amdgcn_mfma_f32_32x32x16_bf16(PAF(2),VFR(6),o[1],0,0,0), C1,4,GL,P1,1,32); \
    GAPB(o[0]=__builtin_amdgcn_mfma_f32_32x32x16_bf16(PAF(3),VFR(3),o[0],0,0,0), C1,8,GL,P1,2,32); \
    GAPB(o[1]=__builtin_amdgcn_mfma_f32_32x32x16_bf16(PAF(3),VFR(7),o[1],0,0,0), C1,12,GL,P1,3,32); \
    }while(0)
  int t=1;
  #undef CMASK
  #define CMASK(P0,P1,t) do{}while(0)
  for(;t+5<NT;t+=2){
    STEP(pB0,pB1,pA0,pA1,t,true,true,true);     WAIT_BAR(2); RESC(); ROT();
    STEP(pA0,pA1,pB0,pB1,t+1,true,true,true);   WAIT_BAR(2); RESC(); ROT();
  }
  #undef CMASK
  #define CMASK(P0,P1,t) do{int jb_=(t)-(NT-4); if(jb_>=0)cmask(P0,P1,jb_,qrel,hi);}while(0)
  #define ENDW(tt) do{ if((tt)+3<NT){WAIT_BAR(2);} else if((tt)+2<NT){WAIT_BAR(1);} else {WAIT_BAR(0);} }while(0)
  for(;t+1<NT;t+=2){
    STEP(pB0,pB1,pA0,pA1,t,(t+3<NT),(t+1<NT),(t+1<NT));       ENDW(t);   RESC(); ROT();
    STEP(pA0,pA1,pB0,pB1,t+1,(t+4<NT),(t+2<NT),(t+2<NT));     ENDW(t+1); RESC(); ROT();
  }
  STEP(pB0,pB1,pA0,pA1,NT-1,false,false,false); RESC();
  { float sacc=pB0[0]+pB0[1]; _Pragma("unroll") for(int r=2;r<16;++r)sacc+=pB0[r]; _Pragma("unroll") for(int r=0;r<16;++r)sacc+=pB1[r]; l_reg+=sacc;
    pw0=(u32x4){PKW(pB0,0),PKW(pB0,2),PKW(pB0,4),PKW(pB0,6)};pw1=(u32x4){PKW(pB0,8),PKW(pB0,10),PKW(pB0,12),PKW(pB0,14)};pw2=(u32x4){PKW(pB1,0),PKW(pB1,2),PKW(pB1,4),PKW(pB1,6)};pw3=(u32x4){PKW(pB1,8),PKW(pB1,10),PKW(pB1,12),PKW(pB1,14)};
    SBAR(); pv(o,vb0+sl_cur,PAF(0),PAF(1),PAF(2),PAF(3)); }
  #undef PKW
  #undef PAF
  #undef VFR
  #undef PIN
  #undef MX3
  #undef GAPA
  #undef GAPB
  #undef EX
  #undef VRD
  #undef KRD
  #undef STEP
  #undef ENDW
  {auto rr=__builtin_amdgcn_permlane32_swap(__float_as_uint(l_reg),__float_as_uint(l_reg),false,false);l_reg=__uint_as_float(rr[0])+__uint_as_float(rr[1]);}
  if(hi==0)wsf[32+r32]=l_reg;asm volatile("s_waitcnt lgkmcnt(0)":::"memory");
  float rli[16];
  #pragma unroll
  for(int r=0;r<16;++r)rli[r]=__builtin_amdgcn_rcpf(wsf[32+crow(r,hi)]);
  bf16*Ow=O+(rowbase+q0+wid*QBLK)*OP+h*D;
  { bf16*stg=(bf16*)(shm+LDS_OST)+wid*2048;
    #pragma unroll
    for(int r=0;r<16;++r){const int orow=crow(r,hi);
      #pragma unroll
      for(int d0=0;d0<2;++d0)stg[orow*64+d0*32+r32]=__float2bfloat16(o[d0][r]*rli[r]);}
    asm volatile("s_waitcnt lgkmcnt(0)":::"memory");
    #pragma unroll
    for(int i=0;i<4;++i){const int row=i*8+(lane>>3),ch=lane&7; const u32x4 v=*(const u32x4*)(stg+row*64+ch*8); ATTN_STORE16(Ow+(long)row*OP+ch*8,v);} }
  asm volatile("s_waitcnt lgkmcnt(0)\n\ts_barrier":::"memory");
  #undef BRD
  #undef BSUB
  #undef BFULL
  #undef DMA_K
  #undef DMA_V
  #undef CMASK
  #undef START
  #undef RESC
  #undef ROT
}
constexpr int ATTN_LDS_BYTES=LDS_BYTES;
#undef SBAR
#undef WAIT_BAR
}
namespace hg {
using attn_body::bf16x8; using attn_body::s16x4; using attn_body::f32x16; using attn_body::u32x4; using attn_body::lds_cptr; using attn_body::vtr; using attn_body::cvtpk_s;
typedef unsigned short us16;
typedef unsigned u32x2h __attribute__((ext_vector_type(2)));
#define HLAS __attribute__((address_space(3)))
constexpr int RS = 272;
constexpr int HC_QE = 0, HC_KT = 64 * RS, HC_V = 2 * 64 * RS, HC_ST = HC_V + 16384, HC_PS = HC_ST + 128 * RS, HC_END = HC_PS + 1024;
__device__ __forceinline__ float blo_(unsigned w) { return __builtin_bit_cast(float, w << 16); }
__device__ __forceinline__ float bhi_(unsigned w) { return __builtin_bit_cast(float, w & 0xffff0000u); }
__device__ __forceinline__ bf16x8 trfrag(lds_cptr blk, int s0, int lane) {
    const int hh = lane >> 5; const lds_cptr p = blk + ((lane >> 4) & 1) * 32 + (lane & 3) * 8 + (s0 + 4 * hh + ((lane & 15) >> 2)) * 64;
    const s16x4 lo = vtr(p), hi = vtr(p + 512);
    return (bf16x8){lo[0], lo[1], lo[2], lo[3], hi[0], hi[1], hi[2], hi[3]};
}
__device__ __forceinline__ void hgrn_a_run(int first, int step, int nitems, const us16* KD, const us16* VH, us16* UST, HLAS unsigned char* lds) {
    int tid_l = threadIdx.x; asm volatile("" : "+v"(tid_l)); const int tid = tid_l, lane = tid & 63, wid = __builtin_amdgcn_readfirstlane(tid >> 6), hh = lane >> 5;
    const lds_cptr KDi = (lds_cptr)lds, Vi = (lds_cptr)lds + 16384;
    const int r = tid >> 3, cc = (tid & 7) * 16;
    u32x4 ra[2], rv[2];
#define HGA_LOAD(item_) do { const int bh_ = (item_) / 129, c_ = (item_) % 129; const size_t g_ = ((size_t)(bh_ >> 3) * 8256 + 64 * c_ + r) * 1024 + (bh_ & 7) * 128 + cc; \
        ra[0] = *(const u32x4*)(KD + g_); ra[1] = *(const u32x4*)(KD + g_ + 8); rv[0] = *(const u32x4*)(VH + g_); rv[1] = *(const u32x4*)(VH + g_ + 8); } while (0)
    if (first < nitems) HGA_LOAD(first);
    for (int item = first; item < nitems; item += step) {
        __syncthreads();
#pragma unroll
        for (int q2 = 0; q2 < 2; ++q2) { const int off = (cc >> 5) * 4096 + r * 64 + ((cc & 31) + 8 * q2) * 2; *(HLAS u32x4*)(lds + off) = ra[q2]; *(HLAS u32x4*)(lds + 16384 + off) = rv[q2]; }
        __syncthreads();
        if (item + step < nitems) HGA_LOAD(item + step);
        const int kt = wid >> 1, vt0 = (wid & 1) * 2;
        f32x16 acc0 = {}, acc1 = {};
#pragma unroll
        for (int ks = 0; ks < 4; ++ks) {
            const bf16x8 a = trfrag(KDi + kt * 4096, 16 * ks, lane), b0 = trfrag(Vi + vt0 * 4096, 16 * ks, lane), b1 = trfrag(Vi + (vt0 + 1) * 4096, 16 * ks, lane);
            acc0 = __builtin_amdgcn_mfma_f32_32x32x16_bf16(a, b0, acc0, 0, 0, 0); acc1 = __builtin_amdgcn_mfma_f32_32x32x16_bf16(a, b1, acc1, 0, 0, 0);
        }
        us16* dst = UST + (size_t)item * 16384 + (size_t)(32 * vt0 + (lane & 31)) * 128 + 32 * kt + 4 * hh;
#pragma unroll
        for (int g = 0; g < 4; ++g) {
            u32x2h w; w.x = cvtpk_s(acc0[4 * g], acc0[4 * g + 1]); w.y = cvtpk_s(acc0[4 * g + 2], acc0[4 * g + 3]); *(u32x2h*)(dst + 8 * g) = w;
            w.x = cvtpk_s(acc1[4 * g], acc1[4 * g + 1]); w.y = cvtpk_s(acc1[4 * g + 2], acc1[4 * g + 3]); *(u32x2h*)(dst + 32 * 128 + 8 * g) = w;
        }
    }
#undef HGA_LOAD
}
__device__ __forceinline__ void hgrn_c_run(int first, int step, int nitems, const us16* QH, const us16* EB, const us16* KT, const us16* VH, const us16* GH, const us16* UST, us16* OH, const float* hnw, float eps, HLAS unsigned char* lds) {
    int tid_l = threadIdx.x; asm volatile("" : "+v"(tid_l)); const int tid = tid_l, lane = tid & 63, wid = __builtin_amdgcn_readfirstlane(tid >> 6), hh = lane >> 5, r32 = lane & 31;
    const lds_cptr L = (lds_cptr)lds;
    const int r = tid >> 3, cc = (tid & 7) * 16;
    u32x4 rq[2], re[2], rk[2], rv[2], rs4[4];
#define HGC_LOAD(item_) do { const int bh_ = (item_) >> 7, c_ = ((item_) & 127) + 1, b_ = bh_ >> 3, h_ = bh_ & 7; \
        const size_t g_ = ((size_t)b_ * 8192 + 64 * (c_ - 1) + r) * 1024 + h_ * 128 + cc, gv_ = ((size_t)b_ * 8256 + 64 * c_ + r) * 1024 + h_ * 128 + cc; \
        rq[0] = *(const u32x4*)(QH + g_); rq[1] = *(const u32x4*)(QH + g_ + 8); re[0] = *(const u32x4*)(EB + g_); re[1] = *(const u32x4*)(EB + g_ + 8); \
        rk[0] = *(const u32x4*)(KT + g_); rk[1] = *(const u32x4*)(KT + g_ + 8); rv[0] = *(const u32x4*)(VH + gv_); rv[1] = *(const u32x4*)(VH + gv_ + 8); \
        const us16* sp_ = UST + ((size_t)bh_ * 129 + (c_ - 1)) * 16384; \
        _Pragma("unroll") for (int i_ = 0; i_ < 4; ++i_) { const int p_ = tid + 512 * i_; rs4[i_] = *(const u32x4*)(sp_ + (p_ >> 4) * 128 + (p_ & 15) * 8); } } while (0)
    if (first < nitems) HGC_LOAD(first);
    for (int item = first; item < nitems; item += step) {
        const int bh = item >> 7, c = (item & 127) + 1, b = bh >> 3, h = bh & 7;
        const size_t r0 = (size_t)b * 8192 + 64 * (c - 1);
        __syncthreads();
#pragma unroll
        for (int q2 = 0; q2 < 2; ++q2) {
            const u32x4 a = rq[q2], e = re[q2];
            u32x4 w; w.x = cvtpk_s(blo_(a.x) * blo_(e.x), bhi_(a.x) * bhi_(e.x)); w.y = cvtpk_s(blo_(a.y) * blo_(e.y), bhi_(a.y) * bhi_(e.y));
            w.z = cvtpk_s(blo_(a.z) * blo_(e.z), bhi_(a.z) * bhi_(e.z)); w.w = cvtpk_s(blo_(a.w) * blo_(e.w), bhi_(a.w) * bhi_(e.w));
            *(HLAS u32x4*)(lds + HC_QE + r * RS + (cc + 8 * q2) * 2) = w;
            *(HLAS u32x4*)(lds + HC_KT + r * RS + (cc + 8 * q2) * 2) = rk[q2];
            *(HLAS u32x4*)(lds + HC_V + (cc >> 5) * 4096 + r * 64 + ((cc & 31) + 8 * q2) * 2) = rv[q2]; }
#pragma unroll
        for (int i = 0; i < 4; ++i) { const int p = tid + 512 * i, row = p >> 4, ch = p & 15; *(HLAS u32x4*)(lds + HC_ST + row * RS + ch * 16) = rs4[i]; }
        __syncthreads();
        if (item + step < nitems) HGC_LOAD(item + step);
        u32x4 gq[2]; { const size_t go = (r0 + r) * 1024 + h * 128 + cc; gq[0] = *(const u32x4*)(GH + go); gq[1] = *(const u32x4*)(GH + go + 8); }
    const int tt = wid >> 2, vt = wid & 3;
    f32x16 o = {};
    const lds_cptr qrow = L + HC_QE + (32 * tt + r32) * RS + 16 * hh;
#pragma unroll
    for (int st = 0; st < 2; ++st) {
        if (st <= tt) {
            f32x16 p = {};
            const lds_cptr krow = L + HC_KT + (32 * st + r32) * RS + 16 * hh;
#pragma unroll
            for (int ks = 0; ks < 8; ++ks) { const bf16x8 a = *(const HLAS bf16x8*)(krow + 32 * ks), q = *(const HLAS bf16x8*)(qrow + 32 * ks); p = __builtin_amdgcn_mfma_f32_32x32x16_bf16(a, q, p, 0, 0, 0); }
            if (st == tt) {
#pragma unroll
                for (int r = 0; r < 16; ++r) { const int s = (r & 3) + 8 * (r >> 2) + 4 * hh; if (s > r32) p[r] = 0.f; }
            }
            u32x4 pw0, pw1;
            pw0.x = cvtpk_s(p[0], p[1]); pw0.y = cvtpk_s(p[2], p[3]); pw0.z = cvtpk_s(p[4], p[5]); pw0.w = cvtpk_s(p[6], p[7]);
            pw1.x = cvtpk_s(p[8], p[9]); pw1.y = cvtpk_s(p[10], p[11]); pw1.z = cvtpk_s(p[12], p[13]); pw1.w = cvtpk_s(p[14], p[15]);
            const bf16x8 v0 = trfrag(L + HC_V + vt * 4096, 32 * st, lane), v1 = trfrag(L + HC_V + vt * 4096, 32 * st + 16, lane);
            o = __builtin_amdgcn_mfma_f32_32x32x16_bf16(__builtin_bit_cast(bf16x8, pw0), v0, o, 0, 0, 0);
            o = __builtin_amdgcn_mfma_f32_32x32x16_bf16(__builtin_bit_cast(bf16x8, pw1), v1, o, 0, 0, 0);
        }
    }
    { const lds_cptr srow = L + HC_ST + (32 * vt + r32) * RS + 16 * hh;
#pragma unroll
      for (int ks = 0; ks < 8; ++ks) { const bf16x8 a = *(const HLAS bf16x8*)(qrow + 32 * ks), s = *(const HLAS bf16x8*)(srow + 32 * ks); o = __builtin_amdgcn_mfma_f32_32x32x16_bf16(a, s, o, 0, 0, 0); } }
    float sq[16];
#pragma unroll
    for (int r = 0; r < 16; ++r) { float s = o[r] * o[r]; s += __shfl_xor(s, 1); s += __shfl_xor(s, 2); s += __shfl_xor(s, 4); s += __shfl_xor(s, 8); s += __shfl_xor(s, 16); sq[r] = s; }
    if (r32 == 0) {
#pragma unroll
        for (int r = 0; r < 16; ++r) *(HLAS float*)(lds + HC_PS + ((32 * tt + (r & 3) + 8 * (r >> 2) + 4 * hh) * 4 + vt) * 4) = sq[r];
    }
    __syncthreads();
#pragma unroll
    for (int r = 0; r < 16; ++r) { const int t = 32 * tt + (r & 3) + 8 * (r >> 2) + 4 * hh; const attn_body::f32x4g ps = *(const HLAS attn_body::f32x4g*)(lds + HC_PS + t * 16);
        const float rs = 1.0f / sqrtf(((ps.x + ps.y) + (ps.z + ps.w)) * (1.0f / 128.0f) + eps);
        *(HLAS us16*)(lds + HC_QE + t * RS + (32 * vt + r32) * 2) = (us16)(cvtpk_s(o[r] * rs, 0.f) & 0xffffu); }
    __syncthreads();
    { const size_t oo = (r0 + r) * 1536 + h * 128 + cc;
#pragma unroll
      for (int q2 = 0; q2 < 2; ++q2) {
          const u32x4 y = *(const HLAS u32x4*)(lds + HC_QE + r * RS + (cc + 8 * q2) * 2), g = gq[q2];
          const attn_body::f32x4g w0 = *(const attn_body::f32x4g*)(hnw + cc + 8 * q2), w1 = *(const attn_body::f32x4g*)(hnw + cc + 8 * q2 + 4);
          u32x4 w; w.x = cvtpk_s(blo_(y.x) * w0.x * blo_(g.x), bhi_(y.x) * w0.y * bhi_(g.x)); w.y = cvtpk_s(blo_(y.y) * w0.z * blo_(g.y), bhi_(y.y) * w0.w * bhi_(g.y));
          w.z = cvtpk_s(blo_(y.z) * w1.x * blo_(g.z), bhi_(y.z) * w1.y * bhi_(g.z)); w.w = cvtpk_s(blo_(y.w) * w1.z * blo_(g.w), bhi_(y.w) * w1.w * bhi_(g.w));
          *(u32x4*)(OH + oo + 8 * q2) = w; } }
    }
#undef HGC_LOAD
}
#undef HLAS
}
#define XB_TMO      128
#define XB_XCNT(j)  (256  + 64 * (j))
#define XB_XSUB(j)  (1280 + 64 * (j))
#define XB_XGEN(j)  (2304 + 64 * (j))
#define XB_TOP      3328
#define XB_TOPGEN   3392
#define XCD_BAR_WORDS 3456
#define XB_SPIN_CAP (1u << 18)

__device__ __forceinline__ unsigned xb_ld(unsigned* p)              { return __hip_atomic_load(p, __ATOMIC_RELAXED, __HIP_MEMORY_SCOPE_AGENT); }
__device__ __forceinline__ unsigned xb_add(unsigned* p, unsigned v) { return __hip_atomic_fetch_add(p, v, __ATOMIC_RELAXED, __HIP_MEMORY_SCOPE_AGENT); }
__device__ __forceinline__ unsigned xb_xcc_id() { return (unsigned)__builtin_amdgcn_s_getreg((3 << 11) | 20) & 0xFu; }
#define XB_SPIN(cond, bar) do { unsigned _sp = 0; while (cond) { __builtin_amdgcn_s_sleep(1); \
    if ((++_sp & 255u) == 0u) { if (xb_ld(&(bar)[XB_TMO])) break; if (_sp > XB_SPIN_CAP) { atomicAdd(&(bar)[XB_TMO], 1u); break; } } } } while (0)

struct XcdBarrier {
    unsigned* bar; unsigned x;
    volatile LAS unsigned* st;
};

__device__ __forceinline__ XcdBarrier xcd_barrier_post(unsigned* bar, volatile LAS unsigned* st) {
    XcdBarrier b; b.bar = bar; b.x = xb_xcc_id(); b.st = st;
    if (threadIdx.x == 0) (void)xb_add(&bar[XB_XCNT(b.x)], 1u);
    return b;
}
__device__ __forceinline__ void xcd_barrier_complete(unsigned* bar, unsigned x, unsigned& nloc, unsigned& nx) {
    const unsigned G = gridDim.x * gridDim.y * gridDim.z;
    unsigned sum, cnt, mine, sp = 0u;
    for (;;) {
        sum = 0u; cnt = 0u; mine = 0u;
#pragma unroll
        for (unsigned j = 0; j < 16; ++j) { const unsigned c = xb_ld(&bar[XB_XCNT(j)]); sum += c; cnt += (c > 0u) ? 1u : 0u; mine = (j == x) ? c : mine; }
        if (sum == G) break;
        __builtin_amdgcn_s_sleep(1);
        if ((++sp & 255u) == 0u) { if (xb_ld(&bar[XB_TMO])) break; if (sp > XB_SPIN_CAP) { atomicAdd(&bar[XB_TMO], 1u); break; } }
    }
    nloc = mine > 0u ? mine : 1u; nx = cnt > 0u ? cnt : 1u;
}

__device__ __forceinline__ void xcd_barrier(const XcdBarrier& b) {
    asm volatile("s_waitcnt vmcnt(0)" ::: "memory");
    __syncthreads();
    if (threadIdx.x == 0) {
        unsigned* bar = b.bar;
        __builtin_amdgcn_s_waitcnt(0);
        unsigned nloc = b.st[0], nx = b.st[1];
        if (nloc == 0u) { xcd_barrier_complete(bar, b.x, nloc, nx); b.st[0] = nloc; b.st[1] = nx; }
        const unsigned old = xb_add(&bar[XB_XSUB(b.x)], 1u);
        const unsigned gen = old / nloc;
        if (old + 1u == (gen + 1u) * nloc) {
            __builtin_amdgcn_fence(__ATOMIC_RELEASE, "agent");
            asm volatile("s_waitcnt vmcnt(0)" ::: "memory");
            const unsigned og = xb_add(&bar[XB_TOP], 1u);
            const unsigned tg = og / nx;
            if (og + 1u == (tg + 1u) * nx) xb_add(&bar[XB_TOPGEN], 1u);
            else XB_SPIN(xb_ld(&bar[XB_TOPGEN]) == tg, bar);
            __builtin_amdgcn_fence(__ATOMIC_ACQUIRE, "agent");
            xb_add(&bar[XB_XGEN(b.x)], 1u);
            asm volatile("s_waitcnt vmcnt(0)" ::: "memory");
        } else {
            XB_SPIN(xb_ld(&bar[XB_XGEN(b.x)]) == gen, bar);
            __builtin_amdgcn_fence(__ATOMIC_ACQUIRE, "agent");
            asm volatile("s_waitcnt vmcnt(0)" ::: "memory");
        }
    }
    __syncthreads();
}
struct Frame {
    LAS unsigned char* lds;
    volatile LAS unsigned* MISC;
    gu32* ctl;
    unsigned char* ws;
    int tid, lane, wave;
    int vcu, G;
    const float* in[18];
    float* out;
};
#ifndef PROBE_MASK
#define PROBE_MASK 0
#endif
#define STAMP(k) do { if (PROBE_MASK != 0 && blockIdx.x == 0 && F.wave == 0) ((volatile LAS unsigned*)(F.lds + MISC_OFF))[16 + (k)] = (unsigned)__builtin_amdgcn_s_memrealtime(); } while (0)
__device__ __forceinline__ float wave_sum(float v) {
#pragma unroll
    for (int o = 1; o < 64; o <<= 1) v += __shfl_xor(v, o);
    return v;
}

__device__ __forceinline__ void p0_transpose_item(const float* W, int ldw, int K, int ncols, bf16* WT, int mode, int row_off, LAS float* scr, int item, int lane, int ldt = 0, int koff = 0) {
    if (ldt == 0) ldt = K;
    const int nblk = ncols / 64, kb = item / nblk, nb = item % nblk, k0 = 64 * kb, n0 = 64 * nb;
    int d0 = row_off + n0;
    if (mode == 1) { d0 = (n0 < 512) ? (256 * (n0 >> 7) + (n0 & 127)) : (256 * ((n0 - 512) >> 7) + 128 + ((n0 - 512) & 127)); }
    const int kr = lane >> 4, nc = 4 * (lane & 15);
    f32x4 v[16];
#pragma unroll
    for (int i = 0; i < 16; ++i) v[i] = *(const f32x4*)(W + (size_t)(k0 + 4 * i + kr) * ldw + n0 + nc);
#pragma unroll
    for (int i = 0; i < 16; ++i) { LAS float* s = scr + (4 * i + kr) * 65 + nc; s[0] = v[i].x; s[1] = v[i].y; s[2] = v[i].z; s[3] = v[i].w; }
    LDS_WAIT(); asm volatile("" ::: "memory");
    const int c = lane & 7;
#pragma unroll
    for (int j = 0; j < 8; ++j) { const int n = (lane >> 3) + 8 * j; const LAS float* s = scr + (8 * c) * 65 + n;
        v4u o; o.x = pk2(s[0 * 65], s[1 * 65]); o.y = pk2(s[2 * 65], s[3 * 65]); o.z = pk2(s[4 * 65], s[5 * 65]); o.w = pk2(s[6 * 65], s[7 * 65]);
        *(GAS v4u*)(WT + (size_t)(d0 + n) * ldt + koff + k0 + 8 * c) = o; }
    LDS_WAIT(); asm volatile("" ::: "memory");
}

__device__ __forceinline__ void p0_meta(Frame& F) {
    const float* meta = F.in[1]; const float* nw = F.in[2]; const float* Win = F.in[3];
    LAS float* um = (LAS float*)(F.lds + RING_OFF);
    LAS float* part = (LAS float*)(F.lds + RING_OFF + 65536);
#pragma unroll
    for (int rr = 0; rr < 2; ++rr) {
        const int r = 2 * F.wave + rr;
        f32x4 v[4]; float ss = 0.f;
#pragma unroll
        for (int j = 0; j < 4; ++j) { v[j] = *(const f32x4*)(meta + (size_t)r * DM + 4 * F.lane + 256 * j); ss += (v[j].x * v[j].x + v[j].y * v[j].y) + (v[j].z * v[j].z + v[j].w * v[j].w); }
        const float rs = 1.0f / sqrtf(wave_sum(ss) * (1.0f / DM) + EPS);
#pragma unroll
        for (int j = 0; j < 4; ++j) { const f32x4 w = *(const f32x4*)(nw + 4 * F.lane + 256 * j); const int k = 4 * F.lane + 256 * j;
            um[(k + 0) * 16 + r] = v[j].x * rs * w.x; um[(k + 1) * 16 + r] = v[j].y * rs * w.y; um[(k + 2) * 16 + r] = v[j].z * rs * w.z; um[(k + 3) * 16 + r] = v[j].w * rs * w.w; }
    }
    __syncthreads();
    const int item = F.vcu;
    int type, strip;
    if (item < 8) { type = 0; strip = item; } else if (item < 16) { type = 1; strip = item - 8; } else if (item < 32) { type = 2; strip = item - 16; } else if (item < 48) { type = 3; strip = item - 32; } else { type = 4; strip = 0; }
    int col;
    if (type == 0) col = 512 + 64 * strip + F.lane; else if (type == 1) col = 1024 + 64 * strip + F.lane; else if (type == 2) col = 2568 + 64 * strip + F.lane;
    else if (type == 3) col = 3592 + 64 * strip + F.lane; else col = 1536 + (F.lane & 7);
    float acc[16];
#pragma unroll
    for (int r = 0; r < 16; ++r) acc[r] = 0.f;
    const int k0 = 128 * F.wave;
#pragma unroll 1
    for (int kb = 0; kb < 128; kb += 8) {
        float w[8];
#pragma unroll
        for (int i = 0; i < 8; ++i) w[i] = Win[(size_t)(k0 + kb + i) * INW + col];
#pragma unroll
        for (int i = 0; i < 8; ++i) {
            const LAS f32x4* up = (const LAS f32x4*)(um + (k0 + kb + i) * 16);
            const f32x4 u0 = up[0], u1 = up[1], u2 = up[2], u3 = up[3];
            acc[0] += w[i] * u0.x; acc[1] += w[i] * u0.y; acc[2] += w[i] * u0.z; acc[3] += w[i] * u0.w;
            acc[4] += w[i] * u1.x; acc[5] += w[i] * u1.y; acc[6] += w[i] * u1.z; acc[7] += w[i] * u1.w;
            acc[8] += w[i] * u2.x; acc[9] += w[i] * u2.y; acc[10] += w[i] * u2.z; acc[11] += w[i] * u2.w;
            acc[12] += w[i] * u3.x; acc[13] += w[i] * u3.y; acc[14] += w[i] * u3.z; acc[15] += w[i] * u3.w;
        }
    }
#pragma unroll
    for (int r = 0; r < 16; ++r) part[(F.wave * 16 + r) * 64 + F.lane] = acc[r];
    __syncthreads();
    if (F.wave == 0) {
#pragma unroll
        for (int r = 0; r < 16; ++r) { float s = 0.f;
#pragma unroll
            for (int w8 = 0; w8 < 8; ++w8) s += part[(w8 * 16 + r) * 64 + F.lane];
            acc[r] = s; }
        const int c = 64 * strip + F.lane;
        if (type == 0 || type == 1) {
            bf16* dst = (bf16*)(F.ws + (type == 0 ? WS_KA : WS_VA));
#pragma unroll
            for (int b = 0; b < 2; ++b) {
#pragma unroll
                for (int r = 0; r < 16; ++r) dst[((size_t)b * KROWS + r) * AWID + c] = (bf16)f2bf(acc[r]);
                for (int r = 16; r < 128; ++r) dst[((size_t)b * KROWS + r) * AWID + c] = (bf16)0;
            }
        } else if (type == 3) {
            bf16* dst = (bf16*)(F.ws + WS_VH);
#pragma unroll
            for (int b = 0; b < 2; ++b) {
                for (int r = 0; r < 48; ++r) dst[((size_t)b * HROWS + r) * DM + c] = (bf16)0;
#pragma unroll
                for (int r = 0; r < 16; ++r) dst[((size_t)b * HROWS + 48 + r) * DM + c] = (bf16)f2bf(acc[r]);
            }
        } else if (type == 2) {
            const float* lbl = F.in[5];
            const float lb = 1.0f / (1.0f + __expf(lbl[1024 + c] - lbl[c]));
            float kk[16], bb[16]; float run = 0.f;
#pragma unroll
            for (int r = 0; r < 16; ++r) { const float f = lb + (1.0f - lb) * (1.0f / (1.0f + __expf(-acc[r]))); kk[r] = 1.0f - f; run += __logf(f); bb[r] = run; }
            bf16* dst = (bf16*)(F.ws + WS_KD);
#pragma unroll
            for (int b = 0; b < 2; ++b) {
                for (int r = 0; r < 48; ++r) dst[((size_t)b * HROWS + r) * DM + c] = (bf16)0;
#pragma unroll
                for (int r = 0; r < 16; ++r) dst[((size_t)b * HROWS + 48 + r) * DM + c] = (bf16)f2bf(kk[r] * __expf(run - bb[r]));
            }
        } else {
            if (F.lane < 8) { float* lfam = (float*)(F.ws + WS_LFAM); const float bias = F.in[4][F.lane];
#pragma unroll
                for (int r = 0; r < 16; ++r) lfam[r * 8 + F.lane] = log_sigmoid(acc[r] + bias); }
        }
    }
    __syncthreads();
}

__device__ __forceinline__ void p0_rows(Frame& F) {
    const float* x = F.in[0]; const float* nw = F.in[2]; const float* Win = F.in[3]; const float* afb = F.in[4];
    LAS float* wfa = (LAS float*)(F.lds + RING_OFF);
    for (int i = F.tid; i < 8 * DM; i += NWAVES * 64) { const int k = i >> 3, h = i & 7; wfa[h * DM + k] = nw[k] * Win[(size_t)k * INW + 1536 + h]; }
    __syncthreads();
    const int gw = F.vcu * NWAVES + F.wave, NGW = F.G * NWAVES;
    f32x4 wv[4];
#pragma unroll
    for (int j = 0; j < 4; ++j) wv[j] = *(const f32x4*)(nw + 4 * F.lane + 256 * j);
    bf16* U = (bf16*)(F.ws + WS_U); float* lfa = (float*)(F.ws + WS_LFA);
    for (int m = gw; m < MR; m += NGW) {
        f32x4 v[4]; float ss = 0.f;
#pragma unroll
        for (int j = 0; j < 4; ++j) { v[j] = *(const f32x4*)(x + (size_t)m * DM + 4 * F.lane + 256 * j); ss += (v[j].x * v[j].x + v[j].y * v[j].y) + (v[j].z * v[j].z + v[j].w * v[j].w); }
        const float rs = 1.0f / sqrtf(wave_sum(ss) * (1.0f / DM) + EPS);
        GAS unsigned long long* o8 = (GAS unsigned long long*)(U + (size_t)m * DM) + F.lane;
#pragma unroll
        for (int j = 0; j < 4; ++j) { const f32x4 u = v[j] * rs * wv[j]; o8[64 * j] = (unsigned long long)pk2(u.x, u.y) | ((unsigned long long)pk2(u.z, u.w) << 32); }
        float z[8];
#pragma unroll
        for (int h = 0; h < 8; ++h) { float s = 0.f;
#pragma unroll
            for (int j = 0; j < 4; ++j) { const f32x4 w = *(const LAS f32x4*)(wfa + h * DM + 4 * F.lane + 256 * j); s += (v[j].x * w.x + v[j].y * w.y) + (v[j].z * w.z + v[j].w * w.w); }
            z[h] = wave_sum(s); }
        float zz = z[0];
#pragma unroll
        for (int h = 1; h < 8; ++h) zz = (F.lane == h) ? z[h] : zz;
        if (F.lane < 8) lfa[(size_t)m * 8 + F.lane] = log_sigmoid(zz * rs + afb[F.lane]);
    }
    __syncthreads();
}

__device__ __forceinline__ void p0_weights(Frame& F) {
    LAS float* scr = (LAS float*)(F.lds + RING_OFF + F.wave * 18432);
    const int gw = F.vcu * NWAVES + F.wave, NGW = F.G * NWAVES;
    constexpr int I1 = 16 * 24, I2 = 16 * 96, IA = 8 * 16, IH = 16 * 16, IO = 16 * 16;
    constexpr int NIT = I1 + I2 + IA + IH + IO;
    bf16* win = (bf16*)(F.ws + WS_WIN);
    for (int it = gw; it < NIT; it += NGW) {
        int r = it;
        if (r < I1) { p0_transpose_item(F.in[3], INW, DM, 1536, win, 0, 0, scr, r, F.lane); continue; } r -= I1;
        if (r < I2) { p0_transpose_item(F.in[3] + 1544, INW, DM, 6144, win, 0, 1536, scr, r, F.lane); continue; } r -= I2;
        if (r < IA) { p0_transpose_item(F.in[7], DM, AWID, DM, (bf16*)(F.ws + WS_WAH), 0, 0, scr, r, F.lane, AWID + DM, 0); continue; } r -= IA;
        if (r < IH) { p0_transpose_item(F.in[8], DM, DM, DM, (bf16*)(F.ws + WS_WAH), 0, 0, scr, r, F.lane, AWID + DM, AWID); continue; } r -= IH;
        p0_transpose_item(F.in[9], DM, DM, DM, (bf16*)(F.ws + WS_WO), 0, 0, scr, r, F.lane);
    }
}
__device__ __forceinline__ void p7_expert_weights(Frame& F) {
    LAS float* scr = (LAS float*)(F.lds + RING_OFF + F.wave * 18432);
    const int gw = F.vcu * NWAVES + F.wave, NGW = F.G * NWAVES;
    constexpr int I1 = 16 * 16, I2 = 8 * 16;
    for (int it = gw; it < NE * (I1 + I2); it += NGW) {
        const int e = it / (I1 + I2); int r = it % (I1 + I2);
        if (r < I1) p0_transpose_item(F.in[15] + (size_t)e * DM * DM, DM, DM, DM, (bf16*)(F.ws + WS_WE1) + (size_t)e * DM * DM, 1, 0, scr, r, F.lane);
        else p0_transpose_item(F.in[16] + (size_t)e * EFF * DM, DM, EFF, DM, (bf16*)(F.ws + WS_WE2) + (size_t)e * DM * EFF, 0, 0, scr, r - I1, F.lane);
    }
}

__device__ __forceinline__ void p1_cumsum(Frame& F, int bh) {
    const int b = bh >> 3, h = bh & 7;
    const float* lfa = (const float*)(F.ws + WS_LFA); const float* lfam = (const float*)(F.ws + WS_LFAM); float* cl = (float*)(F.ws + WS_CL) + (size_t)bh * KROWS;
    LAS float* wtot = (LAS float*)(F.lds + RING_OFF);
    float cm = 0.f;
    for (int r = 0; r < 16; ++r) { cm += lfam[r * 8 + h]; if (F.tid == r) cl[r] = cm * 1.4426950408889634f; }
    if (F.tid >= 16 && F.tid < 128) cl[F.tid] = 1e30f;
    float loc[16]; float run = 0.f;
#pragma unroll
    for (int i = 0; i < 16; ++i) { run += lfa[((size_t)b * SEQ + 16 * F.tid + i) * 8 + h]; loc[i] = run; }
    float inc = run;
#pragma unroll
    for (int o = 1; o < 64; o <<= 1) { const float t = __shfl_up(inc, o); if (F.lane >= o) inc += t; }
    if (F.lane == 63) wtot[F.wave] = inc;
    __syncthreads();
    float pre = cm + (inc - run);
    for (int w = 0; w < F.wave; ++w) pre += wtot[w];
#pragma unroll
    for (int i = 0; i < 16; ++i) cl[128 + 16 * F.tid + i] = (pre + loc[i]) * 1.4426950408889634f;
    __syncthreads();
}


__device__ __forceinline__ void hgrn_scan_t(Frame& F) {
    const bf16* EB = (const bf16*)(F.ws + WS_EB); bf16* US = (bf16*)(F.ws + WS_US);
    for (int idx = blockIdx.x * (NWAVES * 64) + F.tid; idx < 16 * 128 * 64; idx += F.G * NWAVES * 64) {
        const int bh = idx >> 13, rem = idx & 8191, v = rem >> 6, kp = rem & 63, b = bh >> 3, h = bh & 7;
        unsigned* base = (unsigned*)(US + (size_t)bh * NCH * (HK * HV) + v * 128) + kp;
        const unsigned* ap = (const unsigned*)(EB + ((size_t)b * SEQ + 63) * DM + h * 128) + kp;
        unsigned w = base[0]; float s0 = blo(w), s1 = bhi(w);
        for (int c0 = 1; c0 < NCH; c0 += 16) {
            unsigned aw[16], uw[16];
#pragma unroll
            for (int i = 0; i < 16; ++i) { aw[i] = ap[(size_t)(c0 - 1 + i) * 64 * (DM / 2)]; uw[i] = base[(size_t)(c0 + i) * (HK * HV / 2)]; }
#pragma unroll
            for (int i = 0; i < 16; ++i) { s0 = blo(aw[i]) * s0 + blo(uw[i]); s1 = bhi(aw[i]) * s1 + bhi(uw[i]); base[(size_t)(c0 + i) * (HK * HV / 2)] = pk2(s0, s1); }
        }
    }
}


__device__ __forceinline__ float row16_sum(float v) {
    v += __builtin_bit_cast(float, __builtin_amdgcn_update_dpp(0, __builtin_bit_cast(int, v), 0xB1, 0xf, 0xf, true));
    v += __builtin_bit_cast(float, __builtin_amdgcn_update_dpp(0, __builtin_bit_cast(int, v), 0x4E, 0xf, 0xf, true));
    v += __builtin_bit_cast(float, __builtin_amdgcn_update_dpp(0, __builtin_bit_cast(int, v), 0x141, 0xf, 0xf, true));
    v += __builtin_bit_cast(float, __builtin_amdgcn_update_dpp(0, __builtin_bit_cast(int, v), 0x140, 0xf, 0xf, true));
    return v;
}
__device__ __forceinline__ float wave_sum2(float v) { v = row16_sum(v); v += __shfl_xor(v, 16); v += __shfl_xor(v, 32); return v; }
__device__ __forceinline__ void p0_router_table(Frame& F) {
    const float* nfw = F.in[10]; const float* wrg = F.in[11]; const float* wre = F.in[13]; float* TR = (float*)(F.ws + WS_TR);
    for (int i = blockIdx.x * (NWAVES * 64) + F.tid; i < 36 * DM; i += F.G * NWAVES * 64) { const int j = i >> 10, k = i & 1023; TR[i] = nfw[k] * (j < 4 ? wrg[k * 4 + j] : wre[k * 32 + (j - 4)]); }
}
__device__ __forceinline__ void p7_router(Frame& F) {
    const float* h1 = F.out; const float* nfw = F.in[10]; const float* brg = F.in[12]; const float* bre = F.in[14];
    bf16* XN = (bf16*)(F.ws + WS_XN); unsigned* ASG = (unsigned*)(F.ws + WS_ASG); float* GATE = (float*)(F.ws + WS_GATE);
    LAS float* T = (LAS float*)(F.lds + RING_OFF);
    { const f32x4* src = (const f32x4*)(F.ws + WS_TR); for (int i = F.tid; i < 36 * DM / 4; i += NWAVES * 64) ((LAS f32x4*)T)[i] = src[i]; }
    __syncthreads();
    STAMP(14);
    const int gw = F.vcu * NWAVES + F.wave, NGW = F.G * NWAVES;
    volatile LAS unsigned* lcnt = (volatile LAS unsigned*)(F.lds + MISC_OFF) + 64;
    volatile LAS unsigned* gbase = lcnt + 32;
    for (int pass = 0; pass * 2 * NGW < MR / 4; ++pass) {
    if (F.tid < 32) lcnt[F.tid] = 0u;
    __syncthreads();
    unsigned myE = 0u, myL = 0u; float myG = 0.f; int myrow = 0;
#pragma unroll 1
    for (int gi = 0; gi < 2; ++gi) {
        const int g4 = pass * 2 * NGW + 2 * gw + gi;
        if (g4 < MR / 4) {
        const int rowb = g4 * 4;
        f32x4 x[4][4]; float ss[4];
#pragma unroll
        for (int r = 0; r < 4; ++r) { ss[r] = 0.f;
#pragma unroll
            for (int q = 0; q < 4; ++q) { x[r][q] = *(const f32x4*)(h1 + (size_t)(rowb + r) * DM + 256 * q + 4 * F.lane); ss[r] += (x[r][q].x * x[r][q].x + x[r][q].y * x[r][q].y) + (x[r][q].z * x[r][q].z + x[r][q].w * x[r][q].w); } }
        float lgp[4][3];
#pragma unroll
        for (int r = 0; r < 4; ++r) { lgp[r][0] = 0.f; lgp[r][1] = 0.f; lgp[r][2] = 0.f; }
#pragma unroll
        for (int jb = 0; jb < 3; ++jb) {
#pragma unroll 1
            for (int jj = 0; jj < (jb == 2 ? 4 : 16); ++jj) {
                const int j = 16 * jb + jj;
                float a4[4] = {0.f, 0.f, 0.f, 0.f};
#pragma unroll
                for (int q = 0; q < 4; ++q) { const f32x4 w = *(const LAS f32x4*)(T + j * DM + 256 * q + 4 * F.lane);
#pragma unroll
                    for (int r = 0; r < 4; ++r) a4[r] += (x[r][q].x * w.x + x[r][q].y * w.y) + (x[r][q].z * w.z + x[r][q].w * w.w); }
#pragma unroll
                for (int r = 0; r < 4; ++r) { const float s = row16_sum(a4[r]); lgp[r][jb] = ((F.lane & 15) == jj) ? s : lgp[r][jb]; }
            }
        }
#pragma unroll
        for (int r = 0; r < 4; ++r)
#pragma unroll
            for (int jb = 0; jb < 3; ++jb) { float v = lgp[r][jb]; v += __shfl_xor(v, 16); v += __shfl_xor(v, 32); lgp[r][jb] = v; }
        float mybias[3];
        { const int l15 = F.lane & 15; mybias[0] = l15 < 4 ? brg[l15 & 3] : bre[(l15 - 4) & 31]; mybias[1] = bre[12 + l15]; mybias[2] = l15 < 4 ? bre[28 + l15] : 0.f; }
#pragma unroll
        for (int r = 0; r < 4; ++r) {
            const int row = rowb + r;
            const float rs = 1.0f / sqrtf(wave_sum2(ss[r]) * (1.0f / DM) + EPS);
            const float lgv0 = lgp[r][0] * rs + mybias[0], lgv1 = lgp[r][1] * rs + mybias[1], lgv2 = lgp[r][2] * rs + mybias[2];
            float lg[4];
#pragma unroll
            for (int j = 0; j < 4; ++j) lg[j] = __builtin_bit_cast(float, __builtin_amdgcn_readlane(__builtin_bit_cast(int, lgv0), j));
            { GAS unsigned long long* o8 = (GAS unsigned long long*)(XN + (size_t)row * DM) + F.lane;
#pragma unroll
              for (int q = 0; q < 4; ++q) { const f32x4 w = *(const f32x4*)(nfw + 4 * F.lane + 256 * q); const f32x4 u = x[r][q] * rs * w;
                  o8[64 * q] = (unsigned long long)pk2(u.x, u.y) | ((unsigned long long)pk2(u.z, u.w) << 32); } }
            int g = 0; float gm = lg[0];
#pragma unroll
            for (int j = 1; j < 4; ++j) if (lg[j] > gm) { gm = lg[j]; g = j; }
            float gs = 0.f;
#pragma unroll
            for (int j = 0; j < 4; ++j) gs += __expf(lg[j] - gm);
            const float pg = 1.0f / gs;
            float es[8];
#pragma unroll
            for (int i = 0; i < 8; ++i) { const int j = 4 + 8 * g + i, l = j & 15;
                const float e0 = __builtin_bit_cast(float, __builtin_amdgcn_readlane(__builtin_bit_cast(int, lgv0), l)), e1 = __builtin_bit_cast(float, __builtin_amdgcn_readlane(__builtin_bit_cast(int, lgv1), l)),
                            e2 = __builtin_bit_cast(float, __builtin_amdgcn_readlane(__builtin_bit_cast(int, lgv2), l));
                es[i] = j < 16 ? e0 : (j < 32 ? e1 : e2); }
            int i1 = 0; float v1 = es[0];
#pragma unroll
            for (int i = 1; i < 8; ++i) if (es[i] > v1) { v1 = es[i]; i1 = i; }
            int i2 = -1; float v2 = -3.0e38f;
#pragma unroll
            for (int i = 0; i < 8; ++i) if (i != i1 && es[i] > v2) { v2 = es[i]; i2 = i; }
            const float s1 = 1.0f / (1.0f + __expf(v2 - v1));
            if (F.lane == 8 * gi + 2 * r) { myE = (unsigned)(g * 8 + i1); myG = pg * s1; myrow = row; }
            if (F.lane == 8 * gi + 2 * r + 1) { myE = (unsigned)(g * 8 + i2); myG = pg * (1.0f - s1); myrow = row; }
        }
        if ((F.lane >> 3) == gi) myL = __hip_atomic_fetch_add((LAS unsigned*)(F.lds + MISC_OFF) + 64 + myE, 1u, __ATOMIC_RELAXED, __HIP_MEMORY_SCOPE_WORKGROUP);
        }
    }
    __syncthreads();
    if (F.tid < 32) { const unsigned n = lcnt[F.tid]; gbase[F.tid] = n ? __hip_atomic_fetch_add((unsigned*)(F.ctl + CW_CNT + 64 * F.tid), n, RLX_AGENT) : 0u; }
    __syncthreads();
    if (F.lane < 16 && pass * 2 * NGW + 2 * gw + (F.lane >> 3) < MR / 4) { const unsigned pos = gbase[myE] + myL; ASG[2 * myrow + (F.lane & 1)] = (myE << 16) | pos; GATE[2 * myrow + (F.lane & 1)] = myG; }
    __syncthreads();
    }
}
__device__ __forceinline__ void p8_permute(Frame& F) {
    LAS unsigned* pst = (LAS unsigned*)(F.lds + RING_OFF);
    if (F.wave == 0) {
        const unsigned cnt = F.lane < NE ? ald((const unsigned*)(F.ctl + CW_CNT + 64 * (F.lane & 31))) : 0u; const unsigned nt = (cnt + 255u) >> 8;
        unsigned inc = nt;
#pragma unroll
        for (int o = 1; o < 64; o <<= 1) { const unsigned t = __shfl_up(inc, o); if (F.lane >= o) inc += t; }
        const unsigned excl = inc - nt;
        if (F.lane < NE) pst[F.lane] = excl * 256u;
        if (blockIdx.x == 0) {
            if (F.lane == NE - 1) __hip_atomic_store((unsigned*)(F.ctl + CW_NT), inc, RLX_AGENT);
            if (F.lane < NE) for (unsigned t = 0; t < nt; ++t) __hip_atomic_store((unsigned*)(F.ctl + CW_TILEE + excl + t), (unsigned)F.lane, RLX_AGENT);
        }
    }
    __syncthreads();
    const unsigned* ASG = (const unsigned*)(F.ws + WS_ASG); unsigned* SLOT = (unsigned*)(F.ws + WS_SLOT); const bf16* XN = (const bf16*)(F.ws + WS_XN); bf16* XS = (bf16*)(F.ws + WS_XS);
    const int gw = F.vcu * NWAVES + F.wave, NGW = F.G * NWAVES;
    for (int a = gw; a < 2 * MR; a += NGW) {
        const unsigned w = ald(ASG + a); const unsigned e = w >> 16, pos = w & 0xffffu; const unsigned slot = pst[e] + pos;
        if (F.lane == 0) SLOT[a] = slot;
        const v4u* src = (const v4u*)(XN + (size_t)(a >> 1) * DM); v4u* dst = (v4u*)(XS + (size_t)slot * DM);
        dst[F.lane] = src[F.lane]; dst[64 + F.lane] = src[64 + F.lane];
    }
    __syncthreads();
}
__device__ __forceinline__ void p11_final(Frame& F) {
    const unsigned* SLOT = (const unsigned*)(F.ws + WS_SLOT); const float* GATE = (const float*)(F.ws + WS_GATE); const bf16* Y = (const bf16*)(F.ws + WS_Y); const float* fw = F.in[17];
    const int gw = F.vcu * NWAVES + F.wave, NGW = F.G * NWAVES;
    f32x4 wv[4];
#pragma unroll
    for (int j = 0; j < 4; ++j) wv[j] = *(const f32x4*)(fw + 4 * F.lane + 256 * j);
    for (int m0 = gw * 8; m0 < MR; m0 += NGW * 8) {
        const unsigned sl = ald(SLOT + 2 * m0 + (F.lane & 15)); const float gt = aldf(GATE + 2 * m0 + (F.lane & 15));
#pragma unroll
        for (int rr = 0; rr < 8; rr += 2) {
            f32x4 v[2][4]; float ss[2];
#pragma unroll
            for (int t = 0; t < 2; ++t) {
                const int m = m0 + rr + t;
                const unsigned s0 = __shfl(sl, 2 * (rr + t)), s1 = __shfl(sl, 2 * (rr + t) + 1); const float g0 = __shfl(gt, 2 * (rr + t)), g1 = __shfl(gt, 2 * (rr + t) + 1);
                ss[t] = 0.f;
#pragma unroll
                for (int j = 0; j < 4; ++j) { v[t][j] = *(const f32x4*)(F.out + (size_t)m * DM + 4 * F.lane + 256 * j);
                    const v2u y0 = *(const v2u*)(Y + (size_t)s0 * DM + 4 * F.lane + 256 * j), y1 = *(const v2u*)(Y + (size_t)s1 * DM + 4 * F.lane + 256 * j);
                    v[t][j].x += g0 * blo(y0.x) + g1 * blo(y1.x); v[t][j].y += g0 * bhi(y0.x) + g1 * bhi(y1.x); v[t][j].z += g0 * blo(y0.y) + g1 * blo(y1.y); v[t][j].w += g0 * bhi(y0.y) + g1 * bhi(y1.y);
                    ss[t] += (v[t][j].x * v[t][j].x + v[t][j].y * v[t][j].y) + (v[t][j].z * v[t][j].z + v[t][j].w * v[t][j].w); }
            }
#pragma unroll
            for (int t = 0; t < 2; ++t) { const float rs = 1.0f / sqrtf(wave_sum(ss[t]) * (1.0f / DM) + EPS);
#pragma unroll
                for (int j = 0; j < 4; ++j) *(f32x4*)(F.out + (size_t)(m0 + rr + t) * DM + 4 * F.lane + 256 * j) = v[t][j] * rs * wv[j]; }
        }
    }
}

struct Args { const float* in[18]; float* out; unsigned char* ws; int ph_lo, ph_hi, li, pad; };
__global__ void __launch_bounds__(NWAVES * 64, 2) fwd(Args args) {
    extern __shared__ __attribute__((aligned(16))) unsigned char lds[];
    Frame F;
    F.lds = (LAS unsigned char*)lds;
    F.MISC = (volatile LAS unsigned*)(F.lds + MISC_OFF);
    F.tid = threadIdx.x; F.lane = F.tid & 63; F.wave = __builtin_amdgcn_readfirstlane(F.tid >> 6);
    F.G = gridDim.x; { const int bx = blockIdx.x; F.vcu = (F.G % 8 == 0) ? (bx % 8) * (F.G / 8) + bx / 8 : bx; }
    F.ws = args.ws; F.ctl = (gu32*)(args.ws + WS_CTL); F.out = args.out;
#pragma unroll
    for (int i = 0; i < 18; ++i) F.in[i] = args.in[i];
    for (int u = F.tid; u < (LDS_BYTES - LDSCTL_OFF) / 4; u += NWAVES * 64) ((LAS unsigned*)(F.lds + LDSCTL_OFF))[u] = 0u;
    __syncthreads();
    const int bli = (N_LAUNCHES == NPHASE) ? 0 : args.li;
    XcdBarrier bar; bar.bar = (unsigned*)(F.ctl + CW_BAR) + bli * XCD_BAR_WORDS; bar.x = 0; bar.st = nullptr;
    if (N_LAUNCHES != NPHASE) bar = xcd_barrier_post((unsigned*)(F.ctl + CW_BAR) + bli * XCD_BAR_WORDS, F.MISC + 8);
#define GRID_BAR(seam) do { if (N_LAUNCHES == NPHASE) { if (F.tid == 0) __hip_atomic_store(F.ctl + CW_TMO, 0xBADBA0u | (unsigned)(seam), RLX_AGENT); } else { xcd_barrier(bar); } } while (0)
    const int lo = args.ph_lo, hi = args.ph_hi;
#define IN(k) (lo <= (k) && (k) < hi)
#define PHASE_BEGIN() do { int t_ = threadIdx.x; asm volatile("" : "+v"(t_)); F.tid = t_; F.lane = t_ & 63; } while (0)
#define BOTH(k) (IN(k) && IN((k) + 1))
    unsigned char* ws = args.ws;

    if (IN(0)) { PHASE_BEGIN(); STAMP(0);
        if (F.vcu < 49) p0_meta(F);
        p0_router_table(F);
        p0_rows(F);
        p0_weights(F);
        if (BOTH(0)) GRID_BAR(0);
    }
    if (IN(1)) { PHASE_BEGIN(); STAMP(1);
        pg8::Gemm g{(const bf16*)(ws + WS_U), (const bf16*)(ws + WS_WIN), MR, NPROJ, DM, 0};
        pg8::StaticOrder S; S.init(MR, NPROJ, F.G, (int)blockIdx.x);
        pg8::EpiProj E{(bf16*)(ws + WS_QA), (bf16*)(ws + WS_KA), (bf16*)(ws + WS_VA), (bf16*)(ws + WS_QH), (bf16*)(ws + WS_EB), (bf16*)(ws + WS_KT), (bf16*)(ws + WS_KD), (bf16*)(ws + WS_VH),
                       (bf16*)(ws + WS_GH), (bf16*)(ws + WS_GA), (bf16*)(ws + WS_GT), F.in[5]};
        pg8::gemm_phase<pg8::EpiProj, pg8::StaticOrder, true, true>(F.lds + RING_OFF, g, S, E);
        __syncthreads();
        for (int bh = blockIdx.x; bh < 16; bh += F.G) p1_cumsum(F, bh);
        if (BOTH(1)) GRID_BAR(1);
    }
    if (IN(2)) { PHASE_BEGIN(); STAMP(2);
        static_assert(attn_body::ATTN_LDS_BYTES <= RING_BYTES, "attention LDS");
        for (int pid = F.vcu; pid < 256; pid += F.G) { const int bh = pid >> 4, s = pid & 15;
            for (int i = 0; i < 2; ++i)
                attn_body::attn_unit<8>(bh >> 3, bh & 7, i ? 31 - s : s, (const attn_body::bf16*)(ws + WS_QA), (const attn_body::bf16*)(ws + WS_KA), (const attn_body::bf16*)(ws + WS_VA), (attn_body::bf16*)(ws + WS_OAH),
                                        (const float*)(ws + WS_CL) + (size_t)bh * KROWS, (char*)lds + RING_OFF); }
        __syncthreads();
        hg::hgrn_a_run(F.vcu, F.G, 16 * NCH, (const bf16*)(ws + WS_KD), (const bf16*)(ws + WS_VH), (bf16*)(ws + WS_US), F.lds + RING_OFF);
        if (BOTH(2)) GRID_BAR(2);
    }
    if (IN(3)) { PHASE_BEGIN(); STAMP(3); hgrn_scan_t(F); if (BOTH(3)) GRID_BAR(3); }
    if (IN(4)) { PHASE_BEGIN(); STAMP(4);
        static_assert(hg::HC_END <= RING_BYTES, "hgrn LDS");
        hg::hgrn_c_run(F.vcu, F.G, 16 * 128, (const bf16*)(ws + WS_QH), (const bf16*)(ws + WS_EB), (const bf16*)(ws + WS_KT), (const bf16*)(ws + WS_VH), (const bf16*)(ws + WS_GH), (const bf16*)(ws + WS_US), (bf16*)(ws + WS_OAH) + AWID, F.in[6], EPS, F.lds + RING_OFF);
        if (BOTH(4)) GRID_BAR(4);
    }
    if (IN(5)) { PHASE_BEGIN(); STAMP(5);
        pg8::Gemm g{(const bf16*)(ws + WS_OAH), (const bf16*)(ws + WS_WAH), MR, DM, AWID + DM, 0}; pg8::StaticOrder S; S.init(MR, DM, F.G, (int)blockIdx.x);
        pg8::EpiMixed E{(const bf16*)(ws + WS_GA), (const bf16*)(ws + WS_GT), (bf16*)(ws + WS_MIX), AWID / pg8::BK};
        pg8::gemm_phase<pg8::EpiMixed, pg8::StaticOrder, true, true>(F.lds + RING_OFF, g, S, E);
        if (BOTH(5)) GRID_BAR(5);
    }
    if (IN(6)) { PHASE_BEGIN(); STAMP(6);
        pg8::Gemm g{(const bf16*)(ws + WS_MIX), (const bf16*)(ws + WS_WO), MR, DM, DM, 0}; pg8::StaticOrder S; S.init(MR, DM, F.G, (int)blockIdx.x);
        pg8::EpiRes E{F.in[0], F.out};
        pg8::gemm_phase<pg8::EpiRes, pg8::StaticOrder, true, true>(F.lds + RING_OFF, g, S, E);
        if (BOTH(6)) GRID_BAR(6);
    }
    if (IN(7)) { PHASE_BEGIN(); STAMP(7); p7_router(F); STAMP(12); p7_expert_weights(F); STAMP(13); if (BOTH(7)) GRID_BAR(7); }
    if (IN(8)) { PHASE_BEGIN(); STAMP(8); p8_permute(F); if (BOTH(8)) GRID_BAR(8); }
    if (IN(9)) { PHASE_BEGIN(); STAMP(9);
        const int ntile = (int)__builtin_amdgcn_readfirstlane(ald((const unsigned*)(F.ctl + CW_NT)));
        pg8::Gemm g{(const bf16*)(ws + WS_XS), (const bf16*)(ws + WS_WE1), APAD, DM, DM, (size_t)DM * DM * 2};
        pg8::MoeOrder S{ntile * 4, F.G, F.vcu, (const unsigned*)(F.ctl + CW_TILEE)};
        pg8::EpiSwiglu E{(bf16*)(ws + WS_ACT)};
        pg8::gemm_phase<pg8::EpiSwiglu, pg8::MoeOrder, true, true>(F.lds + RING_OFF, g, S, E);
        if (BOTH(9)) GRID_BAR(9);
    }
    if (IN(10)) { PHASE_BEGIN(); STAMP(10);
        const int ntile = (int)__builtin_amdgcn_readfirstlane(ald((const unsigned*)(F.ctl + CW_NT)));
        pg8::Gemm g{(const bf16*)(ws + WS_ACT), (const bf16*)(ws + WS_WE2), APAD, DM, EFF, (size_t)DM * EFF * 2};
        pg8::MoeOrder S{ntile * 4, F.G, F.vcu, (const unsigned*)(F.ctl + CW_TILEE)};
        pg8::EpiPlain E{(bf16*)(ws + WS_Y), DM};
        pg8::gemm_phase<pg8::EpiPlain, pg8::MoeOrder, true, true>(F.lds + RING_OFF, g, S, E);
        if (BOTH(10)) GRID_BAR(10);
    }
    if (IN(11)) { PHASE_BEGIN(); STAMP(11); p11_final(F); }
    if (PROBE_MASK != 0 && blockIdx.x == 0 && F.wave == 0) {
        const unsigned tend = (unsigned)__builtin_amdgcn_s_memrealtime();
        const int A_ = (PROBE_MASK - 1) & 31, B_ = (PROBE_MASK - 1) >> 5;
        const unsigned tb = (B_ == 31) ? tend : ((volatile LAS unsigned*)(F.lds + MISC_OFF))[16 + B_];
        const unsigned extra = tb - ((volatile LAS unsigned*)(F.lds + MISC_OFF))[16 + A_];
        const unsigned long long t0 = __builtin_amdgcn_s_memrealtime();
        while (__builtin_amdgcn_s_memrealtime() - t0 < (unsigned long long)extra) __builtin_amdgcn_s_sleep(8);
    }
#undef IN
#undef BOTH
}

extern "C" void kernel_launch(void* const* d_in, const int* in_sizes, int n_in, void* d_out, int out_size, void* d_ws, size_t ws_size, hipStream_t stream) {
    static int grid = 0;
    if (grid == 0) {
        if (n_in != 18 || in_sizes[0] != MR * DM || out_size != MR * DM || ws_size < WS_END) {
            fprintf(stderr, "kernel_launch: unexpected problem: n_in %d in0 %d out %d ws %zu (need %zu); nothing launched\n", n_in, n_in > 0 ? in_sizes[0] : -1, out_size, ws_size, (size_t)WS_END); grid = -1; return; }
        int dev = 0, cus = 0, per_cu = 0;
        if (hipGetDevice(&dev) != hipSuccess || hipDeviceGetAttribute(&cus, hipDeviceAttributeMultiprocessorCount, dev) != hipSuccess) { grid = -1; return; }
        if (hipFuncSetAttribute((const void*)fwd, hipFuncAttributeMaxDynamicSharedMemorySize, LDS_BYTES) != hipSuccess) { fprintf(stderr, "kernel_launch: hipFuncSetAttribute failed\n"); grid = -1; return; }
        if (hipOccupancyMaxActiveBlocksPerMultiprocessor(&per_cu, (const void*)fwd, NWAVES * 64, LDS_BYTES) != hipSuccess || per_cu < 1)
            fprintf(stderr, "kernel_launch: note: occupancy query reports %d workgroups per CU\n", per_cu);
        (void)hipGetLastError();
        grid = cus;
    }
    if (grid < 0) return;
    if (hipMemsetAsync((char*)d_ws + WS_CTL, 0, CTL_ZERO_BYTES, stream) != hipSuccess) { fprintf(stderr, "kernel_launch: memset failed\n"); return; }
    Args a{};
    for (int i = 0; i < 18; ++i) a.in[i] = (const float*)d_in[i];
    a.out = (float*)d_out; a.ws = (unsigned char*)d_ws;
    for (int li = 0; li < N_LAUNCHES; ++li) {
        if (N_LAUNCHES == NPHASE) { a.ph_lo = li; a.ph_hi = li + 1; } else { a.ph_lo = 0; a.ph_hi = NPHASE; }
        a.li = li;
        hipLaunchKernelGGL(fwd, dim3(grid), dim3(NWAVES * 64), LDS_BYTES, stream, a);
        const hipError_t le = hipPeekAtLastError();
        if (le != hipSuccess) { fprintf(stderr, "kernel_launch: launch %d failed: %s\n", li, hipGetErrorName(le)); break; }
    }
}
```

```cpp
#include <hip/hip_runtime.h>
#include <hip/hip_bf16.h>
#include <cmath>
#include <cstdio>
#include <cstdint>

#ifndef MK_N_LAUNCHES
#define MK_N_LAUNCHES 1
#endif

namespace pg8 {
#define PG8_LAS __attribute__((address_space(3)))
typedef unsigned short bf16_t;
typedef short bf16x8 __attribute__((ext_vector_type(8)));
typedef float f32x4 __attribute__((ext_vector_type(4)));
typedef unsigned u32x4 __attribute__((ext_vector_type(4)));
typedef unsigned u32x2 __attribute__((ext_vector_type(2)));
constexpr int BM = 256, BK = 64, HALF = 128, HTB = HALF * BK * 2  , STAGE_BYTES = 8 * HTB, NXCD = 8, WGM = 8;

__host__ __device__ __forceinline__ int lds_byte(int r, int c) { const int st = (r >> 4) * 2 + (c >> 5), rr = r & 15, cc = c & 31, ob = rr * 64 + cc * 2; return st * 1024 + (ob ^ (((ob >> 9) & 1) << 5)); }
__host__ __device__ __forceinline__ void stage_rc(int b, int& R, int& C) { const int st = b / 1024, sb = b % 1024, swz = sb ^ (((sb >> 9) & 1) << 5); R = (st >> 1) * 16 + swz / 64; C = (st & 1) * 32 + (swz % 64) / 2; }
__host__ __device__ __forceinline__ int perm32(int rho) { const int n = rho >> 4, i = rho & 15; return 8 * (i >> 2) + 4 * n + (i & 3); }

struct Unit { int pm, pn, e; };
struct Gemm { const bf16_t* A; const bf16_t* Bt; int M, N, K; size_t bexp; };

struct StaticOrder {
    int nM, nN, nwg, G, c;
    __host__ __device__ void init(int M, int N, int G_, int c_) { nM = M / BM; nN = N / BM; nwg = nM * nN; G = G_; c = c_; }
    __host__ __device__ bool next(int i, Unit& u) const {
        const long L = (long)i * G + c; if (L >= nwg) return false;
        int wgid = (int)L; { const int q = nwg / NXCD, r = nwg % NXCD, xcd = wgid % NXCD, off = wgid / NXCD; wgid = (xcd < r ? xcd * (q + 1) : r * (q + 1) + (xcd - r) * q) + off; }
        const int nig = WGM * nN, gid = wgid / nig, fm = gid * WGM, gsz = (nM - fm) < WGM ? (nM - fm) : WGM;
        u.pm = fm + ((wgid % nig) % gsz); u.pn = (wgid % nig) / gsz; u.e = 0; return true;
    }
    __device__ __forceinline__ void a_ready(const Unit&) const {}
    __device__ __forceinline__ void done(const Unit&) const {}
};
struct MoeOrder {
    int ntu, G, c; const PG8_LAS unsigned* tile_e; const PG8_LAS unsigned* pst; const PG8_LAS unsigned* cnt; const unsigned* liste;
    __device__ bool next(int i, Unit& u) const {
        const long L = (long)i * G + c; if (L >= ntu) return false;
        u.pm = (int)(L >> 2); u.pn = (int)(L & 3); u.e = (int)__builtin_amdgcn_readfirstlane(tile_e[u.pm]); return true;
    }
    __device__ __forceinline__ int row_tok(const Unit& u, int r) const {
        const unsigned rel = (unsigned)(u.pm * BM + r) - pst[u.e];
        return rel < cnt[u.e] ? (int)liste[(size_t)u.e * 16384 + rel] : 0;
    }
    __device__ __forceinline__ void a_ready(const Unit&) const {}
    __device__ __forceinline__ void done(const Unit&) const {}
};

__device__ __forceinline__ unsigned cvt_pk_bf16(float lo, float hi) { unsigned r; asm volatile("v_cvt_pk_bf16_f32 %0, %1, %2" : "=v"(r) : "v"(lo), "v"(hi)); return r; }
__device__ __forceinline__ float fsig(float x) { return __builtin_amdgcn_rcpf(1.0f + __builtin_amdgcn_exp2f(-1.4426950408889634f * x)); }
__device__ __forceinline__ float bflo(unsigned w) { return __builtin_bit_cast(float, w << 16); }
__device__ __forceinline__ float bfhi(unsigned w) { return __builtin_bit_cast(float, w & 0xffff0000u); }
__device__ __forceinline__ float dpp_shr(float v, int) { return v; }
#define PG8_SCAN16(v) do { \
    v += __builtin_bit_cast(float, __builtin_amdgcn_update_dpp(0, __builtin_bit_cast(int, v), 0x111, 0xf, 0xf, true)); \
    v += __builtin_bit_cast(float, __builtin_amdgcn_update_dpp(0, __builtin_bit_cast(int, v), 0x112, 0xf, 0xf, true)); \
    v += __builtin_bit_cast(float, __builtin_amdgcn_update_dpp(0, __builtin_bit_cast(int, v), 0x114, 0xf, 0xf, true)); \
    v += __builtin_bit_cast(float, __builtin_amdgcn_update_dpp(0, __builtin_bit_cast(int, v), 0x118, 0xf, 0xf, true)); } while (0)

constexpr float ATT_C2 = 0.125f * 1.4426950408889634f;
constexpr float HG_QS = 0.08838834764831845f;

struct EpiProj {
    static constexpr bool PERM = true, AFTER_DRAIN = false, HAS_MID = false;
    bf16_t *QA, *KA, *VA, *QH, *EB, *KT, *KD, *VH, *GH, *GA, *GT; const float* lbl;
    __device__ __forceinline__ void operator()(const f32x4 (&acc)[2][2][4][2], const Unit& u, int wr, int wc, int fr, int fq) const {
        const int pn = u.pn, b = u.pm >> 5;
        const int cofs = wc * 32 + 8 * fq;
        const int row0 = u.pm * BM + wr * 64 + fr;
        if (pn >= 10 && pn < 14) {
            const int colbase = 256 * (pn - 10), lane = fq * 16 + fr, srcl = (lane & 48) | 15;
#pragma unroll
            for (int ai = 0; ai < 2; ++ai)
#pragma unroll
                for (int bj = 0; bj < 2; ++bj)
#pragma unroll
                    for (int n = 0; n < 2; ++n) {
                        const int c0 = colbase + 128 * bj + cofs + 4 * n;
                        const f32x4 l0 = *(const f32x4*)(lbl + c0), l1 = *(const f32x4*)(lbl + 1024 + c0);
                        float eb[4][4], kt[4][4], kd[4][4];
#pragma unroll
                        for (int e = 0; e < 4; ++e) {
                            const float lb = __builtin_amdgcn_rcpf(1.0f + __builtin_amdgcn_exp2f((l1[e] - l0[e]) * 1.4426950408889634f));
                            float lf[4], kk[4];
#pragma unroll
                            for (int m = 0; m < 4; ++m) { const float f = lb + (1.0f - lb) * fsig(acc[ai][bj][m][n][e]); kk[m] = 1.0f - f; lf[m] = __builtin_amdgcn_logf(f); }
#pragma unroll
                            for (int m = 0; m < 4; ++m) PG8_SCAN16(lf[m]);
                            float run = 0.f, bb[4];
#pragma unroll
                            for (int m = 0; m < 4; ++m) { const float tot = __shfl(lf[m], srcl); bb[m] = lf[m] + run; run += tot; }
#pragma unroll
                            for (int m = 0; m < 4; ++m) { eb[m][e] = __builtin_amdgcn_exp2f(bb[m]); kt[m][e] = kk[m] * __builtin_amdgcn_exp2f(-bb[m]); kd[m][e] = kk[m] * __builtin_amdgcn_exp2f(run - bb[m]); }
                        }
#pragma unroll
                        for (int m = 0; m < 4; ++m) {
                            const size_t r = (size_t)(row0 + ai * HALF + m * 16);
                            u32x2 w;
                            w.x = cvt_pk_bf16(eb[m][0], eb[m][1]); w.y = cvt_pk_bf16(eb[m][2], eb[m][3]); *(u32x2*)(EB + r * 1024 + c0) = w;
                            w.x = cvt_pk_bf16(kt[m][0], kt[m][1]); w.y = cvt_pk_bf16(kt[m][2], kt[m][3]); *(u32x2*)(KT + r * 1024 + c0) = w;
                            w.x = cvt_pk_bf16(kd[m][0], kd[m][1]); w.y = cvt_pk_bf16(kd[m][2], kd[m][3]); *(u32x2*)(KD + (r + 64 * (b + 1)) * 1024 + c0) = w;
                        }
                    }
            return;
        }
        bf16_t* base; int ld = 1024, radd = 0, cb; int mode = 0; float sc = 1.f;
        if (pn < 2) { base = QA; ld = 512; cb = 256 * pn; sc = ATT_C2; }
        else if (pn < 4) { base = KA; ld = 512; cb = 256 * (pn - 2); radd = 128 * (b + 1); }
        else if (pn < 6) { base = VA; ld = 512; cb = 256 * (pn - 4); radd = 128 * (b + 1); }
        else if (pn < 10) { base = QH; cb = 256 * (pn - 6); sc = HG_QS; }
        else if (pn < 18) { base = VH; cb = 256 * (pn - 14); radd = 64 * (b + 1); }
        else if (pn < 22) { base = GH; cb = 256 * (pn - 18); mode = 1; }
        else if (pn < 26) { base = GA; cb = 256 * (pn - 22); mode = 1; }
        else { base = GT; cb = 256 * (pn - 26); mode = 1; }
#pragma unroll
        for (int ai = 0; ai < 2; ++ai)
#pragma unroll
            for (int m = 0; m < 4; ++m) { bf16_t* rowp = base + (size_t)(row0 + ai * HALF + m * 16 + radd) * ld + cb + cofs;
#pragma unroll
                for (int bj = 0; bj < 2; ++bj) { f32x4 v0 = acc[ai][bj][m][0], v1 = acc[ai][bj][m][1];
                    if (mode) {
#pragma unroll
                        for (int e = 0; e < 4; ++e) { v0[e] = fsig(v0[e]); v1[e] = fsig(v1[e]); }
                    } else { v0 = v0 * sc; v1 = v1 * sc; }
                    u32x4 w; w.x = cvt_pk_bf16(v0[0], v0[1]); w.y = cvt_pk_bf16(v0[2], v0[3]); w.z = cvt_pk_bf16(v1[0], v1[1]); w.w = cvt_pk_bf16(v1[2], v1[3]);
                    *(u32x4*)(rowp + bj * HALF) = w; } }
    }
};
struct EpiMixed {
    static constexpr bool PERM = true, AFTER_DRAIN = false, HAS_MID = true;
    const bf16_t* GA; const bf16_t* GT; bf16_t* O; int tmid;
    __device__ __forceinline__ void mid(f32x4 (&acc)[2][2][4][2], const Unit& u, int wr, int wc, int fr, int fq) const {
        const int row0 = u.pm * BM + wr * 64 + fr, col0 = u.pn * BM + wc * 32 + 8 * fq;
#pragma unroll
        for (int ai = 0; ai < 2; ++ai)
#pragma unroll
            for (int m = 0; m < 4; ++m) { unsigned off = (unsigned)((row0 + ai * HALF + m * 16) * 1024 + col0); asm volatile("" : "+v"(off));
#pragma unroll
                for (int bj = 0; bj < 2; ++bj) { const u32x4 a = *(const u32x4*)(GA + off + bj * HALF), h = *(const u32x4*)(GT + off + bj * HALF);
                    f32x4& v0 = acc[ai][bj][m][0]; f32x4& v1 = acc[ai][bj][m][1];
                    v0[0] *= bflo(a.x) * __builtin_amdgcn_rcpf(bflo(h.x)); v0[1] *= bfhi(a.x) * __builtin_amdgcn_rcpf(bfhi(h.x)); v0[2] *= bflo(a.y) * __builtin_amdgcn_rcpf(bflo(h.y)); v0[3] *= bfhi(a.y) * __builtin_amdgcn_rcpf(bfhi(h.y));
                    v1[0] *= bflo(a.z) * __builtin_amdgcn_rcpf(bflo(h.z)); v1[1] *= bfhi(a.z) * __builtin_amdgcn_rcpf(bfhi(h.z)); v1[2] *= bflo(a.w) * __builtin_amdgcn_rcpf(bflo(h.w)); v1[3] *= bfhi(a.w) * __builtin_amdgcn_rcpf(bfhi(h.w)); }
                asm volatile("" ::: "memory"); }
    }
    __device__ __forceinline__ void operator()(const f32x4 (&acc)[2][2][4][2], const Unit& u, int wr, int wc, int fr, int fq) const {
        const int row0 = u.pm * BM + wr * 64 + fr, col0 = u.pn * BM + wc * 32 + 8 * fq;
#pragma unroll
        for (int ai = 0; ai < 2; ++ai)
#pragma unroll
            for (int m = 0; m < 4; ++m) { const size_t off = (size_t)(row0 + ai * HALF + m * 16) * 1024 + col0;
#pragma unroll
                for (int bj = 0; bj < 2; ++bj) { const u32x4 g = *(const u32x4*)(GT + off + bj * HALF);
                    f32x4 v0 = acc[ai][bj][m][0], v1 = acc[ai][bj][m][1];
                    v0[0] *= bflo(g.x); v0[1] *= bfhi(g.x); v0[2] *= bflo(g.y); v0[3] *= bfhi(g.y); v1[0] *= bflo(g.z); v1[1] *= bfhi(g.z); v1[2] *= bflo(g.w); v1[3] *= bfhi(g.w);
                    u32x4 w; w.x = cvt_pk_bf16(v0[0], v0[1]); w.y = cvt_pk_bf16(v0[2], v0[3]); w.z = cvt_pk_bf16(v1[0], v1[1]); w.w = cvt_pk_bf16(v1[2], v1[3]);
                    *(u32x4*)(O + off + bj * HALF) = w; } }
    }
};
struct EpiRes {
    static constexpr bool PERM = true, AFTER_DRAIN = false, HAS_MID = false;
    const float* X; float* O;
    __device__ __forceinline__ void operator()(const f32x4 (&acc)[2][2][4][2], const Unit& u, int wr, int wc, int fr, int fq) const {
        const int row0 = u.pm * BM + wr * 64 + fr, col0 = u.pn * BM + wc * 32 + 8 * fq;
#pragma unroll
        for (int ai = 0; ai < 2; ++ai)
#pragma unroll
            for (int m = 0; m < 4; ++m) { const size_t off = (size_t)(row0 + ai * HALF + m * 16) * 1024 + col0;
#pragma unroll
                for (int bj = 0; bj < 2; ++bj) {
                    const f32x4 x0 = *(const f32x4*)(X + off + bj * HALF), x1 = *(const f32x4*)(X + off + bj * HALF + 4);
                    *(f32x4*)(O + off + bj * HALF) = x0 + acc[ai][bj][m][0]; *(f32x4*)(O + off + bj * HALF + 4) = x1 + acc[ai][bj][m][1]; } }
    }
};
struct EpiSwiglu {
    static constexpr bool PERM = true, AFTER_DRAIN = false, HAS_MID = false;
    bf16_t* O;
    __device__ __forceinline__ void operator()(const f32x4 (&acc)[2][2][4][2], const Unit& u, int wr, int wc, int fr, int fq) const {
        const int row0 = u.pm * BM + wr * 64 + fr, col0 = u.pn * HALF + wc * 32 + 8 * fq;
#pragma unroll
        for (int ai = 0; ai < 2; ++ai)
#pragma unroll
            for (int m = 0; m < 4; ++m) { const size_t off = (size_t)(row0 + ai * HALF + m * 16) * 512 + col0;
                f32x4 v0, v1;
#pragma unroll
                for (int e = 0; e < 4; ++e) { const float a0 = acc[ai][0][m][0][e], a1 = acc[ai][0][m][1][e];
                    v0[e] = a0 * fsig(a0) * acc[ai][1][m][0][e]; v1[e] = a1 * fsig(a1) * acc[ai][1][m][1][e]; }
                u32x4 w; w.x = cvt_pk_bf16(v0[0], v0[1]); w.y = cvt_pk_bf16(v0[2], v0[3]); w.z = cvt_pk_bf16(v1[0], v1[1]); w.w = cvt_pk_bf16(v1[2], v1[3]);
                *(u32x4*)(O + off) = w; }
    }
};
struct EpiPlain {
    static constexpr bool PERM = true, AFTER_DRAIN = false, HAS_MID = false;
    bf16_t* O; int ldc;
    __device__ __forceinline__ void operator()(const f32x4 (&acc)[2][2][4][2], const Unit& u, int wr, int wc, int fr, int fq) const {
        const int row0 = u.pm * BM + wr * 64 + fr, col0 = u.pn * BM + wc * 32 + 8 * fq;
#pragma unroll
        for (int ai = 0; ai < 2; ++ai)
#pragma unroll
            for (int m = 0; m < 4; ++m) { const size_t off = (size_t)(row0 + ai * HALF + m * 16) * ldc + col0;
#pragma unroll
                for (int bj = 0; bj < 2; ++bj) { const f32x4 v0 = acc[ai][bj][m][0], v1 = acc[ai][bj][m][1];
                    u32x4 w; w.x = cvt_pk_bf16(v0[0], v0[1]); w.y = cvt_pk_bf16(v0[2], v0[3]); w.z = cvt_pk_bf16(v1[0], v1[1]); w.w = cvt_pk_bf16(v1[2], v1[3]);
                    *(u32x4*)(O + off + bj * HALF) = w; } }
    }
};

template <class Epi, class Sched, bool ALIGN_EPI = false, bool SP2 = false, bool GATHER = false>
__device__ __forceinline__ void gemm_phase(PG8_LAS unsigned char* lds, const Gemm g, const Sched& S, const Epi& E) {
    int tid_l = threadIdx.x; asm volatile("" : "+v"(tid_l));
    const int tid = tid_l, wid = __builtin_amdgcn_readfirstlane(tid >> 6), lane = tid & 63, wr = wid >> 2, wc = wid & 3, fr = lane & 15, fq = lane >> 4;
    const int K = g.K, nt = K / BK;
    unsigned voffA[2], voffB[2]; int Rr[2], Cc[2];
#pragma unroll
    for (int i = 0; i < 2; ++i) { int R, C; stage_rc(tid * 16 + i * 8192, R, C); const int Rb = Epi::PERM ? ((R & ~31) + perm32(R & 31)) : R; Rr[i] = R; Cc[i] = C;
        voffA[i] = (unsigned)(R * K + C) * 2u; voffB[i] = (unsigned)(Rb * K + C) * 2u; }
    static_assert(!GATHER || SP2, "gather needs the SP2 loop");
    unsigned vc[2][2] = {{0u, 0u}, {0u, 0u}}, vn[2][2] = {{0u, 0u}, {0u, 0u}};
#define PG8_GROWS(u_, dst_) do { _Pragma("unroll") for (int h_ = 0; h_ < 2; ++h_) _Pragma("unroll") for (int i_ = 0; i_ < 2; ++i_) dst_[h_][i_] = (unsigned)(S.row_tok(u_, h_ * HALF + Rr[i_]) * K + Cc[i_]) * 2u; } while (0)
    const size_t kstep = (size_t)(BK * 2);
    const size_t hstep = (size_t)HALF * K * 2;
    const size_t hstepA = GATHER ? (size_t)0 : hstep;
    const size_t tstep = 2 * hstep;
    const unsigned ldsw = (unsigned)wid * 1024u;
    const int aoff = lds_byte(wr * 64 + fr, fq * 8), boff = lds_byte(wc * 32 + fr, fq * 8);
#define PG8_SA(b, h) (((b) * 2 + (h)) * HTB)
#define PG8_SB(b, h) ((4 + (b) * 2 + (h)) * HTB)
#define PG8_STAGE(bufoff, gbase, voff) do { _Pragma("unroll") for (int _i = 0; _i < 2; ++_i) \
        __builtin_amdgcn_global_load_lds((const unsigned*)((const char*)(gbase) + (voff)[_i]), (PG8_LAS unsigned*)(lds + (bufoff) + ldsw + _i * 8192), 16, 0, 0); } while (0)
#define PG8_LDA(dst, b, h) do { _Pragma("unroll") for (int m = 0; m < 4; ++m) _Pragma("unroll") for (int k = 0; k < 2; ++k) dst[m][k] = *(const PG8_LAS bf16x8*)(lds + PG8_SA(b, h) + aoff + m * 2048 + k * 1024); } while (0)
#define PG8_LDB(dst, b, h) do { _Pragma("unroll") for (int n = 0; n < 2; ++n) _Pragma("unroll") for (int k = 0; k < 2; ++k) dst[n][k] = *(const PG8_LAS bf16x8*)(lds + PG8_SB(b, h) + boff + n * 2048 + k * 1024); } while (0)
#define PG8_MMA(ai, bj, At, Bt) do { __builtin_amdgcn_s_setprio(1); _Pragma("unroll") for (int m = 0; m < 4; ++m) _Pragma("unroll") for (int n = 0; n < 2; ++n) _Pragma("unroll") for (int k = 0; k < 2; ++k) \
        acc[ai][bj][m][n] = __builtin_amdgcn_mfma_f32_16x16x32_bf16(Bt[n][k], At[m][k], acc[ai][bj][m][n], 0, 0, 0); __builtin_amdgcn_s_setprio(0); } while (0)
#define PG8_WAIT_V(n) asm volatile("s_waitcnt vmcnt(" #n ")" ::: "memory")
#define PG8_WAIT_L(n) asm volatile("s_waitcnt lgkmcnt(" #n ")" ::: "memory")
#define PG8_BAR __builtin_amdgcn_s_barrier()
#define PG8_SCHED __builtin_amdgcn_sched_barrier(0)
    Unit cur, nxt; int ui = 0;
    if (!S.next(0, cur)) return;
    f32x4 acc[2][2][4][2];
#pragma unroll
    for (int a = 0; a < 2; ++a)
#pragma unroll
        for (int b = 0; b < 2; ++b)
#pragma unroll
            for (int m = 0; m < 4; ++m)
#pragma unroll
                for (int n = 0; n < 2; ++n) acc[a][b][m][n] = (f32x4){0.f, 0.f, 0.f, 0.f};
    bf16x8 At[4][2], B0[2][2], B1[2][2];
    const char* cA = (const char*)g.A + (GATHER ? (size_t)0 : (size_t)cur.pm * tstep); const char* cB = (const char*)g.Bt + (size_t)cur.e * g.bexp + (size_t)cur.pn * tstep;
    S.a_ready(cur);
    if constexpr (GATHER) PG8_GROWS(cur, vc);
    if constexpr (SP2) {
        PG8_STAGE(PG8_SB(0, 0), cB, voffB); PG8_STAGE(PG8_SB(0, 1), cB + hstep, voffB); PG8_STAGE(PG8_SA(0, 0), cA, (GATHER ? vc[0] : voffA)); PG8_STAGE(PG8_SA(0, 1), cA + hstepA, (GATHER ? vc[1] : voffA));
        if (wr == 1) PG8_BAR;
        PG8_WAIT_V(2); PG8_BAR;
        PG8_STAGE(PG8_SB(1, 0), cB + kstep, voffB); PG8_STAGE(PG8_SA(1, 0), cA + kstep, (GATHER ? vc[0] : voffA)); PG8_STAGE(PG8_SB(1, 1), cB + hstep + kstep, voffB);
        PG8_WAIT_V(6); PG8_BAR;
    } else {
        PG8_STAGE(PG8_SB(0, 0), cB, voffB); PG8_STAGE(PG8_SA(0, 0), cA, voffA); PG8_STAGE(PG8_SB(0, 1), cB + hstep, voffB); PG8_STAGE(PG8_SA(0, 1), cA + hstep, voffA);
        if (wr == 1) PG8_BAR;
        PG8_WAIT_V(4); PG8_BAR;
        PG8_STAGE(PG8_SB(1, 0), cB + kstep, voffB); PG8_STAGE(PG8_SA(1, 0), cA + kstep, voffA); PG8_STAGE(PG8_SB(1, 1), cB + hstep + kstep, voffB);
        PG8_WAIT_V(6); PG8_BAR;
    }
    for (;;) {
        const bool has_next = S.next(ui + 1, nxt);
        const char* nA = has_next ? (const char*)g.A + (GATHER ? (size_t)0 : (size_t)nxt.pm * tstep) : cA; const char* nB = has_next ? (const char*)g.Bt + (size_t)nxt.e * g.bexp + (size_t)nxt.pn * tstep : cB;
        for (int t = 0; t < nt; t += 2) {
            if constexpr (Epi::HAS_MID) { if (t == E.tmid) E.mid(acc, cur, wr, wc, fr, fq); }
            const bool last = (t == nt - 2);
            const char* a1 = cA + (size_t)(t + 1) * kstep;
            const char* a2 = last ? nA : cA + (size_t)(t + 2) * kstep; const char* b2 = last ? nB : cB + (size_t)(t + 2) * kstep;
            const char* a3 = a2 + kstep; const char* b3 = b2 + kstep;
            if (last && has_next) S.a_ready(nxt);
            unsigned v2[2][2];
            if constexpr (GATHER) { if (last) { if (has_next) PG8_GROWS(nxt, vn); else { vn[0][0] = vc[0][0]; vn[0][1] = vc[0][1]; vn[1][0] = vc[1][0]; vn[1][1] = vc[1][1]; } }
                _Pragma("unroll") for (int h_ = 0; h_ < 2; ++h_) _Pragma("unroll") for (int i_ = 0; i_ < 2; ++i_) v2[h_][i_] = last ? vn[h_][i_] : vc[h_][i_]; }
            if constexpr (SP2) {
            PG8_LDB(B0, 0, 0); PG8_LDB(B1, 0, 1); PG8_SCHED; PG8_LDA(At, 0, 0); PG8_STAGE(PG8_SA(1, 1), a1 + hstepA, (GATHER ? vc[1] : voffA));
            PG8_WAIT_V(8); PG8_WAIT_L(0); PG8_BAR; PG8_MMA(0, 0, At, B0); PG8_MMA(0, 1, At, B1); PG8_BAR; PG8_SCHED;
            PG8_LDA(At, 0, 1); PG8_STAGE(PG8_SB(0, 0), b2, voffB); PG8_STAGE(PG8_SB(0, 1), b2 + hstep, voffB); PG8_STAGE(PG8_SA(0, 0), a2, (GATHER ? v2[0] : voffA));
            PG8_WAIT_V(8); PG8_WAIT_L(0); PG8_BAR; PG8_MMA(1, 0, At, B0); PG8_MMA(1, 1, At, B1); PG8_BAR; PG8_SCHED;
            PG8_LDB(B0, 1, 0); PG8_LDB(B1, 1, 1); PG8_SCHED; PG8_LDA(At, 1, 0); PG8_STAGE(PG8_SA(0, 1), a2 + hstepA, (GATHER ? v2[1] : voffA));
            PG8_WAIT_V(8); PG8_WAIT_L(0); PG8_BAR; PG8_MMA(0, 0, At, B0); PG8_MMA(0, 1, At, B1); PG8_BAR; PG8_SCHED;
            PG8_LDA(At, 1, 1); PG8_STAGE(PG8_SB(1, 0), b3, voffB); PG8_STAGE(PG8_SB(1, 1), b3 + hstep, voffB); PG8_STAGE(PG8_SA(1, 0), a3, (GATHER ? v2[0] : voffA));
            PG8_WAIT_V(8); PG8_WAIT_L(0); PG8_BAR; PG8_MMA(1, 0, At, B0); PG8_MMA(1, 1, At, B1); PG8_BAR; PG8_SCHED;
            } else {
            PG8_LDB(B0, 0, 0); PG8_SCHED; PG8_LDA(At, 0, 0); PG8_STAGE(PG8_SA(1, 1), a1 + hstep, voffA);
            PG8_WAIT_L(8); PG8_BAR; PG8_WAIT_L(0); PG8_MMA(0, 0, At, B0); PG8_BAR; PG8_SCHED;
            PG8_LDB(B1, 0, 1); PG8_STAGE(PG8_SB(0, 0), b2, voffB);
            PG8_BAR; PG8_WAIT_L(0); PG8_MMA(0, 1, At, B1); PG8_BAR;
            PG8_LDA(At, 0, 1); PG8_STAGE(PG8_SA(0, 0), a2, voffA);
            PG8_BAR; PG8_WAIT_L(0); PG8_MMA(1, 0, At, B0); PG8_BAR; PG8_SCHED;
            PG8_STAGE(PG8_SB(0, 1), b2 + hstep, voffB);
            PG8_WAIT_V(6); PG8_BAR; PG8_MMA(1, 1, At, B1); PG8_BAR;
            PG8_LDB(B0, 1, 0); PG8_SCHED; PG8_LDA(At, 1, 0); PG8_STAGE(PG8_SA(0, 1), a2 + hstep, voffA);
            PG8_WAIT_L(8); PG8_BAR; PG8_WAIT_L(0); PG8_MMA(0, 0, At, B0); PG8_BAR; PG8_SCHED;
            PG8_LDB(B1, 1, 1); PG8_STAGE(PG8_SB(1, 0), b3, voffB);
            PG8_BAR; PG8_WAIT_L(0); PG8_MMA(0, 1, At, B1); PG8_BAR;
            PG8_LDA(At, 1, 1); PG8_STAGE(PG8_SA(1, 0), a3, voffA);
            PG8_BAR; PG8_WAIT_L(0); PG8_MMA(1, 0, At, B0); PG8_BAR; PG8_SCHED;
            PG8_STAGE(PG8_SB(1, 1), b3 + hstep, voffB);
            PG8_WAIT_V(6); PG8_BAR; PG8_MMA(1, 1, At, B1); PG8_BAR;
            }
        }
        if constexpr (ALIGN_EPI) { if (wr == 0) PG8_BAR; }
        if constexpr (!Epi::AFTER_DRAIN) { E(acc, cur, wr, wc, fr, fq); S.done(cur); }
        if (!has_next) break;
#pragma unroll
        for (int a = 0; a < 2; ++a)
#pragma unroll
            for (int b = 0; b < 2; ++b)
#pragma unroll
                for (int m = 0; m < 4; ++m)
#pragma unroll
                    for (int n = 0; n < 2; ++n) acc[a][b][m][n] = (f32x4){0.f, 0.f, 0.f, 0.f};
        cur = nxt; cA = nA; cB = nB; ++ui;
        if constexpr (GATHER) { vc[0][0] = vn[0][0]; vc[0][1] = vn[0][1]; vc[1][0] = vn[1][0]; vc[1][1] = vn[1][1]; }
        if constexpr (ALIGN_EPI) { if (wr == 1) PG8_BAR; }
    }
    PG8_WAIT_V(0);
    if constexpr (!ALIGN_EPI) { if (wr == 0) PG8_BAR; }
    PG8_BAR;
    if constexpr (Epi::AFTER_DRAIN) { E.fused(acc, cur, wr, wc, fr, fq, lds, wid, lane); S.done(cur); }
#undef PG8_SA
#undef PG8_SB
#undef PG8_STAGE
#undef PG8_LDA
#undef PG8_LDB
#undef PG8_MMA
#undef PG8_WAIT_V
#undef PG8_WAIT_L
#undef PG8_BAR
#undef PG8_SCHED
#undef PG8_GROWS
}
}

constexpr int NWAVES = 8;
constexpr int NB = 2, SEQ = 8192, DM = 1024, MR = NB * SEQ;
constexpr int NMETA = 16, INW = 7688, NPROJ = 7680;
constexpr int AH = 8, ADH = 64, AWID = 512, KROWS = SEQ + 128;
constexpr int HH = 8, HK = 128, HV = 128, HROWS = SEQ + 64, NCH = 129;
constexpr int NE = 32, EFF = 512, APAD = 40960;
constexpr float EPS = 1e-6f;
constexpr int N_LAUNCHES = MK_N_LAUNCHES;
constexpr int NPHASE = 12;

constexpr size_t MiB = 1u << 20;
constexpr size_t WS_CTL = 0, CTL_ZERO_BYTES = 1 * MiB;
constexpr size_t WS_WIN = 1 * MiB, WS_WAH = 16 * MiB, WS_WO = 19 * MiB;
constexpr size_t WS_LFA = 21 * MiB, WS_LFAM = WS_LFA + 512 * 1024, WS_CL = 22 * MiB, WS_ASG = 23 * MiB, WS_GATE = WS_ASG + 128 * 1024, WS_SLOT = WS_GATE + 128 * 1024, WS_TR = 24 * MiB, WS_LISTE = 24 * MiB + 256 * 1024;
constexpr size_t WS_U = 26 * MiB;
constexpr size_t WS_QA = 58 * MiB, WS_KA = 74 * MiB, WS_VA = 90 * MiB + 512 * 1024;
constexpr size_t WS_QH = 107 * MiB, WS_EB = 139 * MiB, WS_KT = 171 * MiB, WS_KD = 203 * MiB, WS_VH = 235 * MiB + 512 * 1024;
constexpr size_t WS_GH = 268 * MiB, WS_GA = 300 * MiB, WS_GT = 332 * MiB;
constexpr size_t WS_US = 364 * MiB;
constexpr size_t WS_OAH = 429 * MiB;
constexpr size_t WS_MIX = 171 * MiB;
constexpr size_t WS_XN = 26 * MiB, WS_WE1 = 58 * MiB, WS_WE2 = 122 * MiB, WS_XS = 154 * MiB, WS_ACT = 234 * MiB, WS_Y = 274 * MiB;
constexpr size_t WS_END = 477 * MiB;
static_assert(WS_KA + (size_t)2 * KROWS * AWID * 2 <= WS_VA && WS_VA + (size_t)2 * KROWS * AWID * 2 <= WS_QH && WS_KD + (size_t)2 * HROWS * DM * 2 <= WS_VH && WS_VH + (size_t)2 * HROWS * DM * 2 <= WS_GH, "ws map");
static_assert(WS_US + (size_t)16 * NCH * HK * HV * 2 <= WS_OAH && WS_OAH + (size_t)MR * (AWID + DM) * 2 <= WS_END && WS_Y + (size_t)APAD * DM * 2 <= WS_END && WS_XS + (size_t)APAD * DM * 2 <= WS_ACT && WS_ACT + (size_t)APAD * EFF * 2 <= WS_Y, "ws map 2");
constexpr int CW_TMO = 0, CW_CODE = 1;
constexpr int CW_CNT = 8192;
constexpr int CW_NT = 2048;
constexpr int CW_TILEE = 2112;
constexpr int CW_BAR = 4096;

constexpr int RING_OFF = 0, RING_BYTES = 147456;
constexpr int LDSCTL_OFF = RING_BYTES, MISC_OFF = LDSCTL_OFF + 320;
constexpr int LDS_BYTES = 149504;
constexpr int MW_LCNT = 64, MW_GBASE = 96, MW_ECNT = 128, MW_EPST = 160, MW_NT = 192, MW_TILEE = 200;

#define GAS __attribute__((address_space(1)))
#define LAS __attribute__((address_space(3)))
typedef unsigned short bf16;
typedef unsigned v4u __attribute__((ext_vector_type(4)));
typedef unsigned v2u __attribute__((ext_vector_type(2)));
typedef float f32x4 __attribute__((ext_vector_type(4)));
typedef short bf16x8 __attribute__((ext_vector_type(8)));
typedef GAS unsigned gu32;
typedef GAS unsigned long long gu64;
#define RLX_AGENT __ATOMIC_RELAXED, __HIP_MEMORY_SCOPE_AGENT
#define LDS_WAIT() asm volatile("s_waitcnt lgkmcnt(0)" ::: "memory")
#define VM_WAIT() asm volatile("s_waitcnt vmcnt(0)" ::: "memory")
__device__ __forceinline__ unsigned f2bf(float f) { unsigned u = __builtin_bit_cast(unsigned, f); return (u + 0x7fffu + ((u >> 16) & 1u)) >> 16; }
__device__ __forceinline__ unsigned pk2(float lo, float hi) { return f2bf(lo) | (f2bf(hi) << 16); }
__device__ __forceinline__ float bf2f(unsigned short h) { return __builtin_bit_cast(float, (unsigned)h << 16); }
__device__ __forceinline__ float blo(unsigned w) { return __builtin_bit_cast(float, w << 16); }
__device__ __forceinline__ float bhi(unsigned w) { return __builtin_bit_cast(float, w & 0xffff0000u); }
__device__ __forceinline__ float ex2(float x) { return __builtin_amdgcn_exp2f(x); }
__device__ __forceinline__ float sigm(float x) { return __builtin_amdgcn_rcpf(1.0f + ex2(-1.4426950408889634f * x)); }
__device__ __forceinline__ unsigned ald(const unsigned* p) { return __hip_atomic_load(p, __ATOMIC_RELAXED, __HIP_MEMORY_SCOPE_AGENT); }
__device__ __forceinline__ float aldf(const float* p) { return __builtin_bit_cast(float, __hip_atomic_load((const unsigned*)p, __ATOMIC_RELAXED, __HIP_MEMORY_SCOPE_AGENT)); }
__device__ __forceinline__ float log_sigmoid(float z) { const float a = fabsf(z); return fminf(z, 0.f) - __logf(1.0f + __expf(-a)); }

namespace attn_body {
using bf16=__hip_bfloat16;
using bf16x8=__attribute__((ext_vector_type(8)))short;
using s16x4=__attribute__((ext_vector_type(4)))short;
using f32x16=__attribute__((ext_vector_type(16)))float;
using u32x4=__attribute__((ext_vector_type(4)))unsigned;
using f32x4g=__attribute__((ext_vector_type(4)))float;
constexpr int BATCH=2,NHEAD=8,SEQ=8192,D=64,DM=NHEAD*D;
constexpr int KFRONT=128,KSEQ=SEQ+KFRONT,OP=1536;
constexpr int NW=8,QBLK=32,QB=QBLK*NW,KVBLK=64,NQB=SEQ/QB;
constexpr int ATTN_PITCH=DM, ATTN_UNIT_ROWS=QB;
__device__ __forceinline__ int crow(int r,int hi){return (r&3)+8*(r>>2)+4*hi;}
#define SBAR() __builtin_amdgcn_sched_barrier(0)
__device__ __forceinline__ void cmask(f32x16&p0,f32x16&p1,int jb,int qrel,int hi){
  const float NEG=-INFINITY; int kb=64*jb+4*hi;
  #pragma unroll
  for(int r=0;r<16;++r){int kv=kb+(r&3)+8*(r>>2); if(kv>qrel)p0[r]=NEG; if(kv+32>qrel)p1[r]=NEG;}
}

constexpr int NSLOT=3, SLOTB=8192;
constexpr int LDS_K=0, LDS_V=NSLOT*SLOTB, LDS_WS=2*NSLOT*SLOTB, LDS_OST=LDS_WS+NW*64*4, LDS_CLK=LDS_OST+NW*4096, LDS_BYTES=LDS_CLK+KSEQ*4;
constexpr float C2=0.125f*1.4426950408889634f;
__device__ __forceinline__ void glds16s(unsigned voff,const void*sbase,unsigned lds_dst){unsigned keep;
  asm volatile("s_mov_b32 %0, m0\n\ts_mov_b32 m0, %3\n\ts_nop 0\n\tglobal_load_lds_dwordx4 %1, %2\n\ts_mov_b32 m0, %0":"=&s"(keep):"v"(voff),"s"(sbase),"s"(lds_dst):"memory");}
__device__ __forceinline__ void glds16(const void*gsrc,unsigned lds_dst){unsigned keep;
  asm volatile("s_mov_b32 %0, m0\n\ts_mov_b32 m0, %2\n\ts_nop 0\n\tglobal_load_lds_dwordx4 %1, off\n\ts_mov_b32 m0, %0":"=&s"(keep):"v"(gsrc),"s"(lds_dst):"memory");}
__device__ __forceinline__ float max3f(float a,float b,float c){float r;asm("v_max3_f32 %0, %1, %2, %3":"=v"(r):"v"(a),"v"(b),"v"(c));return r;}
__device__ __forceinline__ float max2f(float a,float b){float r;asm("v_max_f32_e32 %0, %1, %2":"=v"(r):"v"(a),"v"(b));return r;}
__device__ __forceinline__ float fadd_s(float a,float b){float r;asm("v_add_f32_e32 %0, %1, %2":"=v"(r):"v"(a),"v"(b));return r;}
__device__ __forceinline__ float fsub_s(float a,float b){float r;asm("v_sub_f32_e32 %0, %1, %2":"=v"(r):"v"(a),"v"(b));return r;}
typedef float f32x2_t __attribute__((ext_vector_type(2))); typedef __bf16 bf16x2_t __attribute__((ext_vector_type(2)));
__device__ __forceinline__ unsigned cvtpk_s(float lo,float hi){f32x2_t v={lo,hi};bf16x2_t b=__builtin_convertvector(v,bf16x2_t);return __builtin_bit_cast(unsigned,b);}
#define WAIT_BAR(N) asm volatile("s_waitcnt vmcnt(" #N ") lgkmcnt(0)\n\ts_barrier":::"memory")

__device__ __forceinline__ void qkt(f32x16&p0,f32x16&p1,const char*Kslot,const bf16x8*qr,int r32,int hi){
  const char*kb=Kslot+hi*1024+r32*16;
  #pragma unroll
  for(int d0=0;d0<4;++d0){
    const bf16x8 b0=*reinterpret_cast<const bf16x8*>(kb+d0*2048);
    const bf16x8 b1=*reinterpret_cast<const bf16x8*>(kb+d0*2048+512);
    p0=__builtin_amdgcn_mfma_f32_32x32x16_bf16(b0,qr[d0],p0,0,0,0);p1=__builtin_amdgcn_mfma_f32_32x32x16_bf16(b1,qr[d0],p1,0,0,0);}
}
typedef __attribute__((address_space(3))) const char* lds_cptr;
typedef short v4i16_t __attribute__((ext_vector_type(4)));
__device__ __forceinline__ void kload8(bf16x8*kf,lds_cptr kp){
  kf[0]=*(const __attribute__((address_space(3))) bf16x8*)(kp);      kf[1]=*(const __attribute__((address_space(3))) bf16x8*)(kp+512);
  kf[2]=*(const __attribute__((address_space(3))) bf16x8*)(kp+2048); kf[3]=*(const __attribute__((address_space(3))) bf16x8*)(kp+2560);
  kf[4]=*(const __attribute__((address_space(3))) bf16x8*)(kp+4096); kf[5]=*(const __attribute__((address_space(3))) bf16x8*)(kp+4608);
  kf[6]=*(const __attribute__((address_space(3))) bf16x8*)(kp+6144); kf[7]=*(const __attribute__((address_space(3))) bf16x8*)(kp+6656);
}
__device__ __forceinline__ void kload2(bf16x8*kf,lds_cptr kp,int j){ kf[2*j]=*(const __attribute__((address_space(3))) bf16x8*)(kp+j*2048); kf[2*j+1]=*(const __attribute__((address_space(3))) bf16x8*)(kp+j*2048+512); }
__device__ __forceinline__ s16x4 vtr(lds_cptr p){ return __builtin_bit_cast(s16x4,__builtin_amdgcn_ds_read_tr16_b64_v4i16((__attribute__((address_space(3))) v4i16_t*)p)); }
__device__ __forceinline__ float rowmax(const f32x16&p0,const f32x16&p1){
  float a=max3f(p0[0],p0[1],p1[0]),b=max3f(p0[2],p0[3],p1[1]);a=max3f(a,p1[2],p1[3]);
  #pragma unroll
  for(int r=4;r<16;r+=4){a=max3f(a,p0[r],p0[r+1]);b=max3f(b,p0[r+2],p0[r+3]);a=max3f(a,p1[r],p1[r+1]);b=max3f(b,p1[r+2],p1[r+3]);}
  const float m=max2f(a,b);
  auto rr=__builtin_amdgcn_permlane32_swap(__float_as_uint(m),__float_as_uint(m),false,false);
  return max2f(__uint_as_float(rr[0]),__uint_as_float(rr[1]));
}
__device__ __forceinline__ void pv(f32x16*o,int vb,bf16x8 pa0,bf16x8 pa1,bf16x8 pa2,bf16x8 pa3){
  #pragma unroll
  for(int d0=0;d0<2;++d0){s16x4 lo[4],hi[4];
    #pragma unroll
    for(int ks=0;ks<4;++ks){
      asm volatile("ds_read_b64_tr_b16 %0,%1 offset:%c2":"=&v"(lo[ks]):"v"(vb),"i"(d0*4096+ks*1024):"memory");
      asm volatile("ds_read_b64_tr_b16 %0,%1 offset:%c2":"=&v"(hi[ks]):"v"(vb),"i"(d0*4096+ks*1024+512):"memory");}
    asm volatile("s_waitcnt lgkmcnt(0)":::"memory");SBAR();
    #define PK(k) (bf16x8){lo[k][0],lo[k][1],lo[k][2],lo[k][3],hi[k][0],hi[k][1],hi[k][2],hi[k][3]}
    o[d0]=__builtin_amdgcn_mfma_f32_32x32x16_bf16(pa0,PK(0),o[d0],0,0,0);
    o[d0]=__builtin_amdgcn_mfma_f32_32x32x16_bf16(pa1,PK(1),o[d0],0,0,0);
    o[d0]=__builtin_amdgcn_mfma_f32_32x32x16_bf16(pa2,PK(2),o[d0],0,0,0);
    o[d0]=__builtin_amdgcn_mfma_f32_32x32x16_bf16(pa3,PK(3),o[d0],0,0,0);
    #undef PK
  }
}

#ifndef ATTN_STORE16
#define ATTN_STORE16(p,v) (*(u32x4*)(p)=(v))
#endif
template<int THRL> __device__ __forceinline__ void attn_unit(int b,int h,int qb,const bf16*Q,const bf16*__restrict__ K,const bf16*__restrict__ V,bf16*O,const float*CLg,char*shm){
  int tid_l=threadIdx.x; asm volatile("":"+v"(tid_l)); const int tid=tid_l,lane=tid&63,r32=lane&31,hi=lane>>5; const int wid=__builtin_amdgcn_readfirstlane(tid>>6);
  const long rowbase=(long)b*SEQ; const int q0=qb*QB;
  const bf16*Qw=Q+(rowbase+q0+wid*QBLK)*DM+h*D;
  const bf16*Kh=K+(long)b*KSEQ*DM+h*D,*Vh=V+(long)b*KSEQ*DM+h*D;
  const unsigned lds0=(unsigned)(uintptr_t)shm;
  float*wsf=(float*)(shm+LDS_WS)+wid*64;
  const unsigned koff=(unsigned)((lane*DM+wid*8)*2);
  const unsigned voff=(unsigned)(((16*(wid&3)+(lane>>2))*DM+(wid>>2)*32+(lane&3)*8)*2);
  const unsigned kdst=lds0+LDS_K+wid*1024, vdst=lds0+LDS_V+wid*1024;
  #define DMA_K(t,slot) glds16s(koff,Kh+(long)(t)*KVBLK*DM,(unsigned)__builtin_amdgcn_readfirstlane(kdst+(slot)))
  #define DMA_V(t,slot) glds16s(voff,Vh+(long)(t)*KVBLK*DM,(unsigned)__builtin_amdgcn_readfirstlane(vdst+(slot)))
  const int vb0=(int)(lds0+LDS_V)+((lane>>4)&1)*32+(lane&3)*8+(4*hi+((lane&15)>>2))*64;
  const char*Kbase=shm+LDS_K; bf16x8 kf[8];
  const lds_cptr shm3=(lds_cptr)shm; const lds_cptr kp0=shm3+LDS_K+hi*1024+r32*16; const lds_cptr vp0=shm3+LDS_V+((lane>>4)&1)*32+(lane&3)*8+(4*hi+((lane&15)>>2))*64;
  const int NT=(KFRONT+q0+QB)/KVBLK;
  DMA_K(0,0);DMA_V(0,0);DMA_K(1,SLOTB);
  bf16x8 qr[4];
  #pragma unroll
  for(int d0=0;d0<4;++d0)qr[d0]=*reinterpret_cast<const bf16x8*>(&Qw[(long)r32*DM+d0*16+hi*8]);
  { const f32x4g*src=(const f32x4g*)CLg; __attribute__((address_space(3))) f32x4g*dst=(__attribute__((address_space(3))) f32x4g*)(shm3+LDS_CLK);
    for(int i=tid;i<NT*16;i+=NW*64)dst[i]=src[i]; }
  const float clq=CLg[KFRONT+q0+wid*QBLK+r32];
  const __attribute__((address_space(3))) float*clkp=(const __attribute__((address_space(3))) float*)(shm3+LDS_CLK)+4*hi;
  float mhat=0.f,l_reg=0.f;f32x16 o[2];o[0]=f32x16{};o[1]=f32x16{};
  const int qrel=wid*QBLK+r32;
  #define CMASK(P0,P1,t) do{int jb_=(t)-(NT-4); if(jb_>=0)cmask(P0,P1,jb_,qrel,hi);}while(0)
  #define BRD(X0,X1,tt) do{ const __attribute__((address_space(3))) float*c_=clkp+(tt)*KVBLK; \
    _Pragma("unroll") for(int g_=0;g_<4;++g_){ const f32x4g a_=*(const __attribute__((address_space(3))) f32x4g*)(c_+8*g_), b_=*(const __attribute__((address_space(3))) f32x4g*)(c_+32+8*g_); \
      X0[4*g_]=a_.x;X0[4*g_+1]=a_.y;X0[4*g_+2]=a_.z;X0[4*g_+3]=a_.w; X1[4*g_]=b_.x;X1[4*g_+1]=b_.y;X1[4*g_+2]=b_.z;X1[4*g_+3]=b_.w; } }while(0)
  #define BSUB(X,g,nb) do{ X[4*(g)]=(nb)-X[4*(g)]; X[4*(g)+1]=(nb)-X[4*(g)+1]; X[4*(g)+2]=(nb)-X[4*(g)+2]; X[4*(g)+3]=(nb)-X[4*(g)+3]; }while(0)
  #define BFULL(X0,X1,tt,nb) do{ BRD(X0,X1,tt); _Pragma("unroll") for(int g_=0;g_<4;++g_){ BSUB(X0,g_,nb); BSUB(X1,g_,nb); } }while(0)
  bool resc=false;
  #define START(P0,P1) do{ const float rm=rowmax(P0,P1); resc=false; \
    { const float dl=rm; mhat=fadd_s(mhat,dl); \
      _Pragma("unroll") for(int r=0;r<16;++r){P0[r]=fsub_s(P0[r],dl);P1[r]=fsub_s(P1[r],dl);} } \
    _Pragma("unroll") for(int r=0;r<16;++r)P0[r]=__builtin_amdgcn_exp2f(P0[r]); }while(0)
  #define RESC() do{ if(resc){ asm volatile("s_waitcnt lgkmcnt(0)":::"memory"); \
      _Pragma("unroll") for(int d_=0;d_<2;++d_) _Pragma("unroll") for(int r=0;r<16;++r)o[d_][r]*=wsf[crow(r,hi)]; } }while(0)
  f32x16 pA0,pA1,pB0,pB1;
  int sl_prev=0,sl_cur=0,sl_next=SLOTB;
  #define ROT() do{sl_prev=sl_cur;sl_cur=sl_next;sl_next=(sl_next==(NSLOT-1)*SLOTB)?0:sl_next+SLOTB;}while(0)
  DMA_K(2,2*SLOTB);
  WAIT_BAR(3);
  BFULL(pA0,pA1,0,clq);
  qkt(pA0,pA1,Kbase,qr,r32,hi);asm volatile("s_nop 15\n\ts_nop 7":"+v"(pA0),"+v"(pA1));CMASK(pA0,pA1,0);
  START(pA0,pA1);
  { const float nb0_=clq-mhat; BFULL(pB0,pB1,1,nb0_); }
  _Pragma("unroll") for(int r=0;r<16;++r)pA1[r]=__builtin_amdgcn_exp2f(pA1[r]);
  WAIT_BAR(0);
  DMA_K(3,0);DMA_V(1,SLOTB);
  ROT();
  kload8(kf,kp0+sl_cur);
  WAIT_BAR(2);
  s16x4 vlo[8],vhi[8]; u32x4 pw0,pw1,pw2,pw3;
  #define PKW(P,B) cvtpk_s(P[B],P[B+1])
  #define PAF(k) __builtin_bit_cast(bf16x8,pw##k)
  #define VFR(i) (bf16x8){vlo[i][0],vlo[i][1],vlo[i][2],vlo[i][3],vhi[i][0],vhi[i][1],vhi[i][2],vhi[i][3]}
  #define PIN(x) asm volatile("":"+v"(x))
  #define MX3(a,b,c) __builtin_fmaxf(__builtin_fmaxf((a),(b)),(c))
  #define GAPA(MF,A0,A1,A2,A3,W0,W1,PW) do{ MF; sacc+=A0; sacc+=A1; sacc+=A2; sacc+=A3; PIN(sacc); W0; W1; PIN(PW); SBAR(); }while(0)
  #define EX(v) __builtin_amdgcn_exp2f(v)
  #define GAPB(MF,X,B,G,PX,g,OFS) do{ f32x4g c4_; if(G){ c4_=*(const __attribute__((address_space(3))) f32x4g*)(cn_+(OFS)+8*(g)); } MF; X[B]=EX(X[B]); X[B+1]=EX(X[B+1]); X[B+2]=EX(X[B+2]); X[B+3]=EX(X[B+3]); PIN(X); \
    if(G){ PX[4*(g)]=nb_-c4_.x; PX[4*(g)+1]=nb_-c4_.y; PX[4*(g)+2]=nb_-c4_.z; PX[4*(g)+3]=nb_-c4_.w; PIN(PX); } SBAR(); }while(0)
  #define VRD(i) do{ vlo[i]=vtr(vp_+(((i)>>2)*4096+((i)&3)*1024)); vhi[i]=vtr(vp_+(((i)>>2)*4096+((i)&3)*1024+512)); }while(0)
  #define KRD(G,j) do{ if(G){ kload2(kf,kp0+sl_next,j); SBAR(); } }while(0)
  #define STEP(C0,C1,P0,P1,t,GK,GV,GL) do{ SBAR(); \
    const lds_cptr vp_=vp0+sl_prev; \
    VRD(0); SBAR(); float sacc=(P0[0]+P0[1]); \
    GAPA(C0=__builtin_amdgcn_mfma_f32_32x32x16_bf16(kf[0],qr[0],C0,0,0,0), P0[2],P0[3],P0[4],P0[5],     pw0[0]=PKW(P0,0), pw0[1]=PKW(P0,2), pw0); \
    VRD(4); SBAR(); GAPA(C1=__builtin_amdgcn_mfma_f32_32x32x16_bf16(kf[1],qr[0],C1,0,0,0), P0[6],P0[7],P0[8],P0[9],     pw0[2]=PKW(P0,4), pw0[3]=PKW(P0,6), pw0); \
    VRD(1); SBAR(); GAPA(C0=__builtin_amdgcn_mfma_f32_32x32x16_bf16(kf[2],qr[1],C0,0,0,0),   P0[10],P0[11],P0[12],P0[13], pw1[0]=PKW(P0,8), pw1[1]=PKW(P0,10), pw1); \
    VRD(5); SBAR(); GAPA(C1=__builtin_amdgcn_mfma_f32_32x32x16_bf16(kf[3],qr[1],C1,0,0,0),   P0[14],P0[15],P1[0],P1[1],   pw1[2]=PKW(P0,12),pw1[3]=PKW(P0,14), pw1); \
    VRD(2); SBAR(); GAPA(C0=__builtin_amdgcn_mfma_f32_32x32x16_bf16(kf[4],qr[2],C0,0,0,0),   P1[2],P1[3],P1[4],P1[5],     pw2[0]=PKW(P1,0), pw2[1]=PKW(P1,2), pw2); \
    VRD(6); SBAR(); GAPA(C1=__builtin_amdgcn_mfma_f32_32x32x16_bf16(kf[5],qr[2],C1,0,0,0),   P1[6],P1[7],P1[8],P1[9],     pw2[2]=PKW(P1,4), pw2[3]=PKW(P1,6), pw2); \
    VRD(3); SBAR(); GAPA(C0=__builtin_amdgcn_mfma_f32_32x32x16_bf16(kf[6],qr[3],C0,0,0,0),   P1[10],P1[11],P1[12],P1[13], pw3[0]=PKW(P1,8), pw3[1]=PKW(P1,10), pw3); \
    VRD(7); SBAR(); GAPA(C1=__builtin_amdgcn_mfma_f32_32x32x16_bf16(kf[7],qr[3],C1,0,0,0),   P1[14],P1[15],0.f,0.f,       pw3[2]=PKW(P1,12),pw3[3]=PKW(P1,14), pw3); \
    l_reg+=sacc; \
    if(GK){DMA_K((t)+3,sl_cur);} if(GV){DMA_V((t)+1,sl_next);} \
    CMASK(C0,C1,t); \
    { float a=MX3(C0[0],C0[1],C1[0]),b=MX3(C0[2],C0[3],C1[1]); a=MX3(a,C1[2],C1[3]); \
      _Pragma("unroll") for(int r=4;r<16;r+=4){a=MX3(a,C0[r],C0[r+1]);b=MX3(b,C0[r+2],C0[r+3]);a=MX3(a,C1[r],C1[r+1]);b=MX3(b,C1[r+2],C1[r+3]);} \
      float rm=__builtin_fmaxf(a,b); { auto rr=__builtin_amdgcn_permlane32_swap(__float_as_uint(rm),__float_as_uint(rm),false,false); rm=__builtin_fmaxf(__uint_as_float(rr[0]),__uint_as_float(rr[1])); } \
      resc=false; \
      if(__builtin_expect(__any(rm>(float)THRL),0)){ const float dl=__builtin_fmaxf(rm,0.f); mhat+=dl; \
        _Pragma("unroll") for(int r=0;r<16;++r){C0[r]-=dl;C1[r]-=dl;} \
        const float f=__builtin_amdgcn_exp2f(-dl); l_reg*=f; if(hi==0)wsf[r32]=f; resc=true; } } \
    const float nb_=clq-mhat; const __attribute__((address_space(3))) float*cn_=clkp+((t)+1)*KVBLK; \
    SBAR(); \
    GAPB(o[0]=__builtin_amdgcn_mfma_f32_32x32x16_bf16(PAF(0),VFR(0),o[0],0,0,0), C0,0,GL,P0,0,0); \
    GAPB(o[1]=__builtin_amdgcn_mfma_f32_32x32x16_bf16(PAF(0),VFR(4),o[1],0,0,0), C0,4,GL,P0,1,0); \
    KRD(GL,0); GAPB(o[0]=__builtin_amdgcn_mfma_f32_32x32x16_bf16(PAF(1),VFR(1),o[0],0,0,0), C0,8,GL,P0,2,0); \
    KRD(GL,1); GAPB(o[1]=__builtin_amdgcn_mfma_f32_32x32x16_bf16(PAF(1),VFR(5),o[1],0,0,0), C0,12,GL,P0,3,0); \
    KRD(GL,2); GAPB(o[0]=__builtin_amdgcn_mfma_f32_32x32x16_bf16(PAF(2),VFR(2),o[0],0,0,0), C1,0,GL,P1,0,32); \
    KRD(GL,3); GAPB(o[1]=__builtin_amdgcn_mfma_f32_32x32x16_bf16(PAF(2),VFR(6),o[1],0,0,0), C1,4,GL,P1,1,32); \
    GAPB(o[0]=__builtin_amdgcn_mfma_f32_32x32x16_bf16(PAF(3),VFR(3),o[0],0,0,0), C1,8,GL,P1,2,32); \
    GAPB(o[1]=__builtin_amdgcn_mfma_f32_32x32x16_bf16(PAF(3),VFR(7),o[1],0,0,0), C1,12,GL,P1,3,32); \
    }while(0)
  int t=1;
  #undef CMASK
  #define CMASK(P0,P1,t) do{}while(0)
  for(;t+5<NT;t+=2){
    STEP(pB0,pB1,pA0,pA1,t,true,true,true);     WAIT_BAR(2); RESC(); ROT();
    STEP(pA0,pA1,pB0,pB1,t+1,true,true,true);   WAIT_BAR(2); RESC(); ROT();
  }
  #undef CMASK
  #define CMASK(P0,P1,t) do{int jb_=(t)-(NT-4); if(jb_>=0)cmask(P0,P1,jb_,qrel,hi);}while(0)
  #define ENDW(tt) do{ if((tt)+3<NT){WAIT_BAR(2);} else if((tt)+2<NT){WAIT_BAR(1);} else {WAIT_BAR(0);} }while(0)
  for(;t+1<NT;t+=2){
    STEP(pB0,pB1,pA0,pA1,t,(t+3<NT),(t+1<NT),(t+1<NT));       ENDW(t);   RESC(); ROT();
    STEP(pA0,pA1,pB0,pB1,t+1,(t+4<NT),(t+2<NT),(t+2<NT));     ENDW(t+1); RESC(); ROT();
  }
  STEP(pB0,pB1,pA0,pA1,NT-1,false,false,false); RESC();
  { float sacc=pB0[0]+pB0[1]; _Pragma("unroll") for(int r=2;r<16;++r)sacc+=pB0[r]; _Pragma("unroll") for(int r=0;r<16;++r)sacc+=pB1[r]; l_reg+=sacc;
    pw0=(u32x4){PKW(pB0,0),PKW(pB0,2),PKW(pB0,4),PKW(pB0,6)};pw1=(u32x4){PKW(pB0,8),PKW(pB0,10),PKW(pB0,12),PKW(pB0,14)};pw2=(u32x4){PKW(pB1,0),PKW(pB1,2),PKW(pB1,4),PKW(pB1,6)};pw3=(u32x4){PKW(pB1,8),PKW(pB1,10),PKW(pB1,12),PKW(pB1,14)};
    SBAR(); pv(o,vb0+sl_cur,PAF(0),PAF(1),PAF(2),PAF(3)); }
  #undef PKW
  #undef PAF
  #undef VFR
  #undef PIN
  #undef MX3
  #undef GAPA
  #undef GAPB
  #undef EX
  #undef VRD
  #undef KRD
  #undef STEP
  #undef ENDW
  {auto rr=__builtin_amdgcn_permlane32_swap(__float_as_uint(l_reg),__float_as_uint(l_reg),false,false);l_reg=__uint_as_float(rr[0])+__uint_as_float(rr[1]);}
  if(hi==0)wsf[32+r32]=l_reg;asm volatile("s_waitcnt lgkmcnt(0)":::"memory");
  float rli[16];
  #pragma unroll
  for(int r=0;r<16;++r)rli[r]=__builtin_amdgcn_rcpf(wsf[32+crow(r,hi)]);
  bf16*Ow=O+(rowbase+q0+wid*QBLK)*OP+h*D;
  { bf16*stg=(bf16*)(shm+LDS_OST)+wid*2048;
    #pragma unroll
    for(int r=0;r<16;++r){const int orow=crow(r,hi);
      #pragma unroll
      for(int d0=0;d0<2;++d0)stg[orow*64+d0*32+r32]=__float2bfloat16(o[d0][r]*rli[r]);}
    asm volatile("s_waitcnt lgkmcnt(0)":::"memory");
    #pragma unroll
    for(int i=0;i<4;++i){const int row=i*8+(lane>>3),ch=lane&7; const u32x4 v=*(const u32x4*)(stg+row*64+ch*8); ATTN_STORE16(Ow+(long)row*OP+ch*8,v);} }
  asm volatile("s_waitcnt lgkmcnt(0)\n\ts_barrier":::"memory");
  #undef BRD
  #undef BSUB
  #undef BFULL
  #undef DMA_K
  #undef DMA_V
  #undef CMASK
  #undef START
  #undef RESC
  #undef ROT
}
constexpr int ATTN_LDS_BYTES=LDS_BYTES;
#undef SBAR
#undef WAIT_BAR
}
namespace hg {
using attn_body::bf16x8; using attn_body::s16x4; using attn_body::f32x16; using attn_body::u32x4; using attn_body::lds_cptr; using attn_body::vtr; using attn_body::cvtpk_s;
typedef unsigned short us16;
typedef unsigned u32x2h __attribute__((ext_vector_type(2)));
#define HLAS __attribute__((address_space(3)))
constexpr int RS = 272;
constexpr int HC_QE = 0, HC_KT = 64 * RS, HC_V = 2 * 64 * RS, HC_ST = HC_V + 16384, HC_PS = HC_ST + 128 * RS, HC_END = HC_PS + 1024;
__device__ __forceinline__ float blo_(unsigned w) { return __builtin_bit_cast(float, w << 16); }
__device__ __forceinline__ float bhi_(unsigned w) { return __builtin_bit_cast(float, w & 0xffff0000u); }
__device__ __forceinline__ bf16x8 trfrag(lds_cptr blk, int s0, int lane) {
    const int hh = lane >> 5; const lds_cptr p = blk + ((lane >> 4) & 1) * 32 + (lane & 3) * 8 + (s0 + 4 * hh + ((lane & 15) >> 2)) * 64;
    const s16x4 lo = vtr(p), hi = vtr(p + 512);
    return (bf16x8){lo[0], lo[1], lo[2], lo[3], hi[0], hi[1], hi[2], hi[3]};
}
__device__ __forceinline__ void hgrn_a_run(int first, int step, int nitems, const us16* KD, const us16* VH, us16* UST, HLAS unsigned char* lds) {
    int tid_l = threadIdx.x; asm volatile("" : "+v"(tid_l)); const int tid = tid_l, lane = tid & 63, wid = __builtin_amdgcn_readfirstlane(tid >> 6), hh = lane >> 5;
    const lds_cptr KDi = (lds_cptr)lds, Vi = (lds_cptr)lds + 16384;
    const int r = tid >> 3, cc = (tid & 7) * 16;
    u32x4 ra[2], rv[2];
#define HGA_LOAD(item_) do { const int bh_ = (item_) / 129, c_ = (item_) % 129; const size_t g_ = ((size_t)(bh_ >> 3) * 8256 + 64 * c_ + r) * 1024 + (bh_ & 7) * 128 + cc; \
        ra[0] = *(const u32x4*)(KD + g_); ra[1] = *(const u32x4*)(KD + g_ + 8); rv[0] = *(const u32x4*)(VH + g_); rv[1] = *(const u32x4*)(VH + g_ + 8); } while (0)
    if (first < nitems) HGA_LOAD(first);
    for (int item = first; item < nitems; item += step) {
        __syncthreads();
#pragma unroll
        for (int q2 = 0; q2 < 2; ++q2) { const int off = (cc >> 5) * 4096 + r * 64 + ((cc & 31) + 8 * q2) * 2; *(HLAS u32x4*)(lds + off) = ra[q2]; *(HLAS u32x4*)(lds + 16384 + off) = rv[q2]; }
        __syncthreads();
        if (item + step < nitems) HGA_LOAD(item + step);
        const int kt = wid >> 1, vt0 = (wid & 1) * 2;
        f32x16 acc0 = {}, acc1 = {};
#pragma unroll
        for (int ks = 0; ks < 4; ++ks) {
            const bf16x8 a = trfrag(KDi + kt * 4096, 16 * ks, lane), b0 = trfrag(Vi + vt0 * 4096, 16 * ks, lane), b1 = trfrag(Vi + (vt0 + 1) * 4096, 16 * ks, lane);
            acc0 = __builtin_amdgcn_mfma_f32_32x32x16_bf16(a, b0, acc0, 0, 0, 0); acc1 = __builtin_amdgcn_mfma_f32_32x32x16_bf16(a, b1, acc1, 0, 0, 0);
        }
        us16* dst = UST + (size_t)item * 16384 + (size_t)(32 * vt0 + (lane & 31)) * 128 + 32 * kt + 4 * hh;
#pragma unroll
        for (int g = 0; g < 4; ++g) {
            u32x2h w; w.x = cvtpk_s(acc0[4 * g], acc0[4 * g + 1]); w.y = cvtpk_s(acc0[4 * g + 2], acc0[4 * g + 3]); *(u32x2h*)(dst + 8 * g) = w;
            w.x = cvtpk_s(acc1[4 * g], acc1[4 * g + 1]); w.y = cvtpk_s(acc1[4 * g + 2], acc1[4 * g + 3]); *(u32x2h*)(dst + 32 * 128 + 8 * g) = w;
        }
    }
#undef HGA_LOAD
}
__device__ __forceinline__ void hgrn_c_run(int first, int step, int nitems, const us16* QH, const us16* EB, const us16* KT, const us16* VH, const us16* GH, const us16* UST, us16* OH, const float* hnw, float eps, HLAS unsigned char* lds) {
    int tid_l = threadIdx.x; asm volatile("" : "+v"(tid_l)); const int tid = tid_l, lane = tid & 63, wid = __builtin_amdgcn_readfirstlane(tid >> 6), hh = lane >> 5, r32 = lane & 31;
    const lds_cptr L = (lds_cptr)lds;
    const int r = tid >> 3, cc = (tid & 7) * 16;
    u32x4 rq[2], re[2], rk[2], rv[2], rs4[4];
#define HGC_LOAD(item_) do { const int bh_ = (item_) >> 7, c_ = ((item_) & 127) + 1, b_ = bh_ >> 3, h_ = bh_ & 7; \
        const size_t g_ = ((size_t)b_ * 8192 + 64 * (c_ - 1) + r) * 1024 + h_ * 128 + cc, gv_ = ((size_t)b_ * 8256 + 64 * c_ + r) * 1024 + h_ * 128 + cc; \
        rq[0] = *(const u32x4*)(QH + g_); rq[1] = *(const u32x4*)(QH + g_ + 8); re[0] = *(const u32x4*)(EB + g_); re[1] = *(const u32x4*)(EB + g_ + 8); \
        rk[0] = *(const u32x4*)(KT + g_); rk[1] = *(const u32x4*)(KT + g_ + 8); rv[0] = *(const u32x4*)(VH + gv_); rv[1] = *(const u32x4*)(VH + gv_ + 8); \
        const us16* sp_ = UST + ((size_t)bh_ * 129 + (c_ - 1)) * 16384; \
        _Pragma("unroll") for (int i_ = 0; i_ < 4; ++i_) { const int p_ = tid + 512 * i_; rs4[i_] = *(const u32x4*)(sp_ + (p_ >> 4) * 128 + (p_ & 15) * 8); } } while (0)
    if (first < nitems) HGC_LOAD(first);
    for (int item = first; item < nitems; item += step) {
        const int bh = item >> 7, c = (item & 127) + 1, b = bh >> 3, h = bh & 7;
        const size_t r0 = (size_t)b * 8192 + 64 * (c - 1);
        __syncthreads();
#pragma unroll
        for (int q2 = 0; q2 < 2; ++q2) {
            const u32x4 a = rq[q2], e = re[q2];
            u32x4 w; w.x = cvtpk_s(blo_(a.x) * blo_(e.x), bhi_(a.x) * bhi_(e.x)); w.y = cvtpk_s(blo_(a.y) * blo_(e.y), bhi_(a.y) * bhi_(e.y));
            w.z = cvtpk_s(blo_(a.z) * blo_(e.z), bhi_(a.z) * bhi_(e.z)); w.w = cvtpk_s(blo_(a.w) * blo_(e.w), bhi_(a.w) * bhi_(e.w));
            *(HLAS u32x4*)(lds + HC_QE + r * RS + (cc + 8 * q2) * 2) = w;
            *(HLAS u32x4*)(lds + HC_KT + r * RS + (cc + 8 * q2) * 2) = rk[q2];
            *(HLAS u32x4*)(lds + HC_V + (cc >> 5) * 4096 + r * 64 + ((cc & 31) + 8 * q2) * 2) = rv[q2]; }
#pragma unroll
        for (int i = 0; i < 4; ++i) { const int p = tid + 512 * i, row = p >> 4, ch = p & 15; *(HLAS u32x4*)(lds + HC_ST + row * RS + ch * 16) = rs4[i]; }
        __syncthreads();
        if (item + step < nitems) HGC_LOAD(item + step);
        u32x4 gq[2]; { const size_t go = (r0 + r) * 1024 + h * 128 + cc; gq[0] = *(const u32x4*)(GH + go); gq[1] = *(const u32x4*)(GH + go + 8); }
    const int tt = wid >> 2, vt = wid & 3;
    f32x16 o = {};
    const lds_cptr qrow = L + HC_QE + (32 * tt + r32) * RS + 16 * hh;
#pragma unroll
    for (int st = 0; st < 2; ++st) {
        if (st <= tt) {
            f32x16 p = {};
            const lds_cptr krow = L + HC_KT + (32 * st + r32) * RS + 16 * hh;
#pragma unroll
            for (int ks = 0; ks < 8; ++ks) { const bf16x8 a = *(const HLAS bf16x8*)(krow + 32 * ks), q = *(const HLAS bf16x8*)(qrow + 32 * ks); p = __builtin_amdgcn_mfma_f32_32x32x16_bf16(a, q, p, 0, 0, 0); }
            if (st == tt) {
#pragma unroll
                for (int r = 0; r < 16; ++r) { const int s = (r & 3) + 8 * (r >> 2) + 4 * hh; if (s > r32) p[r] = 0.f; }
            }
            u32x4 pw0, pw1;
            pw0.x = cvtpk_s(p[0], p[1]); pw0.y = cvtpk_s(p[2], p[3]); pw0.z = cvtpk_s(p[4], p[5]); pw0.w = cvtpk_s(p[6], p[7]);
            pw1.x = cvtpk_s(p[8], p[9]); pw1.y = cvtpk_s(p[10], p[11]); pw1.z = cvtpk_s(p[12], p[13]); pw1.w = cvtpk_s(p[14], p[15]);
            const bf16x8 v0 = trfrag(L + HC_V + vt * 4096, 32 * st, lane), v1 = trfrag(L + HC_V + vt * 4096, 32 * st + 16, lane);
            o = __builtin_amdgcn_mfma_f32_32x32x16_bf16(__builtin_bit_cast(bf16x8, pw0), v0, o, 0, 0, 0);
            o = __builtin_amdgcn_mfma_f32_32x32x16_bf16(__builtin_bit_cast(bf16x8, pw1), v1, o, 0, 0, 0);
        }
    }
    { const lds_cptr srow = L + HC_ST + (32 * vt + r32) * RS + 16 * hh;
#pragma unroll
      for (int ks = 0; ks < 8; ++ks) { const bf16x8 a = *(const HLAS bf16x8*)(qrow + 32 * ks), s = *(const HLAS bf16x8*)(srow + 32 * ks); o = __builtin_amdgcn_mfma_f32_32x32x16_bf16(a, s, o, 0, 0, 0); } }
    float sq[16];
#pragma unroll
    for (int r = 0; r < 16; ++r) { float s = o[r] * o[r]; s += __shfl_xor(s, 1); s += __shfl_xor(s, 2); s += __shfl_xor(s, 4); s += __shfl_xor(s, 8); s += __shfl_xor(s, 16); sq[r] = s; }
    if (r32 == 0) {
#pragma unroll
        for (int r = 0; r < 16; ++r) *(HLAS float*)(lds + HC_PS + ((32 * tt + (r & 3) + 8 * (r >> 2) + 4 * hh) * 4 + vt) * 4) = sq[r];
    }
    __syncthreads();
#pragma unroll
    for (int r = 0; r < 16; ++r) { const int t = 32 * tt + (r & 3) + 8 * (r >> 2) + 4 * hh; const attn_body::f32x4g ps = *(const HLAS attn_body::f32x4g*)(lds + HC_PS + t * 16);
        const float rs = 1.0f / sqrtf(((ps.x + ps.y) + (ps.z + ps.w)) * (1.0f / 128.0f) + eps);
        *(HLAS us16*)(lds + HC_QE + t * RS + (32 * vt + r32) * 2) = (us16)(cvtpk_s(o[r] * rs, 0.f) & 0xffffu); }
    __syncthreads();
    { const size_t oo = (r0 + r) * 1536 + h * 128 + cc;
#pragma unroll
      for (int q2 = 0; q2 < 2; ++q2) {
          const u32x4 y = *(const HLAS u32x4*)(lds + HC_QE + r * RS + (cc + 8 * q2) * 2), g = gq[q2];
          const attn_body::f32x4g w0 = *(const attn_body::f32x4g*)(hnw + cc + 8 * q2), w1 = *(const attn_body::f32x4g*)(hnw + cc + 8 * q2 + 4);
          u32x4 w; w.x = cvtpk_s(blo_(y.x) * w0.x * blo_(g.x), bhi_(y.x) * w0.y * bhi_(g.x)); w.y = cvtpk_s(blo_(y.y) * w0.z * blo_(g.y), bhi_(y.y) * w0.w * bhi_(g.y));
          w.z = cvtpk_s(blo_(y.z) * w1.x * blo_(g.z), bhi_(y.z) * w1.y * bhi_(g.z)); w.w = cvtpk_s(blo_(y.w) * w1.z * blo_(g.w), bhi_(y.w) * w1.w * bhi_(g.w));
          *(u32x4*)(OH + oo + 8 * q2) = w; } }
    }
#undef HGC_LOAD
}
#undef HLAS
}
#define XB_TMO      128
#define XB_XCNT(j)  (256  + 64 * (j))
#define XB_XSUB(j)  (1280 + 64 * (j))
#define XB_XGEN(j)  (2304 + 64 * (j))
#define XB_TOP      3328
#define XB_TOPGEN   3392
#define XCD_BAR_WORDS 3456
#define XB_SPIN_CAP (1u << 18)

__device__ __forceinline__ unsigned xb_ld(unsigned* p)              { return __hip_atomic_load(p, __ATOMIC_RELAXED, __HIP_MEMORY_SCOPE_AGENT); }
__device__ __forceinline__ unsigned xb_add(unsigned* p, unsigned v) { return __hip_atomic_fetch_add(p, v, __ATOMIC_RELAXED, __HIP_MEMORY_SCOPE_AGENT); }
__device__ __forceinline__ unsigned xb_xcc_id() { return (unsigned)__builtin_amdgcn_s_getreg((3 << 11) | 20) & 0xFu; }
#define XB_SPIN(cond, bar) do { unsigned _sp = 0; while (cond) { __builtin_amdgcn_s_sleep(1); \
    if ((++_sp & 255u) == 0u) { if (xb_ld(&(bar)[XB_TMO])) break; if (_sp > XB_SPIN_CAP) { atomicAdd(&(bar)[XB_TMO], 1u); break; } } } } while (0)

struct XcdBarrier {
    unsigned* bar; unsigned x;
    volatile LAS unsigned* st;
};

__device__ __forceinline__ XcdBarrier xcd_barrier_post(unsigned* bar, volatile LAS unsigned* st) {
    XcdBarrier b; b.bar = bar; b.x = xb_xcc_id(); b.st = st;
    if (threadIdx.x == 0) (void)xb_add(&bar[XB_XCNT(b.x)], 1u);
    return b;
}
__device__ __forceinline__ void xcd_barrier_complete(unsigned* bar, unsigned x, unsigned& nloc, unsigned& nx) {
    const unsigned G = gridDim.x * gridDim.y * gridDim.z;
    unsigned sum, cnt, mine, sp = 0u;
    for (;;) {
        sum = 0u; cnt = 0u; mine = 0u;
#pragma unroll
        for (unsigned j = 0; j < 16; ++j) { const unsigned c = xb_ld(&bar[XB_XCNT(j)]); sum += c; cnt += (c > 0u) ? 1u : 0u; mine = (j == x) ? c : mine; }
        if (sum == G) break;
        __builtin_amdgcn_s_sleep(1);
        if ((++sp & 255u) == 0u) { if (xb_ld(&bar[XB_TMO])) break; if (sp > XB_SPIN_CAP) { atomicAdd(&bar[XB_TMO], 1u); break; } }
    }
    nloc = mine > 0u ? mine : 1u; nx = cnt > 0u ? cnt : 1u;
}

__device__ __forceinline__ void xcd_barrier(const XcdBarrier& b) {
    asm volatile("s_waitcnt vmcnt(0)" ::: "memory");
    __syncthreads();
    if (threadIdx.x == 0) {
        unsigned* bar = b.bar;
        __builtin_amdgcn_s_waitcnt(0);
        unsigned nloc = b.st[0], nx = b.st[1];
        if (nloc == 0u) { xcd_barrier_complete(bar, b.x, nloc, nx); b.st[0] = nloc; b.st[1] = nx; }
        const unsigned old = xb_add(&bar[XB_XSUB(b.x)], 1u);
        const unsigned gen = old / nloc;
        if (old + 1u == (gen + 1u) * nloc) {
            __builtin_amdgcn_fence(__ATOMIC_RELEASE, "agent");
            asm volatile("s_waitcnt vmcnt(0)" ::: "memory");
            const unsigned og = xb_add(&bar[XB_TOP], 1u);
            const unsigned tg = og / nx;
            if (og + 1u == (tg + 1u) * nx) xb_add(&bar[XB_TOPGEN], 1u);
            else XB_SPIN(xb_ld(&bar[XB_TOPGEN]) == tg, bar);
            __builtin_amdgcn_fence(__ATOMIC_ACQUIRE, "agent");
            xb_add(&bar[XB_XGEN(b.x)], 1u);
            asm volatile("s_waitcnt vmcnt(0)" ::: "memory");
        } else {
            XB_SPIN(xb_ld(&bar[XB_XGEN(b.x)]) == gen, bar);
            __builtin_amdgcn_fence(__ATOMIC_ACQUIRE, "agent");
            asm volatile("s_waitcnt vmcnt(0)" ::: "memory");
        }
    }
    __syncthreads();
}
struct Frame {
    LAS unsigned char* lds;
    volatile LAS unsigned* MISC;
    gu32* ctl;
    unsigned char* ws;
    int tid, lane, wave;
    int vcu, G;
    const float* in[18];
    float* out;
};
#ifndef PROBE_MASK
#define PROBE_MASK 0
#endif
#define STAMP(k) do { if (PROBE_MASK != 0 && blockIdx.x == 0 && F.wave == 0) ((volatile LAS unsigned*)(F.lds + MISC_OFF))[16 + (k)] = (unsigned)__builtin_amdgcn_s_memrealtime(); } while (0)
__device__ __forceinline__ float wave_sum(float v) {
#pragma unroll
    for (int o = 1; o < 64; o <<= 1) v += __shfl_xor(v, o);
    return v;
}

__device__ __forceinline__ void p0_transpose_item(const float* W, int ldw, int K, int ncols, bf16* WT, int mode, int row_off, LAS float* scr, int item, int lane, int ldt = 0, int koff = 0) {
    if (ldt == 0) ldt = K;
    const int nblk = ncols / 64, kb = item / nblk, nb = item % nblk, k0 = 64 * kb, n0 = 64 * nb;
    int d0 = row_off + n0;
    if (mode == 1) { d0 = (n0 < 512) ? (256 * (n0 >> 7) + (n0 & 127)) : (256 * ((n0 - 512) >> 7) + 128 + ((n0 - 512) & 127)); }
    const int kr = lane >> 4, nc = 4 * (lane & 15);
    f32x4 v[16];
#pragma unroll
    for (int i = 0; i < 16; ++i) v[i] = *(const f32x4*)(W + (size_t)(k0 + 4 * i + kr) * ldw + n0 + nc);
#pragma unroll
    for (int i = 0; i < 16; ++i) { LAS float* s = scr + (4 * i + kr) * 65 + nc; s[0] = v[i].x; s[1] = v[i].y; s[2] = v[i].z; s[3] = v[i].w; }
    LDS_WAIT(); asm volatile("" ::: "memory");
    const int c = lane & 7;
#pragma unroll
    for (int j = 0; j < 8; ++j) { const int n = (lane >> 3) + 8 * j; const LAS float* s = scr + (8 * c) * 65 + n;
        v4u o; o.x = pk2(s[0 * 65], s[1 * 65]); o.y = pk2(s[2 * 65], s[3 * 65]); o.z = pk2(s[4 * 65], s[5 * 65]); o.w = pk2(s[6 * 65], s[7 * 65]);
        *(GAS v4u*)(WT + (size_t)(d0 + n) * ldt + koff + k0 + 8 * c) = o; }
    LDS_WAIT(); asm volatile("" ::: "memory");
}

__device__ __forceinline__ void p0_meta(Frame& F) {
    const float* meta = F.in[1]; const float* nw = F.in[2]; const float* Win = F.in[3];
    LAS float* um = (LAS float*)(F.lds + RING_OFF);
    LAS float* part = (LAS float*)(F.lds + RING_OFF + 65536);
#pragma unroll
    for (int rr = 0; rr < 2; ++rr) {
        const int r = 2 * F.wave + rr;
        f32x4 v[4]; float ss = 0.f;
#pragma unroll
        for (int j = 0; j < 4; ++j) { v[j] = *(const f32x4*)(meta + (size_t)r * DM + 4 * F.lane + 256 * j); ss += (v[j].x * v[j].x + v[j].y * v[j].y) + (v[j].z * v[j].z + v[j].w * v[j].w); }
        const float rs = 1.0f / sqrtf(wave_sum(ss) * (1.0f / DM) + EPS);
#pragma unroll
        for (int j = 0; j < 4; ++j) { const f32x4 w = *(const f32x4*)(nw + 4 * F.lane + 256 * j); const int k = 4 * F.lane + 256 * j;
            um[(k + 0) * 16 + r] = v[j].x * rs * w.x; um[(k + 1) * 16 + r] = v[j].y * rs * w.y; um[(k + 2) * 16 + r] = v[j].z * rs * w.z; um[(k + 3) * 16 + r] = v[j].w * rs * w.w; }
    }
    __syncthreads();
    const int item = F.vcu;
    int type, strip;
    if (item < 8) { type = 0; strip = item; } else if (item < 16) { type = 1; strip = item - 8; } else if (item < 32) { type = 2; strip = item - 16; } else if (item < 48) { type = 3; strip = item - 32; } else { type = 4; strip = 0; }
    int col;
    if (type == 0) col = 512 + 64 * strip + F.lane; else if (type == 1) col = 1024 + 64 * strip + F.lane; else if (type == 2) col = 2568 + 64 * strip + F.lane;
    else if (type == 3) col = 3592 + 64 * strip + F.lane; else col = 1536 + (F.lane & 7);
    float acc[16];
#pragma unroll
    for (int r = 0; r < 16; ++r) acc[r] = 0.f;
    const int k0 = 128 * F.wave;
#pragma unroll 1
    for (int kb = 0; kb < 128; kb += 8) {
        float w[8];
#pragma unroll
        for (int i = 0; i < 8; ++i) w[i] = Win[(size_t)(k0 + kb + i) * INW + col];
#pragma unroll
        for (int i = 0; i < 8; ++i) {
            const LAS f32x4* up = (const LAS f32x4*)(um + (k0 + kb + i) * 16);
            const f32x4 u0 = up[0], u1 = up[1], u2 = up[2], u3 = up[3];
            acc[0] += w[i] * u0.x; acc[1] += w[i] * u0.y; acc[2] += w[i] * u0.z; acc[3] += w[i] * u0.w;
            acc[4] += w[i] * u1.x; acc[5] += w[i] * u1.y; acc[6] += w[i] * u1.z; acc[7] += w[i] * u1.w;
            acc[8] += w[i] * u2.x; acc[9] += w[i] * u2.y; acc[10] += w[i] * u2.z; acc[11] += w[i] * u2.w;
            acc[12] += w[i] * u3.x; acc[13] += w[i] * u3.y; acc[14] += w[i] * u3.z; acc[15] += w[i] * u3.w;
        }
    }
#pragma unroll
    for (int r = 0; r < 16; ++r) part[(F.wave * 16 + r) * 64 + F.lane] = acc[r];
    __syncthreads();
    if (F.wave == 0) {
#pragma unroll
        for (int r = 0; r < 16; ++r) { float s = 0.f;
#pragma unroll
            for (int w8 = 0; w8 < 8; ++w8) s += part[(w8 * 16 + r) * 64 + F.lane];
            acc[r] = s; }
        const int c = 64 * strip + F.lane;
        if (type == 0 || type == 1) {
            bf16* dst = (bf16*)(F.ws + (type == 0 ? WS_KA : WS_VA));
#pragma unroll
            for (int b = 0; b < 2; ++b) {
#pragma unroll
                for (int r = 0; r < 16; ++r) dst[((size_t)b * KROWS + r) * AWID + c] = (bf16)f2bf(acc[r]);
                for (int r = 16; r < 128; ++r) dst[((size_t)b * KROWS + r) * AWID + c] = (bf16)0;
            }
        } else if (type == 3) {
            bf16* dst = (bf16*)(F.ws + WS_VH);
#pragma unroll
            for (int b = 0; b < 2; ++b) {
                for (int r = 0; r < 48; ++r) dst[((size_t)b * HROWS + r) * DM + c] = (bf16)0;
#pragma unroll
                for (int r = 0; r < 16; ++r) dst[((size_t)b * HROWS + 48 + r) * DM + c] = (bf16)f2bf(acc[r]);
            }
        } else if (type == 2) {
            const float* lbl = F.in[5];
            const float lb = 1.0f / (1.0f + __expf(lbl[1024 + c] - lbl[c]));
            float kk[16], bb[16]; float run = 0.f;
#pragma unroll
            for (int r = 0; r < 16; ++r) { const float f = lb + (1.0f - lb) * (1.0f / (1.0f + __expf(-acc[r]))); kk[r] = 1.0f - f; run += __logf(f); bb[r] = run; }
            bf16* dst = (bf16*)(F.ws + WS_KD);
#pragma unroll
            for (int b = 0; b < 2; ++b) {
                for (int r = 0; r < 48; ++r) dst[((size_t)b * HROWS + r) * DM + c] = (bf16)0;
#pragma unroll
                for (int r = 0; r < 16; ++r) dst[((size_t)b * HROWS + 48 + r) * DM + c] = (bf16)f2bf(kk[r] * __expf(run - bb[r]));
            }
        } else {
            if (F.lane < 8) { float* lfam = (float*)(F.ws + WS_LFAM); const float bias = F.in[4][F.lane];
#pragma unroll
                for (int r = 0; r < 16; ++r) lfam[r * 8 + F.lane] = log_sigmoid(acc[r] + bias); }
        }
    }
    __syncthreads();
}

__device__ __forceinline__ void p0_rows(Frame& F) {
    const float* x = F.in[0]; const float* nw = F.in[2]; const float* Win = F.in[3]; const float* afb = F.in[4];
    LAS float* wfa = (LAS float*)(F.lds + RING_OFF);
    for (int i = F.tid; i < 8 * DM; i += NWAVES * 64) { const int k = i >> 3, h = i & 7; wfa[h * DM + k] = nw[k] * Win[(size_t)k * INW + 1536 + h]; }
    __syncthreads();
    const int gw = F.vcu * NWAVES + F.wave, NGW = F.G * NWAVES;
    f32x4 wv[4];
#pragma unroll
    for (int j = 0; j < 4; ++j) wv[j] = *(const f32x4*)(nw + 4 * F.lane + 256 * j);
    bf16* U = (bf16*)(F.ws + WS_U); float* lfa = (float*)(F.ws + WS_LFA);
    for (int m = gw; m < MR; m += NGW) {
        f32x4 v[4]; float ss = 0.f;
#pragma unroll
        for (int j = 0; j < 4; ++j) { v[j] = *(const f32x4*)(x + (size_t)m * DM + 4 * F.lane + 256 * j); ss += (v[j].x * v[j].x + v[j].y * v[j].y) + (v[j].z * v[j].z + v[j].w * v[j].w); }
        const float rs = 1.0f / sqrtf(wave_sum(ss) * (1.0f / DM) + EPS);
        GAS unsigned long long* o8 = (GAS unsigned long long*)(U + (size_t)m * DM) + F.lane;
#pragma unroll
        for (int j = 0; j < 4; ++j) { const f32x4 u = v[j] * rs * wv[j]; o8[64 * j] = (unsigned long long)pk2(u.x, u.y) | ((unsigned long long)pk2(u.z, u.w) << 32); }
        float z[8];
#pragma unroll
        for (int h = 0; h < 8; ++h) { float s = 0.f;
#pragma unroll
            for (int j = 0; j < 4; ++j) { const f32x4 w = *(const LAS f32x4*)(wfa + h * DM + 4 * F.lane + 256 * j); s += (v[j].x * w.x + v[j].y * w.y) + (v[j].z * w.z + v[j].w * w.w); }
            z[h] = wave_sum(s); }
        float zz = z[0];
#pragma unroll
        for (int h = 1; h < 8; ++h) zz = (F.lane == h) ? z[h] : zz;
        if (F.lane < 8) lfa[(size_t)m * 8 + F.lane] = log_sigmoid(zz * rs + afb[F.lane]);
    }
    __syncthreads();
}

__device__ __forceinline__ void p0_weights(Frame& F) {
    LAS float* scr = (LAS float*)(F.lds + RING_OFF + F.wave * 18432);
    const int gw = F.vcu * NWAVES + F.wave, NGW = F.G * NWAVES;
    constexpr int I1 = 16 * 24, I2 = 16 * 96, IA = 8 * 16, IH = 16 * 16, IO = 16 * 16;
    constexpr int NIT = I1 + I2 + IA + IH + IO;
    bf16* win = (bf16*)(F.ws + WS_WIN);
    for (int it = gw; it < NIT; it += NGW) {
        int r = it;
        if (r < I1) { p0_transpose_item(F.in[3], INW, DM, 1536, win, 0, 0, scr, r, F.lane); continue; } r -= I1;
        if (r < I2) { p0_transpose_item(F.in[3] + 1544, INW, DM, 6144, win, 0, 1536, scr, r, F.lane); continue; } r -= I2;
        if (r < IA) { p0_transpose_item(F.in[7], DM, AWID, DM, (bf16*)(F.ws + WS_WAH), 0, 0, scr, r, F.lane, AWID + DM, 0); continue; } r -= IA;
        if (r < IH) { p0_transpose_item(F.in[8], DM, DM, DM, (bf16*)(F.ws + WS_WAH), 0, 0, scr, r, F.lane, AWID + DM, AWID); continue; } r -= IH;
        p0_transpose_item(F.in[9], DM, DM, DM, (bf16*)(F.ws + WS_WO), 0, 0, scr, r, F.lane);
    }
}
__device__ __forceinline__ void p7_expert_weights(Frame& F) {
    LAS float* scr = (LAS float*)(F.lds + RING_OFF + F.wave * 18432);
    const int gw = F.vcu * NWAVES + F.wave, NGW = F.G * NWAVES;
    constexpr int I1 = 16 * 16, I2 = 8 * 16;
    for (int it = gw; it < NE * (I1 + I2); it += NGW) {
        const int e = it / (I1 + I2); int r = it % (I1 + I2);
        if (r < I1) p0_transpose_item(F.in[15] + (size_t)e * DM * DM, DM, DM, DM, (bf16*)(F.ws + WS_WE1) + (size_t)e * DM * DM, 1, 0, scr, r, F.lane);
        else p0_transpose_item(F.in[16] + (size_t)e * EFF * DM, DM, EFF, DM, (bf16*)(F.ws + WS_WE2) + (size_t)e * DM * EFF, 0, 0, scr, r - I1, F.lane);
    }
}

__device__ __forceinline__ void p1_cumsum(Frame& F, int bh) {
    const int b = bh >> 3, h = bh & 7;
    const float* lfa = (const float*)(F.ws + WS_LFA); const float* lfam = (const float*)(F.ws + WS_LFAM); float* cl = (float*)(F.ws + WS_CL) + (size_t)bh * KROWS;
    LAS float* wtot = (LAS float*)(F.lds + RING_OFF);
    float cm = 0.f;
    for (int r = 0; r < 16; ++r) { cm += lfam[r * 8 + h]; if (F.tid == r) cl[r] = cm * 1.4426950408889634f; }
    if (F.tid >= 16 && F.tid < 128) cl[F.tid] = 1e30f;
    float loc[16]; float run = 0.f;
#pragma unroll
    for (int i = 0; i < 16; ++i) { run += lfa[((size_t)b * SEQ + 16 * F.tid + i) * 8 + h]; loc[i] = run; }
    float inc = run;
#pragma unroll
    for (int o = 1; o < 64; o <<= 1) { const float t = __shfl_up(inc, o); if (F.lane >= o) inc += t; }
    if (F.lane == 63) wtot[F.wave] = inc;
    __syncthreads();
    float pre = cm + (inc - run);
    for (int w = 0; w < F.wave; ++w) pre += wtot[w];
#pragma unroll
    for (int i = 0; i < 16; ++i) cl[128 + 16 * F.tid + i] = (pre + loc[i]) * 1.4426950408889634f;
    __syncthreads();
}


__device__ __forceinline__ void hgrn_scan_t(Frame& F) {
    const bf16* EB = (const bf16*)(F.ws + WS_EB); bf16* US = (bf16*)(F.ws + WS_US);
    for (int idx = blockIdx.x * (NWAVES * 64) + F.tid; idx < 16 * 128 * 64; idx += F.G * NWAVES * 64) {
        const int bh = idx >> 13, rem = idx & 8191, v = rem >> 6, kp = rem & 63, b = bh >> 3, h = bh & 7;
        unsigned* base = (unsigned*)(US + (size_t)bh * NCH * (HK * HV) + v * 128) + kp;
        const unsigned* ap = (const unsigned*)(EB + ((size_t)b * SEQ + 63) * DM + h * 128) + kp;
        unsigned w = base[0]; float s0 = blo(w), s1 = bhi(w);
        for (int c0 = 1; c0 < NCH; c0 += 16) {
            unsigned aw[16], uw[16];
#pragma unroll
            for (int i = 0; i < 16; ++i) { aw[i] = ap[(size_t)(c0 - 1 + i) * 64 * (DM / 2)]; uw[i] = base[(size_t)(c0 + i) * (HK * HV / 2)]; }
#pragma unroll
            for (int i = 0; i < 16; ++i) { s0 = blo(aw[i]) * s0 + blo(uw[i]); s1 = bhi(aw[i]) * s1 + bhi(uw[i]); base[(size_t)(c0 + i) * (HK * HV / 2)] = pk2(s0, s1); }
        }
    }
}


__device__ __forceinline__ float row16_sum(float v) {
    v += __builtin_bit_cast(float, __builtin_amdgcn_update_dpp(0, __builtin_bit_cast(int, v), 0xB1, 0xf, 0xf, true));
    v += __builtin_bit_cast(float, __builtin_amdgcn_update_dpp(0, __builtin_bit_cast(int, v), 0x4E, 0xf, 0xf, true));
    v += __builtin_bit_cast(float, __builtin_amdgcn_update_dpp(0, __builtin_bit_cast(int, v), 0x141, 0xf, 0xf, true));
    v += __builtin_bit_cast(float, __builtin_amdgcn_update_dpp(0, __builtin_bit_cast(int, v), 0x140, 0xf, 0xf, true));
    return v;
}
__device__ __forceinline__ float wave_sum2(float v) { v = row16_sum(v); v += __shfl_xor(v, 16); v += __shfl_xor(v, 32); return v; }
__device__ __forceinline__ void p0_router_table(Frame& F) {
    const float* nfw = F.in[10]; const float* wrg = F.in[11]; const float* wre = F.in[13]; float* TR = (float*)(F.ws + WS_TR);
    for (int i = blockIdx.x * (NWAVES * 64) + F.tid; i < 36 * DM; i += F.G * NWAVES * 64) { const int j = i >> 10, k = i & 1023; TR[i] = nfw[k] * (j < 4 ? wrg[k * 4 + j] : wre[k * 32 + (j - 4)]); }
}
__device__ __forceinline__ void p7_router(Frame& F) {
    const float* h1 = F.out; const float* nfw = F.in[10]; const float* brg = F.in[12]; const float* bre = F.in[14];
    bf16* XN = (bf16*)(F.ws + WS_XN); unsigned* ASG = (unsigned*)(F.ws + WS_ASG); float* GATE = (float*)(F.ws + WS_GATE);
    LAS float* T = (LAS float*)(F.lds + RING_OFF);
    { const f32x4* src = (const f32x4*)(F.ws + WS_TR); for (int i = F.tid; i < 36 * DM / 4; i += NWAVES * 64) ((LAS f32x4*)T)[i] = src[i]; }
    __syncthreads();
    STAMP(14);
    const int gw = F.vcu * NWAVES + F.wave, NGW = F.G * NWAVES;
    volatile LAS unsigned* lcnt = (volatile LAS unsigned*)(F.lds + MISC_OFF) + 64;
    volatile LAS unsigned* gbase = lcnt + 32;
    for (int pass = 0; pass * 2 * NGW < MR / 4; ++pass) {
    if (F.tid < 32) lcnt[F.tid] = 0u;
    __syncthreads();
    unsigned myE = 0u, myL = 0u; float myG = 0.f; int myrow = 0;
#pragma unroll 1
    for (int gi = 0; gi < 2; ++gi) {
        const int g4 = pass * 2 * NGW + 2 * gw + gi;
        if (g4 < MR / 4) {
        const int rowb = g4 * 4;
        f32x4 x[4][4]; float ss[4];
#pragma unroll
        for (int r = 0; r < 4; ++r) { ss[r] = 0.f;
#pragma unroll
            for (int q = 0; q < 4; ++q) { x[r][q] = *(const f32x4*)(h1 + (size_t)(rowb + r) * DM + 256 * q + 4 * F.lane); ss[r] += (x[r][q].x * x[r][q].x + x[r][q].y * x[r][q].y) + (x[r][q].z * x[r][q].z + x[r][q].w * x[r][q].w); } }
        float lgp[4][3];
#pragma unroll
        for (int r = 0; r < 4; ++r) { lgp[r][0] = 0.f; lgp[r][1] = 0.f; lgp[r][2] = 0.f; }
#pragma unroll
        for (int jb = 0; jb < 3; ++jb) {
#pragma unroll 1
            for (int jj = 0; jj < (jb == 2 ? 4 : 16); ++jj) {
                const int j = 16 * jb + jj;
                float a4[4] = {0.f, 0.f, 0.f, 0.f};
#pragma unroll
                for (int q = 0; q < 4; ++q) { const f32x4 w = *(const LAS f32x4*)(T + j * DM + 256 * q + 4 * F.lane);
#pragma unroll
                    for (int r = 0; r < 4; ++r) a4[r] += (x[r][q].x * w.x + x[r][q].y * w.y) + (x[r][q].z * w.z + x[r][q].w * w.w); }
#pragma unroll
                for (int r = 0; r < 4; ++r) { const float s = row16_sum(a4[r]); lgp[r][jb] = ((F.lane & 15) == jj) ? s : lgp[r][jb]; }
            }
        }
#pragma unroll
        for (int r = 0; r < 4; ++r)
#pragma unroll
            for (int jb = 0; jb < 3; ++jb) { float v = lgp[r][jb]; v += __shfl_xor(v, 16); v += __shfl_xor(v, 32); lgp[r][jb] = v; }
        float mybias[3];
        { const int l15 = F.lane & 15; mybias[0] = l15 < 4 ? brg[l15 & 3] : bre[(l15 - 4) & 31]; mybias[1] = bre[12 + l15]; mybias[2] = l15 < 4 ? bre[28 + l15] : 0.f; }
#pragma unroll
        for (int r = 0; r < 4; ++r) {
            const int row = rowb + r;
            const float rs = 1.0f / sqrtf(wave_sum2(ss[r]) * (1.0f / DM) + EPS);
            const float lgv0 = lgp[r][0] * rs + mybias[0], lgv1 = lgp[r][1] * rs + mybias[1], lgv2 = lgp[r][2] * rs + mybias[2];
            float lg[4];
#pragma unroll
            for (int j = 0; j < 4; ++j) lg[j] = __builtin_bit_cast(float, __builtin_amdgcn_readlane(__builtin_bit_cast(int, lgv0), j));
            { GAS unsigned long long* o8 = (GAS unsigned long long*)(XN + (size_t)row * DM) + F.lane;
#pragma unroll
              for (int q = 0; q < 4; ++q) { const f32x4 w = *(const f32x4*)(nfw + 4 * F.lane + 256 * q); const f32x4 u = x[r][q] * rs * w;
                  o8[64 * q] = (unsigned long long)pk2(u.x, u.y) | ((unsigned long long)pk2(u.z, u.w) << 32); } }
            int g = 0; float gm = lg[0];
#pragma unroll
            for (int j = 1; j < 4; ++j) if (lg[j] > gm) { gm = lg[j]; g = j; }
            float gs = 0.f;
#pragma unroll
            for (int j = 0; j < 4; ++j) gs += __expf(lg[j] - gm);
            const float pg = 1.0f / gs;
            float es[8];
#pragma unroll
            for (int i = 0; i < 8; ++i) { const int j = 4 + 8 * g + i, l = j & 15;
                const float e0 = __builtin_bit_cast(float, __builtin_amdgcn_readlane(__builtin_bit_cast(int, lgv0), l)), e1 = __builtin_bit_cast(float, __builtin_amdgcn_readlane(__builtin_bit_cast(int, lgv1), l)),
                            e2 = __builtin_bit_cast(float, __builtin_amdgcn_readlane(__builtin_bit_cast(int, lgv2), l));
                es[i] = j < 16 ? e0 : (j < 32 ? e1 : e2); }
            int i1 = 0; float v1 = es[0];
#pragma unroll
            for (int i = 1; i < 8; ++i) if (es[i] > v1) { v1 = es[i]; i1 = i; }
            int i2 = -1; float v2 = -3.0e38f;
#pragma unroll
            for (int i = 0; i < 8; ++i) if (i != i1 && es[i] > v2) { v2 = es[i]; i2 = i; }
            const float s1 = 1.0f / (1.0f + __expf(v2 - v1));
            if (F.lane == 8 * gi + 2 * r) { myE = (unsigned)(g * 8 + i1); myG = pg * s1; myrow = row; }
            if (F.lane == 8 * gi + 2 * r + 1) { myE = (unsigned)(g * 8 + i2); myG = pg * (1.0f - s1); myrow = row; }
        }
        if ((F.lane >> 3) == gi) myL = __hip_atomic_fetch_add((LAS unsigned*)(F.lds + MISC_OFF) + 64 + myE, 1u, __ATOMIC_RELAXED, __HIP_MEMORY_SCOPE_WORKGROUP);
        }
    }
    __syncthreads();
    if (F.tid < 32) { const unsigned n = lcnt[F.tid]; gbase[F.tid] = n ? __hip_atomic_fetch_add((unsigned*)(F.ctl + CW_CNT + 64 * F.tid), n, RLX_AGENT) : 0u; }
    __syncthreads();
    if (F.lane < 16 && pass * 2 * NGW + 2 * gw + (F.lane >> 3) < MR / 4) { const unsigned pos = gbase[myE] + myL; ASG[2 * myrow + (F.lane & 1)] = (myE << 16) | pos; GATE[2 * myrow + (F.lane & 1)] = myG; ((unsigned*)(F.ws + WS_LISTE))[(size_t)myE * 16384 + pos] = (unsigned)myrow; }
    __syncthreads();
    }
}
__device__ __forceinline__ void moe_tables(Frame& F) {
    volatile LAS unsigned* M = (volatile LAS unsigned*)(F.lds + MISC_OFF);
    if (F.wave == 0) {
        const unsigned cnt = F.lane < NE ? ald((const unsigned*)(F.ctl + CW_CNT + 64 * (F.lane & 31))) : 0u; const unsigned nt = (cnt + 255u) >> 8;
        unsigned inc = nt;
#pragma unroll
        for (int o = 1; o < 64; o <<= 1) { const unsigned t = __shfl_up(inc, o); if (F.lane >= o) inc += t; }
        const unsigned excl = inc - nt;
        if (F.lane < NE) { M[MW_ECNT + F.lane] = cnt; M[MW_EPST + F.lane] = excl * 256u; for (unsigned t = 0; t < nt; ++t) M[MW_TILEE + excl + t] = (unsigned)F.lane; }
        if (F.lane == NE - 1) M[MW_NT] = inc;
    }
    __syncthreads();
}
__device__ __forceinline__ void p11_final(Frame& F) {
    const unsigned* ASG = (const unsigned*)(F.ws + WS_ASG); const LAS unsigned* pst = (const LAS unsigned*)(F.lds + MISC_OFF) + MW_EPST; const float* GATE = (const float*)(F.ws + WS_GATE); const bf16* Y = (const bf16*)(F.ws + WS_Y); const float* fw = F.in[17];
    const int gw = F.vcu * NWAVES + F.wave, NGW = F.G * NWAVES;
    f32x4 wv[4];
#pragma unroll
    for (int j = 0; j < 4; ++j) wv[j] = *(const f32x4*)(fw + 4 * F.lane + 256 * j);
    for (int m0 = gw * 8; m0 < MR; m0 += NGW * 8) {
        const unsigned aw = ald(ASG + 2 * m0 + (F.lane & 15)); const unsigned sl = pst[aw >> 16] + (aw & 0xffffu); const float gt = aldf(GATE + 2 * m0 + (F.lane & 15));
#pragma unroll 1
        for (int rr = 0; rr < 8; rr += 2) {
            f32x4 v[2][4]; float ss[2];
#pragma unroll
            for (int t = 0; t < 2; ++t) {
                const int m = m0 + rr + t;
                const unsigned s0 = __shfl(sl, 2 * (rr + t)), s1 = __shfl(sl, 2 * (rr + t) + 1); const float g0 = __shfl(gt, 2 * (rr + t)), g1 = __shfl(gt, 2 * (rr + t) + 1);
                ss[t] = 0.f;
#pragma unroll
                for (int j = 0; j < 4; ++j) { v[t][j] = *(const f32x4*)(F.out + (size_t)m * DM + 4 * F.lane + 256 * j);
                    const v2u y0 = *(const v2u*)(Y + (size_t)s0 * DM + 4 * F.lane + 256 * j), y1 = *(const v2u*)(Y + (size_t)s1 * DM + 4 * F.lane + 256 * j);
                    v[t][j].x += g0 * blo(y0.x) + g1 * blo(y1.x); v[t][j].y += g0 * bhi(y0.x) + g1 * bhi(y1.x); v[t][j].z += g0 * blo(y0.y) + g1 * blo(y1.y); v[t][j].w += g0 * bhi(y0.y) + g1 * bhi(y1.y);
                    ss[t] += (v[t][j].x * v[t][j].x + v[t][j].y * v[t][j].y) + (v[t][j].z * v[t][j].z + v[t][j].w * v[t][j].w); }
            }
#pragma unroll
            for (int t = 0; t < 2; ++t) { const float rs = 1.0f / sqrtf(wave_sum(ss[t]) * (1.0f / DM) + EPS);
#pragma unroll
                for (int j = 0; j < 4; ++j) *(f32x4*)(F.out + (size_t)(m0 + rr + t) * DM + 4 * F.lane + 256 * j) = v[t][j] * rs * wv[j]; }
        }
    }
}

struct Args { const float* in[18]; float* out; unsigned char* ws; int ph_lo, ph_hi, li, pad; };
__global__ void __launch_bounds__(NWAVES * 64, 2) fwd(Args args) {
    extern __shared__ __attribute__((aligned(16))) unsigned char lds[];
    Frame F;
    F.lds = (LAS unsigned char*)lds;
    F.MISC = (volatile LAS unsigned*)(F.lds + MISC_OFF);
    F.tid = threadIdx.x; F.lane = F.tid & 63; F.wave = __builtin_amdgcn_readfirstlane(F.tid >> 6);
    F.G = gridDim.x; { const int bx = blockIdx.x; F.vcu = (F.G % 8 == 0) ? (bx % 8) * (F.G / 8) + bx / 8 : bx; }
    F.ws = args.ws; F.ctl = (gu32*)(args.ws + WS_CTL); F.out = args.out;
#pragma unroll
    for (int i = 0; i < 18; ++i) F.in[i] = args.in[i];
    for (int u = F.tid; u < (LDS_BYTES - LDSCTL_OFF) / 4; u += NWAVES * 64) ((LAS unsigned*)(F.lds + LDSCTL_OFF))[u] = 0u;
    __syncthreads();
    const int bli = (N_LAUNCHES == NPHASE) ? 0 : args.li;
    XcdBarrier bar; bar.bar = (unsigned*)(F.ctl + CW_BAR) + bli * XCD_BAR_WORDS; bar.x = 0; bar.st = nullptr;
    if (N_LAUNCHES != NPHASE) bar = xcd_barrier_post((unsigned*)(F.ctl + CW_BAR) + bli * XCD_BAR_WORDS, F.MISC + 8);
#define GRID_BAR(seam) do { if (N_LAUNCHES == NPHASE) { if (F.tid == 0) __hip_atomic_store(F.ctl + CW_TMO, 0xBADBA0u | (unsigned)(seam), RLX_AGENT); } else { xcd_barrier(bar); } } while (0)
    const int lo = args.ph_lo, hi = args.ph_hi;
#define IN(k) (lo <= (k) && (k) < hi)
#define PHASE_BEGIN() do { int t_ = threadIdx.x; asm volatile("" : "+v"(t_)); F.tid = t_; F.lane = t_ & 63; } while (0)
#define BOTH(k) (IN(k) && IN((k) + 1))
    unsigned char* ws = args.ws;

    if (IN(0)) { PHASE_BEGIN(); STAMP(0);
        if (F.vcu < 49) p0_meta(F);
        p0_router_table(F);
        p0_rows(F);
        p0_weights(F);
        if (BOTH(0)) GRID_BAR(0);
    }
    if (IN(1)) { PHASE_BEGIN(); STAMP(1);
        pg8::Gemm g{(const bf16*)(ws + WS_U), (const bf16*)(ws + WS_WIN), MR, NPROJ, DM, 0};
        pg8::StaticOrder S; S.init(MR, NPROJ, F.G, (int)blockIdx.x);
        pg8::EpiProj E{(bf16*)(ws + WS_QA), (bf16*)(ws + WS_KA), (bf16*)(ws + WS_VA), (bf16*)(ws + WS_QH), (bf16*)(ws + WS_EB), (bf16*)(ws + WS_KT), (bf16*)(ws + WS_KD), (bf16*)(ws + WS_VH),
                       (bf16*)(ws + WS_GH), (bf16*)(ws + WS_GA), (bf16*)(ws + WS_GT), F.in[5]};
        pg8::gemm_phase<pg8::EpiProj, pg8::StaticOrder, true, true>(F.lds + RING_OFF, g, S, E);
        __syncthreads();
        for (int bh = blockIdx.x; bh < 16; bh += F.G) p1_cumsum(F, bh);
        if (BOTH(1)) GRID_BAR(1);
    }
    if (IN(2)) { PHASE_BEGIN(); STAMP(2);
        static_assert(attn_body::ATTN_LDS_BYTES <= RING_BYTES, "attention LDS");
        for (int pid = F.vcu; pid < 256; pid += F.G) { const int bh = pid >> 4, s = pid & 15;
            for (int i = 0; i < 2; ++i)
                attn_body::attn_unit<8>(bh >> 3, bh & 7, i ? 31 - s : s, (const attn_body::bf16*)(ws + WS_QA), (const attn_body::bf16*)(ws + WS_KA), (const attn_body::bf16*)(ws + WS_VA), (attn_body::bf16*)(ws + WS_OAH),
                                        (const float*)(ws + WS_CL) + (size_t)bh * KROWS, (char*)lds + RING_OFF); }
        __syncthreads();
        hg::hgrn_a_run(F.vcu, F.G, 16 * NCH, (const bf16*)(ws + WS_KD), (const bf16*)(ws + WS_VH), (bf16*)(ws + WS_US), F.lds + RING_OFF);
        if (BOTH(2)) GRID_BAR(2);
    }
    if (IN(3)) { PHASE_BEGIN(); STAMP(3); hgrn_scan_t(F); if (BOTH(3)) GRID_BAR(3); }
    if (IN(4)) { PHASE_BEGIN(); STAMP(4);
        static_assert(hg::HC_END <= RING_BYTES, "hgrn LDS");
        hg::hgrn_c_run(F.vcu, F.G, 16 * 128, (const bf16*)(ws + WS_QH), (const bf16*)(ws + WS_EB), (const bf16*)(ws + WS_KT), (const bf16*)(ws + WS_VH), (const bf16*)(ws + WS_GH), (const bf16*)(ws + WS_US), (bf16*)(ws + WS_OAH) + AWID, F.in[6], EPS, F.lds + RING_OFF);
        if (BOTH(4)) GRID_BAR(4);
    }
    if (IN(5)) { PHASE_BEGIN(); STAMP(5);
        pg8::Gemm g{(const bf16*)(ws + WS_OAH), (const bf16*)(ws + WS_WAH), MR, DM, AWID + DM, 0}; pg8::StaticOrder S; S.init(MR, DM, F.G, (int)blockIdx.x);
        pg8::EpiMixed E{(const bf16*)(ws + WS_GA), (const bf16*)(ws + WS_GT), (bf16*)(ws + WS_MIX), AWID / pg8::BK};
        pg8::gemm_phase<pg8::EpiMixed, pg8::StaticOrder, true, true>(F.lds + RING_OFF, g, S, E);
        if (BOTH(5)) GRID_BAR(5);
    }
    if (IN(6)) { PHASE_BEGIN(); STAMP(6);
        pg8::Gemm g{(const bf16*)(ws + WS_MIX), (const bf16*)(ws + WS_WO), MR, DM, DM, 0}; pg8::StaticOrder S; S.init(MR, DM, F.G, (int)blockIdx.x);
        pg8::EpiRes E{F.in[0], F.out};
        pg8::gemm_phase<pg8::EpiRes, pg8::StaticOrder, true, true>(F.lds + RING_OFF, g, S, E);
        if (BOTH(6)) GRID_BAR(6);
    }
    if (IN(7)) { PHASE_BEGIN(); STAMP(7); p7_router(F); STAMP(12); p7_expert_weights(F); STAMP(13); if (BOTH(7)) GRID_BAR(7); }
    if (IN(8)) { STAMP(8); }
    if (IN(9)) { PHASE_BEGIN(); STAMP(9);
        moe_tables(F);
        const LAS unsigned* M = (const LAS unsigned*)(F.lds + MISC_OFF);
        const int ntile = (int)__builtin_amdgcn_readfirstlane(M[MW_NT]);
        pg8::Gemm g{(const bf16*)(ws + WS_XN), (const bf16*)(ws + WS_WE1), MR, DM, DM, (size_t)DM * DM * 2};
        pg8::MoeOrder S{ntile * 4, F.G, F.vcu, M + MW_TILEE, M + MW_EPST, M + MW_ECNT, (const unsigned*)(ws + WS_LISTE)};
        pg8::EpiSwiglu E{(bf16*)(ws + WS_ACT)};
        pg8::gemm_phase<pg8::EpiSwiglu, pg8::MoeOrder, true, true, true>(F.lds + RING_OFF, g, S, E);
        if (BOTH(9)) GRID_BAR(9);
    }
    if (IN(10)) { PHASE_BEGIN(); STAMP(10);
        const LAS unsigned* M = (const LAS unsigned*)(F.lds + MISC_OFF);
        const int ntile = (int)__builtin_amdgcn_readfirstlane(M[MW_NT]);
        pg8::Gemm g{(const bf16*)(ws + WS_ACT), (const bf16*)(ws + WS_WE2), APAD, DM, EFF, (size_t)DM * EFF * 2};
        pg8::MoeOrder S{ntile * 4, F.G, F.vcu, M + MW_TILEE, M + MW_EPST, M + MW_ECNT, (const unsigned*)(ws + WS_LISTE)};
        pg8::EpiPlain E{(bf16*)(ws + WS_Y), DM};
        pg8::gemm_phase<pg8::EpiPlain, pg8::MoeOrder, true, true>(F.lds + RING_OFF, g, S, E);
        if (BOTH(10)) GRID_BAR(10);
    }
    if (IN(11)) { PHASE_BEGIN(); STAMP(11); p11_final(F); }
    if (PROBE_MASK != 0 && blockIdx.x == 0 && F.wave == 0) {
        const unsigned tend = (unsigned)__builtin_amdgcn_s_memrealtime();
        const int A_ = (PROBE_MASK - 1) & 31, B_ = (PROBE_MASK - 1) >> 5;
        const unsigned tb = (B_ == 31) ? tend : ((volatile LAS unsigned*)(F.lds + MISC_OFF))[16 + B_];
        const unsigned extra = tb - ((volatile LAS unsigned*)(F.lds + MISC_OFF))[16 + A_];
        const unsigned long long t0 = __builtin_amdgcn_s_memrealtime();
        while (__builtin_amdgcn_s_memrealtime() - t0 < (unsigned long long)extra) __builtin_amdgcn_s_sleep(8);
    }
#undef IN
#undef BOTH
}

extern "C" void kernel_launch(void* const* d_in, const int* in_sizes, int n_in, void* d_out, int out_size, void* d_ws, size_t ws_size, hipStream_t stream) {
    static int grid = 0;
    if (grid == 0) {
        if (n_in != 18 || in_sizes[0] != MR * DM || out_size != MR * DM || ws_size < WS_END) {
            fprintf(stderr, "kernel_launch: unexpected problem: n_in %d in0 %d out %d ws %zu (need %zu); nothing launched\n", n_in, n_in > 0 ? in_sizes[0] : -1, out_size, ws_size, (size_t)WS_END); grid = -1; return; }
        int dev = 0, cus = 0, per_cu = 0;
        if (hipGetDevice(&dev) != hipSuccess || hipDeviceGetAttribute(&cus, hipDeviceAttributeMultiprocessorCount, dev) != hipSuccess) { grid = -1; return; }
        if (hipFuncSetAttribute((const void*)fwd, hipFuncAttributeMaxDynamicSharedMemorySize, LDS_BYTES) != hipSuccess) { fprintf(stderr, "kernel_launch: hipFuncSetAttribute failed\n"); grid = -1; return; }
        if (hipOccupancyMaxActiveBlocksPerMultiprocessor(&per_cu, (const void*)fwd, NWAVES * 64, LDS_BYTES) != hipSuccess || per_cu < 1)
            fprintf(stderr, "kernel_launch: note: occupancy query reports %d workgroups per CU\n", per_cu);
        (void)hipGetLastError();
        grid = cus;
    }
    if (grid < 0) return;
    if (hipMemsetAsync((char*)d_ws + WS_CTL, 0, CTL_ZERO_BYTES, stream) != hipSuccess) { fprintf(stderr, "kernel_launch: memset failed\n"); return; }
    Args a{};
    for (int i = 0; i < 18; ++i) a.in[i] = (const float*)d_in[i];
    a.out = (float*)d_out; a.ws = (unsigned char*)d_ws;
    for (int li = 0; li < N_LAUNCHES; ++li) {
        if (N_LAUNCHES == NPHASE) { a.ph_lo = li; a.ph_hi = li + 1; } else { a.ph_lo = 0; a.ph_hi = NPHASE; }
        a.li = li;
        hipLaunchKernelGGL(fwd, dim3(grid), dim3(NWAVES * 64), LDS_BYTES, stream, a);
        const hipError_t le = hipPeekAtLastError();
        if (le != hipSuccess) { fprintf(stderr, "kernel_launch: launch %d failed: %s\n", li, hipGetErrorName(le)); break; }
    }
}
```
